# Optimizing an MI355X kernel written in HIP

```python
import math
import jax, jax.numpy as jnp
from jax import lax
import numpy as np

D_MODEL = 1024
BATCH = 8
SEQ = 2048
DEPTH = 2

N_A_LAYERS = DEPTH // 2
N_B_LAYERS = DEPTH - N_A_LAYERS
CONV_WIDTH = 3
D_FF = 4 * D_MODEL
HEAD_DIM = 64
N_HEADS = D_MODEL // HEAD_DIM
N_KV_GROUPS = 4
HEADS_PER_GROUP = N_HEADS // N_KV_GROUPS
N_BRANCH = 3
CMP_BLOCK = 32
CMP_STRIDE = 16
CMP_HIDDEN = 4 * HEAD_DIM
SEL_BLOCK = 64
N_SEL = 16
WINDOW = 512
Q_BLOCK = 64
EPS = 1e-6
NEG = -1e30
BIG = 1e30

kernel_name = "yoco_shortconv_nsa_hybrid"


def rms_norm(x, gain):
    xf = x.astype(jnp.float32)
    y = xf * lax.rsqrt(jnp.mean(xf * xf, axis=-1, keepdims=True) + EPS)
    return (y * gain.astype(jnp.float32)).astype(x.dtype)


def modulate(h, shift, scale):
    return h * (1 + scale[:, None, :]) + shift[:, None, :]


def masked_softmax(s, mask):
    s = jnp.where(mask, s.astype(jnp.float32), NEG)
    p = jnp.where(mask, jnp.exp(s - jnp.max(s, axis=-1, keepdims=True)), 0.0)
    return p / jnp.maximum(jnp.sum(p, axis=-1, keepdims=True), 1e-30)


def short_conv_mixer(h, w_in, conv_w, w_out):
    gate_b, gate_c, u = jnp.split(h @ w_in, 3, axis=-1)
    v = gate_c * u
    v = lax.conv_general_dilated(
        v, conv_w[:, None, :], window_strides=(1,),
        padding=[(CONV_WIDTH - 1, 0)],
        dimension_numbers=("NWC", "WIO", "NWC"),
        feature_group_count=v.shape[-1])
    return (gate_b * v) @ w_out


def squared_relu_mlp(h, w1, w2):
    return jnp.square(jax.nn.relu(h @ w1)) @ w2


def n_compressed(seq):
    return (seq - CMP_BLOCK) // CMP_STRIDE + 1


def cmp_to_sel_matrix(seq):
    n_cmp, n_sel = n_compressed(seq), seq // SEL_BLOCK
    c0 = np.arange(n_cmp)[:, None] * CMP_STRIDE
    s0 = np.arange(n_sel)[None, :] * SEL_BLOCK
    ov = np.minimum(c0 + CMP_BLOCK, s0 + SEL_BLOCK) - np.maximum(c0, s0)
    return (np.clip(ov, 0, None) / CMP_BLOCK).astype(np.float32)


def shared_kv(h, w_kv, k_gain, cmp_pe, cmp_w1, cmp_w2):
    B, S, _ = h.shape
    kv = (h @ w_kv).reshape(B, S, 2 * N_BRANCH, N_KV_GROUPS, HEAD_DIM)
    kv = kv.transpose(2, 0, 3, 1, 4)
    kc_raw, vc_raw, ks, vs, kw, vw = kv[0], kv[1], kv[2], kv[3], kv[4], kv[5]
    n_cmp = n_compressed(S)
    idx = np.arange(n_cmp)[:, None] * CMP_STRIDE + np.arange(CMP_BLOCK)[None, :]

    def compress(t, pe, w1, w2):
        blk = t[:, :, idx, :] + pe
        blk = blk.reshape(B, N_KV_GROUPS, n_cmp, CMP_BLOCK * HEAD_DIM)
        return jax.nn.gelu(blk @ w1) @ w2

    kc = rms_norm(compress(kc_raw, cmp_pe[0], cmp_w1[0], cmp_w2[0]), k_gain[0])
    vc = compress(vc_raw, cmp_pe[1], cmp_w1[1], cmp_w2[1])
    ks = rms_norm(ks, k_gain[1])
    kw = rms_norm(kw, k_gain[2])
    pad = ((0, 0), (0, 0), (WINDOW, 0), (0, 0))
    return kc, vc, ks, vs, jnp.pad(kw, pad), jnp.pad(vw, pad)


def nsa_attention(h, w_qg, q_gain, w_o, kc, vc, ks, vs, kw, vw):
    B, S, _ = h.shape
    G, Hg = N_KV_GROUPS, HEADS_PER_GROUP
    qg = h @ w_qg
    q = qg[..., :N_HEADS * HEAD_DIM].reshape(B, S, N_HEADS, HEAD_DIM)
    q = rms_norm(q, q_gain) * (HEAD_DIM ** -0.5)
    q = q.reshape(B, S, G, Hg, HEAD_DIM).transpose(0, 2, 3, 1, 4)
    gates = jax.nn.sigmoid(qg[..., N_HEADS * HEAD_DIM:].astype(jnp.float32))
    gates = gates.reshape(B, S, G, Hg, N_BRANCH).transpose(0, 2, 3, 1, 4)

    n_cmp = kc.shape[2]
    n_sel = S // SEL_BLOCK
    n_top = min(N_SEL, n_sel)
    cmp_map = jnp.asarray(cmp_to_sel_matrix(S))
    cmp_end = jnp.arange(n_cmp) * CMP_STRIDE + CMP_BLOCK - 1
    sel_ids = jnp.arange(n_sel)
    b_ix = jnp.arange(B)[:, None, None, None]
    g_ix = jnp.arange(G)[None, :, None, None]

    def query_block(s0):
        qb = lax.dynamic_slice_in_dim(q, s0, Q_BLOCK, axis=3)
        gb = lax.dynamic_slice_in_dim(gates, s0, Q_BLOCK, axis=3)
        t = s0 + jnp.arange(Q_BLOCK)
        sc = jnp.einsum("bgkqd,bgnd->bgkqn", qb, kc)
        p_cmp = masked_softmax(sc, cmp_end[None, :] <= t[:, None])
        o_cmp = jnp.einsum("bgkqn,bgnd->bgkqd", p_cmp.astype(vc.dtype), vc)
        imp = jnp.einsum("bgkqn,nj->bgqj", p_cmp, cmp_map)
        cur = t[:, None] // SEL_BLOCK
        forced = (sel_ids[None] == 0) | (sel_ids[None] == cur) | (sel_ids[None] == cur - 1)
        causal = sel_ids[None] * SEL_BLOCK <= t[:, None]
        score = jnp.where(forced, BIG, jnp.where(causal, imp, NEG))
        _, top = lax.top_k(score, n_top)
        tok = (top[..., None] * SEL_BLOCK + jnp.arange(SEL_BLOCK)).reshape(
            B, G, Q_BLOCK, n_top * SEL_BLOCK)
        k_sel = ks[b_ix, g_ix, tok]
        v_sel = vs[b_ix, g_ix, tok]
        ss = jnp.einsum("bgkqd,bgqmd->bgkqm", qb, k_sel)
        p_sel = masked_softmax(ss, (tok <= t[:, None])[:, :, None])
        o_sel = jnp.einsum("bgkqm,bgqmd->bgkqd", p_sel.astype(v_sel.dtype), v_sel)
        k_win = lax.dynamic_slice_in_dim(kw, s0, WINDOW + Q_BLOCK, axis=2)
        v_win = lax.dynamic_slice_in_dim(vw, s0, WINDOW + Q_BLOCK, axis=2)
        kpos = s0 - WINDOW + jnp.arange(WINDOW + Q_BLOCK)
        wmask = ((kpos[None] <= t[:, None]) & (kpos[None] > t[:, None] - WINDOW)
                 & (kpos[None] >= 0))
        sw = jnp.einsum("bgkqd,bgnd->bgkqn", qb, k_win)
        p_win = masked_softmax(sw, wmask)
        o_win = jnp.einsum("bgkqn,bgnd->bgkqd", p_win.astype(v_win.dtype), v_win)
        o = gb[..., 0:1] * o_cmp + gb[..., 1:2] * o_sel + gb[..., 2:3] * o_win
        return o.astype(qb.dtype)

    starts = jnp.arange(S // Q_BLOCK) * Q_BLOCK
    out = lax.map(query_block, starts)
    out = out.transpose(1, 0, 4, 2, 3, 5).reshape(B, S, N_HEADS * HEAD_DIM)
    return out @ w_o


def setup_inputs(seed: int = 0) -> dict:
    key = jax.random.key(seed)
    ks = jax.random.split(key, 24)
    D, G = D_MODEL, N_KV_GROUPS
    nrm = jax.random.normal
    f32 = jnp.float32
    return {
        "x": nrm(ks[0], (BATCH, SEQ, D), f32),
        "c": nrm(ks[1], (BATCH, D), f32),
        "norm_gain": 1.0 + 0.1 * nrm(ks[2], (DEPTH, 2, D), f32),
        "w_ada": 0.5 * D ** -0.5 * nrm(ks[3], (DEPTH, D, 6 * D), f32),
        "b_ada": 0.01 * nrm(ks[4], (DEPTH, 6 * D), f32),
        "w_a_in": D ** -0.5 * nrm(ks[5], (N_A_LAYERS, D, 3 * D), f32),
        "conv_w": CONV_WIDTH ** -0.5 * nrm(ks[6], (N_A_LAYERS, CONV_WIDTH, D), f32),
        "w_a_out": D ** -0.5 * nrm(ks[7], (N_A_LAYERS, D, D), f32),
        "w_qg": D ** -0.5 * nrm(ks[8], (N_B_LAYERS, D, N_HEADS * HEAD_DIM + N_BRANCH * N_HEADS), f32),
        "q_gain": 1.0 + 0.1 * nrm(ks[9], (N_B_LAYERS, HEAD_DIM), f32),
        "w_o": (N_HEADS * HEAD_DIM) ** -0.5 * nrm(ks[10], (N_B_LAYERS, N_HEADS * HEAD_DIM, D), f32),
        "kv_norm_gain": 1.0 + 0.1 * nrm(ks[11], (D,), f32),
        "w_ada_kv": 0.5 * D ** -0.5 * nrm(ks[12], (D, 2 * D), f32),
        "b_ada_kv": 0.01 * nrm(ks[13], (2 * D,), f32),
        "w_kv": D ** -0.5 * nrm(ks[14], (D, 2 * N_BRANCH * G * HEAD_DIM), f32),
        "k_gain": 1.0 + 0.1 * nrm(ks[15], (N_BRANCH, HEAD_DIM), f32),
        "cmp_pe": 0.2 * nrm(ks[16], (2, CMP_BLOCK, HEAD_DIM), f32),
        "cmp_w1": (CMP_BLOCK * HEAD_DIM) ** -0.5 * nrm(ks[17], (2, CMP_BLOCK * HEAD_DIM, CMP_HIDDEN), f32),
        "cmp_w2": CMP_HIDDEN ** -0.5 * nrm(ks[18], (2, CMP_HIDDEN, HEAD_DIM), f32),
        "w_mlp1": D ** -0.5 * nrm(ks[19], (DEPTH, D, D_FF), f32),
        "w_mlp2": D_FF ** -0.5 * nrm(ks[20], (DEPTH, D_FF, D), f32),
    }


def reference(x, c, norm_gain, w_ada, b_ada, w_a_in, conv_w, w_a_out, w_qg, q_gain, w_o,
              kv_norm_gain, w_ada_kv, b_ada_kv, w_kv, k_gain, cmp_pe, cmp_w1, cmp_w2,
              w_mlp1, w_mlp2):
    c_act = jax.nn.silu(c)
    kvs = None
    for i in range(DEPTH):
        mod = c_act @ w_ada[i] + b_ada[i]
        sh1, sc1, g1, sh2, sc2, g2 = jnp.split(mod, 6, axis=-1)
        if i == N_A_LAYERS:
            sh_kv, sc_kv = jnp.split(c_act @ w_ada_kv + b_ada_kv, 2, axis=-1)
            h_kv = modulate(rms_norm(x, kv_norm_gain), sh_kv, sc_kv)
            kvs = shared_kv(h_kv, w_kv, k_gain, cmp_pe, cmp_w1, cmp_w2)
        h = modulate(rms_norm(x, norm_gain[i, 0]), sh1, sc1)
        if i < N_A_LAYERS:
            mix = short_conv_mixer(h, w_a_in[i], conv_w[i], w_a_out[i])
        else:
            j = i - N_A_LAYERS
            mix = nsa_attention(h, w_qg[j], q_gain[j], w_o[j], *kvs)
        x = x + g1[:, None, :] * mix
        h = modulate(rms_norm(x, norm_gain[i, 1]), sh2, sc2)
        x = x + g2[:, None, :] * squared_relu_mlp(h, w_mlp1[i], w_mlp2[i])
    return x
```

```cpp
#include <hip/hip_runtime.h>
#include <cstdio>
#include <cstdint>
#include <cmath>

#ifndef MK_N_LAUNCHES
#define MK_N_LAUNCHES 1
#endif
constexpr int N_PHASES = 13;

#define LAS __attribute__((address_space(3)))
typedef unsigned short bf16_t;
typedef short bf16x8 __attribute__((ext_vector_type(8)));
typedef short s16x4 __attribute__((ext_vector_type(4)));
typedef float f32x2 __attribute__((ext_vector_type(2)));
typedef float f32x4 __attribute__((ext_vector_type(4)));
typedef float f32x16 __attribute__((ext_vector_type(16)));
typedef unsigned u32x4 __attribute__((ext_vector_type(4)));
typedef unsigned u32x2 __attribute__((ext_vector_type(2)));
typedef __bf16 bf16x2_t __attribute__((ext_vector_type(2)));

constexpr int BATCH = 8, SEQ = 2048, DM = 1024, FF = 4096, M_TOK = BATCH * SEQ;
constexpr int NKVQ = 2816;
constexpr float EPS = 1e-6f;
constexpr float QSCALE = 0.125f * 1.4426950408889634f;

constexpr size_t MiB = 1u << 20;
constexpr size_t WS_ZERO = 0, ZERO_BYTES = 1 * MiB;
constexpr size_t WS_MOD0 = 0, WS_MOD1 = 196608, WS_MODKV = 393216;
constexpr size_t WS_SS1 = 524288, WS_SS2 = 589824, WS_SS3 = 655360;
constexpr size_t WS_BAR = 786432;
constexpr size_t WS_BM1L0 = 1 * MiB, WS_BM1L1 = WS_BM1L0 + 131072, WS_BKVQ = WS_BM1L1 + 131072, WS_PEB = WS_BKVQ + 131072, WS_WC2 = WS_PEB + 4096;
constexpr size_t WS_WAIN = 2 * MiB, WS_WAOUT = 8 * MiB, WS_WM1 = 10 * MiB  , WS_WM2 = 26 * MiB  , WS_WKVQ = 42 * MiB, WS_WO = 48 * MiB, WS_WC1 = 50 * MiB;
constexpr size_t WS_R = 56 * MiB;
constexpr size_t SLAB = 16 * MiB;
constexpr size_t SO_GB = 0, SO_V = 4 * MiB, SO_Y = 8 * MiB;
constexpr size_t WS_H = WS_R;
constexpr size_t SO_Q = 0, SO_KV = 4 * MiB  , SO_O = 10 * MiB, SO_GATES = 14 * MiB  , SO_KC = 14 * MiB + 512 * 1024  , SO_VC = SO_KC + 65536;
constexpr size_t WS_A1 = 184 * MiB, WS_A2 = 216 * MiB, WS_END = 248 * MiB;

constexpr int LDS_BYTES = 147456;
constexpr int NWAVES = 8;

__device__ __forceinline__ unsigned cvtpk(float lo, float hi) { f32x2 v = {lo, hi}; bf16x2_t b = __builtin_convertvector(v, bf16x2_t); return __builtin_bit_cast(unsigned, b); }
__device__ __forceinline__ float bf_lo(unsigned u) { return __builtin_bit_cast(float, u << 16); }
__device__ __forceinline__ float bf_hi(unsigned u) { return __builtin_bit_cast(float, u & 0xffff0000u); }
__device__ __forceinline__ float wave_sum(float v) {
#pragma unroll
    for (int o = 1; o < 64; o <<= 1) v += __shfl_xor(v, o);
    return v;
}
#define LDS_WAIT() asm volatile("s_waitcnt lgkmcnt(0)" ::: "memory")
#define LAUNDER(x) asm volatile("" : "+v"(x))

namespace pg8 {
constexpr int BM = 256, BK = 64, HALF = 128, HTB = HALF * BK * 2, STAGE_BYTES = 8 * HTB, NXCD = 8, WGM = 8;
__host__ __device__ __forceinline__ int lds_byte(int r, int c) { const int st = (r >> 4) * 2 + (c >> 5), rr = r & 15, cc = c & 31, ob = rr * 64 + cc * 2; return st * 1024 + (ob ^ (((ob >> 9) & 1) << 5)); }
__host__ __device__ __forceinline__ void stage_rc(int b, int& R, int& C) { const int st = b / 1024, sb = b % 1024, swz = sb ^ (((sb >> 9) & 1) << 5); R = (st >> 1) * 16 + swz / 64; C = (st & 1) * 32 + (swz % 64) / 2; }
__host__ __device__ __forceinline__ int perm32(int rho) { const int n = rho >> 4, i = rho & 15; return 8 * (i >> 2) + 4 * n + (i & 3); }

struct Unit { int pm, pn; };
struct Gemm { const bf16_t* A; const bf16_t* A2; int pn_split; const bf16_t* Bt; int M, N, K; size_t abatch; };

struct StaticOrder {
    int nM, nN, nwg, G, c, ain;
    __device__ void init(int M, int N, int G_, int c_) { nM = M / BM; nN = N / BM; nwg = nM * nN; G = G_; c = c_; ain = 0; }
    __device__ void init_ain(int G_, int c_) { init(M_TOK, 3072, G_, c_); ain = 1; }
    __device__ bool next(int i, Unit& u) const {
        if (ain) { if (i >= 3) return false; const int x = c & 7, rk = c >> 3, p = rk >> 3; u.pm = 8 * x + (rk & 7); u.pn = (i == 2) ? p : 4 + 2 * p + i; return true; }
        const long L = (long)i * G + c; if (L >= nwg) return false;
        int wgid = (int)L; { const int q = nwg / NXCD, r = nwg % NXCD, xcd = wgid % NXCD, off = wgid / NXCD; wgid = (xcd < r ? xcd * (q + 1) : r * (q + 1) + (xcd - r) * q) + off; }
        const int nig = WGM * nN, gid = wgid / nig, fm = gid * WGM, gsz = (nM - fm) < WGM ? (nM - fm) : WGM;
        u.pm = fm + ((wgid % nig) % gsz); u.pn = (wgid % nig) / gsz; return true;
    }
};

template <class Epi>
__device__ __forceinline__ void gemm_phase(LAS unsigned char* lds, const Gemm g, const StaticOrder& S, const Epi& E) {
    const int tid = threadIdx.x, wid = __builtin_amdgcn_readfirstlane(tid >> 6), lane = tid & 63, wr = wid >> 2, wc = wid & 3, fr = lane & 15, fq = lane >> 4;
    const int K = g.K, nt = K / BK;
    unsigned voffA[2], voffB[2];
#pragma unroll
    for (int i = 0; i < 2; ++i) { int R, C; stage_rc(tid * 16 + i * 8192, R, C); const int Rb = Epi::PERM ? ((R & ~31) + perm32(R & 31)) : R;
        voffA[i] = (unsigned)(R * K + C) * 2u; voffB[i] = (unsigned)(Rb * K + C) * 2u; }
    const size_t kstep = (size_t)(BK * 2);
    const size_t hstep = (size_t)HALF * K * 2;
    const size_t tstep = 2 * hstep;
    const unsigned ldsw = (unsigned)wid * 1024u;
    const int aoff = lds_byte(wr * 64 + fr, fq * 8), boff = lds_byte(wc * 32 + fr, fq * 8);
#define PG8_SA(b, h) (((b) * 2 + (h)) * HTB)
#define PG8_SB(b, h) ((4 + (b) * 2 + (h)) * HTB)
#define PG8_STAGE(bufoff, gbase, voff) do { _Pragma("unroll") for (int _i = 0; _i < 2; ++_i) \
        __builtin_amdgcn_global_load_lds((const unsigned*)((const char*)(gbase) + (voff)[_i]), (LAS unsigned*)(lds + (bufoff) + ldsw + _i * 8192), 16, 0, 0); } while (0)
#define PG8_LDA(dst, b, h) do { _Pragma("unroll") for (int m = 0; m < 4; ++m) _Pragma("unroll") for (int k = 0; k < 2; ++k) dst[m][k] = *(const LAS bf16x8*)(lds + PG8_SA(b, h) + aoff + m * 2048 + k * 1024); } while (0)
#define PG8_LDB(dst, b, h) do { _Pragma("unroll") for (int n = 0; n < 2; ++n) _Pragma("unroll") for (int k = 0; k < 2; ++k) dst[n][k] = *(const LAS bf16x8*)(lds + PG8_SB(b, h) + boff + n * 2048 + k * 1024); } while (0)
#define PG8_MMA(ai, bj, At, Bt) do { __builtin_amdgcn_s_setprio(1); _Pragma("unroll") for (int m = 0; m < 4; ++m) _Pragma("unroll") for (int n = 0; n < 2; ++n) _Pragma("unroll") for (int k = 0; k < 2; ++k) \
        acc[ai][bj][m][n] = __builtin_amdgcn_mfma_f32_16x16x32_bf16(Bt[n][k], At[m][k], acc[ai][bj][m][n], 0, 0, 0); __builtin_amdgcn_s_setprio(0); } while (0)
#define PG8_WAIT_V(n) asm volatile("s_waitcnt vmcnt(" #n ")" ::: "memory")
#define PG8_WAIT_L(n) asm volatile("s_waitcnt lgkmcnt(" #n ")" ::: "memory")
#define PG8_BAR __builtin_amdgcn_s_barrier()
#define PG8_SCHED __builtin_amdgcn_sched_barrier(0)
#define PG8_ABASE(u) ((const char*)((u).pn < g.pn_split ? g.A : g.A2) + (size_t)((u).pm >> 3) * g.abatch + (size_t)((u).pm & 7) * tstep)
    Unit cur, nxt; int ui = 0;
    if (!S.next(0, cur)) return;
    f32x4 acc[2][2][4][2];
#pragma unroll
    for (int a = 0; a < 2; ++a)
#pragma unroll
        for (int b = 0; b < 2; ++b)
#pragma unroll
            for (int m = 0; m < 4; ++m)
#pragma unroll
                for (int n = 0; n < 2; ++n) acc[a][b][m][n] = (f32x4){0.f, 0.f, 0.f, 0.f};
    bf16x8 At[4][2], B0[2][2], B1[2][2];
    const char* cA = PG8_ABASE(cur); const char* cB = (const char*)g.Bt + (size_t)cur.pn * tstep;
    PG8_STAGE(PG8_SB(0, 0), cB, voffB); PG8_STAGE(PG8_SB(0, 1), cB + hstep, voffB); PG8_STAGE(PG8_SA(0, 0), cA, voffA); PG8_STAGE(PG8_SA(0, 1), cA + hstep, voffA);
    if (wr == 1) PG8_BAR;
    PG8_WAIT_V(2); PG8_BAR;
    PG8_STAGE(PG8_SB(1, 0), cB + kstep, voffB); PG8_STAGE(PG8_SA(1, 0), cA + kstep, voffA); PG8_STAGE(PG8_SB(1, 1), cB + hstep + kstep, voffB);
    PG8_WAIT_V(6); PG8_BAR;
    for (;;) {
        const bool has_next = S.next(ui + 1, nxt);
        const char* nA = has_next ? PG8_ABASE(nxt) : cA; const char* nB = has_next ? (const char*)g.Bt + (size_t)nxt.pn * tstep : cB;
        for (int t = 0; t < nt; t += 2) {
            const bool last = (t == nt - 2);
            const char* a1 = cA + (size_t)(t + 1) * kstep;
            const char* a2 = last ? nA : cA + (size_t)(t + 2) * kstep; const char* b2 = last ? nB : cB + (size_t)(t + 2) * kstep;
            const char* a3 = a2 + kstep; const char* b3 = b2 + kstep;
            PG8_LDB(B0, 0, 0); PG8_LDB(B1, 0, 1); PG8_SCHED; PG8_LDA(At, 0, 0); PG8_STAGE(PG8_SA(1, 1), a1 + hstep, voffA);
            PG8_WAIT_V(8); PG8_WAIT_L(0); PG8_BAR; PG8_MMA(0, 0, At, B0); PG8_MMA(0, 1, At, B1); PG8_BAR; PG8_SCHED;
            PG8_LDA(At, 0, 1); PG8_STAGE(PG8_SB(0, 0), b2, voffB); PG8_STAGE(PG8_SB(0, 1), b2 + hstep, voffB); PG8_STAGE(PG8_SA(0, 0), a2, voffA);
            PG8_WAIT_V(8); PG8_WAIT_L(0); PG8_BAR; PG8_MMA(1, 0, At, B0); PG8_MMA(1, 1, At, B1); PG8_BAR; PG8_SCHED;
            PG8_LDB(B0, 1, 0); PG8_LDB(B1, 1, 1); PG8_SCHED; PG8_LDA(At, 1, 0); PG8_STAGE(PG8_SA(0, 1), a2 + hstep, voffA);
            PG8_WAIT_V(8); PG8_WAIT_L(0); PG8_BAR; PG8_MMA(0, 0, At, B0); PG8_MMA(0, 1, At, B1); PG8_BAR; PG8_SCHED;
            PG8_LDA(At, 1, 1); PG8_STAGE(PG8_SB(1, 0), b3, voffB); PG8_STAGE(PG8_SB(1, 1), b3 + hstep, voffB); PG8_STAGE(PG8_SA(1, 0), a3, voffA);
            PG8_WAIT_V(8); PG8_WAIT_L(0); PG8_BAR; PG8_MMA(1, 0, At, B0); PG8_MMA(1, 1, At, B1); PG8_BAR; PG8_SCHED;
        }
        if (wr == 0) PG8_BAR;
        E(acc, cur, wr, wc, fr, fq);
        if (!has_next) break;
#pragma unroll
        for (int a = 0; a < 2; ++a)
#pragma unroll
            for (int b = 0; b < 2; ++b)
#pragma unroll
                for (int m = 0; m < 4; ++m)
#pragma unroll
                    for (int n = 0; n < 2; ++n) acc[a][b][m][n] = (f32x4){0.f, 0.f, 0.f, 0.f};
        cur = nxt; cA = nA; cB = nB; ++ui;
        if (wr == 1) PG8_BAR;
    }
    PG8_WAIT_V(0);
    PG8_BAR;
#undef PG8_SA
#undef PG8_SB
#undef PG8_STAGE
#undef PG8_LDA
#undef PG8_LDB
#undef PG8_MMA
#undef PG8_WAIT_V
#undef PG8_WAIT_L
#undef PG8_BAR
#undef PG8_SCHED
#undef PG8_ABASE
}

typedef f32x4 Acc[2][2][4][2];

struct EpiAin {
    static constexpr bool PERM = true;
    static constexpr bool HAS_PRE = false; struct Pre {};
    unsigned char* slab0;
    const float* conv_w;
    __device__ __forceinline__ void operator()(const Acc& acc, const Unit& u, int wr, int wc, int fr, int fq) const {
        const int rip0 = wr * 64 + fr;
        const int row0 = (u.pm & 7) * BM + rip0;
        unsigned char* slab = slab0 + (size_t)(u.pm >> 3) * SLAB;
        bf16_t* V = (bf16_t*)(slab + SO_V);
        if (u.pn < 4) {
            bf16_t* Y = (bf16_t*)(slab + SO_Y); bf16_t* GBH = (bf16_t*)(slab + SO_GB) + (size_t)(u.pm & 7) * 2 * DM;
            const int col0 = u.pn * BM + wc * 32 + 8 * fq;
#pragma unroll
            for (int bj = 0; bj < 2; ++bj) { const int cw = col0 + bj * HALF;
                f32x4 w0[2], w1[2], w2[2];
#pragma unroll
                for (int n = 0; n < 2; ++n) { w0[n] = *(const f32x4*)(conv_w + cw + 4 * n); w1[n] = *(const f32x4*)(conv_w + DM + cw + 4 * n); w2[n] = *(const f32x4*)(conv_w + 2 * DM + cw + 4 * n); }
#pragma unroll
                for (int ai = 0; ai < 2; ++ai)
#pragma unroll
                    for (int mp = 0; mp < 2; ++mp) {
                        u32x4 vr[2][3];
#pragma unroll
                        for (int mm = 0; mm < 2; ++mm) { const int rip = rip0 + ai * HALF + (2 * mp + mm) * 16; const bf16_t* vp = V + (size_t)(row0 + ai * HALF + (2 * mp + mm) * 16) * DM + cw;
#pragma unroll
                            for (int k = 0; k < 3; ++k) vr[mm][k] = (rip >= 2) ? *(const u32x4*)(vp - (size_t)k * DM) : (u32x4){0u, 0u, 0u, 0u}; }
                        asm volatile("" : "+v"(vr[0][0]), "+v"(vr[0][1]), "+v"(vr[0][2]), "+v"(vr[1][0]), "+v"(vr[1][1]), "+v"(vr[1][2]));
#pragma unroll
                        for (int mm = 0; mm < 2; ++mm) { const int m = 2 * mp + mm; const int rip = rip0 + ai * HALF + m * 16;
                            const f32x4 g0 = acc[ai][bj][m][0], g1 = acc[ai][bj][m][1];
                            u32x4 w;
                            if (rip >= 2) {
                                const u32x4 a = vr[mm][0], b1 = vr[mm][1], b2 = vr[mm][2];
                                const f32x4 v0a = (f32x4){bf_lo(a.x), bf_hi(a.x), bf_lo(a.y), bf_hi(a.y)}, v0b = (f32x4){bf_lo(a.z), bf_hi(a.z), bf_lo(a.w), bf_hi(a.w)};
                                const f32x4 v1a = (f32x4){bf_lo(b1.x), bf_hi(b1.x), bf_lo(b1.y), bf_hi(b1.y)}, v1b = (f32x4){bf_lo(b1.z), bf_hi(b1.z), bf_lo(b1.w), bf_hi(b1.w)};
                                const f32x4 v2a = (f32x4){bf_lo(b2.x), bf_hi(b2.x), bf_lo(b2.y), bf_hi(b2.y)}, v2b = (f32x4){bf_lo(b2.z), bf_hi(b2.z), bf_lo(b2.w), bf_hi(b2.w)};
                                const f32x4 ya = g0 * (w2[0] * v0a + w1[0] * v1a + w0[0] * v2a), yb = g1 * (w2[1] * v0b + w1[1] * v1b + w0[1] * v2b);
                                w.x = cvtpk(ya[0], ya[1]); w.y = cvtpk(ya[2], ya[3]); w.z = cvtpk(yb[0], yb[1]); w.w = cvtpk(yb[2], yb[3]);
                                *(u32x4*)(Y + (size_t)(row0 + ai * HALF + m * 16) * DM + cw) = w;
                            } else {
                                w.x = cvtpk(g0[0], g0[1]); w.y = cvtpk(g0[2], g0[3]); w.z = cvtpk(g1[0], g1[1]); w.w = cvtpk(g1[2], g1[3]);
                                *(u32x4*)(GBH + (size_t)rip * DM + cw) = w;
                            } } }
            }
        } else {
            const int col0 = (u.pn - 4) * HALF + wc * 32 + 8 * fq;
#pragma unroll
            for (int ai = 0; ai < 2; ++ai)
#pragma unroll
                for (int m = 0; m < 4; ++m) { bf16_t* rowp = V + (size_t)(row0 + ai * HALF + m * 16) * DM + col0;
                    const f32x4 v0 = acc[ai][0][m][0] * acc[ai][1][m][0], v1 = acc[ai][0][m][1] * acc[ai][1][m][1];
                    u32x4 w; w.x = cvtpk(v0[0], v0[1]); w.y = cvtpk(v0[2], v0[3]); w.z = cvtpk(v1[0], v1[1]); w.w = cvtpk(v1[2], v1[3]);
                    *(u32x4*)rowp = w; }
        }
    }
};

template <int NA, int INM, int OUTM> struct EpiRes {
    static constexpr bool PERM = true;
    const void* xin; void* xout; const float* gate; int gate_stride;
    const float* gain0; const float* sc0; int sc0_stride; bf16_t* A0;
    const float* gain1; const float* sc1; int sc1_stride; bf16_t* A1;
    float* sumsq;
    const float* gain_in; const float* sc_in; int sc_in_stride;
    __device__ __forceinline__ void operator()(const Acc& acc, const Unit& u, int wr, int wc, int fr, int fq) const {
        constexpr bool IN16 = INM != 0, OUT16 = false;
        const int b = u.pm >> 3;
        const int row0 = u.pm * BM + wr * 64 + fr, col0 = u.pn * BM + wc * 32 + 8 * fq;
        f32x4 gv[2][2], a0[2][2], a1[2][2], ia[2][2];
#pragma unroll
        for (int bj = 0; bj < 2; ++bj)
#pragma unroll
            for (int n = 0; n < 2; ++n) { const int c = col0 + bj * HALF + 4 * n;
                gv[bj][n] = *(const f32x4*)(gate + (size_t)b * gate_stride + c);
                if (NA >= 1) a0[bj][n] = *(const f32x4*)(gain0 + c) * (*(const f32x4*)(sc0 + (size_t)b * sc0_stride + c) + 1.0f);
                if (NA >= 2) a1[bj][n] = *(const f32x4*)(gain1 + c) * (*(const f32x4*)(sc1 + (size_t)b * sc1_stride + c) + 1.0f);
                if (INM == 2) { const f32x4 t = *(const f32x4*)(gain_in + c) * (*(const f32x4*)(sc_in + (size_t)b * sc_in_stride + c) + 1.0f); ia[bj][n] = (f32x4){1.0f / t[0], 1.0f / t[1], 1.0f / t[2], 1.0f / t[3]}; } }
#pragma unroll
        for (int ai = 0; ai < 2; ++ai)
#pragma unroll
          for (int mp = 0; mp < 2; ++mp) {
            f32x4 xr[2][2][2]; u32x4 xh[2][2];
#pragma unroll
            for (int mm = 0; mm < 2; ++mm)
#pragma unroll
                for (int bj = 0; bj < 2; ++bj) { const size_t o = (size_t)(row0 + ai * HALF + (2 * mp + mm) * 16) * DM + col0 + bj * HALF;
                    if (IN16) xh[mm][bj] = __builtin_nontemporal_load((const u32x4*)((const bf16_t*)xin + o));
                    else { xr[mm][bj][0] = __builtin_nontemporal_load((const f32x4*)((const float*)xin + o)); xr[mm][bj][1] = __builtin_nontemporal_load((const f32x4*)((const float*)xin + o + 4)); } }
            if (IN16) asm volatile("" : "+v"(xh[0][0]), "+v"(xh[0][1]), "+v"(xh[1][0]), "+v"(xh[1][1]));
            else asm volatile("" : "+v"(xr[0][0][0]), "+v"(xr[0][0][1]), "+v"(xr[0][1][0]), "+v"(xr[0][1][1]), "+v"(xr[1][0][0]), "+v"(xr[1][0][1]), "+v"(xr[1][1][0]), "+v"(xr[1][1][1]));
#pragma unroll
            for (int mm = 0; mm < 2; ++mm) { const int m = 2 * mp + mm; const int row = row0 + ai * HALF + m * 16; const size_t off = (size_t)row * DM + col0; float ss = 0.f;
#pragma unroll
                for (int bj = 0; bj < 2; ++bj) { const size_t o = off + bj * HALF;
                    f32x4 x0, x1;
                    if (IN16) { const u32x4 w = xh[mm][bj]; x0 = (f32x4){bf_lo(w.x), bf_hi(w.x), bf_lo(w.y), bf_hi(w.y)}; x1 = (f32x4){bf_lo(w.z), bf_hi(w.z), bf_lo(w.w), bf_hi(w.w)}; }
                    else { x0 = xr[mm][bj][0]; x1 = xr[mm][bj][1]; }
                    if (INM == 2) { x0 = x0 * ia[bj][0]; x1 = x1 * ia[bj][1]; }
                    x0 = x0 + gv[bj][0] * acc[ai][bj][m][0]; x1 = x1 + gv[bj][1] * acc[ai][bj][m][1];
                    if (OUTM == 0) { *(f32x4*)((float*)xout + o) = x0; *(f32x4*)((float*)xout + o + 4) = x1; }
                    if (NA >= 1) { ss += ((x0[0] * x0[0] + x0[1] * x0[1]) + (x0[2] * x0[2] + x0[3] * x0[3])) + ((x1[0] * x1[0] + x1[1] * x1[1]) + (x1[2] * x1[2] + x1[3] * x1[3]));
                        const f32x4 t0 = x0 * a0[bj][0], t1 = x1 * a0[bj][1]; u32x4 w; w.x = cvtpk(t0[0], t0[1]); w.y = cvtpk(t0[2], t0[3]); w.z = cvtpk(t1[0], t1[1]); w.w = cvtpk(t1[2], t1[3]); *(u32x4*)(A0 + o) = w; }
                    if (NA >= 2) { const f32x4 t0 = x0 * a1[bj][0], t1 = x1 * a1[bj][1]; u32x4 w; w.x = cvtpk(t0[0], t0[1]); w.y = cvtpk(t0[2], t0[3]); w.z = cvtpk(t1[0], t1[1]); w.w = cvtpk(t1[2], t1[3]); *(u32x4*)(A1 + o) = w; } }
                if (NA >= 1) { ss += __shfl_xor(ss, 16); ss += __shfl_xor(ss, 32); if (fq == 0) unsafeAtomicAdd(sumsq + row, ss); } }
          }
    }
};

struct EpiMlp1 {
    static constexpr bool PERM = true;
    bf16_t* H; const float* bias; const float* sumsq;
    __device__ __forceinline__ void operator()(const Acc& acc, const Unit& u, int wr, int wc, int fr, int fq) const {
        const int b = u.pm >> 3;
        const int row0 = u.pm * BM + wr * 64 + fr, col0 = u.pn * BM + wc * 32 + 8 * fq;
        f32x4 bv[2][2];
#pragma unroll
        for (int bj = 0; bj < 2; ++bj)
#pragma unroll
            for (int n = 0; n < 2; ++n) bv[bj][n] = *(const f32x4*)(bias + (size_t)b * FF + col0 + bj * HALF + 4 * n);
        float ssv[8];
#pragma unroll
        for (int q = 0; q < 8; ++q) ssv[q] = sumsq[row0 + (q >> 2) * HALF + (q & 3) * 16];
        asm volatile("" : "+v"(ssv[0]), "+v"(ssv[1]), "+v"(ssv[2]), "+v"(ssv[3]), "+v"(ssv[4]), "+v"(ssv[5]), "+v"(ssv[6]), "+v"(ssv[7]));
#pragma unroll
        for (int ai = 0; ai < 2; ++ai)
#pragma unroll
            for (int m = 0; m < 4; ++m) { const int row = row0 + ai * HALF + m * 16; const float rs = rsqrtf(ssv[ai * 4 + m] * (1.0f / DM) + EPS);
                bf16_t* rowp = H + (size_t)row * FF + col0;
#pragma unroll
                for (int bj = 0; bj < 2; ++bj) { f32x4 v0 = acc[ai][bj][m][0] * rs + bv[bj][0], v1 = acc[ai][bj][m][1] * rs + bv[bj][1];
#pragma unroll
                    for (int e = 0; e < 4; ++e) { const float r0 = fmaxf(v0[e], 0.f), r1 = fmaxf(v1[e], 0.f); v0[e] = r0 * r0; v1[e] = r1 * r1; }
                    u32x4 w; w.x = cvtpk(v0[0], v0[1]); w.y = cvtpk(v0[2], v0[3]); w.z = cvtpk(v1[0], v1[1]); w.w = cvtpk(v1[2], v1[3]);
                    __builtin_nontemporal_store(w, (u32x4*)(rowp + bj * HALF)); } }
    }
};

struct EpiKVQ {
    static constexpr bool PERM = true;
    unsigned char* slab0; const float* bias; const float* sumsq; const float* k_gain; const float* q_gain;
    __device__ __forceinline__ void operator()(const Acc& acc, const Unit& u, int wr, int wc, int fr, int fq) const {
        const int b = u.pm >> 3, pn = u.pn;
        const int row0 = u.pm * BM + wr * 64 + fr;
        unsigned char* slab = slab0 + (size_t)b * SLAB;
        bf16_t* KV = (bf16_t*)(slab + SO_KV); bf16_t* Q = (bf16_t*)(slab + SO_Q); float* gates = (float*)(slab + SO_GATES);
        f32x4 bv[2][2];
#pragma unroll
        for (int bj = 0; bj < 2; ++bj)
#pragma unroll
            for (int n = 0; n < 2; ++n) bv[bj][n] = *(const f32x4*)(bias + (size_t)b * NKVQ + pn * BM + bj * HALF + wc * 32 + 8 * fq + 4 * n);
        float ssv[8];
#pragma unroll
        for (int q = 0; q < 8; ++q) ssv[q] = sumsq[row0 + (q >> 2) * HALF + (q & 3) * 16];
        asm volatile("" : "+v"(ssv[0]), "+v"(ssv[1]), "+v"(ssv[2]), "+v"(ssv[3]), "+v"(ssv[4]), "+v"(ssv[5]), "+v"(ssv[6]), "+v"(ssv[7]));
        if (pn == 10) {
            if (wc < 2) {
#pragma unroll
                for (int ai = 0; ai < 2; ++ai)
#pragma unroll
                    for (int m = 0; m < 4; ++m) { const int row = row0 + ai * HALF + m * 16; const float rs = rsqrtf(ssv[ai * 4 + m] * (1.0f / DM) + EPS);
#pragma unroll
                        for (int n = 0; n < 2; ++n) { const int c = wc * 32 + 8 * fq + 4 * n;
                            if (c < 48) { const f32x4 v = acc[ai][0][m][n] * rs + bv[0][n]; f32x4 o;
#pragma unroll
                                for (int e = 0; e < 4; ++e) o[e] = 1.0f / (1.0f + __expf(-v[e]));
                                *(f32x4*)(gates + (size_t)(row & (SEQ - 1)) * 48 + c) = o; } } }
            }
            return;
        }
        const bool is_q = pn >= 6;
        const bool do_norm = is_q || pn == 2 || pn == 4;
        f32x4 gn[2][2];
        { const float* gp = is_q ? q_gain : (k_gain + (pn == 2 ? 64 : 128)); const float sc = is_q ? QSCALE : 1.0f;
#pragma unroll
          for (int bj = 0; bj < 2; ++bj)
#pragma unroll
              for (int n = 0; n < 2; ++n) gn[bj][n] = do_norm ? *(const f32x4*)(gp + 32 * bj + 8 * fq + 4 * n) * sc : (f32x4){1.f, 1.f, 1.f, 1.f}; }
#pragma unroll
        for (int ai = 0; ai < 2; ++ai)
#pragma unroll
            for (int m = 0; m < 4; ++m) { const int row = row0 + ai * HALF + m * 16; const float rs = rsqrtf(ssv[ai * 4 + m] * (1.0f / DM) + EPS);
                f32x4 v[2][2]; float ss = 0.f;
#pragma unroll
                for (int bj = 0; bj < 2; ++bj)
#pragma unroll
                    for (int n = 0; n < 2; ++n) { v[bj][n] = acc[ai][bj][m][n] * rs + bv[bj][n]; const f32x4 t = v[bj][n]; ss += (t[0] * t[0] + t[1] * t[1]) + (t[2] * t[2] + t[3] * t[3]); }
                float hs = 1.0f;
                if (do_norm) { ss += __shfl_xor(ss, 16); ss += __shfl_xor(ss, 32); hs = rsqrtf(ss * (1.0f / 64.0f) + EPS); }
                bf16_t* rowp;
                if (is_q) rowp = Q + (size_t)(row & (SEQ - 1)) * DM + ((pn - 6) * 4 + wc) * 64 + 8 * fq;
                else rowp = KV + ((size_t)(pn * 4 + wc) * SEQ + (row & (SEQ - 1))) * 64 + 8 * fq;
#pragma unroll
                for (int bj = 0; bj < 2; ++bj) { const f32x4 v0 = v[bj][0] * hs * gn[bj][0], v1 = v[bj][1] * hs * gn[bj][1];
                    u32x4 w; w.x = cvtpk(v0[0], v0[1]); w.y = cvtpk(v0[2], v0[3]); w.z = cvtpk(v1[0], v1[1]); w.w = cvtpk(v1[2], v1[3]);
                    *(u32x4*)(rowp + 32 * bj) = w; } }
    }
};
}

namespace att {
constexpr int SLOTB = 8192;
constexpr int L_K = 0, L_V = 3 * SLOTB, L_WS = 6 * SLOTB, L_SEL = L_WS + 4096, L_NIB = L_SEL + 256, L_SC = L_NIB + 768, L_IA = L_SC + 8704, L_IB = L_IA + 33792, L_END = L_IB + 33792, L_OST = L_IA;
static_assert(L_END <= 131072 && (L_IA % 16) == 0 && (L_SC % 16) == 0, "attention LDS map");
#define SBAR() __builtin_amdgcn_sched_barrier(0)
#define ATT_WAIT_BAR(N) asm volatile("s_waitcnt vmcnt(" #N ") lgkmcnt(0)\n\ts_barrier" ::: "memory")
__device__ __forceinline__ int crow(int r, int hi) { return (r & 3) + 8 * (r >> 2) + 4 * hi; }
__device__ __forceinline__ void glds16(const void* gsrc, unsigned lds_dst) { unsigned keep;
    asm volatile("s_mov_b32 %0, m0\n\ts_mov_b32 m0, %2\n\ts_nop 0\n\tglobal_load_lds_dwordx4 %1, off\n\ts_mov_b32 m0, %0" : "=&s"(keep) : "v"(gsrc), "s"(lds_dst) : "memory"); }

__device__ __forceinline__ void qkt_c(f32x16& p0, f32x16& p1, const LAS unsigned char* Kslot, const bf16x8* qr, const f32x16& ci, int r32, int hi) {
    const LAS unsigned char* kb = Kslot + hi * 1024 + r32 * 16;
    bf16x8 kf[8];
#pragma unroll
    for (int i = 0; i < 8; ++i) kf[i] = *(const LAS bf16x8*)(kb + (i >> 1) * 2048 + (i & 1) * 512);
    asm volatile("" : "+v"(kf[0]), "+v"(kf[1]), "+v"(kf[2]), "+v"(kf[3]), "+v"(kf[4]), "+v"(kf[5]), "+v"(kf[6]), "+v"(kf[7]));
    p0 = __builtin_amdgcn_mfma_f32_32x32x16_bf16(kf[0], qr[0], ci, 0, 0, 0); p1 = __builtin_amdgcn_mfma_f32_32x32x16_bf16(kf[1], qr[0], ci, 0, 0, 0);
#pragma unroll
    for (int d0 = 1; d0 < 4; ++d0) { p0 = __builtin_amdgcn_mfma_f32_32x32x16_bf16(kf[2 * d0], qr[d0], p0, 0, 0, 0); p1 = __builtin_amdgcn_mfma_f32_32x32x16_bf16(kf[2 * d0 + 1], qr[d0], p1, 0, 0, 0); }
}
__device__ __forceinline__ void qkt(f32x16& p0, f32x16& p1, const LAS unsigned char* Kslot, const bf16x8* qr, int r32, int hi) {
    const LAS unsigned char* kb = Kslot + hi * 1024 + r32 * 16;
    bf16x8 kf[8];
#pragma unroll
    for (int i = 0; i < 8; ++i) kf[i] = *(const LAS bf16x8*)(kb + (i >> 1) * 2048 + (i & 1) * 512);
    asm volatile("" : "+v"(kf[0]), "+v"(kf[1]), "+v"(kf[2]), "+v"(kf[3]), "+v"(kf[4]), "+v"(kf[5]), "+v"(kf[6]), "+v"(kf[7]));
    const f32x16 z = f32x16{};
    p0 = __builtin_amdgcn_mfma_f32_32x32x16_bf16(kf[0], qr[0], z, 0, 0, 0); p1 = __builtin_amdgcn_mfma_f32_32x32x16_bf16(kf[1], qr[0], z, 0, 0, 0);
#pragma unroll
    for (int d0 = 1; d0 < 4; ++d0) { p0 = __builtin_amdgcn_mfma_f32_32x32x16_bf16(kf[2 * d0], qr[d0], p0, 0, 0, 0); p1 = __builtin_amdgcn_mfma_f32_32x32x16_bf16(kf[2 * d0 + 1], qr[d0], p1, 0, 0, 0); }
}
__device__ __forceinline__ void range_mask(f32x16& p0, f32x16& p1, int lo, int hv, int hi) {
    const int lo2 = lo - 4 * hi, hv2 = hv - 4 * hi;
#pragma unroll
    for (int r = 0; r < 16; ++r) { const int kc = (r & 3) + 8 * (r >> 2); if (kc < lo2 || kc > hv2) p0[r] = -INFINITY; if (kc + 32 < lo2 || kc + 32 > hv2) p1[r] = -INFINITY; }
}
__device__ __forceinline__ float max3f(float a, float b, float c) { float r; asm("v_max3_f32 %0, %1, %2, %3" : "=v"(r) : "v"(a), "v"(b), "v"(c)); return r; }
__device__ __forceinline__ float max2f(float a, float b) { float r; asm("v_max_f32_e32 %0, %1, %2" : "=v"(r) : "v"(a), "v"(b)); return r; }
__device__ __forceinline__ float rowmax(const f32x16& p0, const f32x16& p1) {
    float a = max3f(p0[0], p0[1], p1[0]), b = max3f(p0[2], p0[3], p1[1]); a = max3f(a, p1[2], p1[3]);
#pragma unroll
    for (int r = 4; r < 16; r += 4) { a = max3f(a, p0[r], p0[r + 1]); b = max3f(b, p0[r + 2], p0[r + 3]); a = max3f(a, p1[r], p1[r + 1]); b = max3f(b, p1[r + 2], p1[r + 3]); }
    const float m = max2f(a, b);
    auto rr = __builtin_amdgcn_permlane32_swap(__float_as_uint(m), __float_as_uint(m), false, false);
    return max2f(__uint_as_float(rr[0]), __uint_as_float(rr[1]));
}
__device__ __forceinline__ float halfsum(float a) {
    auto rr = __builtin_amdgcn_permlane32_swap(__float_as_uint(a), __float_as_uint(a), false, false);
    return __uint_as_float(rr[0]) + __uint_as_float(rr[1]);
}
__device__ __forceinline__ void pv(f32x16* o, int vb, bf16x8 pa0, bf16x8 pa1, bf16x8 pa2, bf16x8 pa3) {
    s16x4 lo[8], hi4[8];
#pragma unroll
    for (int q = 0; q < 8; ++q) {
        asm volatile("ds_read_b64_tr_b16 %0,%1 offset:%c2" : "=&v"(lo[q]) : "v"(vb), "i"((q >> 2) * 4096 + (q & 3) * 1024) : "memory");
        asm volatile("ds_read_b64_tr_b16 %0,%1 offset:%c2" : "=&v"(hi4[q]) : "v"(vb), "i"((q >> 2) * 4096 + (q & 3) * 1024 + 512) : "memory"); }
    asm volatile("s_waitcnt lgkmcnt(0)" ::: "memory"); SBAR();
#define PK(k) (bf16x8){lo[k][0], lo[k][1], lo[k][2], lo[k][3], hi4[k][0], hi4[k][1], hi4[k][2], hi4[k][3]}
    o[0] = __builtin_amdgcn_mfma_f32_32x32x16_bf16(pa0, PK(0), o[0], 0, 0, 0);
    o[1] = __builtin_amdgcn_mfma_f32_32x32x16_bf16(pa0, PK(4), o[1], 0, 0, 0);
    o[0] = __builtin_amdgcn_mfma_f32_32x32x16_bf16(pa1, PK(1), o[0], 0, 0, 0);
    o[1] = __builtin_amdgcn_mfma_f32_32x32x16_bf16(pa1, PK(5), o[1], 0, 0, 0);
    o[0] = __builtin_amdgcn_mfma_f32_32x32x16_bf16(pa2, PK(2), o[0], 0, 0, 0);
    o[1] = __builtin_amdgcn_mfma_f32_32x32x16_bf16(pa2, PK(6), o[1], 0, 0, 0);
    o[0] = __builtin_amdgcn_mfma_f32_32x32x16_bf16(pa3, PK(3), o[0], 0, 0, 0);
    o[1] = __builtin_amdgcn_mfma_f32_32x32x16_bf16(pa3, PK(7), o[1], 0, 0, 0);
#undef PK
}
__device__ __forceinline__ bf16x8 pack8(const f32x16& p, int base) {
    u32x4 w; w.x = cvtpk(p[base], p[base + 1]); w.y = cvtpk(p[base + 2], p[base + 3]); w.z = cvtpk(p[base + 4], p[base + 5]); w.w = cvtpk(p[base + 6], p[base + 7]);
    return __builtin_bit_cast(bf16x8, w);
}
__device__ __forceinline__ void row_bcast(float v, float (&out)[16], LAS float* wsf, int r32, int hi) {
    if (hi == 0) wsf[r32] = v;
#pragma unroll
    for (int i = 0; i < 4; ++i) { const f32x4 t = *(const LAS f32x4*)(wsf + 8 * i + 4 * hi); out[4 * i] = t[0]; out[4 * i + 1] = t[1]; out[4 * i + 2] = t[2]; out[4 * i + 3] = t[3]; }
}

struct Ctx {
    int lane, r32, hi, wid, ql, qb; unsigned lds0; LAS unsigned char* shm; LAS float* wsf; int koff, voff; unsigned kdst, vdst; int vb0;
};
__device__ __forceinline__ void dma_k(const Ctx& c, const bf16_t* base, int tile, int slot) { glds16(base + (size_t)tile * 4096 + c.koff, (unsigned)__builtin_amdgcn_readfirstlane(c.kdst + slot * SLOTB)); }
__device__ __forceinline__ void dma_v(const Ctx& c, const bf16_t* base, int tile, int slot) { glds16(base + (size_t)tile * 4096 + c.voff, (unsigned)__builtin_amdgcn_readfirstlane(c.vdst + slot * SLOTB)); }

constexpr float THR = 8.0f;
struct BrState { float mhat, l; f32x16 negm; f32x16 o[2]; };
__device__ __forceinline__ void br_reset(BrState& st) { st.mhat = 0.f; st.l = 0.f; st.negm = f32x16{}; st.o[0] = f32x16{}; st.o[1] = f32x16{}; }
__device__ __forceinline__ void stream_step(const Ctx& c, int slot, const bf16x8* qr, bool row_on, bool use_range, int lo, int hv, bool first, BrState& st) {
    f32x16 p0, p1;
    if (__any(!row_on)) { f32x16 ci;
#pragma unroll
        for (int r = 0; r < 16; ++r) ci[r] = row_on ? st.negm[r] : -INFINITY;
        qkt_c(p0, p1, c.shm + L_K + slot * SLOTB, qr, ci, c.r32, c.hi);
    } else qkt_c(p0, p1, c.shm + L_K + slot * SLOTB, qr, st.negm, c.r32, c.hi);
    if (use_range) range_mask(p0, p1, lo, hv, c.hi);
    const float rm = rowmax(p0, p1);
    if (first || __any(rm > THR)) {
        float dl = first ? rm : fmaxf(rm, 0.f);
        if (dl == -INFINITY) dl = 0.f;
        st.mhat += dl;
#pragma unroll
        for (int r = 0; r < 16; ++r) { p0[r] -= dl; p1[r] -= dl; st.negm[r] = -st.mhat; }
        if (!first) { const float f = __builtin_amdgcn_exp2f(-dl); st.l *= f; float al[16]; row_bcast(f, al, c.wsf, c.r32, c.hi);
#pragma unroll
            for (int r = 0; r < 16; ++r) { st.o[0][r] *= al[r]; st.o[1][r] *= al[r]; } }
    }
#pragma unroll
    for (int r = 0; r < 16; ++r) { p0[r] = __builtin_amdgcn_exp2f(p0[r]); p1[r] = __builtin_amdgcn_exp2f(p1[r]); }
    { const f32x16 sv = p0 + p1; st.l += ((sv[0] + sv[1]) + (sv[2] + sv[3])) + ((sv[4] + sv[5]) + (sv[6] + sv[7])) + ((sv[8] + sv[9]) + (sv[10] + sv[11])) + ((sv[12] + sv[13]) + (sv[14] + sv[15])); }
    pv(st.o, c.vb0 + slot * SLOTB, pack8(p0, 0), pack8(p0, 8), pack8(p1, 0), pack8(p1, 8));
}
struct Cursor { unsigned sm, wm; };
__device__ __forceinline__ int cur_pop(Cursor& k, int& br) {
    if (k.sm) { const int t = __builtin_ctz(k.sm); k.sm &= k.sm - 1u; br = 1; return t; }
    const int t = 31 - __builtin_clz(k.wm); k.wm &= ~(1u << t); br = 2; return t;
}

typedef __attribute__((address_space(3))) const char* lds_cptr;
typedef short v4i16_t __attribute__((ext_vector_type(4)));
__device__ __forceinline__ void kload8(bf16x8* kf, lds_cptr kp) {
    kf[0] = *(const LAS bf16x8*)(kp);        kf[1] = *(const LAS bf16x8*)(kp + 512);
    kf[2] = *(const LAS bf16x8*)(kp + 2048); kf[3] = *(const LAS bf16x8*)(kp + 2560);
    kf[4] = *(const LAS bf16x8*)(kp + 4096); kf[5] = *(const LAS bf16x8*)(kp + 4608);
    kf[6] = *(const LAS bf16x8*)(kp + 6144); kf[7] = *(const LAS bf16x8*)(kp + 6656);
}
__device__ __forceinline__ void kload2(bf16x8* kf, lds_cptr kp, int j) { kf[2 * j] = *(const LAS bf16x8*)(kp + j * 2048); kf[2 * j + 1] = *(const LAS bf16x8*)(kp + j * 2048 + 512); }
__device__ __forceinline__ s16x4 vtr(lds_cptr p) { return __builtin_bit_cast(s16x4, __builtin_amdgcn_ds_read_tr16_b64_v4i16((LAS v4i16_t*)p)); }
__device__ __forceinline__ float fadd_s(float a, float b) { float r; asm("v_add_f32_e32 %0, %1, %2" : "=v"(r) : "v"(a), "v"(b)); return r; }
__device__ __forceinline__ float fsub_s(float a, float b) { float r; asm("v_sub_f32_e32 %0, %1, %2" : "=v"(r) : "v"(a), "v"(b)); return r; }
template <int THRL>
__device__ __forceinline__ void sel_stream(const Ctx& c, const bf16_t* Kb, const bf16_t* Vb, const bf16x8* qr, unsigned msel, int qb, f32x16* o, float& l_out) {
  const int lane = c.lane, r32 = c.r32, hi = c.hi;
  LAS float* wsf = c.wsf;
  const lds_cptr shm3 = (lds_cptr)c.shm;
  const lds_cptr kp0 = shm3 + L_K + hi * 1024 + r32 * 16;
  const lds_cptr vp0 = shm3 + L_V + ((lane >> 4) & 1) * 32 + (lane & 3) * 8 + (4 * hi + ((lane & 15) >> 2)) * 64;
  const int NTr = qb + 1, NT = NTr < 4 ? 4 : ((NTr + 1) & ~1);
  #define WAIT_BAR(N) asm volatile("s_waitcnt vmcnt(" #N ") lgkmcnt(0)\n\ts_barrier":::"memory")
  #define TILE_OF(t) (((t) < NTr) ? (t) : qb)
  #define DMA_K(t, slotb) glds16(Kb + (size_t)TILE_OF(t) * 4096 + c.koff, (unsigned)__builtin_amdgcn_readfirstlane(c.kdst + (slotb)))
  #define DMA_V(t, slotb) glds16(Vb + (size_t)TILE_OF(t) * 4096 + c.voff, (unsigned)__builtin_amdgcn_readfirstlane(c.vdst + (slotb)))
  #define CMASK(P0, P1, t) do { const bool on_ = ((t) < NTr) && (((msel >> ((t) & 31)) & 1u) != 0u); \
      if (__any(!on_)) { const float ng_ = on_ ? 0.f : -INFINITY; _Pragma("unroll") for (int r = 0; r < 16; ++r) { P0[r] += ng_; P1[r] += ng_; } } \
      if ((t) == qb) range_mask(P0, P1, 0, c.ql, hi); } while (0)
  float mhat = 0.f, l_reg = 0.f; o[0] = f32x16{}; o[1] = f32x16{}; f32x16 negm = f32x16{}; asm volatile("" : "+v"(negm));
  bf16x8 kf[8];
  bool resc = false;
  #define START(P0,P1) do{ const float rm=rowmax(P0,P1); resc=false; \
    { const float dl=rm; mhat=fadd_s(mhat,dl); \
      _Pragma("unroll") for(int r=0;r<16;++r){P0[r]=fsub_s(P0[r],dl);P1[r]=fsub_s(P1[r],dl);} \
      _Pragma("unroll") for(int r=0;r<16;++r)negm[r]=-mhat; asm volatile("":"+v"(negm)); } \
    _Pragma("unroll") for(int r=0;r<16;++r)P0[r]=__builtin_amdgcn_exp2f(P0[r]); }while(0)
  #define RESC() do{ if(resc){ asm volatile("s_waitcnt lgkmcnt(0)":::"memory"); \
      _Pragma("unroll") for(int d_=0;d_<2;++d_) _Pragma("unroll") for(int r=0;r<16;++r)o[d_][r]*=wsf[crow(r,hi)]; } }while(0)
  f32x16 pA0,pA1,pB0,pB1;
  int sl_prev=SLOTB,sl_cur=2*SLOTB,sl_next=0;
  #define ROT() do{sl_prev=sl_cur;sl_cur=sl_next;sl_next=(sl_next==2*SLOTB)?0:sl_next+SLOTB;}while(0)
  DMA_K(1,0); DMA_K(2,SLOTB);
  { const f32x16 z = f32x16{}; qkt_c(pA0,pA1,c.shm+L_K+2*SLOTB,qr,z,r32,hi); }
  asm volatile("s_nop 15\n\ts_nop 7":"+v"(pA0),"+v"(pA1)); CMASK(pA0,pA1,0);
  START(pA0,pA1);
  _Pragma("unroll") for(int r=0;r<16;++r)pA1[r]=__builtin_amdgcn_exp2f(pA1[r]);
  WAIT_BAR(0);
  DMA_K(3,2*SLOTB);DMA_V(1,0);
  ROT();
  kload8(kf,kp0+sl_cur);
  WAIT_BAR(2);
  s16x4 vlo[8],vhi[8]; u32x4 pw0,pw1,pw2,pw3;
  #define PKW(P,B) cvtpk(P[B],P[B+1])
  #define PAF(k) __builtin_bit_cast(bf16x8,pw##k)
  #define VFR(i) (bf16x8){vlo[i][0],vlo[i][1],vlo[i][2],vlo[i][3],vhi[i][0],vhi[i][1],vhi[i][2],vhi[i][3]}
  #define PIN(x) asm volatile("":"+v"(x))
  #define MX3(a,b,c) __builtin_fmaxf(__builtin_fmaxf((a),(b)),(c))
  #define GAPA(MF,A0,A1,A2,A3,W0,W1,PW) do{ MF; sacc+=A0; sacc+=A1; sacc+=A2; sacc+=A3; PIN(sacc); W0; W1; PIN(PW); SBAR(); }while(0)
  #define EX(v) __builtin_amdgcn_exp2f(v)
  #define GAPB(MF,X,B) do{ MF; X[B]=EX(X[B]); X[B+1]=EX(X[B+1]); X[B+2]=EX(X[B+2]); X[B+3]=EX(X[B+3]); PIN(X); SBAR(); }while(0)
  #define VRD(i) do{ vlo[i]=vtr(vp_+(((i)>>2)*4096+((i)&3)*1024)); vhi[i]=vtr(vp_+(((i)>>2)*4096+((i)&3)*1024+512)); }while(0)
  #define KRD(G,j) do{ if(G){ kload2(kf,kp0+sl_next,j); SBAR(); } }while(0)
  #define STEP(C0,C1,P0,P1,t,GK,GV,GL) do{ SBAR(); \
    const lds_cptr vp_=vp0+sl_prev; \
    VRD(0); SBAR(); float sacc=(P0[0]+P0[1]); \
    GAPA(C0=__builtin_amdgcn_mfma_f32_32x32x16_bf16(kf[0],qr[0],negm,0,0,0), P0[2],P0[3],P0[4],P0[5],     pw0[0]=PKW(P0,0), pw0[1]=PKW(P0,2), pw0); \
    VRD(4); SBAR(); GAPA(C1=__builtin_amdgcn_mfma_f32_32x32x16_bf16(kf[1],qr[0],negm,0,0,0), P0[6],P0[7],P0[8],P0[9],     pw0[2]=PKW(P0,4), pw0[3]=PKW(P0,6), pw0); \
    VRD(1); SBAR(); GAPA(C0=__builtin_amdgcn_mfma_f32_32x32x16_bf16(kf[2],qr[1],C0,0,0,0),   P0[10],P0[11],P0[12],P0[13], pw1[0]=PKW(P0,8), pw1[1]=PKW(P0,10), pw1); \
    VRD(5); SBAR(); GAPA(C1=__builtin_amdgcn_mfma_f32_32x32x16_bf16(kf[3],qr[1],C1,0,0,0),   P0[14],P0[15],P1[0],P1[1],   pw1[2]=PKW(P0,12),pw1[3]=PKW(P0,14), pw1); \
    VRD(2); SBAR(); GAPA(C0=__builtin_amdgcn_mfma_f32_32x32x16_bf16(kf[4],qr[2],C0,0,0,0),   P1[2],P1[3],P1[4],P1[5],     pw2[0]=PKW(P1,0), pw2[1]=PKW(P1,2), pw2); \
    VRD(6); SBAR(); GAPA(C1=__builtin_amdgcn_mfma_f32_32x32x16_bf16(kf[5],qr[2],C1,0,0,0),   P1[6],P1[7],P1[8],P1[9],     pw2[2]=PKW(P1,4), pw2[3]=PKW(P1,6), pw2); \
    VRD(3); SBAR(); GAPA(C0=__builtin_amdgcn_mfma_f32_32x32x16_bf16(kf[6],qr[3],C0,0,0,0),   P1[10],P1[11],P1[12],P1[13], pw3[0]=PKW(P1,8), pw3[1]=PKW(P1,10), pw3); \
    VRD(7); SBAR(); GAPA(C1=__builtin_amdgcn_mfma_f32_32x32x16_bf16(kf[7],qr[3],C1,0,0,0),   P1[14],P1[15],0.f,0.f,       pw3[2]=PKW(P1,12),pw3[3]=PKW(P1,14), pw3); \
    l_reg+=sacc; \
    if(GK){DMA_K((t)+3,sl_cur);} if(GV){DMA_V((t)+1,sl_next);} \
    CMASK(C0,C1,t); \
    { float a=MX3(C0[0],C0[1],C1[0]),b=MX3(C0[2],C0[3],C1[1]); a=MX3(a,C1[2],C1[3]); \
      _Pragma("unroll") for(int r=4;r<16;r+=4){a=MX3(a,C0[r],C0[r+1]);b=MX3(b,C0[r+2],C0[r+3]);a=MX3(a,C1[r],C1[r+1]);b=MX3(b,C1[r+2],C1[r+3]);} \
      float rm=__builtin_fmaxf(a,b); { auto rr=__builtin_amdgcn_permlane32_swap(__float_as_uint(rm),__float_as_uint(rm),false,false); rm=__builtin_fmaxf(__uint_as_float(rr[0]),__uint_as_float(rr[1])); } \
      resc=false; \
      if(__builtin_expect(__any(rm>(float)THRL),0)){ const float dl=__builtin_fmaxf(rm,0.f); mhat+=dl; \
        _Pragma("unroll") for(int r=0;r<16;++r){C0[r]-=dl;C1[r]-=dl;} \
        _Pragma("unroll") for(int r=0;r<16;++r)negm[r]=-mhat; asm volatile("":"+v"(negm)); \
        const float f=__builtin_amdgcn_exp2f(-dl); l_reg*=f; if(hi==0)wsf[r32]=f; resc=true; } } \
    SBAR(); \
    GAPB(o[0]=__builtin_amdgcn_mfma_f32_32x32x16_bf16(PAF(0),VFR(0),o[0],0,0,0), C0,0); \
    GAPB(o[1]=__builtin_amdgcn_mfma_f32_32x32x16_bf16(PAF(0),VFR(4),o[1],0,0,0), C0,4); \
    KRD(GL,0); GAPB(o[0]=__builtin_amdgcn_mfma_f32_32x32x16_bf16(PAF(1),VFR(1),o[0],0,0,0), C0,8); \
    KRD(GL,1); GAPB(o[1]=__builtin_amdgcn_mfma_f32_32x32x16_bf16(PAF(1),VFR(5),o[1],0,0,0), C0,12); \
    KRD(GL,2); GAPB(o[0]=__builtin_amdgcn_mfma_f32_32x32x16_bf16(PAF(2),VFR(2),o[0],0,0,0), C1,0); \
    KRD(GL,3); GAPB(o[1]=__builtin_amdgcn_mfma_f32_32x32x16_bf16(PAF(2),VFR(6),o[1],0,0,0), C1,4); \
    GAPB(o[0]=__builtin_amdgcn_mfma_f32_32x32x16_bf16(PAF(3),VFR(3),o[0],0,0,0), C1,8); \
    GAPB(o[1]=__builtin_amdgcn_mfma_f32_32x32x16_bf16(PAF(3),VFR(7),o[1],0,0,0), C1,12); \
    }while(0)
  #define ENDW(tt) do{ if((tt)+3<NT){WAIT_BAR(2);} else if((tt)+2<NT){WAIT_BAR(1);} else {WAIT_BAR(0);} }while(0)
  int t=1;
  for(;t+1<NT;t+=2){
    STEP(pB0,pB1,pA0,pA1,t,(t+3<NT),(t+1<NT),(t+1<NT));       ENDW(t);   RESC(); ROT();
    STEP(pA0,pA1,pB0,pB1,t+1,(t+4<NT),(t+2<NT),(t+2<NT));     ENDW(t+1); RESC(); ROT();
  }
  STEP(pB0,pB1,pA0,pA1,NT-1,false,false,false); RESC();
  { float sacc=pB0[0]+pB0[1]; _Pragma("unroll") for(int r=2;r<16;++r)sacc+=pB0[r]; _Pragma("unroll") for(int r=0;r<16;++r)sacc+=pB1[r]; l_reg+=sacc;
    SBAR(); pv(o, c.vb0 + sl_cur, pack8(pB0,0), pack8(pB0,8), pack8(pB1,0), pack8(pB1,8)); }
  l_out = l_reg;
  asm volatile("s_waitcnt lgkmcnt(0)\n\ts_barrier":::"memory");
  #undef WAIT_BAR
  #undef TILE_OF
  #undef DMA_K
  #undef DMA_V
  #undef CMASK
  #undef START
  #undef RESC
  #undef ROT
  #undef PKW
  #undef PAF
  #undef VFR
  #undef PIN
  #undef MX3
  #undef GAPA
  #undef EX
  #undef GAPB
  #undef VRD
  #undef KRD
  #undef STEP
  #undef ENDW
}

__device__ __forceinline__ void attn_unit(int b, int g, int qb, unsigned char* slab, LAS unsigned char* shm) {
    const bf16_t* Q = (const bf16_t*)(slab + SO_Q); const bf16_t* KV = (const bf16_t*)(slab + SO_KV); const bf16_t* KC = (const bf16_t*)(slab + SO_KC); const bf16_t* VC = (const bf16_t*)(slab + SO_VC);
    const float* gates = (const float*)(slab + SO_GATES); bf16_t* O = (bf16_t*)(slab + SO_O);
    Ctx c;
    const int tid = threadIdx.x;
    c.lane = tid & 63; c.r32 = c.lane & 31; c.hi = c.lane >> 5; c.wid = __builtin_amdgcn_readfirstlane(tid >> 6);
    const int kh = c.wid >> 1, qh = c.wid & 1, head = g * 4 + kh;
    c.ql = qh * 32 + c.r32; c.qb = qb; c.shm = shm; c.lds0 = (unsigned)(size_t)shm;
    c.wsf = (LAS float*)(shm + L_WS) + c.wid * 128;
    c.koff = c.lane * 64 + c.wid * 8;
    c.voff = (16 * (c.wid & 3) + (c.lane >> 2)) * 64 + (c.wid >> 2) * 32 + (c.lane & 3) * 8;
    c.kdst = c.lds0 + L_K + c.wid * 1024; c.vdst = c.lds0 + L_V + c.wid * 1024;
    c.vb0 = (int)(c.lds0 + L_V) + ((c.lane >> 4) & 1) * 32 + (c.lane & 3) * 8 + (4 * c.hi + ((c.lane & 15) >> 2)) * 64;
    const int t = qb * 64 + c.ql;
    const size_t mrow = (size_t)t;
    const size_t bg = (size_t)g;
    const bf16_t* KSb = KV + ((size_t)2 * 4 + g) * (SEQ * 64);
    const bf16_t* VSb = KV + ((size_t)3 * 4 + g) * (SEQ * 64);
    const bf16_t* KWb = KV + ((size_t)4 * 4 + g) * (SEQ * 64);
    const bf16_t* VWb = KV + ((size_t)5 * 4 + g) * (SEQ * 64);
    const bf16_t* KCb = KC + bg * 8192; const bf16_t* VCb = VC + bg * 8192;
    dma_k(c, KCb, 0, 0); dma_k(c, KCb, 1, 1); dma_v(c, VCb, 0, 0); dma_v(c, VCb, 1, 1);
    dma_k(c, KSb, 0, 2); dma_v(c, VSb, 0, 2);
    bf16x8 qr[4];
    { const bf16_t* Qw = Q + mrow * DM + head * 64 + c.hi * 8;
#pragma unroll
      for (int d0 = 0; d0 < 4; ++d0) qr[d0] = *(const bf16x8*)(Qw + d0 * 16); }
    const float* gp = gates + mrow * 48 + head * 3;
    const float g0 = gp[0], g1 = gp[1], g2 = gp[2];
    f32x16 ot[2];
    f32x16 o[2];
    const bool two = qb >= 16;
    ATT_WAIT_BAR(2);
    {
        f32x16 a0, a1, b0, b1;
        qkt(a0, a1, shm + L_K, qr, c.r32, c.hi);
        const int nmax = (t >= 31) ? ((t - 31) >> 4) : -1;
        range_mask(a0, a1, 0, nmax, c.hi);
        float rm = rowmax(a0, a1);
        if (two) { qkt(b0, b1, shm + L_K + SLOTB, qr, c.r32, c.hi); range_mask(b0, b1, 0, nmax - 64, c.hi); rm = fmaxf(rm, rowmax(b0, b1)); }
        const float mu = (rm == -INFINITY) ? 0.f : rm;
        float s = 0.f;
#pragma unroll
        for (int r = 0; r < 16; ++r) { a0[r] = __builtin_amdgcn_exp2f(a0[r] - mu); a1[r] = __builtin_amdgcn_exp2f(a1[r] - mu); s += a0[r] + a1[r]; }
        if (two) {
#pragma unroll
            for (int r = 0; r < 16; ++r) { b0[r] = __builtin_amdgcn_exp2f(b0[r] - mu); b1[r] = __builtin_amdgcn_exp2f(b1[r] - mu); s += b0[r] + b1[r]; }
        }
        s = halfsum(s);
        const float inv = (s > 0.f) ? 1.0f / s : 0.f;
#pragma unroll
        for (int r = 0; r < 16; ++r) { a0[r] *= inv; a1[r] *= inv; }
        if (two) {
#pragma unroll
            for (int r = 0; r < 16; ++r) { b0[r] *= inv; b1[r] *= inv; }
            int qlx = c.ql; LAUNDER(qlx);
            LAS float* IA = (LAS float*)(shm + L_IA) + (kh * 64 + qlx) * 33;
            LAS float* IB = (LAS float*)(shm + L_IB) + (kh * 64 + qlx) * 33;
#pragma unroll
            for (int i = 0; i < 4; ++i) {
                const int j = 2 * i + c.hi;
                IA[j]      = a0[4 * i] + a0[4 * i + 1] + a0[4 * i + 2] + 0.5f * a0[4 * i + 3]; IB[j + 1]  = 0.5f * a0[4 * i + 3];
                IA[j + 8]  = a1[4 * i] + a1[4 * i + 1] + a1[4 * i + 2] + 0.5f * a1[4 * i + 3]; IB[j + 9]  = 0.5f * a1[4 * i + 3];
                IA[j + 16] = b0[4 * i] + b0[4 * i + 1] + b0[4 * i + 2] + 0.5f * b0[4 * i + 3]; IB[j + 17] = 0.5f * b0[4 * i + 3];
                IA[j + 24] = b1[4 * i] + b1[4 * i + 1] + b1[4 * i + 2] + 0.5f * b1[4 * i + 3]; IB[j + 25] = 0.5f * b1[4 * i + 3];
            }
        }
        o[0] = f32x16{}; o[1] = f32x16{};
        pv(o, c.vb0, pack8(a0, 0), pack8(a0, 8), pack8(a1, 0), pack8(a1, 8));
        if (two) pv(o, c.vb0 + SLOTB, pack8(b0, 0), pack8(b0, 8), pack8(b1, 0), pack8(b1, 8));
        float cf[16]; row_bcast(g0, cf, c.wsf, c.r32, c.hi);
#pragma unroll
        for (int r = 0; r < 16; ++r) { ot[0][r] = o[0][r] * cf[r]; ot[1][r] = o[1][r] * cf[r]; }
    }
    ATT_WAIT_BAR(0);
    LAS unsigned* SEL = (LAS unsigned*)(shm + L_SEL);
    if (two) {
        int q = tid & 63, jg = tid >> 6; LAUNDER(q); LAUNDER(jg);
        LAS float* SC = (LAS float*)(shm + L_SC);
        const LAS float* IA = (const LAS float*)(shm + L_IA); const LAS float* IB = (const LAS float*)(shm + L_IB);
#pragma unroll
        for (int jj = 0; jj < 4; ++jj) { const int j = 4 * jg + jj; float sc = 0.f;
#pragma unroll
            for (int k = 0; k < 4; ++k) { sc += IA[(k * 64 + q) * 33 + j]; if (j > 0) sc += IB[(k * 64 + q) * 33 + j]; }
            const bool forced = (j == 0) || (j == qb) || (j == qb - 1);
            SC[q * 33 + j] = forced ? 1e30f : ((j <= qb) ? sc : -1e30f); }
        ATT_WAIT_BAR(0);
        unsigned nib = 0u;
        float sj[4];
#pragma unroll
        for (int jj = 0; jj < 4; ++jj) sj[jj] = SC[q * 33 + 4 * jg + jj];
        int rank[4] = {0, 0, 0, 0};
        for (int i = 0; i < 32; ++i) { const float si = SC[q * 33 + i];
#pragma unroll
            for (int jj = 0; jj < 4; ++jj) { const int j = 4 * jg + jj; rank[jj] += (si > sj[jj] || (si == sj[jj] && i < j)) ? 1 : 0; } }
#pragma unroll
        for (int jj = 0; jj < 4; ++jj) nib |= (rank[jj] < 16 ? 1u : 0u) << jj;
        ((LAS unsigned char*)(shm + L_NIB))[q * 8 + jg] = (unsigned char)nib;
        ATT_WAIT_BAR(0);
        if (tid < 64) { unsigned mk = 0u; int tq = tid; LAUNDER(tq);
#pragma unroll
            for (int k = 0; k < 8; ++k) mk |= (unsigned)((LAS unsigned char*)(shm + L_NIB))[tq * 8 + k] << (4 * k);
            SEL[tq] = mk; }
        ATT_WAIT_BAR(0);
    } else {
        if (tid < 64) SEL[tid] = (1u << (qb + 1)) - 1u;
        ATT_WAIT_BAR(0);
    }
    int lnx = c.lane, qlx2 = c.ql; LAUNDER(lnx); LAUNDER(qlx2);
    LAS float* accp = (LAS float*)(shm + L_IA) + c.wid * 2048 + lnx;
#pragma unroll
    for (int r = 0; r < 16; ++r) { accp[r * 64] = ot[0][r]; accp[(16 + r) * 64] = ot[1][r]; }
    unsigned um = SEL[lnx];
#pragma unroll
    for (int sft = 1; sft < 64; sft <<= 1) um |= (unsigned)__shfl_xor((int)um, sft);
    um = (unsigned)__builtin_amdgcn_readfirstlane((int)um);
    um &= (qb == 31) ? 0xffffffffu : ((1u << (qb + 1)) - 1u);
    const unsigned msel = SEL[qlx2];
    (void)um;
    {
        float l_sel; f32x16 osel[2];
        sel_stream<8>(c, KSb, VSb, qr, msel, qb, osel, l_sel);
        const float lt = halfsum(l_sel);
        float cf[16]; row_bcast((lt > 0.f) ? g1 / lt : 0.f, cf, c.wsf, c.r32, c.hi);
#pragma unroll
        for (int r = 0; r < 16; ++r) { accp[r * 64] += osel[0][r] * cf[r]; accp[(16 + r) * 64] += osel[1][r] * cf[r]; }
    }
    {
        const int lo_t = qb >= 8 ? qb - 8 : 0, nw = qb - lo_t + 1;
        dma_k(c, KWb, qb, 0); dma_v(c, VWb, qb, 0);
        if (nw > 1) { dma_k(c, KWb, qb - 1, 1); dma_v(c, VWb, qb - 1, 1); }
        BrState st; br_reset(st);
        int slot = 0;
        for (int j = 0; j < nw; ++j) {
            if (j + 1 < nw) ATT_WAIT_BAR(2); else ATT_WAIT_BAR(0);
            if (j + 2 < nw) { const int ps = (slot == 0) ? 2 : slot - 1; dma_k(c, KWb, qb - j - 2, ps); dma_v(c, VWb, qb - j - 2, ps); }
            const int tc = qb - j;
            bool use_range = false; int lo = 0, hv = 63;
            if (j == 0) { use_range = true; hv = c.ql; }
            else if (tc == qb - 8) { use_range = true; lo = c.ql + 1; }
            stream_step(c, slot, qr, true, use_range, lo, hv, j == 0, st);
            slot = (slot == 2) ? 0 : slot + 1;
        }
        const float lt = halfsum(st.l);
        float cf[16]; row_bcast((lt > 0.f) ? g2 / lt : 0.f, cf, c.wsf, c.r32, c.hi);
#pragma unroll
        for (int r = 0; r < 16; ++r) { ot[0][r] = accp[r * 64] + st.o[0][r] * cf[r]; ot[1][r] = accp[(16 + r) * 64] + st.o[1][r] * cf[r]; }
        LDS_WAIT();
    }
    {
        LAS bf16_t* stg = (LAS bf16_t*)(shm + L_IA) + c.wid * 4096;
        int lny = c.lane; LAUNDER(lny);
        LAS bf16_t* stw = stg + ((lny >> 5) * 4) * 64 + (lny & 31);
#pragma unroll
        for (int r = 0; r < 16; ++r) { const int orow = (r & 3) + 8 * (r >> 2);
#pragma unroll
            for (int d0 = 0; d0 < 2; ++d0) stw[orow * 64 + d0 * 32] = (bf16_t)(cvtpk(ot[d0][r], 0.f) & 0xffffu); }
        LDS_WAIT();
        bf16_t* Ow = O + ((size_t)qb * 64 + qh * 32) * DM + head * 64;
#pragma unroll
        for (int i = 0; i < 4; ++i) { const int row = i * 8 + (lny >> 3), chn = lny & 7; const u32x4 v = *(const LAS u32x4*)(stg + row * 64 + chn * 8); *(u32x4*)(Ow + (size_t)row * DM + chn * 8) = v; }
    }
    ATT_WAIT_BAR(0);
}
#undef SBAR
}

#define XB_TMO      128
#define XB_XCNT(j)  (256  + 64 * (j))
#define XB_XSUB(j)  (1280 + 64 * (j))
#define XB_XGEN(j)  (2304 + 64 * (j))
#define XB_TOP      3328
#define XB_TOPGEN   3392
#define XB_LSUB(j)  (3456 + 64 * (j))
#define XB_LGEN(j)  (4480 + 64 * (j))
#define XCD_BAR_WORDS 5504
#define XB_SPIN_CAP (1u << 18)
__device__ __forceinline__ unsigned xb_ld(unsigned* p)              { return __hip_atomic_load(p, __ATOMIC_RELAXED, __HIP_MEMORY_SCOPE_AGENT); }
__device__ __forceinline__ unsigned xb_add(unsigned* p, unsigned v) { return __hip_atomic_fetch_add(p, v, __ATOMIC_RELAXED, __HIP_MEMORY_SCOPE_AGENT); }
__device__ __forceinline__ unsigned xb_xcc_id() { return (unsigned)__builtin_amdgcn_s_getreg((3 << 11) | 20) & 0xFu; }
#define XB_SPIN(cond, bar) do { unsigned _sp = 0; while (cond) { __builtin_amdgcn_s_sleep(1); \
    if ((++_sp & 255u) == 0u) { if (xb_ld(&(bar)[XB_TMO])) break; if (_sp > XB_SPIN_CAP) { atomicAdd(&(bar)[XB_TMO], 1u); break; } } } } while (0)
struct XcdBarrier { unsigned* bar; unsigned x; volatile LAS unsigned* st; };
__device__ __forceinline__ XcdBarrier xcd_barrier_post(unsigned* bar, volatile LAS unsigned* st) {
    XcdBarrier b; b.bar = bar; b.x = xb_xcc_id(); b.st = st;
    if (threadIdx.x == 0) { st[2] = xb_add(&bar[XB_XCNT(b.x)], 1u); st[4] = b.x; }
    return b;
}
__device__ __forceinline__ void xcd_barrier_complete(unsigned* bar, unsigned x, unsigned& nloc, unsigned& nx, unsigned& uniform) {
    const unsigned G = gridDim.x * gridDim.y * gridDim.z;
    unsigned sum, cnt, mine, sp = 0u, uni;
    for (;;) {
        sum = 0u; cnt = 0u; mine = 0u; uni = 1u;
#pragma unroll
        for (unsigned j = 0; j < 16; ++j) { const unsigned c = xb_ld(&bar[XB_XCNT(j)]); sum += c; cnt += (c > 0u) ? 1u : 0u; mine = (j == x) ? c : mine;
            if (j < 8u ? (c != 32u) : (c != 0u)) uni = 0u; }
        if (sum == G) break;
        __builtin_amdgcn_s_sleep(1);
        if ((++sp & 255u) == 0u) { if (xb_ld(&bar[XB_TMO])) break; if (sp > XB_SPIN_CAP) { atomicAdd(&bar[XB_TMO], 1u); break; } }
    }
    nloc = mine > 0u ? mine : 1u; nx = cnt > 0u ? cnt : 1u;
    uniform = (uni != 0u && sum == G && G == 256u) ? 1u : 0u;
}
__device__ __forceinline__ void xcd_barrier(const XcdBarrier& b) {
    asm volatile("s_waitcnt vmcnt(0)" ::: "memory");
    __syncthreads();
    if (threadIdx.x == 0) {
        unsigned* bar = b.bar;
        __builtin_amdgcn_s_waitcnt(0);
        unsigned nloc = b.st[0], nx = b.st[1];
        if (nloc == 0u) { unsigned uf; xcd_barrier_complete(bar, b.x, nloc, nx, uf); b.st[0] = nloc; b.st[1] = nx; b.st[3] = uf; }
        const unsigned old = xb_add(&bar[XB_XSUB(b.x)], 1u);
        const unsigned gen = old / nloc;
        if (old + 1u == (gen + 1u) * nloc) {
            __builtin_amdgcn_fence(__ATOMIC_RELEASE, "agent");
            asm volatile("s_waitcnt vmcnt(0)" ::: "memory");
            const unsigned og = xb_add(&bar[XB_TOP], 1u);
            const unsigned tg = og / nx;
            if (og + 1u == (tg + 1u) * nx) xb_add(&bar[XB_TOPGEN], 1u);
            else XB_SPIN(xb_ld(&bar[XB_TOPGEN]) == tg, bar);
            __builtin_amdgcn_fence(__ATOMIC_ACQUIRE, "agent");
            xb_add(&bar[XB_XGEN(b.x)], 1u);
            asm volatile("s_waitcnt vmcnt(0)" ::: "memory");
        } else {
            XB_SPIN(xb_ld(&bar[XB_XGEN(b.x)]) == gen, bar);
            __builtin_amdgcn_fence(__ATOMIC_ACQUIRE, "agent");
            asm volatile("s_waitcnt vmcnt(0)" ::: "memory");
        }
    }
    __syncthreads();
}

__device__ __forceinline__ void xcd_local_barrier(const XcdBarrier& b) {
    asm volatile("s_waitcnt vmcnt(0)" ::: "memory");
    __syncthreads();
    if (threadIdx.x == 0) {
        unsigned* bar = b.bar;
        __builtin_amdgcn_s_waitcnt(0);
        const unsigned nloc = b.st[0];
        const unsigned old = xb_add(&bar[XB_LSUB(b.x)], 1u);
        const unsigned gen = old / nloc;
        if (old + 1u == (gen + 1u) * nloc) xb_add(&bar[XB_LGEN(b.x)], 1u);
        else XB_SPIN(xb_ld(&bar[XB_LGEN(b.x)]) == gen, bar);
        __builtin_amdgcn_fence(__ATOMIC_ACQUIRE, "agent");
        asm volatile("s_waitcnt vmcnt(0)" ::: "memory");
    }
    __syncthreads();
}

struct Args {
    const float *x, *c, *norm_gain, *w_ada, *b_ada, *w_a_in, *conv_w, *w_a_out, *w_qg, *q_gain, *w_o, *kv_norm_gain, *w_ada_kv, *b_ada_kv, *w_kv, *k_gain, *cmp_pe, *cmp_w1, *cmp_w2, *w_mlp1, *w_mlp2;
    float* out; unsigned char* ws; int ph_lo, ph_hi;
};

__device__ __forceinline__ void transpose_item(const float* W, int ldn, int srccol, int nvalid, int k0, bf16_t* WT, int Kd, int drow0, LAS float* scr, int lane) {
    if (nvalid == 32) {
        f32x4 t[8];
#pragma unroll
        for (int i = 0; i < 8; ++i) t[i] = __builtin_nontemporal_load((const f32x4*)(W + (size_t)(k0 + 8 * i + (lane >> 3)) * ldn + srccol + (lane & 7) * 4));
#pragma unroll
        for (int i = 0; i < 8; ++i) { LAS float* d = scr + (8 * i + (lane >> 3)) * 33 + (lane & 7) * 4; d[0] = t[i][0]; d[1] = t[i][1]; d[2] = t[i][2]; d[3] = t[i][3]; }
    } else {
#pragma unroll 8
        for (int i = 0; i < 32; ++i) { const int kk = 2 * i + (lane >> 5), n = lane & 31; scr[kk * 33 + n] = (n < nvalid) ? W[(size_t)(k0 + kk) * ldn + srccol + n] : 0.f; }
    }
    LDS_WAIT(); asm volatile("" ::: "memory");
    const int ch = lane & 7;
#pragma unroll
    for (int j = 0; j < 4; ++j) { const int n = (lane >> 3) + 8 * j; const LAS float* s = scr + (8 * ch) * 33 + n;
        u32x4 o; o.x = cvtpk(s[0 * 33], s[1 * 33]); o.y = cvtpk(s[2 * 33], s[3 * 33]); o.z = cvtpk(s[4 * 33], s[5 * 33]); o.w = cvtpk(s[6 * 33], s[7 * 33]);
        *(u32x4*)(WT + (size_t)(drow0 + n) * Kd + k0 + 8 * ch) = o; }
    LDS_WAIT(); asm volatile("" ::: "memory");
}
__device__ __forceinline__ int perm_head_cols(int d) { const int t = d >> 8, p = d & 255; return 256 * t + 64 * ((p >> 5) & 3) + 32 * (p >> 7) + (p & 31); }

constexpr int TI_AIN = 1536, TI_AOUT = 512, TI_M1 = 2048, TI_M2 = 2048, TI_KV = 768, TI_QG = 640, TI_O = 512, TI_C1 = 256, TI_C2 = 8;
constexpr int TI_TOTAL = TI_AIN + TI_AOUT + 2 * TI_M1 + 2 * TI_M2 + TI_KV + TI_QG + TI_O + 2 * TI_C1 + 2 * TI_C2;

__device__ __forceinline__ void p0_item(const Args& a, int it, LAS float* scr, int lane) {
    unsigned char* ws = a.ws;
    int r = it;
    if (r < TI_AIN) { const int kb = r / 96, nb = r % 96, d = 32 * nb; int src;
        if (d < 1024) src = d; else { const int t = (d - 1024) >> 8, p = (d - 1024) & 255; src = (p < 128) ? (1024 + 128 * t + p) : (2048 + 128 * t + (p - 128)); }
        transpose_item(a.w_a_in, 3072, src, 32, 64 * kb, (bf16_t*)(ws + WS_WAIN), 1024, d, scr, lane); return; }
    r -= TI_AIN;
    if (r < TI_AOUT) { const int kb = r / 32, nb = r % 32; transpose_item(a.w_a_out, 1024, 32 * nb, 32, 64 * kb, (bf16_t*)(ws + WS_WAOUT), 1024, 32 * nb, scr, lane); return; }
    r -= TI_AOUT;
    if (r < 2 * TI_M1) { const int L = r / TI_M1, q = r % TI_M1, kb = q / 128, nb = q % 128;
        transpose_item(a.w_mlp1 + (size_t)L * DM * FF, FF, 32 * nb, 32, 64 * kb, (bf16_t*)(ws + WS_WM1) + (size_t)L * FF * DM, DM, 32 * nb, scr, lane); return; }
    r -= 2 * TI_M1;
    if (r < 2 * TI_M2) { const int L = r / TI_M2, q = r % TI_M2, kb = q / 32, nb = q % 32;
        transpose_item(a.w_mlp2 + (size_t)L * FF * DM, DM, 32 * nb, 32, 64 * kb, (bf16_t*)(ws + WS_WM2) + (size_t)L * DM * FF, FF, 32 * nb, scr, lane); return; }
    r -= 2 * TI_M2;
    if (r < TI_KV) { const int kb = r / 48, nb = r % 48, d = 32 * nb;
        transpose_item(a.w_kv, 1536, perm_head_cols(d), 32, 64 * kb, (bf16_t*)(ws + WS_WKVQ), DM, d, scr, lane); return; }
    r -= TI_KV;
    if (r < TI_QG) { const int kb = r / 40, nb = r % 40, d = 32 * nb; int src, nv = 32;
        if (d < 1024) src = perm_head_cols(d); else { const int p = d - 1024; src = 1024 + p; nv = 48 - p; nv = nv < 0 ? 0 : (nv > 32 ? 32 : nv); if (nv == 0) src = 0; }
        transpose_item(a.w_qg, 1072, src, nv, 64 * kb, (bf16_t*)(ws + WS_WKVQ), DM, 1536 + d, scr, lane); return; }
    r -= TI_QG;
    if (r < TI_O) { const int kb = r / 32, nb = r % 32; transpose_item(a.w_o, 1024, 32 * nb, 32, 64 * kb, (bf16_t*)(ws + WS_WO), 1024, 32 * nb, scr, lane); return; }
    r -= TI_O;
    if (r < 2 * TI_C1) { const int kv = r / TI_C1, q = r % TI_C1, kb = q / 8, nb = q % 8;
        transpose_item(a.cmp_w1 + (size_t)kv * 2048 * 256, 256, 32 * nb, 32, 64 * kb, (bf16_t*)(ws + WS_WC1) + (size_t)kv * 256 * 2048, 2048, 32 * nb, scr, lane); return; }
    r -= 2 * TI_C1;
    { const int kv = r / TI_C2, q = r % TI_C2, kb = q / 2, nb = q % 2;
        transpose_item(a.cmp_w2 + (size_t)kv * 256 * 64, 64, 32 * nb, 32, 64 * kb, (bf16_t*)(ws + WS_WC2) + (size_t)kv * 64 * 256, 256, 32 * nb, scr, lane); }
}

__device__ __forceinline__ void p0_mods(const Args& a, LAS unsigned char* lds, int vblk, int G) {
    LAS float* cact = (LAS float*)lds;
    LAS float* red = (LAS float*)(lds + 32768);
    const int tid = threadIdx.x, lane = tid & 63, wave = tid >> 6;
    bool have = false;
    for (int u = vblk; u < 224; u += G) {
        if (!have) { for (int i = tid; i < 8 * DM; i += 512) { const float cv = a.c[i]; cact[i] = cv / (1.0f + __expf(-cv)); } have = true; }
        __syncthreads();
        const int col = u * 64 + lane;
        const float* W; const float* bias; float* dst; int N, c0;
        if (col < 6144) { W = a.w_ada; bias = a.b_ada; dst = (float*)(a.ws + WS_MOD0); N = 6144; c0 = col; }
        else if (col < 12288) { W = a.w_ada + (size_t)DM * 6144; bias = a.b_ada + 6144; dst = (float*)(a.ws + WS_MOD1); N = 6144; c0 = col - 6144; }
        else { W = a.w_ada_kv; bias = a.b_ada_kv; dst = (float*)(a.ws + WS_MODKV); N = 2048; c0 = col - 12288; }
        float acc[8];
#pragma unroll
        for (int b = 0; b < 8; ++b) acc[b] = 0.f;
        const float* wp = W + (size_t)(wave * 128) * N + c0;
        const LAS float* cp = cact + wave * 128;
#pragma unroll 8
        for (int k = 0; k < 128; ++k) { const float w = __builtin_nontemporal_load(wp + (size_t)k * N);
#pragma unroll
            for (int b = 0; b < 8; ++b) acc[b] += w * cp[b * DM + k]; }
#pragma unroll
        for (int b = 0; b < 8; ++b) red[(wave * 8 + b) * 64 + lane] = acc[b];
        __syncthreads();
        { const int b = wave; float sacc = bias[c0];
#pragma unroll
          for (int w = 0; w < 8; ++w) sacc += red[(w * 8 + b) * 64 + lane];
          dst[(size_t)b * N + c0] = sacc; }
        __syncthreads();
    }
    __syncthreads();
}

__device__ __forceinline__ void p1_norm_row2(const Args& a, int m0, int lane) {
    const int b = m0 >> 11;
    const float* mod0 = (const float*)(a.ws + WS_MOD0) + (size_t)b * 6144;
    const f32x4* xr = (const f32x4*)(a.x + (size_t)m0 * DM) + lane;
    f32x4 v[2][4]; float s0 = 0.f, s1 = 0.f;
#pragma unroll
    for (int j = 0; j < 4; ++j) { v[0][j] = __builtin_nontemporal_load(xr + 64 * j); v[1][j] = __builtin_nontemporal_load(xr + 256 + 64 * j); }
#pragma unroll
    for (int j = 0; j < 4; ++j) { s0 += (v[0][j][0] * v[0][j][0] + v[0][j][1] * v[0][j][1]) + (v[0][j][2] * v[0][j][2] + v[0][j][3] * v[0][j][3]);
                                  s1 += (v[1][j][0] * v[1][j][0] + v[1][j][1] * v[1][j][1]) + (v[1][j][2] * v[1][j][2] + v[1][j][3] * v[1][j][3]); }
#pragma unroll
    for (int o = 1; o < 64; o <<= 1) { s0 += __shfl_xor(s0, o); s1 += __shfl_xor(s1, o); }
    const float r0 = rsqrtf(s0 * (1.0f / DM) + EPS), r1 = rsqrtf(s1 * (1.0f / DM) + EPS);
    u32x2* o8 = (u32x2*)((bf16_t*)(a.ws + WS_A2) + (size_t)m0 * DM) + lane;
#pragma unroll
    for (int j = 0; j < 4; ++j) { const int col = 4 * lane + 256 * j;
        const f32x4 gn = *(const f32x4*)(a.norm_gain + col), sh = *(const f32x4*)(mod0 + col), sc = *(const f32x4*)(mod0 + 1024 + col) + 1.0f;
        const f32x4 h0 = (v[0][j] * r0 * gn) * sc + sh, h1 = (v[1][j] * r1 * gn) * sc + sh;
        u32x2 w; w.x = cvtpk(h0[0], h0[1]); w.y = cvtpk(h0[2], h0[3]); o8[64 * j] = w;
        w.x = cvtpk(h1[0], h1[1]); w.y = cvtpk(h1[2], h1[3]); o8[256 + 64 * j] = w; }
}
__device__ __forceinline__ void p1_bias_task(const bf16_t* Wt, int n0, const float* shift, int shift_stride, float* bias, int bias_stride, int lane) {
    const int r = lane & 15, kq = lane >> 4;
    const bf16_t* wp = Wt + (size_t)(n0 + r) * DM + 8 * kq;
    const float* sp = shift + (size_t)(r & 7) * shift_stride + 8 * kq;
    f32x4 acc = (f32x4){0.f, 0.f, 0.f, 0.f};
#pragma unroll 8
    for (int k0 = 0; k0 < DM; k0 += 32) {
        const bf16x8 bf = *(const bf16x8*)(wp + k0);
        const f32x4 s0 = *(const f32x4*)(sp + k0), s1 = *(const f32x4*)(sp + k0 + 4);
        u32x4 aw; aw.x = cvtpk(s0[0], s0[1]); aw.y = cvtpk(s0[2], s0[3]); aw.z = cvtpk(s1[0], s1[1]); aw.w = cvtpk(s1[2], s1[3]);
        if (r >= 8) aw = (u32x4){0u, 0u, 0u, 0u};
        acc = __builtin_amdgcn_mfma_f32_16x16x32_bf16(__builtin_bit_cast(bf16x8, aw), bf, acc, 0, 0, 0);
    }
    if (kq < 2) {
#pragma unroll
        for (int e = 0; e < 4; ++e) bias[(size_t)(4 * kq + e) * bias_stride + n0 + r] = acc[e];
    }
}
__device__ __forceinline__ void p1_pebias(const Args& a, int idx, int lane) {
    const int kv = idx >> 8;
    const bf16_t* wrow = (const bf16_t*)(a.ws + WS_WC1) + (size_t)idx * 2048;
    const float* pe = a.cmp_pe + (size_t)kv * 2048;
    float d = 0.f;
#pragma unroll
    for (int j = 0; j < 4; ++j) { const int k = (lane + 64 * j) * 8; const u32x4 w = *(const u32x4*)(wrow + k); const f32x4 p0 = *(const f32x4*)(pe + k), p1 = *(const f32x4*)(pe + k + 4);
        d += p0[0] * bf_lo(w.x) + p0[1] * bf_hi(w.x) + p0[2] * bf_lo(w.y) + p0[3] * bf_hi(w.y) + p1[0] * bf_lo(w.z) + p1[1] * bf_hi(w.z) + p1[2] * bf_lo(w.w) + p1[3] * bf_hi(w.w); }
    d = wave_sum(d);
    if (lane == 0) ((float*)(a.ws + WS_PEB))[idx] = d;
}

__device__ __forceinline__ void unpack8(const u32x4 w, float (&f)[8]) { f[0] = bf_lo(w.x); f[1] = bf_hi(w.x); f[2] = bf_lo(w.y); f[3] = bf_hi(w.y); f[4] = bf_lo(w.z); f[5] = bf_hi(w.z); f[6] = bf_lo(w.w); f[7] = bf_hi(w.w); }
__device__ __forceinline__ void p3_conv(const Args& a, int gtid, int nthreads) {
    for (int it0 = gtid; it0 < 128 * 2048; it0 += nthreads) {
        const int pass = it0 / nthreads, vt = it0 - pass * nthreads;
        const int it = (nthreads == 131072) ? ((vt >> 14) * 32768 + pass * 16384 + (vt & 16383)) : it0;
        const int cch = it & 127, rch = it >> 7, col = cch * 8, r0 = (rch * 8) & (SEQ - 1);
        unsigned char* slab = a.ws + WS_R + (size_t)((rch * 8) >> 11) * SLAB;
        const bf16_t* GB = (const bf16_t*)(slab + SO_GB); const bf16_t* V = (const bf16_t*)(slab + SO_V); bf16_t* Y = (bf16_t*)(slab + SO_Y);
        float w0[8], w1[8], w2[8];
        { const f32x4 t0 = *(const f32x4*)(a.conv_w + col), t1 = *(const f32x4*)(a.conv_w + col + 4); w0[0] = t0[0]; w0[1] = t0[1]; w0[2] = t0[2]; w0[3] = t0[3]; w0[4] = t1[0]; w0[5] = t1[1]; w0[6] = t1[2]; w0[7] = t1[3]; }
        { const f32x4 t0 = *(const f32x4*)(a.conv_w + 1024 + col), t1 = *(const f32x4*)(a.conv_w + 1024 + col + 4); w1[0] = t0[0]; w1[1] = t0[1]; w1[2] = t0[2]; w1[3] = t0[3]; w1[4] = t1[0]; w1[5] = t1[1]; w1[6] = t1[2]; w1[7] = t1[3]; }
        { const f32x4 t0 = *(const f32x4*)(a.conv_w + 2048 + col), t1 = *(const f32x4*)(a.conv_w + 2048 + col + 4); w2[0] = t0[0]; w2[1] = t0[1]; w2[2] = t0[2]; w2[3] = t0[3]; w2[4] = t1[0]; w2[5] = t1[1]; w2[6] = t1[2]; w2[7] = t1[3]; }
        float vm2[8], vm1[8];
        if ((r0 & (SEQ - 1)) != 0) { unpack8(*(const u32x4*)(V + (size_t)(r0 - 2) * DM + col), vm2); unpack8(*(const u32x4*)(V + (size_t)(r0 - 1) * DM + col), vm1); }
        else {
#pragma unroll
            for (int e = 0; e < 8; ++e) { vm2[e] = 0.f; vm1[e] = 0.f; } }
#pragma unroll
        for (int i = 0; i < 8; ++i) { float vc[8], gb[8], y[8];
            unpack8(*(const u32x4*)(V + (size_t)(r0 + i) * DM + col), vc); unpack8(*(const u32x4*)(GB + (size_t)(r0 + i) * DM + col), gb);
#pragma unroll
            for (int e = 0; e < 8; ++e) { y[e] = gb[e] * (w2[e] * vc[e] + w1[e] * vm1[e] + w0[e] * vm2[e]); vm2[e] = vm1[e]; vm1[e] = vc[e]; }
            u32x4 w; w.x = cvtpk(y[0], y[1]); w.y = cvtpk(y[2], y[3]); w.z = cvtpk(y[4], y[5]); w.w = cvtpk(y[6], y[7]);
            *(u32x4*)(Y + (size_t)(r0 + i) * DM + col) = w; }
    }
}

__device__ __forceinline__ float gelu_tanh(float x) {
    const float z = 0.7978845608028654f * (x + 0.044715f * x * x * x);
    const float e = __builtin_amdgcn_exp2f(z * 2.8853900817779268f);
    const float th = 1.0f - 2.0f / (e + 1.0f);
    return 0.5f * x * (1.0f + th);
}
constexpr int C_CH = 2064;
constexpr int C_RB0 = 68608;
constexpr int C_HOFF = C_RB0, C_HROW = 528;
__device__ __forceinline__ void p8_unit(const Args& a, int u, LAS unsigned char* lds) {
    const int tid = threadIdx.x, lane = tid & 63, wid = __builtin_amdgcn_readfirstlane(tid >> 6), r = lane & 31, h = lane >> 5;
    const int kv = u >> 7, bg = (u >> 2) & 31, rq = u & 3;
    unsigned char* slab = a.ws + WS_R + (size_t)(bg >> 2) * SLAB;
    const bf16_t* src = (const bf16_t*)(slab + SO_KV) + ((size_t)(kv * 4 + (bg & 3)) * SEQ + 512 * rq) * 64;
    __syncthreads();
    { u32x4 v[8];
#pragma unroll
      for (int j = 0; j < 8; ++j) v[j] = *(const u32x4*)(src + (size_t)(tid + 512 * j) * 8);
      u32x4 vl = (u32x4){0u, 0u, 0u, 0u};
      if (tid < 128 && rq != 3) vl = *(const u32x4*)(src + (size_t)32 * 1024 + tid * 8);
#pragma unroll
      for (int j = 0; j < 8; ++j) { const int idx = tid + 512 * j; *(LAS u32x4*)(lds + (idx >> 7) * C_CH + (idx & 127) * 16) = v[j]; }
      if (tid < 128) *(LAS u32x4*)(lds + 32 * C_CH + tid * 16) = vl; }
    __syncthreads();
    f32x16 acc = f32x16{};
    const unsigned lds0 = (unsigned)(size_t)lds;
    const bf16_t* Wsrc = (const bf16_t*)(a.ws + WS_WC1) + (size_t)(kv * 256) * 2048;
    const int drow = 16 * wid + (lane >> 2);
    const bf16_t* dsrc0 = Wsrc + (size_t)drow * 2048 + 8 * ((lane & 3) ^ ((drow >> 2) & 3));
    const bf16_t* dsrc1 = dsrc0 + (size_t)128 * 2048;
    const unsigned ddst0 = lds0 + C_RB0 + wid * 1024, ddst1 = ddst0 + 8192;
    const int brow = 32 * wid + r;
    const unsigned boff = C_RB0 + brow * 64, bkey = (brow >> 2) & 3;
#define P8_DMA(stg) do { att::glds16(dsrc0 + 32 * (stg), (unsigned)__builtin_amdgcn_readfirstlane(ddst0 + ((stg) & 3) * 16384)); att::glds16(dsrc1 + 32 * (stg), (unsigned)__builtin_amdgcn_readfirstlane(ddst1 + ((stg) & 3) * 16384)); } while (0)
#define P8_STEP(stg, WAITN) do { asm volatile("s_waitcnt vmcnt(" #WAITN ") lgkmcnt(0)\n\ts_barrier" ::: "memory"); \
        if ((stg) + 3 < 64) P8_DMA((stg) + 3); \
        { const LAS unsigned char* bp = lds + boff + ((stg) & 3) * 16384; \
          const LAS unsigned char* ap = lds + (r + ((stg) >> 5)) * C_CH + ((32 * (stg)) & 1023) * 2 + 16 * h; \
          const bf16x8 a0 = *(const LAS bf16x8*)ap, a1 = *(const LAS bf16x8*)(ap + 32); \
          const bf16x8 b0 = *(const LAS bf16x8*)(bp + 16 * ((unsigned)h ^ bkey)), b1 = *(const LAS bf16x8*)(bp + 16 * ((unsigned)(2 + h) ^ bkey)); \
          acc = __builtin_amdgcn_mfma_f32_32x32x16_bf16(a0, b0, acc, 0, 0, 0); acc = __builtin_amdgcn_mfma_f32_32x32x16_bf16(a1, b1, acc, 0, 0, 0); } } while (0)
    P8_DMA(0); P8_DMA(1); P8_DMA(2);
    for (int s4 = 0; s4 < 60; s4 += 4) { P8_STEP(s4, 4); P8_STEP(s4 + 1, 4); P8_STEP(s4 + 2, 4); P8_STEP(s4 + 3, 4); }
    P8_STEP(60, 4); P8_STEP(61, 4); P8_STEP(62, 2); P8_STEP(63, 0);
    asm volatile("s_waitcnt lgkmcnt(0)\n\ts_barrier" ::: "memory");
#undef P8_DMA
#undef P8_STEP
    { const float pb = ((const float*)(a.ws + WS_PEB))[kv * 256 + 32 * wid + r];
      LAS bf16_t* H = (LAS bf16_t*)(lds + C_HOFF);
#pragma unroll
      for (int rg = 0; rg < 16; ++rg) { const int row = att::crow(rg, h); H[row * (C_HROW / 2) + 32 * wid + r] = (bf16_t)(cvtpk(gelu_tanh(acc[rg] + pb), 0.f) & 0xffffu); } }
    __syncthreads();
    if (wid == 0) {
        f32x16 o0 = f32x16{}, o1 = f32x16{};
        const bf16_t* W2 = (const bf16_t*)(a.ws + WS_WC2) + (size_t)kv * 64 * 256;
#pragma unroll
        for (int s = 0; s < 16; ++s) {
            const bf16x8 af = *(const LAS bf16x8*)(lds + C_HOFF + r * C_HROW + (16 * s + 8 * h) * 2);
            const bf16x8 b0 = *(const bf16x8*)(W2 + (size_t)r * 256 + 16 * s + 8 * h), b1 = *(const bf16x8*)(W2 + (size_t)(32 + r) * 256 + 16 * s + 8 * h);
            o0 = __builtin_amdgcn_mfma_f32_32x32x16_bf16(af, b0, o0, 0, 0, 0); o1 = __builtin_amdgcn_mfma_f32_32x32x16_bf16(af, b1, o1, 0, 0, 0);
        }
        const float gk0 = a.k_gain[r], gk1 = a.k_gain[32 + r];
        bf16_t* dst = (bf16_t*)(slab + (kv == 0 ? SO_KC : SO_VC)) + (size_t)(bg & 3) * 8192;
#pragma unroll
        for (int rg = 0; rg < 16; ++rg) { float v0 = o0[rg], v1 = o1[rg];
            if (kv == 0) { float ss = v0 * v0 + v1 * v1;
#pragma unroll
                for (int sft = 1; sft < 32; sft <<= 1) ss += __shfl_xor(ss, sft);
                const float rs = rsqrtf(ss * (1.0f / 64.0f) + EPS); v0 *= rs * gk0; v1 *= rs * gk1; }
            const int n = 32 * rq + att::crow(rg, h);
            if (n == 127) { v0 = 0.f; v1 = 0.f; }
            dst[n * 64 + r] = (bf16_t)(cvtpk(v0, 0.f) & 0xffffu); dst[n * 64 + 32 + r] = (bf16_t)(cvtpk(v1, 0.f) & 0xffffu); }
    }
}

__device__ __forceinline__ void p4_fixup(const Args& a, int pm) {
    const int tid = threadIdx.x;
    if (tid < 256) {
        const int rr = tid >> 7, cc = (tid & 127) * 8, pml = pm & 7, srow = pml * 256 + rr;
        unsigned char* slab = a.ws + WS_R + (size_t)(pm >> 3) * SLAB;
        const bf16_t* V = (const bf16_t*)(slab + SO_V); const bf16_t* GBH = (const bf16_t*)(slab + SO_GB) + (size_t)pml * 2 * DM; bf16_t* Y = (bf16_t*)(slab + SO_Y);
        float gb[8], v0[8], v1[8], v2[8], y[8];
        unpack8(*(const u32x4*)(GBH + (size_t)rr * DM + cc), gb);
        unpack8(*(const u32x4*)(V + (size_t)srow * DM + cc), v0);
        if (srow >= 1) unpack8(*(const u32x4*)(V + (size_t)(srow - 1) * DM + cc), v1); else {
#pragma unroll
            for (int e = 0; e < 8; ++e) v1[e] = 0.f; }
        if (srow >= 2) unpack8(*(const u32x4*)(V + (size_t)(srow - 2) * DM + cc), v2); else {
#pragma unroll
            for (int e = 0; e < 8; ++e) v2[e] = 0.f; }
#pragma unroll
        for (int e = 0; e < 8; ++e) y[e] = gb[e] * (a.conv_w[2 * DM + cc + e] * v0[e] + a.conv_w[DM + cc + e] * v1[e] + a.conv_w[cc + e] * v2[e]);
        u32x4 w; w.x = cvtpk(y[0], y[1]); w.y = cvtpk(y[2], y[3]); w.z = cvtpk(y[4], y[5]); w.w = cvtpk(y[6], y[7]);
        *(u32x4*)(Y + (size_t)srow * DM + cc) = w;
    }
}

__global__ void __launch_bounds__(NWAVES * 64, 2) yoco_fwd(Args args) {
    extern __shared__ __attribute__((aligned(16))) unsigned char lds_raw[];
    LAS unsigned char* lds = (LAS unsigned char*)lds_raw;
    const int tid = threadIdx.x, lane = tid & 63, wave = __builtin_amdgcn_readfirstlane(tid >> 6);
    const int G = gridDim.x, bx = blockIdx.x;
    int vcu = (G % 8 == 0) ? (bx % 8) * (G / 8) + bx / 8 : bx;
    int cid = bx;
    const int gw = vcu * NWAVES + wave, NGW = G * NWAVES;
    unsigned char* ws = args.ws;
    const int lo = args.ph_lo, hi = args.ph_hi;
    volatile LAS unsigned* MISC = (volatile LAS unsigned*)(lds + LDS_BYTES - 256);
    if (tid < 8) MISC[tid] = 0u;
    __syncthreads();
    XcdBarrier bar; bar.bar = (unsigned*)(ws + WS_BAR); bar.x = 0; bar.st = MISC;
    if (hi - lo > 1) bar = xcd_barrier_post((unsigned*)(ws + WS_BAR), MISC);
#define IN(k) (lo <= (k) && (k) < hi)
#define SEAM(k) do { if (IN(k) && IN((k) + 1)) xcd_barrier(bar); } while (0)
#define LSEAM(k) do { if (IN(k) && IN((k) + 1)) { if (local_ok) xcd_local_barrier(bar); else xcd_barrier(bar); } } while (0)
    bool local_ok = false;
    float* MOD0 = (float*)(ws + WS_MOD0); float* MOD1 = (float*)(ws + WS_MOD1); float* MODKV = (float*)(ws + WS_MODKV);
    float* SS1 = (float*)(ws + WS_SS1); float* SS2 = (float*)(ws + WS_SS2); float* SS3 = (float*)(ws + WS_SS3);
    bf16_t* A1 = (bf16_t*)(ws + WS_A1); bf16_t* A2 = (bf16_t*)(ws + WS_A2);
    bf16_t* HB = (bf16_t*)(ws + WS_H);

    if (IN(0)) {
        p0_mods(args, lds, vcu, G);
        LAS float* scr = (LAS float*)(lds + wave * 16384);
        for (int it = gw; it < TI_TOTAL; it += NGW) p0_item(args, it, scr, lane);
    }
    SEAM(0);
    if (IN(1)) {
        for (int m = gw; m < M_TOK / 2; m += NGW) p1_norm_row2(args, 2 * m, lane);
        for (int it = gw; it < (2 * FF + NKVQ) / 16 + 512; it += NGW) {
            const int n = it * 16;
            if (n < FF) p1_bias_task((const bf16_t*)(ws + WS_WM1), n, MOD0 + 3072, 6144, (float*)(ws + WS_BM1L0), FF, lane);
            else if (n < 2 * FF) p1_bias_task((const bf16_t*)(ws + WS_WM1) + (size_t)FF * DM, n - FF, MOD1 + 3072, 6144, (float*)(ws + WS_BM1L1), FF, lane);
            else if (n < 2 * FF + 1536) p1_bias_task((const bf16_t*)(ws + WS_WKVQ), n - 2 * FF, MODKV, 2048, (float*)(ws + WS_BKVQ), NKVQ, lane);
            else if (n < 2 * FF + NKVQ) p1_bias_task((const bf16_t*)(ws + WS_WKVQ), n - 2 * FF, MOD1, 6144, (float*)(ws + WS_BKVQ), NKVQ, lane);
            else p1_pebias(args, it - (2 * FF + NKVQ) / 16, lane);
        }
    }
    SEAM(1);
    if (hi - lo > 1 && lo <= 1) {
        local_ok = MISC[3] != 0u;
        if (local_ok) { const int x = (int)MISC[4], rk = (int)MISC[2]; vcu = x * 32 + rk; cid = rk * 8 + x; }
    }
    if (IN(2)) {
        pg8::Gemm g{A2, A2, 1 << 30, (const bf16_t*)(ws + WS_WAIN), M_TOK, 3072, DM, (size_t)SEQ * DM * 2}; pg8::StaticOrder S; S.init_ain(G, cid);
        pg8::EpiAin E{ws + WS_R, args.conv_w};
        pg8::gemm_phase(lds, g, S, E);
    }
    LSEAM(2);
    if (IN(4)) {
        pg8::Gemm g{(const bf16_t*)(ws + WS_R + SO_Y), (const bf16_t*)(ws + WS_R + SO_Y), 1 << 30, (const bf16_t*)(ws + WS_WAOUT), M_TOK, DM, DM, SLAB}; pg8::StaticOrder S; S.init(M_TOK, DM, G, cid);
        { pg8::Unit fu; for (int i = 0; S.next(i, fu); ++i) p4_fixup(args, fu.pm); asm volatile("s_waitcnt vmcnt(0)" ::: "memory"); __syncthreads(); }
        pg8::EpiRes<1, 0, 2> E{args.x, nullptr, MOD0 + 2048, 6144, args.norm_gain + 1024, MOD0 + 4096, 6144, A1, nullptr, nullptr, 0, nullptr, SS1, nullptr, nullptr, 0};
        pg8::gemm_phase(lds, g, S, E);
    }
    LSEAM(4);
    if (IN(5)) {
        pg8::Gemm g{A1, A1, 1 << 30, (const bf16_t*)(ws + WS_WM1), M_TOK, FF, DM, (size_t)SEQ * DM * 2}; pg8::StaticOrder S; S.init(M_TOK, FF, G, cid);
        pg8::EpiMlp1 E{HB, (const float*)(ws + WS_BM1L0), SS1};
        pg8::gemm_phase(lds, g, S, E);
    }
    LSEAM(5);
    if (IN(6)) {
        pg8::Gemm g{HB, HB, 1 << 30, (const bf16_t*)(ws + WS_WM2), M_TOK, DM, FF, (size_t)SEQ * FF * 2}; pg8::StaticOrder S; S.init(M_TOK, DM, G, cid);
        pg8::EpiRes<2, 2, 2> E{A1, nullptr, MOD0 + 5120, 6144, args.kv_norm_gain, MODKV + 1024, 2048, A1, args.norm_gain + 2048, MOD1 + 1024, 6144, A2, SS2, args.norm_gain + 1024, MOD0 + 4096, 6144};
        pg8::gemm_phase(lds, g, S, E);
    }
    LSEAM(6);
    if (IN(7)) {
        pg8::Gemm g{A1, A2, 6, (const bf16_t*)(ws + WS_WKVQ), M_TOK, NKVQ, DM, (size_t)SEQ * DM * 2}; pg8::StaticOrder S; S.init(M_TOK, NKVQ, G, cid);
        pg8::EpiKVQ E{ws + WS_R, (const float*)(ws + WS_BKVQ), SS2, args.k_gain, args.q_gain};
        pg8::gemm_phase(lds, g, S, E);
    }
    LSEAM(7);
    if (IN(8)) { for (int v = vcu; v < 256; v += G) { const int rk = v & 31; p8_unit(args, ((rk >> 4) << 7) | ((((v >> 5) << 2) | ((rk >> 2) & 3)) << 2) | (rk & 3), lds); } __syncthreads(); }
    LSEAM(8);
    if (IN(9)) {
        for (int v = vcu; v < 256; v += G) { const int bgp = v >> 3, s = v & 7;
            for (int i = 0; i < 4; ++i) { const int qb = (i == 0) ? s : (i == 1) ? 15 - s : (i == 2) ? 16 + s : 31 - s;
                att::attn_unit(bgp >> 2, bgp & 3, qb, ws + WS_R + (size_t)(bgp >> 2) * SLAB, lds); } }
    }
    LSEAM(9);
    if (IN(10)) {
        pg8::Gemm g{(const bf16_t*)(ws + WS_R + SO_O), (const bf16_t*)(ws + WS_R + SO_O), 1 << 30, (const bf16_t*)(ws + WS_WO), M_TOK, DM, DM, SLAB}; pg8::StaticOrder S; S.init(M_TOK, DM, G, cid);
        pg8::EpiRes<1, 2, 2> E{A2, nullptr, MOD1 + 2048, 6144, args.norm_gain + 3072, MOD1 + 4096, 6144, A1, nullptr, nullptr, 0, nullptr, SS3, args.norm_gain + 2048, MOD1 + 1024, 6144};
        pg8::gemm_phase(lds, g, S, E);
    }
    LSEAM(10);
    if (IN(11)) {
        pg8::Gemm g{A1, A1, 1 << 30, (const bf16_t*)(ws + WS_WM1) + (size_t)FF * DM, M_TOK, FF, DM, (size_t)SEQ * DM * 2}; pg8::StaticOrder S; S.init(M_TOK, FF, G, cid);
        pg8::EpiMlp1 E{HB, (const float*)(ws + WS_BM1L1), SS3};
        pg8::gemm_phase(lds, g, S, E);
    }
    LSEAM(11);
    if (IN(12)) {
        pg8::Gemm g{HB, HB, 1 << 30, (const bf16_t*)(ws + WS_WM2) + (size_t)DM * FF, M_TOK, DM, FF, (size_t)SEQ * FF * 2}; pg8::StaticOrder S; S.init(M_TOK, DM, G, cid);
        pg8::EpiRes<0, 2, 0> E{A1, args.out, MOD1 + 5120, 6144, nullptr, nullptr, 0, nullptr, nullptr, nullptr, 0, nullptr, nullptr, args.norm_gain + 3072, MOD1 + 4096, 6144};
        pg8::gemm_phase(lds, g, S, E);
    }
#undef IN
#undef SEAM
}

extern "C" void kernel_launch(void* const* d_in, const int* in_sizes, int n_in, void* d_out, int out_size, void* d_ws, size_t ws_size, hipStream_t stream) {
    static int grid = 0;
    if (grid == 0) {
        if (n_in != 21 || in_sizes[0] != M_TOK * DM || out_size != M_TOK * DM || ws_size < WS_END) { fprintf(stderr, "kernel_launch: unexpected shapes (n_in %d, in0 %d, out %d, ws %zu); nothing launched\n", n_in, n_in > 0 ? in_sizes[0] : -1, out_size, ws_size); grid = -1; return; }
        int dev = 0, cus = 0, per_cu = 0;
        if (hipGetDevice(&dev) != hipSuccess || hipDeviceGetAttribute(&cus, hipDeviceAttributeMultiprocessorCount, dev) != hipSuccess) { grid = -1; return; }
        if (hipFuncSetAttribute((const void*)yoco_fwd, hipFuncAttributeMaxDynamicSharedMemorySize, LDS_BYTES) != hipSuccess) { fprintf(stderr, "kernel_launch: hipFuncSetAttribute failed\n"); grid = -1; return; }
        if (hipOccupancyMaxActiveBlocksPerMultiprocessor(&per_cu, (const void*)yoco_fwd, NWAVES * 64, LDS_BYTES) != hipSuccess || per_cu < 1) { fprintf(stderr, "kernel_launch: occupancy query says %d blocks per CU\n", per_cu); per_cu = 1; }
        (void)hipGetLastError();
        grid = cus;
        if (grid != 256) { fprintf(stderr, "kernel_launch: this build deals the w_a_in tiles to exactly 256 workgroups (device has %d CUs); nothing launched\n", cus); grid = -1; return; }
    }
    if (grid < 0) return;
    (void)hipMemsetAsync((char*)d_ws + WS_ZERO, 0, ZERO_BYTES, stream);
    Args a{};
    a.x = (const float*)d_in[0]; a.c = (const float*)d_in[1]; a.norm_gain = (const float*)d_in[2]; a.w_ada = (const float*)d_in[3]; a.b_ada = (const float*)d_in[4];
    a.w_a_in = (const float*)d_in[5]; a.conv_w = (const float*)d_in[6]; a.w_a_out = (const float*)d_in[7]; a.w_qg = (const float*)d_in[8]; a.q_gain = (const float*)d_in[9];
    a.w_o = (const float*)d_in[10]; a.kv_norm_gain = (const float*)d_in[11]; a.w_ada_kv = (const float*)d_in[12]; a.b_ada_kv = (const float*)d_in[13]; a.w_kv = (const float*)d_in[14];
    a.k_gain = (const float*)d_in[15]; a.cmp_pe = (const float*)d_in[16]; a.cmp_w1 = (const float*)d_in[17]; a.cmp_w2 = (const float*)d_in[18]; a.w_mlp1 = (const float*)d_in[19]; a.w_mlp2 = (const float*)d_in[20];
    a.out = (float*)d_out; a.ws = (unsigned char*)d_ws;
#if MK_N_LAUNCHES == 1
    a.ph_lo = 0; a.ph_hi = N_PHASES;
    void* kargs[] = {&a};
    hipError_t e = hipLaunchCooperativeKernel((const void*)yoco_fwd, dim3(grid), dim3(NWAVES * 64), kargs, LDS_BYTES, stream);
    if (e != hipSuccess) fprintf(stderr, "kernel_launch: cooperative launch failed: %s (grid %d)\n", hipGetErrorString(e), grid);
#else
    for (int p = 0; p < N_PHASES; ++p) { a.ph_lo = p; a.ph_hi = p + 1; hipLaunchKernelGGL(yoco_fwd, dim3(grid), dim3(NWAVES * 64), LDS_BYTES, stream, a); }
#endif
}
```

```cpp
#include <hip/hip_runtime.h>
#include <cstdio>
#include <cstdint>
#include <cmath>

#ifndef MK_N_LAUNCHES
#define MK_N_LAUNCHES 1
#endif
constexpr int N_PHASES = 13;

#define LAS __attribute__((address_space(3)))
typedef unsigned short bf16_t;
typedef short bf16x8 __attribute__((ext_vector_type(8)));
typedef short s16x4 __attribute__((ext_vector_type(4)));
typedef float f32x2 __attribute__((ext_vector_type(2)));
typedef float f32x4 __attribute__((ext_vector_type(4)));
typedef float f32x16 __attribute__((ext_vector_type(16)));
typedef unsigned u32x4 __attribute__((ext_vector_type(4)));
typedef unsigned u32x2 __attribute__((ext_vector_type(2)));
typedef __bf16 bf16x2_t __attribute__((ext_vector_type(2)));

constexpr int BATCH = 8, SEQ = 2048, DM = 1024, FF = 4096, M_TOK = BATCH * SEQ;
constexpr int NKVQ = 2816;
constexpr float EPS = 1e-6f;
constexpr float QSCALE = 0.125f * 1.4426950408889634f;

constexpr size_t MiB = 1u << 20;
constexpr size_t WS_ZERO = 0, ZERO_BYTES = 1 * MiB;
constexpr size_t WS_MOD0 = 0, WS_MOD1 = 196608, WS_MODKV = 393216;
constexpr size_t WS_SS1 = 524288, WS_SS2 = 589824, WS_SS3 = 655360;
constexpr size_t WS_BAR = 786432;
constexpr size_t WS_BM1L0 = 1 * MiB, WS_BM1L1 = WS_BM1L0 + 131072, WS_BKVQ = WS_BM1L1 + 131072, WS_PEB = WS_BKVQ + 131072, WS_WC2 = WS_PEB + 4096;
constexpr size_t WS_WAIN = 2 * MiB, WS_WAOUT = 8 * MiB, WS_WM1 = 10 * MiB  , WS_WM2 = 26 * MiB  , WS_WKVQ = 42 * MiB, WS_WO = 48 * MiB, WS_WC1 = 50 * MiB;
constexpr size_t WS_R = 56 * MiB;
constexpr size_t SLAB = 16 * MiB;
constexpr size_t SO_GB = 0, SO_V = 4 * MiB, SO_Y = 8 * MiB;
constexpr size_t WS_H = WS_R;
constexpr size_t SO_Q = 0, SO_KV = 4 * MiB  , SO_O = 10 * MiB, SO_GATES = 14 * MiB  , SO_KC = 14 * MiB + 512 * 1024  , SO_VC = SO_KC + 65536;
constexpr size_t WS_A1 = 184 * MiB, WS_A2 = 216 * MiB, WS_END = 248 * MiB;

constexpr int LDS_BYTES = 147456;
constexpr int NWAVES = 8;

__device__ __forceinline__ unsigned cvtpk(float lo, float hi) { f32x2 v = {lo, hi}; bf16x2_t b = __builtin_convertvector(v, bf16x2_t); return __builtin_bit_cast(unsigned, b); }
__device__ __forceinline__ float bf_lo(unsigned u) { return __builtin_bit_cast(float, u << 16); }
__device__ __forceinline__ float bf_hi(unsigned u) { return __builtin_bit_cast(float, u & 0xffff0000u); }
__device__ __forceinline__ float wave_sum(float v) {
#pragma unroll
    for (int o = 1; o < 64; o <<= 1) v += __shfl_xor(v, o);
    return v;
}
#define LDS_WAIT() asm volatile("s_waitcnt lgkmcnt(0)" ::: "memory")
#define LAUNDER(x) asm volatile("" : "+v"(x))

namespace pg8 {
constexpr int BM = 256, BK = 64, HALF = 128, HTB = HALF * BK * 2, STAGE_BYTES = 8 * HTB, NXCD = 8, WGM = 8;
__host__ __device__ __forceinline__ int lds_byte(int r, int c) { const int st = (r >> 4) * 2 + (c >> 5), rr = r & 15, cc = c & 31, ob = rr * 64 + cc * 2; return st * 1024 + (ob ^ (((ob >> 9) & 1) << 5)); }
__host__ __device__ __forceinline__ void stage_rc(int b, int& R, int& C) { const int st = b / 1024, sb = b % 1024, swz = sb ^ (((sb >> 9) & 1) << 5); R = (st >> 1) * 16 + swz / 64; C = (st & 1) * 32 + (swz % 64) / 2; }
__host__ __device__ __forceinline__ int perm32(int rho) { const int n = rho >> 4, i = rho & 15; return 8 * (i >> 2) + 4 * n + (i & 3); }

struct Unit { int pm, pn; };
struct Gemm { const bf16_t* A; const bf16_t* A2; int pn_split; const bf16_t* Bt; int M, N, K; size_t abatch; };

struct StaticOrder {
    int nM, nN, nwg, G, c, ain;
    __device__ void init(int M, int N, int G_, int c_) { nM = M / BM; nN = N / BM; nwg = nM * nN; G = G_; c = c_; ain = 0; }
    __device__ void init_ain(int G_, int c_) { init(M_TOK, 3072, G_, c_); ain = 1; }
    __device__ bool next(int i, Unit& u) const {
        if (ain) { if (i >= 3) return false; const int x = c & 7, rk = c >> 3, p = rk >> 3; u.pm = 8 * x + (rk & 7); u.pn = (i == 2) ? p : 4 + 2 * p + i; return true; }
        const long L = (long)i * G + c; if (L >= nwg) return false;
        int wgid = (int)L; { const int q = nwg / NXCD, r = nwg % NXCD, xcd = wgid % NXCD, off = wgid / NXCD; wgid = (xcd < r ? xcd * (q + 1) : r * (q + 1) + (xcd - r) * q) + off; }
        const int nig = WGM * nN, gid = wgid / nig, fm = gid * WGM, gsz = (nM - fm) < WGM ? (nM - fm) : WGM;
        u.pm = fm + ((wgid % nig) % gsz); u.pn = (wgid % nig) / gsz; return true;
    }
};

template <class Epi>
__device__ __forceinline__ void gemm_phase(LAS unsigned char* lds, const Gemm g, const StaticOrder& S, const Epi& E) {
    const int tid = threadIdx.x, wid = __builtin_amdgcn_readfirstlane(tid >> 6), lane = tid & 63, wr = wid >> 2, wc = wid & 3, fr = lane & 15, fq = lane >> 4;
    const int K = g.K, nt = K / BK;
    unsigned voffA[2], voffB[2];
#pragma unroll
    for (int i = 0; i < 2; ++i) { int R, C; stage_rc(tid * 16 + i * 8192, R, C); const int Rb = Epi::PERM ? ((R & ~31) + perm32(R & 31)) : R;
        voffA[i] = (unsigned)(R * K + C) * 2u; voffB[i] = (unsigned)(Rb * K + C) * 2u; }
    const size_t kstep = (size_t)(BK * 2);
    const size_t hstep = (size_t)HALF * K * 2;
    const size_t tstep = 2 * hstep;
    const unsigned ldsw = (unsigned)wid * 1024u;
    const int aoff = lds_byte(wr * 64 + fr, fq * 8), boff = lds_byte(wc * 32 + fr, fq * 8);
#define PG8_SA(b, h) (((b) * 2 + (h)) * HTB)
#define PG8_SB(b, h) ((4 + (b) * 2 + (h)) * HTB)
#define PG8_STAGE(bufoff, gbase, voff) do { _Pragma("unroll") for (int _i = 0; _i < 2; ++_i) \
        __builtin_amdgcn_global_load_lds((const unsigned*)((const char*)(gbase) + (voff)[_i]), (LAS unsigned*)(lds + (bufoff) + ldsw + _i * 8192), 16, 0, 0); } while (0)
#define PG8_LDA(dst, b, h) do { _Pragma("unroll") for (int m = 0; m < 4; ++m) _Pragma("unroll") for (int k = 0; k < 2; ++k) dst[m][k] = *(const LAS bf16x8*)(lds + PG8_SA(b, h) + aoff + m * 2048 + k * 1024); } while (0)
#define PG8_LDB(dst, b, h) do { _Pragma("unroll") for (int n = 0; n < 2; ++n) _Pragma("unroll") for (int k = 0; k < 2; ++k) dst[n][k] = *(const LAS bf16x8*)(lds + PG8_SB(b, h) + boff + n * 2048 + k * 1024); } while (0)
#define PG8_MMA(ai, bj, At, Bt) do { __builtin_amdgcn_s_setprio(1); _Pragma("unroll") for (int m = 0; m < 4; ++m) _Pragma("unroll") for (int n = 0; n < 2; ++n) _Pragma("unroll") for (int k = 0; k < 2; ++k) \
        acc[ai][bj][m][n] = __builtin_amdgcn_mfma_f32_16x16x32_bf16(Bt[n][k], At[m][k], acc[ai][bj][m][n], 0, 0, 0); __builtin_amdgcn_s_setprio(0); } while (0)
#define PG8_WAIT_V(n) asm volatile("s_waitcnt vmcnt(" #n ")" ::: "memory")
#define PG8_WAIT_L(n) asm volatile("s_waitcnt lgkmcnt(" #n ")" ::: "memory")
#define PG8_BAR __builtin_amdgcn_s_barrier()
#define PG8_SCHED __builtin_amdgcn_sched_barrier(0)
#define PG8_ABASE(u) ((const char*)((u).pn < g.pn_split ? g.A : g.A2) + (size_t)((u).pm >> 3) * g.abatch + (size_t)((u).pm & 7) * tstep)
    Unit cur, nxt; int ui = 0;
    if (!S.next(0, cur)) return;
    f32x4 acc[2][2][4][2];
#pragma unroll
    for (int a = 0; a < 2; ++a)
#pragma unroll
        for (int b = 0; b < 2; ++b)
#pragma unroll
            for (int m = 0; m < 4; ++m)
#pragma unroll
                for (int n = 0; n < 2; ++n) acc[a][b][m][n] = (f32x4){0.f, 0.f, 0.f, 0.f};
    bf16x8 At[4][2], B0[2][2], B1[2][2];
    const char* cA = PG8_ABASE(cur); const char* cB = (const char*)g.Bt + (size_t)cur.pn * tstep;
    PG8_STAGE(PG8_SB(0, 0), cB, voffB); PG8_STAGE(PG8_SB(0, 1), cB + hstep, voffB); PG8_STAGE(PG8_SA(0, 0), cA, voffA); PG8_STAGE(PG8_SA(0, 1), cA + hstep, voffA);
    if (wr == 1) PG8_BAR;
    PG8_WAIT_V(2); PG8_BAR;
    PG8_STAGE(PG8_SB(1, 0), cB + kstep, voffB); PG8_STAGE(PG8_SA(1, 0), cA + kstep, voffA); PG8_STAGE(PG8_SB(1, 1), cB + hstep + kstep, voffB);
    PG8_WAIT_V(6); PG8_BAR;
    for (;;) {
        const bool has_next = S.next(ui + 1, nxt);
        const char* nA = has_next ? PG8_ABASE(nxt) : cA; const char* nB = has_next ? (const char*)g.Bt + (size_t)nxt.pn * tstep : cB;
        for (int t = 0; t < nt; t += 2) {
            const bool last = (t == nt - 2);
            const char* a1 = cA + (size_t)(t + 1) * kstep;
            const char* a2 = last ? nA : cA + (size_t)(t + 2) * kstep; const char* b2 = last ? nB : cB + (size_t)(t + 2) * kstep;
            const char* a3 = a2 + kstep; const char* b3 = b2 + kstep;
            PG8_LDB(B0, 0, 0); PG8_LDB(B1, 0, 1); PG8_SCHED; PG8_LDA(At, 0, 0); PG8_STAGE(PG8_SA(1, 1), a1 + hstep, voffA);
            PG8_WAIT_V(8); PG8_WAIT_L(0); PG8_BAR; PG8_MMA(0, 0, At, B0); PG8_MMA(0, 1, At, B1); PG8_BAR; PG8_SCHED;
            PG8_LDA(At, 0, 1); PG8_STAGE(PG8_SB(0, 0), b2, voffB); PG8_STAGE(PG8_SB(0, 1), b2 + hstep, voffB); PG8_STAGE(PG8_SA(0, 0), a2, voffA);
            PG8_WAIT_V(8); PG8_WAIT_L(0); PG8_BAR; PG8_MMA(1, 0, At, B0); PG8_MMA(1, 1, At, B1); PG8_BAR; PG8_SCHED;
            PG8_LDB(B0, 1, 0); PG8_LDB(B1, 1, 1); PG8_SCHED; PG8_LDA(At, 1, 0); PG8_STAGE(PG8_SA(0, 1), a2 + hstep, voffA);
            PG8_WAIT_V(8); PG8_WAIT_L(0); PG8_BAR; PG8_MMA(0, 0, At, B0); PG8_MMA(0, 1, At, B1); PG8_BAR; PG8_SCHED;
            PG8_LDA(At, 1, 1); PG8_STAGE(PG8_SB(1, 0), b3, voffB); PG8_STAGE(PG8_SB(1, 1), b3 + hstep, voffB); PG8_STAGE(PG8_SA(1, 0), a3, voffA);
            PG8_WAIT_V(8); PG8_WAIT_L(0); PG8_BAR; PG8_MMA(1, 0, At, B0); PG8_MMA(1, 1, At, B1); PG8_BAR; PG8_SCHED;
        }
        if (wr == 0) PG8_BAR;
        E(acc, cur, wr, wc, fr, fq);
        if (!has_next) break;
#pragma unroll
        for (int a = 0; a < 2; ++a)
#pragma unroll
            for (int b = 0; b < 2; ++b)
#pragma unroll
                for (int m = 0; m < 4; ++m)
#pragma unroll
                    for (int n = 0; n < 2; ++n) acc[a][b][m][n] = (f32x4){0.f, 0.f, 0.f, 0.f};
        cur = nxt; cA = nA; cB = nB; ++ui;
        if (wr == 1) PG8_BAR;
    }
    PG8_WAIT_V(0);
    PG8_BAR;
#undef PG8_SA
#undef PG8_SB
#undef PG8_STAGE
#undef PG8_LDA
#undef PG8_LDB
#undef PG8_MMA
#undef PG8_WAIT_V
#undef PG8_WAIT_L
#undef PG8_BAR
#undef PG8_SCHED
#undef PG8_ABASE
}

typedef f32x4 Acc[2][2][4][2];

struct EpiAin {
    static constexpr bool PERM = true;
    static constexpr bool HAS_PRE = false; struct Pre {};
    unsigned char* slab0;
    const float* conv_w;
    __device__ __forceinline__ void operator()(const Acc& acc, const Unit& u, int wr, int wc, int fr, int fq) const {
        const int rip0 = wr * 64 + fr;
        const int row0 = (u.pm & 7) * BM + rip0;
        unsigned char* slab = slab0 + (size_t)(u.pm >> 3) * SLAB;
        bf16_t* V = (bf16_t*)(slab + SO_V);
        if (u.pn < 4) {
            bf16_t* Y = (bf16_t*)(slab + SO_Y); bf16_t* GBH = (bf16_t*)(slab + SO_GB) + (size_t)(u.pm & 7) * 2 * DM;
            const int col0 = u.pn * BM + wc * 32 + 8 * fq;
#pragma unroll
            for (int bj = 0; bj < 2; ++bj) { const int cw = col0 + bj * HALF;
                f32x4 w0[2], w1[2], w2[2];
#pragma unroll
                for (int n = 0; n < 2; ++n) { w0[n] = *(const f32x4*)(conv_w + cw + 4 * n); w1[n] = *(const f32x4*)(conv_w + DM + cw + 4 * n); w2[n] = *(const f32x4*)(conv_w + 2 * DM + cw + 4 * n); }
#pragma unroll
                for (int ai = 0; ai < 2; ++ai)
#pragma unroll
                    for (int mp = 0; mp < 2; ++mp) {
                        u32x4 vr[2][3];
#pragma unroll
                        for (int mm = 0; mm < 2; ++mm) { const int rip = rip0 + ai * HALF + (2 * mp + mm) * 16; const bf16_t* vp = V + (size_t)(row0 + ai * HALF + (2 * mp + mm) * 16) * DM + cw;
#pragma unroll
                            for (int k = 0; k < 3; ++k) vr[mm][k] = (rip >= 2) ? *(const u32x4*)(vp - (size_t)k * DM) : (u32x4){0u, 0u, 0u, 0u}; }
                        asm volatile("" : "+v"(vr[0][0]), "+v"(vr[0][1]), "+v"(vr[0][2]), "+v"(vr[1][0]), "+v"(vr[1][1]), "+v"(vr[1][2]));
#pragma unroll
                        for (int mm = 0; mm < 2; ++mm) { const int m = 2 * mp + mm; const int rip = rip0 + ai * HALF + m * 16;
                            const f32x4 g0 = acc[ai][bj][m][0], g1 = acc[ai][bj][m][1];
                            u32x4 w;
                            if (rip >= 2) {
                                const u32x4 a = vr[mm][0], b1 = vr[mm][1], b2 = vr[mm][2];
                                const f32x4 v0a = (f32x4){bf_lo(a.x), bf_hi(a.x), bf_lo(a.y), bf_hi(a.y)}, v0b = (f32x4){bf_lo(a.z), bf_hi(a.z), bf_lo(a.w), bf_hi(a.w)};
                                const f32x4 v1a = (f32x4){bf_lo(b1.x), bf_hi(b1.x), bf_lo(b1.y), bf_hi(b1.y)}, v1b = (f32x4){bf_lo(b1.z), bf_hi(b1.z), bf_lo(b1.w), bf_hi(b1.w)};
                                const f32x4 v2a = (f32x4){bf_lo(b2.x), bf_hi(b2.x), bf_lo(b2.y), bf_hi(b2.y)}, v2b = (f32x4){bf_lo(b2.z), bf_hi(b2.z), bf_lo(b2.w), bf_hi(b2.w)};
                                const f32x4 ya = g0 * (w2[0] * v0a + w1[0] * v1a + w0[0] * v2a), yb = g1 * (w2[1] * v0b + w1[1] * v1b + w0[1] * v2b);
                                w.x = cvtpk(ya[0], ya[1]); w.y = cvtpk(ya[2], ya[3]); w.z = cvtpk(yb[0], yb[1]); w.w = cvtpk(yb[2], yb[3]);
                                *(u32x4*)(Y + (size_t)(row0 + ai * HALF + m * 16) * DM + cw) = w;
                            } else {
                                w.x = cvtpk(g0[0], g0[1]); w.y = cvtpk(g0[2], g0[3]); w.z = cvtpk(g1[0], g1[1]); w.w = cvtpk(g1[2], g1[3]);
                                *(u32x4*)(GBH + (size_t)rip * DM + cw) = w;
                            } } }
            }
        } else {
            const int col0 = (u.pn - 4) * HALF + wc * 32 + 8 * fq;
#pragma unroll
            for (int ai = 0; ai < 2; ++ai)
#pragma unroll
                for (int m = 0; m < 4; ++m) { bf16_t* rowp = V + (size_t)(row0 + ai * HALF + m * 16) * DM + col0;
                    const f32x4 v0 = acc[ai][0][m][0] * acc[ai][1][m][0], v1 = acc[ai][0][m][1] * acc[ai][1][m][1];
                    u32x4 w; w.x = cvtpk(v0[0], v0[1]); w.y = cvtpk(v0[2], v0[3]); w.z = cvtpk(v1[0], v1[1]); w.w = cvtpk(v1[2], v1[3]);
                    *(u32x4*)rowp = w; }
        }
    }
};

template <int NA, int INM, int OUTM> struct EpiRes {
    static constexpr bool PERM = true;
    const void* xin; void* xout; const float* gate; int gate_stride;
    const float* gain0; const float* sc0; int sc0_stride; bf16_t* A0;
    const float* gain1; const float* sc1; int sc1_stride; bf16_t* A1;
    float* sumsq;
    const float* gain_in; const float* sc_in; int sc_in_stride;
    __device__ __forceinline__ void operator()(const Acc& acc, const Unit& u, int wr, int wc, int fr, int fq) const {
        constexpr bool IN16 = INM != 0, OUT16 = false;
        const int b = u.pm >> 3;
        const int row0 = u.pm * BM + wr * 64 + fr, col0 = u.pn * BM + wc * 32 + 8 * fq;
        f32x4 gv[2][2], a0[2][2], a1[2][2], ia[2][2];
#pragma unroll
        for (int bj = 0; bj < 2; ++bj)
#pragma unroll
            for (int n = 0; n < 2; ++n) { const int c = col0 + bj * HALF + 4 * n;
                gv[bj][n] = *(const f32x4*)(gate + (size_t)b * gate_stride + c);
                if (NA >= 1) a0[bj][n] = *(const f32x4*)(gain0 + c) * (*(const f32x4*)(sc0 + (size_t)b * sc0_stride + c) + 1.0f);
                if (NA >= 2) a1[bj][n] = *(const f32x4*)(gain1 + c) * (*(const f32x4*)(sc1 + (size_t)b * sc1_stride + c) + 1.0f);
                if (INM == 2) { const f32x4 t = *(const f32x4*)(gain_in + c) * (*(const f32x4*)(sc_in + (size_t)b * sc_in_stride + c) + 1.0f); ia[bj][n] = (f32x4){1.0f / t[0], 1.0f / t[1], 1.0f / t[2], 1.0f / t[3]}; } }
#pragma unroll
        for (int ai = 0; ai < 2; ++ai)
#pragma unroll
          for (int mp = 0; mp < 2; ++mp) {
            f32x4 xr[2][2][2]; u32x4 xh[2][2];
#pragma unroll
            for (int mm = 0; mm < 2; ++mm)
#pragma unroll
                for (int bj = 0; bj < 2; ++bj) { const size_t o = (size_t)(row0 + ai * HALF + (2 * mp + mm) * 16) * DM + col0 + bj * HALF;
                    if (IN16) xh[mm][bj] = __builtin_nontemporal_load((const u32x4*)((const bf16_t*)xin + o));
                    else { xr[mm][bj][0] = __builtin_nontemporal_load((const f32x4*)((const float*)xin + o)); xr[mm][bj][1] = __builtin_nontemporal_load((const f32x4*)((const float*)xin + o + 4)); } }
            if (IN16) asm volatile("" : "+v"(xh[0][0]), "+v"(xh[0][1]), "+v"(xh[1][0]), "+v"(xh[1][1]));
            else asm volatile("" : "+v"(xr[0][0][0]), "+v"(xr[0][0][1]), "+v"(xr[0][1][0]), "+v"(xr[0][1][1]), "+v"(xr[1][0][0]), "+v"(xr[1][0][1]), "+v"(xr[1][1][0]), "+v"(xr[1][1][1]));
#pragma unroll
            for (int mm = 0; mm < 2; ++mm) { const int m = 2 * mp + mm; const int row = row0 + ai * HALF + m * 16; const size_t off = (size_t)row * DM + col0; float ss = 0.f;
#pragma unroll
                for (int bj = 0; bj < 2; ++bj) { const size_t o = off + bj * HALF;
                    f32x4 x0, x1;
                    if (IN16) { const u32x4 w = xh[mm][bj]; x0 = (f32x4){bf_lo(w.x), bf_hi(w.x), bf_lo(w.y), bf_hi(w.y)}; x1 = (f32x4){bf_lo(w.z), bf_hi(w.z), bf_lo(w.w), bf_hi(w.w)}; }
                    else { x0 = xr[mm][bj][0]; x1 = xr[mm][bj][1]; }
                    if (INM == 2) { x0 = x0 * ia[bj][0]; x1 = x1 * ia[bj][1]; }
                    x0 = x0 + gv[bj][0] * acc[ai][bj][m][0]; x1 = x1 + gv[bj][1] * acc[ai][bj][m][1];
                    if (OUTM == 0) { *(f32x4*)((float*)xout + o) = x0; *(f32x4*)((float*)xout + o + 4) = x1; }
                    if (NA >= 1) { ss += ((x0[0] * x0[0] + x0[1] * x0[1]) + (x0[2] * x0[2] + x0[3] * x0[3])) + ((x1[0] * x1[0] + x1[1] * x1[1]) + (x1[2] * x1[2] + x1[3] * x1[3]));
                        const f32x4 t0 = x0 * a0[bj][0], t1 = x1 * a0[bj][1]; u32x4 w; w.x = cvtpk(t0[0], t0[1]); w.y = cvtpk(t0[2], t0[3]); w.z = cvtpk(t1[0], t1[1]); w.w = cvtpk(t1[2], t1[3]); *(u32x4*)(A0 + o) = w; }
                    if (NA >= 2) { const f32x4 t0 = x0 * a1[bj][0], t1 = x1 * a1[bj][1]; u32x4 w; w.x = cvtpk(t0[0], t0[1]); w.y = cvtpk(t0[2], t0[3]); w.z = cvtpk(t1[0], t1[1]); w.w = cvtpk(t1[2], t1[3]); *(u32x4*)(A1 + o) = w; } }
                if (NA >= 1) { ss += __shfl_xor(ss, 16); ss += __shfl_xor(ss, 32); if (fq == 0) unsafeAtomicAdd(sumsq + row, ss); } }
          }
    }
};

struct EpiMlp1 {
    static constexpr bool PERM = true;
    bf16_t* H; const float* bias; const float* sumsq;
    __device__ __forceinline__ void operator()(const Acc& acc, const Unit& u, int wr, int wc, int fr, int fq) const {
        const int b = u.pm >> 3;
        const int row0 = u.pm * BM + wr * 64 + fr, col0 = u.pn * BM + wc * 32 + 8 * fq;
        f32x4 bv[2][2];
#pragma unroll
        for (int bj = 0; bj < 2; ++bj)
#pragma unroll
            for (int n = 0; n < 2; ++n) bv[bj][n] = *(const f32x4*)(bias + (size_t)b * FF + col0 + bj * HALF + 4 * n);
        float ssv[8];
#pragma unroll
        for (int q = 0; q < 8; ++q) ssv[q] = sumsq[row0 + (q >> 2) * HALF + (q & 3) * 16];
        asm volatile("" : "+v"(ssv[0]), "+v"(ssv[1]), "+v"(ssv[2]), "+v"(ssv[3]), "+v"(ssv[4]), "+v"(ssv[5]), "+v"(ssv[6]), "+v"(ssv[7]));
#pragma unroll
        for (int ai = 0; ai < 2; ++ai)
#pragma unroll
            for (int m = 0; m < 4; ++m) { const int row = row0 + ai * HALF + m * 16; const float rs = rsqrtf(ssv[ai * 4 + m] * (1.0f / DM) + EPS);
                bf16_t* rowp = H + (size_t)row * FF + col0;
#pragma unroll
                for (int bj = 0; bj < 2; ++bj) { f32x4 v0 = acc[ai][bj][m][0] * rs + bv[bj][0], v1 = acc[ai][bj][m][1] * rs + bv[bj][1];
#pragma unroll
                    for (int e = 0; e < 4; ++e) { const float r0 = fmaxf(v0[e], 0.f), r1 = fmaxf(v1[e], 0.f); v0[e] = r0 * r0; v1[e] = r1 * r1; }
                    u32x4 w; w.x = cvtpk(v0[0], v0[1]); w.y = cvtpk(v0[2], v0[3]); w.z = cvtpk(v1[0], v1[1]); w.w = cvtpk(v1[2], v1[3]);
                    *(u32x4*)(rowp + bj * HALF) = w; } }
    }
};

struct EpiKVQ {
    static constexpr bool PERM = true;
    unsigned char* slab0; const float* bias; const float* sumsq; const float* k_gain; const float* q_gain;
    __device__ __forceinline__ void operator()(const Acc& acc, const Unit& u, int wr, int wc, int fr, int fq) const {
        const int b = u.pm >> 3, pn = u.pn;
        const int row0 = u.pm * BM + wr * 64 + fr;
        unsigned char* slab = slab0 + (size_t)b * SLAB;
        bf16_t* KV = (bf16_t*)(slab + SO_KV); bf16_t* Q = (bf16_t*)(slab + SO_Q); float* gates = (float*)(slab + SO_GATES);
        f32x4 bv[2][2];
#pragma unroll
        for (int bj = 0; bj < 2; ++bj)
#pragma unroll
            for (int n = 0; n < 2; ++n) bv[bj][n] = *(const f32x4*)(bias + (size_t)b * NKVQ + pn * BM + bj * HALF + wc * 32 + 8 * fq + 4 * n);
        float ssv[8];
#pragma unroll
        for (int q = 0; q < 8; ++q) ssv[q] = sumsq[row0 + (q >> 2) * HALF + (q & 3) * 16];
        asm volatile("" : "+v"(ssv[0]), "+v"(ssv[1]), "+v"(ssv[2]), "+v"(ssv[3]), "+v"(ssv[4]), "+v"(ssv[5]), "+v"(ssv[6]), "+v"(ssv[7]));
        if (pn == 10) {
            if (wc < 2) {
#pragma unroll
                for (int ai = 0; ai < 2; ++ai)
#pragma unroll
                    for (int m = 0; m < 4; ++m) { const int row = row0 + ai * HALF + m * 16; const float rs = rsqrtf(ssv[ai * 4 + m] * (1.0f / DM) + EPS);
#pragma unroll
                        for (int n = 0; n < 2; ++n) { const int c = wc * 32 + 8 * fq + 4 * n;
                            if (c < 48) { const f32x4 v = acc[ai][0][m][n] * rs + bv[0][n]; f32x4 o;
#pragma unroll
                                for (int e = 0; e < 4; ++e) o[e] = 1.0f / (1.0f + __expf(-v[e]));
                                *(f32x4*)(gates + (size_t)(row & (SEQ - 1)) * 48 + c) = o; } } }
            }
            return;
        }
        const bool is_q = pn >= 6;
        const bool do_norm = is_q || pn == 2 || pn == 4;
        f32x4 gn[2][2];
        { const float* gp = is_q ? q_gain : (k_gain + (pn == 2 ? 64 : 128)); const float sc = is_q ? QSCALE : 1.0f;
#pragma unroll
          for (int bj = 0; bj < 2; ++bj)
#pragma unroll
              for (int n = 0; n < 2; ++n) gn[bj][n] = do_norm ? *(const f32x4*)(gp + 32 * bj + 8 * fq + 4 * n) * sc : (f32x4){1.f, 1.f, 1.f, 1.f}; }
#pragma unroll
        for (int ai = 0; ai < 2; ++ai)
#pragma unroll
            for (int m = 0; m < 4; ++m) { const int row = row0 + ai * HALF + m * 16; const float rs = rsqrtf(ssv[ai * 4 + m] * (1.0f / DM) + EPS);
                f32x4 v[2][2]; float ss = 0.f;
#pragma unroll
                for (int bj = 0; bj < 2; ++bj)
#pragma unroll
                    for (int n = 0; n < 2; ++n) { v[bj][n] = acc[ai][bj][m][n] * rs + bv[bj][n]; const f32x4 t = v[bj][n]; ss += (t[0] * t[0] + t[1] * t[1]) + (t[2] * t[2] + t[3] * t[3]); }
                float hs = 1.0f;
                if (do_norm) { ss += __shfl_xor(ss, 16); ss += __shfl_xor(ss, 32); hs = rsqrtf(ss * (1.0f / 64.0f) + EPS); }
                bf16_t* rowp;
                if (is_q) rowp = Q + (size_t)(row & (SEQ - 1)) * DM + ((pn - 6) * 4 + wc) * 64 + 8 * fq;
                else rowp = KV + ((size_t)(pn * 4 + wc) * SEQ + (row & (SEQ - 1))) * 64 + 8 * fq;
#pragma unroll
                for (int bj = 0; bj < 2; ++bj) { const f32x4 v0 = v[bj][0] * hs * gn[bj][0], v1 = v[bj][1] * hs * gn[bj][1];
                    u32x4 w; w.x = cvtpk(v0[0], v0[1]); w.y = cvtpk(v0[2], v0[3]); w.z = cvtpk(v1[0], v1[1]); w.w = cvtpk(v1[2], v1[3]);
                    *(u32x4*)(rowp + 32 * bj) = w; } }
    }
};
}

namespace att {
constexpr int SLOTB = 8192;
constexpr int L_K = 0, L_V = 3 * SLOTB, L_WS = 6 * SLOTB, L_SEL = L_WS + 4096, L_NIB = L_SEL + 256, L_SC = L_NIB + 768, L_IA = L_SC + 8704, L_IB = L_IA + 33792, L_END = L_IB + 33792, L_OST = L_IA;
static_assert(L_END <= 131072 && (L_IA % 16) == 0 && (L_SC % 16) == 0, "attention LDS map");
#define SBAR() __builtin_amdgcn_sched_barrier(0)
#define ATT_WAIT_BAR(N) asm volatile("s_waitcnt vmcnt(" #N ") lgkmcnt(0)\n\ts_barrier" ::: "memory")
__device__ __forceinline__ int crow(int r, int hi) { return (r & 3) + 8 * (r >> 2) + 4 * hi; }
__device__ __forceinline__ void glds16(const void* gsrc, unsigned lds_dst) { unsigned keep;
    asm volatile("s_mov_b32 %0, m0\n\ts_mov_b32 m0, %2\n\ts_nop 0\n\tglobal_load_lds_dwordx4 %1, off\n\ts_mov_b32 m0, %0" : "=&s"(keep) : "v"(gsrc), "s"(lds_dst) : "memory"); }

__device__ __forceinline__ void qkt_c(f32x16& p0, f32x16& p1, const LAS unsigned char* Kslot, const bf16x8* qr, const f32x16& ci, int r32, int hi) {
    const LAS unsigned char* kb = Kslot + hi * 1024 + r32 * 16;
    bf16x8 kf[8];
#pragma unroll
    for (int i = 0; i < 8; ++i) kf[i] = *(const LAS bf16x8*)(kb + (i >> 1) * 2048 + (i & 1) * 512);
    asm volatile("" : "+v"(kf[0]), "+v"(kf[1]), "+v"(kf[2]), "+v"(kf[3]), "+v"(kf[4]), "+v"(kf[5]), "+v"(kf[6]), "+v"(kf[7]));
    p0 = __builtin_amdgcn_mfma_f32_32x32x16_bf16(kf[0], qr[0], ci, 0, 0, 0); p1 = __builtin_amdgcn_mfma_f32_32x32x16_bf16(kf[1], qr[0], ci, 0, 0, 0);
#pragma unroll
    for (int d0 = 1; d0 < 4; ++d0) { p0 = __builtin_amdgcn_mfma_f32_32x32x16_bf16(kf[2 * d0], qr[d0], p0, 0, 0, 0); p1 = __builtin_amdgcn_mfma_f32_32x32x16_bf16(kf[2 * d0 + 1], qr[d0], p1, 0, 0, 0); }
}
__device__ __forceinline__ void qkt(f32x16& p0, f32x16& p1, const LAS unsigned char* Kslot, const bf16x8* qr, int r32, int hi) {
    const LAS unsigned char* kb = Kslot + hi * 1024 + r32 * 16;
    bf16x8 kf[8];
#pragma unroll
    for (int i = 0; i < 8; ++i) kf[i] = *(const LAS bf16x8*)(kb + (i >> 1) * 2048 + (i & 1) * 512);
    asm volatile("" : "+v"(kf[0]), "+v"(kf[1]), "+v"(kf[2]), "+v"(kf[3]), "+v"(kf[4]), "+v"(kf[5]), "+v"(kf[6]), "+v"(kf[7]));
    const f32x16 z = f32x16{};
    p0 = __builtin_amdgcn_mfma_f32_32x32x16_bf16(kf[0], qr[0], z, 0, 0, 0); p1 = __builtin_amdgcn_mfma_f32_32x32x16_bf16(kf[1], qr[0], z, 0, 0, 0);
#pragma unroll
    for (int d0 = 1; d0 < 4; ++d0) { p0 = __builtin_amdgcn_mfma_f32_32x32x16_bf16(kf[2 * d0], qr[d0], p0, 0, 0, 0); p1 = __builtin_amdgcn_mfma_f32_32x32x16_bf16(kf[2 * d0 + 1], qr[d0], p1, 0, 0, 0); }
}
__device__ __forceinline__ void range_mask(f32x16& p0, f32x16& p1, int lo, int hv, int hi) {
    const int lo2 = lo - 4 * hi, hv2 = hv - 4 * hi;
#pragma unroll
    for (int r = 0; r < 16; ++r) { const int kc = (r & 3) + 8 * (r >> 2); if (kc < lo2 || kc > hv2) p0[r] = -INFINITY; if (kc + 32 < lo2 || kc + 32 > hv2) p1[r] = -INFINITY; }
}
__device__ __forceinline__ float max3f(float a, float b, float c) { float r; asm("v_max3_f32 %0, %1, %2, %3" : "=v"(r) : "v"(a), "v"(b), "v"(c)); return r; }
__device__ __forceinline__ float max2f(float a, float b) { float r; asm("v_max_f32_e32 %0, %1, %2" : "=v"(r) : "v"(a), "v"(b)); return r; }
__device__ __forceinline__ float rowmax(const f32x16& p0, const f32x16& p1) {
    float a = max3f(p0[0], p0[1], p1[0]), b = max3f(p0[2], p0[3], p1[1]); a = max3f(a, p1[2], p1[3]);
#pragma unroll
    for (int r = 4; r < 16; r += 4) { a = max3f(a, p0[r], p0[r + 1]); b = max3f(b, p0[r + 2], p0[r + 3]); a = max3f(a, p1[r], p1[r + 1]); b = max3f(b, p1[r + 2], p1[r + 3]); }
    const float m = max2f(a, b);
    auto rr = __builtin_amdgcn_permlane32_swap(__float_as_uint(m), __float_as_uint(m), false, false);
    return max2f(__uint_as_float(rr[0]), __uint_as_float(rr[1]));
}
__device__ __forceinline__ float halfsum(float a) {
    auto rr = __builtin_amdgcn_permlane32_swap(__float_as_uint(a), __float_as_uint(a), false, false);
    return __uint_as_float(rr[0]) + __uint_as_float(rr[1]);
}
__device__ __forceinline__ void pv(f32x16* o, int vb, bf16x8 pa0, bf16x8 pa1, bf16x8 pa2, bf16x8 pa3) {
    s16x4 lo[8], hi4[8];
#pragma unroll
    for (int q = 0; q < 8; ++q) {
        asm volatile("ds_read_b64_tr_b16 %0,%1 offset:%c2" : "=&v"(lo[q]) : "v"(vb), "i"((q >> 2) * 4096 + (q & 3) * 1024) : "memory");
        asm volatile("ds_read_b64_tr_b16 %0,%1 offset:%c2" : "=&v"(hi4[q]) : "v"(vb), "i"((q >> 2) * 4096 + (q & 3) * 1024 + 512) : "memory"); }
    asm volatile("s_waitcnt lgkmcnt(0)" ::: "memory"); SBAR();
#define PK(k) (bf16x8){lo[k][0], lo[k][1], lo[k][2], lo[k][3], hi4[k][0], hi4[k][1], hi4[k][2], hi4[k][3]}
    o[0] = __builtin_amdgcn_mfma_f32_32x32x16_bf16(pa0, PK(0), o[0], 0, 0, 0);
    o[1] = __builtin_amdgcn_mfma_f32_32x32x16_bf16(pa0, PK(4), o[1], 0, 0, 0);
    o[0] = __builtin_amdgcn_mfma_f32_32x32x16_bf16(pa1, PK(1), o[0], 0, 0, 0);
    o[1] = __builtin_amdgcn_mfma_f32_32x32x16_bf16(pa1, PK(5), o[1], 0, 0, 0);
    o[0] = __builtin_amdgcn_mfma_f32_32x32x16_bf16(pa2, PK(2), o[0], 0, 0, 0);
    o[1] = __builtin_amdgcn_mfma_f32_32x32x16_bf16(pa2, PK(6), o[1], 0, 0, 0);
    o[0] = __builtin_amdgcn_mfma_f32_32x32x16_bf16(pa3, PK(3), o[0], 0, 0, 0);
    o[1] = __builtin_amdgcn_mfma_f32_32x32x16_bf16(pa3, PK(7), o[1], 0, 0, 0);
#undef PK
}
__device__ __forceinline__ bf16x8 pack8(const f32x16& p, int base) {
    u32x4 w; w.x = cvtpk(p[base], p[base + 1]); w.y = cvtpk(p[base + 2], p[base + 3]); w.z = cvtpk(p[base + 4], p[base + 5]); w.w = cvtpk(p[base + 6], p[base + 7]);
    return __builtin_bit_cast(bf16x8, w);
}
__device__ __forceinline__ void row_bcast(float v, float (&out)[16], LAS float* wsf, int r32, int hi) {
    if (hi == 0) wsf[r32] = v;
#pragma unroll
    for (int i = 0; i < 4; ++i) { const f32x4 t = *(const LAS f32x4*)(wsf + 8 * i + 4 * hi); out[4 * i] = t[0]; out[4 * i + 1] = t[1]; out[4 * i + 2] = t[2]; out[4 * i + 3] = t[3]; }
}

struct Ctx {
    int lane, r32, hi, wid, ql, qb; unsigned lds0; LAS unsigned char* shm; LAS float* wsf; int koff, voff; unsigned kdst, vdst; int vb0;
};
__device__ __forceinline__ void dma_k(const Ctx& c, const bf16_t* base, int tile, int slot) { glds16(base + (size_t)tile * 4096 + c.koff, (unsigned)__builtin_amdgcn_readfirstlane(c.kdst + slot * SLOTB)); }
__device__ __forceinline__ void dma_v(const Ctx& c, const bf16_t* base, int tile, int slot) { glds16(base + (size_t)tile * 4096 + c.voff, (unsigned)__builtin_amdgcn_readfirstlane(c.vdst + slot * SLOTB)); }

constexpr float THR = 8.0f;
struct BrState { float mhat, l; f32x16 negm; f32x16 o[2]; };
__device__ __forceinline__ void br_reset(BrState& st) { st.mhat = 0.f; st.l = 0.f; st.negm = f32x16{}; st.o[0] = f32x16{}; st.o[1] = f32x16{}; }
__device__ __forceinline__ void stream_step(const Ctx& c, int slot, const bf16x8* qr, bool row_on, bool use_range, int lo, int hv, bool first, BrState& st) {
    f32x16 p0, p1;
    if (__any(!row_on)) { f32x16 ci;
#pragma unroll
        for (int r = 0; r < 16; ++r) ci[r] = row_on ? st.negm[r] : -INFINITY;
        qkt_c(p0, p1, c.shm + L_K + slot * SLOTB, qr, ci, c.r32, c.hi);
    } else qkt_c(p0, p1, c.shm + L_K + slot * SLOTB, qr, st.negm, c.r32, c.hi);
    if (use_range) range_mask(p0, p1, lo, hv, c.hi);
    const float rm = rowmax(p0, p1);
    if (first || __any(rm > THR)) {
        float dl = first ? rm : fmaxf(rm, 0.f);
        if (dl == -INFINITY) dl = 0.f;
        st.mhat += dl;
#pragma unroll
        for (int r = 0; r < 16; ++r) { p0[r] -= dl; p1[r] -= dl; st.negm[r] = -st.mhat; }
        if (!first) { const float f = __builtin_amdgcn_exp2f(-dl); st.l *= f; float al[16]; row_bcast(f, al, c.wsf, c.r32, c.hi);
#pragma unroll
            for (int r = 0; r < 16; ++r) { st.o[0][r] *= al[r]; st.o[1][r] *= al[r]; } }
    }
#pragma unroll
    for (int r = 0; r < 16; ++r) { p0[r] = __builtin_amdgcn_exp2f(p0[r]); p1[r] = __builtin_amdgcn_exp2f(p1[r]); }
    { const f32x16 sv = p0 + p1; st.l += ((sv[0] + sv[1]) + (sv[2] + sv[3])) + ((sv[4] + sv[5]) + (sv[6] + sv[7])) + ((sv[8] + sv[9]) + (sv[10] + sv[11])) + ((sv[12] + sv[13]) + (sv[14] + sv[15])); }
    pv(st.o, c.vb0 + slot * SLOTB, pack8(p0, 0), pack8(p0, 8), pack8(p1, 0), pack8(p1, 8));
}
struct Cursor { unsigned sm, wm; };
__device__ __forceinline__ int cur_pop(Cursor& k, int& br) {
    if (k.sm) { const int t = __builtin_ctz(k.sm); k.sm &= k.sm - 1u; br = 1; return t; }
    const int t = 31 - __builtin_clz(k.wm); k.wm &= ~(1u << t); br = 2; return t;
}

typedef __attribute__((address_space(3))) const char* lds_cptr;
typedef short v4i16_t __attribute__((ext_vector_type(4)));
__device__ __forceinline__ void kload8(bf16x8* kf, lds_cptr kp) {
    kf[0] = *(const LAS bf16x8*)(kp);        kf[1] = *(const LAS bf16x8*)(kp + 512);
    kf[2] = *(const LAS bf16x8*)(kp + 2048); kf[3] = *(const LAS bf16x8*)(kp + 2560);
    kf[4] = *(const LAS bf16x8*)(kp + 4096); kf[5] = *(const LAS bf16x8*)(kp + 4608);
    kf[6] = *(const LAS bf16x8*)(kp + 6144); kf[7] = *(const LAS bf16x8*)(kp + 6656);
}
__device__ __forceinline__ void kload2(bf16x8* kf, lds_cptr kp, int j) { kf[2 * j] = *(const LAS bf16x8*)(kp + j * 2048); kf[2 * j + 1] = *(const LAS bf16x8*)(kp + j * 2048 + 512); }
__device__ __forceinline__ s16x4 vtr(lds_cptr p) { return __builtin_bit_cast(s16x4, __builtin_amdgcn_ds_read_tr16_b64_v4i16((LAS v4i16_t*)p)); }
__device__ __forceinline__ float fadd_s(float a, float b) { float r; asm("v_add_f32_e32 %0, %1, %2" : "=v"(r) : "v"(a), "v"(b)); return r; }
__device__ __forceinline__ float fsub_s(float a, float b) { float r; asm("v_sub_f32_e32 %0, %1, %2" : "=v"(r) : "v"(a), "v"(b)); return r; }
template <int THRL>
__device__ __forceinline__ void sel_stream(const Ctx& c, const bf16_t* Kb, const bf16_t* Vb, const bf16x8* qr, unsigned msel, int qb, f32x16* o, float& l_out) {
  const int lane = c.lane, r32 = c.r32, hi = c.hi;
  LAS float* wsf = c.wsf;
  const lds_cptr shm3 = (lds_cptr)c.shm;
  const lds_cptr kp0 = shm3 + L_K + hi * 1024 + r32 * 16;
  const lds_cptr vp0 = shm3 + L_V + ((lane >> 4) & 1) * 32 + (lane & 3) * 8 + (4 * hi + ((lane & 15) >> 2)) * 64;
  const int NTr = qb + 1, NT = NTr < 4 ? 4 : ((NTr + 1) & ~1);
  #define WAIT_BAR(N) asm volatile("s_waitcnt vmcnt(" #N ") lgkmcnt(0)\n\ts_barrier":::"memory")
  #define TILE_OF(t) (((t) < NTr) ? (t) : qb)
  #define DMA_K(t, slotb) glds16(Kb + (size_t)TILE_OF(t) * 4096 + c.koff, (unsigned)__builtin_amdgcn_readfirstlane(c.kdst + (slotb)))
  #define DMA_V(t, slotb) glds16(Vb + (size_t)TILE_OF(t) * 4096 + c.voff, (unsigned)__builtin_amdgcn_readfirstlane(c.vdst + (slotb)))
  #define CMASK(P0, P1, t) do { const bool on_ = ((t) < NTr) && (((msel >> ((t) & 31)) & 1u) != 0u); \
      if (__any(!on_)) { const float ng_ = on_ ? 0.f : -INFINITY; _Pragma("unroll") for (int r = 0; r < 16; ++r) { P0[r] += ng_; P1[r] += ng_; } } \
      if ((t) == qb) range_mask(P0, P1, 0, c.ql, hi); } while (0)
  float mhat = 0.f, l_reg = 0.f; o[0] = f32x16{}; o[1] = f32x16{}; f32x16 negm = f32x16{}; asm volatile("" : "+v"(negm));
  bf16x8 kf[8];
  bool resc = false;
  #define START(P0,P1) do{ const float rm=rowmax(P0,P1); resc=false; \
    { const float dl=rm; mhat=fadd_s(mhat,dl); \
      _Pragma("unroll") for(int r=0;r<16;++r){P0[r]=fsub_s(P0[r],dl);P1[r]=fsub_s(P1[r],dl);} \
      _Pragma("unroll") for(int r=0;r<16;++r)negm[r]=-mhat; asm volatile("":"+v"(negm)); } \
    _Pragma("unroll") for(int r=0;r<16;++r)P0[r]=__builtin_amdgcn_exp2f(P0[r]); }while(0)
  #define RESC() do{ if(resc){ asm volatile("s_waitcnt lgkmcnt(0)":::"memory"); \
      _Pragma("unroll") for(int d_=0;d_<2;++d_) _Pragma("unroll") for(int r=0;r<16;++r)o[d_][r]*=wsf[crow(r,hi)]; } }while(0)
  f32x16 pA0,pA1,pB0,pB1;
  int sl_prev=SLOTB,sl_cur=2*SLOTB,sl_next=0;
  #define ROT() do{sl_prev=sl_cur;sl_cur=sl_next;sl_next=(sl_next==2*SLOTB)?0:sl_next+SLOTB;}while(0)
  DMA_K(1,0); DMA_K(2,SLOTB);
  { const f32x16 z = f32x16{}; qkt_c(pA0,pA1,c.shm+L_K+2*SLOTB,qr,z,r32,hi); }
  asm volatile("s_nop 15\n\ts_nop 7":"+v"(pA0),"+v"(pA1)); CMASK(pA0,pA1,0);
  START(pA0,pA1);
  _Pragma("unroll") for(int r=0;r<16;++r)pA1[r]=__builtin_amdgcn_exp2f(pA1[r]);
  WAIT_BAR(0);
  DMA_K(3,2*SLOTB);DMA_V(1,0);
  ROT();
  kload8(kf,kp0+sl_cur);
  WAIT_BAR(2);
  s16x4 vlo[8],vhi[8]; u32x4 pw0,pw1,pw2,pw3;
  #define PKW(P,B) cvtpk(P[B],P[B+1])
  #define PAF(k) __builtin_bit_cast(bf16x8,pw##k)
  #define VFR(i) (bf16x8){vlo[i][0],vlo[i][1],vlo[i][2],vlo[i][3],vhi[i][0],vhi[i][1],vhi[i][2],vhi[i][3]}
  #define PIN(x) asm volatile("":"+v"(x))
  #define MX3(a,b,c) __builtin_fmaxf(__builtin_fmaxf((a),(b)),(c))
  #define GAPA(MF,A0,A1,A2,A3,W0,W1,PW) do{ MF; sacc+=A0; sacc+=A1; sacc+=A2; sacc+=A3; PIN(sacc); W0; W1; PIN(PW); SBAR(); }while(0)
  #define EX(v) __builtin_amdgcn_exp2f(v)
  #define GAPB(MF,X,B) do{ MF; X[B]=EX(X[B]); X[B+1]=EX(X[B+1]); X[B+2]=EX(X[B+2]); X[B+3]=EX(X[B+3]); PIN(X); SBAR(); }while(0)
  #define VRD(i) do{ vlo[i]=vtr(vp_+(((i)>>2)*4096+((i)&3)*1024)); vhi[i]=vtr(vp_+(((i)>>2)*4096+((i)&3)*1024+512)); }while(0)
  #define KRD(G,j) do{ if(G){ kload2(kf,kp0+sl_next,j); SBAR(); } }while(0)
  #define STEP(C0,C1,P0,P1,t,GK,GV,GL) do{ SBAR(); \
    const lds_cptr vp_=vp0+sl_prev; \
    VRD(0); SBAR(); float sacc=(P0[0]+P0[1]); \
    GAPA(C0=__builtin_amdgcn_mfma_f32_32x32x16_bf16(kf[0],qr[0],negm,0,0,0), P0[2],P0[3],P0[4],P0[5],     pw0[0]=PKW(P0,0), pw0[1]=PKW(P0,2), pw0); \
    VRD(4); SBAR(); GAPA(C1=__builtin_amdgcn_mfma_f32_32x32x16_bf16(kf[1],qr[0],negm,0,0,0), P0[6],P0[7],P0[8],P0[9],     pw0[2]=PKW(P0,4), pw0[3]=PKW(P0,6), pw0); \
    VRD(1); SBAR(); GAPA(C0=__builtin_amdgcn_mfma_f32_32x32x16_bf16(kf[2],qr[1],C0,0,0,0),   P0[10],P0[11],P0[12],P0[13], pw1[0]=PKW(P0,8), pw1[1]=PKW(P0,10), pw1); \
    VRD(5); SBAR(); GAPA(C1=__builtin_amdgcn_mfma_f32_32x32x16_bf16(kf[3],qr[1],C1,0,0,0),   P0[14],P0[15],P1[0],P1[1],   pw1[2]=PKW(P0,12),pw1[3]=PKW(P0,14), pw1); \
    VRD(2); SBAR(); GAPA(C0=__builtin_amdgcn_mfma_f32_32x32x16_bf16(kf[4],qr[2],C0,0,0,0),   P1[2],P1[3],P1[4],P1[5],     pw2[0]=PKW(P1,0), pw2[1]=PKW(P1,2), pw2); \
    VRD(6); SBAR(); GAPA(C1=__builtin_amdgcn_mfma_f32_32x32x16_bf16(kf[5],qr[2],C1,0,0,0),   P1[6],P1[7],P1[8],P1[9],     pw2[2]=PKW(P1,4), pw2[3]=PKW(P1,6), pw2); \
    VRD(3); SBAR(); GAPA(C0=__builtin_amdgcn_mfma_f32_32x32x16_bf16(kf[6],qr[3],C0,0,0,0),   P1[10],P1[11],P1[12],P1[13], pw3[0]=PKW(P1,8), pw3[1]=PKW(P1,10), pw3); \
    VRD(7); SBAR(); GAPA(C1=__builtin_amdgcn_mfma_f32_32x32x16_bf16(kf[7],qr[3],C1,0,0,0),   P1[14],P1[15],0.f,0.f,       pw3[2]=PKW(P1,12),pw3[3]=PKW(P1,14), pw3); \
    l_reg+=sacc; \
    if(GK){DMA_K((t)+3,sl_cur);} if(GV){DMA_V((t)+1,sl_next);} \
    CMASK(C0,C1,t); \
    { float a=MX3(C0[0],C0[1],C1[0]),b=MX3(C0[2],C0[3],C1[1]); a=MX3(a,C1[2],C1[3]); \
      _Pragma("unroll") for(int r=4;r<16;r+=4){a=MX3(a,C0[r],C0[r+1]);b=MX3(b,C0[r+2],C0[r+3]);a=MX3(a,C1[r],C1[r+1]);b=MX3(b,C1[r+2],C1[r+3]);} \
      float rm=__builtin_fmaxf(a,b); { auto rr=__builtin_amdgcn_permlane32_swap(__float_as_uint(rm),__float_as_uint(rm),false,false); rm=__builtin_fmaxf(__uint_as_float(rr[0]),__uint_as_float(rr[1])); } \
      resc=false; \
      if(__builtin_expect(__any(rm>(float)THRL),0)){ const float dl=__builtin_fmaxf(rm,0.f); mhat+=dl; \
        _Pragma("unroll") for(int r=0;r<16;++r){C0[r]-=dl;C1[r]-=dl;} \
        _Pragma("unroll") for(int r=0;r<16;++r)negm[r]=-mhat; asm volatile("":"+v"(negm)); \
        const float f=__builtin_amdgcn_exp2f(-dl); l_reg*=f; if(hi==0)wsf[r32]=f; resc=true; } } \
    SBAR(); \
    GAPB(o[0]=__builtin_amdgcn_mfma_f32_32x32x16_bf16(PAF(0),VFR(0),o[0],0,0,0), C0,0); \
    GAPB(o[1]=__builtin_amdgcn_mfma_f32_32x32x16_bf16(PAF(0),VFR(4),o[1],0,0,0), C0,4); \
    KRD(GL,0); GAPB(o[0]=__builtin_amdgcn_mfma_f32_32x32x16_bf16(PAF(1),VFR(1),o[0],0,0,0), C0,8); \
    KRD(GL,1); GAPB(o[1]=__builtin_amdgcn_mfma_f32_32x32x16_bf16(PAF(1),VFR(5),o[1],0,0,0), C0,12); \
    KRD(GL,2); GAPB(o[0]=__builtin_amdgcn_mfma_f32_32x32x16_bf16(PAF(2),VFR(2),o[0],0,0,0), C1,0); \
    KRD(GL,3); GAPB(o[1]=__builtin_amdgcn_mfma_f32_32x32x16_bf16(PAF(2),VFR(6),o[1],0,0,0), C1,4); \
    GAPB(o[0]=__builtin_amdgcn_mfma_f32_32x32x16_bf16(PAF(3),VFR(3),o[0],0,0,0), C1,8); \
    GAPB(o[1]=__builtin_amdgcn_mfma_f32_32x32x16_bf16(PAF(3),VFR(7),o[1],0,0,0), C1,12); \
    }while(0)
  #define ENDW(tt) do{ if((tt)+3<NT){WAIT_BAR(2);} else if((tt)+2<NT){WAIT_BAR(1);} else {WAIT_BAR(0);} }while(0)
  int t=1;
  for(;t+1<NT;t+=2){
    STEP(pB0,pB1,pA0,pA1,t,(t+3<NT),(t+1<NT),(t+1<NT));       ENDW(t);   RESC(); ROT();
    STEP(pA0,pA1,pB0,pB1,t+1,(t+4<NT),(t+2<NT),(t+2<NT));     ENDW(t+1); RESC(); ROT();
  }
  STEP(pB0,pB1,pA0,pA1,NT-1,false,false,false); RESC();
  { float sacc=pB0[0]+pB0[1]; _Pragma("unroll") for(int r=2;r<16;++r)sacc+=pB0[r]; _Pragma("unroll") for(int r=0;r<16;++r)sacc+=pB1[r]; l_reg+=sacc;
    SBAR(); pv(o, c.vb0 + sl_cur, pack8(pB0,0), pack8(pB0,8), pack8(pB1,0), pack8(pB1,8)); }
  l_out = l_reg;
  asm volatile("s_waitcnt lgkmcnt(0)\n\ts_barrier":::"memory");
  #undef WAIT_BAR
  #undef TILE_OF
  #undef DMA_K
  #undef DMA_V
  #undef CMASK
  #undef START
  #undef RESC
  #undef ROT
  #undef PKW
  #undef PAF
  #undef VFR
  #undef PIN
  #undef MX3
  #undef GAPA
  #undef EX
  #undef GAPB
  #undef VRD
  #undef KRD
  #undef STEP
  #undef ENDW
}

__device__ __forceinline__ void attn_unit(int b, int g, int qb, unsigned char* slab, LAS unsigned char* shm) {
    const bf16_t* Q = (const bf16_t*)(slab + SO_Q); const bf16_t* KV = (const bf16_t*)(slab + SO_KV); const bf16_t* KC = (const bf16_t*)(slab + SO_KC); const bf16_t* VC = (const bf16_t*)(slab + SO_VC);
    const float* gates = (const float*)(slab + SO_GATES); bf16_t* O = (bf16_t*)(slab + SO_O);
    Ctx c;
    const int tid = threadIdx.x;
    c.lane = tid & 63; c.r32 = c.lane & 31; c.hi = c.lane >> 5; c.wid = __builtin_amdgcn_readfirstlane(tid >> 6);
    const int kh = c.wid >> 1, qh = c.wid & 1, head = g * 4 + kh;
    c.ql = qh * 32 + c.r32; c.qb = qb; c.shm = shm; c.lds0 = (unsigned)(size_t)shm;
    c.wsf = (LAS float*)(shm + L_WS) + c.wid * 128;
    c.koff = c.lane * 64 + c.wid * 8;
    c.voff = (16 * (c.wid & 3) + (c.lane >> 2)) * 64 + (c.wid >> 2) * 32 + (c.lane & 3) * 8;
    c.kdst = c.lds0 + L_K + c.wid * 1024; c.vdst = c.lds0 + L_V + c.wid * 1024;
    c.vb0 = (int)(c.lds0 + L_V) + ((c.lane >> 4) & 1) * 32 + (c.lane & 3) * 8 + (4 * c.hi + ((c.lane & 15) >> 2)) * 64;
    const int t = qb * 64 + c.ql;
    const size_t mrow = (size_t)t;
    const size_t bg = (size_t)g;
    const bf16_t* KSb = KV + ((size_t)2 * 4 + g) * (SEQ * 64);
    const bf16_t* VSb = KV + ((size_t)3 * 4 + g) * (SEQ * 64);
    const bf16_t* KWb = KV + ((size_t)4 * 4 + g) * (SEQ * 64);
    const bf16_t* VWb = KV + ((size_t)5 * 4 + g) * (SEQ * 64);
    const bf16_t* KCb = KC + bg * 8192; const bf16_t* VCb = VC + bg * 8192;
    dma_k(c, KCb, 0, 0); dma_k(c, KCb, 1, 1); dma_v(c, VCb, 0, 0); dma_v(c, VCb, 1, 1);
    dma_k(c, KSb, 0, 2); dma_v(c, VSb, 0, 2);
    bf16x8 qr[4];
    { const bf16_t* Qw = Q + mrow * DM + head * 64 + c.hi * 8;
#pragma unroll
      for (int d0 = 0; d0 < 4; ++d0) qr[d0] = __builtin_nontemporal_load((const bf16x8*)(Qw + d0 * 16)); }
    const float* gp = gates + mrow * 48 + head * 3;
    const float g0 = gp[0], g1 = gp[1], g2 = gp[2];
    f32x16 ot[2];
    f32x16 o[2];
    const bool two = qb >= 16;
    ATT_WAIT_BAR(2);
    {
        f32x16 a0, a1, b0, b1;
        qkt(a0, a1, shm + L_K, qr, c.r32, c.hi);
        const int nmax = (t >= 31) ? ((t - 31) >> 4) : -1;
        range_mask(a0, a1, 0, nmax, c.hi);
        float rm = rowmax(a0, a1);
        if (two) { qkt(b0, b1, shm + L_K + SLOTB, qr, c.r32, c.hi); range_mask(b0, b1, 0, nmax - 64, c.hi); rm = fmaxf(rm, rowmax(b0, b1)); }
        const float mu = (rm == -INFINITY) ? 0.f : rm;
        float s = 0.f;
#pragma unroll
        for (int r = 0; r < 16; ++r) { a0[r] = __builtin_amdgcn_exp2f(a0[r] - mu); a1[r] = __builtin_amdgcn_exp2f(a1[r] - mu); s += a0[r] + a1[r]; }
        if (two) {
#pragma unroll
            for (int r = 0; r < 16; ++r) { b0[r] = __builtin_amdgcn_exp2f(b0[r] - mu); b1[r] = __builtin_amdgcn_exp2f(b1[r] - mu); s += b0[r] + b1[r]; }
        }
        s = halfsum(s);
        const float inv = (s > 0.f) ? 1.0f / s : 0.f;
#pragma unroll
        for (int r = 0; r < 16; ++r) { a0[r] *= inv; a1[r] *= inv; }
        if (two) {
#pragma unroll
            for (int r = 0; r < 16; ++r) { b0[r] *= inv; b1[r] *= inv; }
            int qlx = c.ql; LAUNDER(qlx);
            LAS float* IA = (LAS float*)(shm + L_IA) + (kh * 64 + qlx) * 33;
            LAS float* IB = (LAS float*)(shm + L_IB) + (kh * 64 + qlx) * 33;
#pragma unroll
            for (int i = 0; i < 4; ++i) {
                const int j = 2 * i + c.hi;
                IA[j]      = a0[4 * i] + a0[4 * i + 1] + a0[4 * i + 2] + 0.5f * a0[4 * i + 3]; IB[j + 1]  = 0.5f * a0[4 * i + 3];
                IA[j + 8]  = a1[4 * i] + a1[4 * i + 1] + a1[4 * i + 2] + 0.5f * a1[4 * i + 3]; IB[j + 9]  = 0.5f * a1[4 * i + 3];
                IA[j + 16] = b0[4 * i] + b0[4 * i + 1] + b0[4 * i + 2] + 0.5f * b0[4 * i + 3]; IB[j + 17] = 0.5f * b0[4 * i + 3];
                IA[j + 24] = b1[4 * i] + b1[4 * i + 1] + b1[4 * i + 2] + 0.5f * b1[4 * i + 3]; IB[j + 25] = 0.5f * b1[4 * i + 3];
            }
        }
        o[0] = f32x16{}; o[1] = f32x16{};
        pv(o, c.vb0, pack8(a0, 0), pack8(a0, 8), pack8(a1, 0), pack8(a1, 8));
        if (two) pv(o, c.vb0 + SLOTB, pack8(b0, 0), pack8(b0, 8), pack8(b1, 0), pack8(b1, 8));
        float cf[16]; row_bcast(g0, cf, c.wsf, c.r32, c.hi);
#pragma unroll
        for (int r = 0; r < 16; ++r) { ot[0][r] = o[0][r] * cf[r]; ot[1][r] = o[1][r] * cf[r]; }
    }
    ATT_WAIT_BAR(0);
    LAS unsigned* SEL = (LAS unsigned*)(shm + L_SEL);
    if (two) {
        int q = tid & 63, jg = tid >> 6; LAUNDER(q); LAUNDER(jg);
        LAS float* SC = (LAS float*)(shm + L_SC);
        const LAS float* IA = (const LAS float*)(shm + L_IA); const LAS float* IB = (const LAS float*)(shm + L_IB);
#pragma unroll
        for (int jj = 0; jj < 4; ++jj) { const int j = 4 * jg + jj; float sc = 0.f;
#pragma unroll
            for (int k = 0; k < 4; ++k) { sc += IA[(k * 64 + q) * 33 + j]; if (j > 0) sc += IB[(k * 64 + q) * 33 + j]; }
            const bool forced = (j == 0) || (j == qb) || (j == qb - 1);
            SC[q * 33 + j] = forced ? 1e30f : ((j <= qb) ? sc : -1e30f); }
        ATT_WAIT_BAR(0);
        unsigned nib = 0u;
        float sj[4];
#pragma unroll
        for (int jj = 0; jj < 4; ++jj) sj[jj] = SC[q * 33 + 4 * jg + jj];
        int rank[4] = {0, 0, 0, 0};
        for (int i = 0; i < 32; ++i) { const float si = SC[q * 33 + i];
#pragma unroll
            for (int jj = 0; jj < 4; ++jj) { const int j = 4 * jg + jj; rank[jj] += (si > sj[jj] || (si == sj[jj] && i < j)) ? 1 : 0; } }
#pragma unroll
        for (int jj = 0; jj < 4; ++jj) nib |= (rank[jj] < 16 ? 1u : 0u) << jj;
        ((LAS unsigned char*)(shm + L_NIB))[q * 8 + jg] = (unsigned char)nib;
        ATT_WAIT_BAR(0);
        if (tid < 64) { unsigned mk = 0u; int tq = tid; LAUNDER(tq);
#pragma unroll
            for (int k = 0; k < 8; ++k) mk |= (unsigned)((LAS unsigned char*)(shm + L_NIB))[tq * 8 + k] << (4 * k);
            SEL[tq] = mk; }
        ATT_WAIT_BAR(0);
    } else {
        if (tid < 64) SEL[tid] = (1u << (qb + 1)) - 1u;
        ATT_WAIT_BAR(0);
    }
    int lnx = c.lane, qlx2 = c.ql; LAUNDER(lnx); LAUNDER(qlx2);
    LAS float* accp = (LAS float*)(shm + L_IA) + c.wid * 2048 + lnx;
#pragma unroll
    for (int r = 0; r < 16; ++r) { accp[r * 64] = ot[0][r]; accp[(16 + r) * 64] = ot[1][r]; }
    unsigned um = SEL[lnx];
#pragma unroll
    for (int sft = 1; sft < 64; sft <<= 1) um |= (unsigned)__shfl_xor((int)um, sft);
    um = (unsigned)__builtin_amdgcn_readfirstlane((int)um);
    um &= (qb == 31) ? 0xffffffffu : ((1u << (qb + 1)) - 1u);
    const unsigned msel = SEL[qlx2];
    (void)um;
    {
        float l_sel; f32x16 osel[2];
        sel_stream<8>(c, KSb, VSb, qr, msel, qb, osel, l_sel);
        const float lt = halfsum(l_sel);
        float cf[16]; row_bcast((lt > 0.f) ? g1 / lt : 0.f, cf, c.wsf, c.r32, c.hi);
#pragma unroll
        for (int r = 0; r < 16; ++r) { accp[r * 64] += osel[0][r] * cf[r]; accp[(16 + r) * 64] += osel[1][r] * cf[r]; }
    }
    {
        const int lo_t = qb >= 8 ? qb - 8 : 0, nw = qb - lo_t + 1;
        dma_k(c, KWb, qb, 0); dma_v(c, VWb, qb, 0);
        if (nw > 1) { dma_k(c, KWb, qb - 1, 1); dma_v(c, VWb, qb - 1, 1); }
        BrState st; br_reset(st);
        int slot = 0;
        for (int j = 0; j < nw; ++j) {
            if (j + 1 < nw) ATT_WAIT_BAR(2); else ATT_WAIT_BAR(0);
            if (j + 2 < nw) { const int ps = (slot == 0) ? 2 : slot - 1; dma_k(c, KWb, qb - j - 2, ps); dma_v(c, VWb, qb - j - 2, ps); }
            const int tc = qb - j;
            bool use_range = false; int lo = 0, hv = 63;
            if (j == 0) { use_range = true; hv = c.ql; }
            else if (tc == qb - 8) { use_range = true; lo = c.ql + 1; }
            stream_step(c, slot, qr, true, use_range, lo, hv, j == 0, st);
            slot = (slot == 2) ? 0 : slot + 1;
        }
        const float lt = halfsum(st.l);
        float cf[16]; row_bcast((lt > 0.f) ? g2 / lt : 0.f, cf, c.wsf, c.r32, c.hi);
#pragma unroll
        for (int r = 0; r < 16; ++r) { ot[0][r] = accp[r * 64] + st.o[0][r] * cf[r]; ot[1][r] = accp[(16 + r) * 64] + st.o[1][r] * cf[r]; }
        LDS_WAIT();
    }
    {
        LAS bf16_t* stg = (LAS bf16_t*)(shm + L_IA) + c.wid * 4096;
        int lny = c.lane; LAUNDER(lny);
        LAS bf16_t* stw = stg + ((lny >> 5) * 4) * 64 + (lny & 31);
#pragma unroll
        for (int r = 0; r < 16; ++r) { const int orow = (r & 3) + 8 * (r >> 2);
#pragma unroll
            for (int d0 = 0; d0 < 2; ++d0) stw[orow * 64 + d0 * 32] = (bf16_t)(cvtpk(ot[d0][r], 0.f) & 0xffffu); }
        LDS_WAIT();
        bf16_t* Ow = O + ((size_t)qb * 64 + qh * 32) * DM + head * 64;
#pragma unroll
        for (int i = 0; i < 4; ++i) { const int row = i * 8 + (lny >> 3), chn = lny & 7; const u32x4 v = *(const LAS u32x4*)(stg + row * 64 + chn * 8); *(u32x4*)(Ow + (size_t)row * DM + chn * 8) = v; }
    }
    ATT_WAIT_BAR(0);
}
#undef SBAR
}

#define XB_TMO      128
#define XB_XCNT(j)  (256  + 64 * (j))
#define XB_XSUB(j)  (1280 + 64 * (j))
#define XB_XGEN(j)  (2304 + 64 * (j))
#define XB_TOP      3328
#define XB_TOPGEN   3392
#define XB_LSUB(j)  (3456 + 64 * (j))
#define XB_LGEN(j)  (4480 + 64 * (j))
#define XCD_BAR_WORDS 5504
#define XB_SPIN_CAP (1u << 18)
__device__ __forceinline__ unsigned xb_ld(unsigned* p)              { return __hip_atomic_load(p, __ATOMIC_RELAXED, __HIP_MEMORY_SCOPE_AGENT); }
__device__ __forceinline__ unsigned xb_add(unsigned* p, unsigned v) { return __hip_atomic_fetch_add(p, v, __ATOMIC_RELAXED, __HIP_MEMORY_SCOPE_AGENT); }
__device__ __forceinline__ unsigned xb_xcc_id() { return (unsigned)__builtin_amdgcn_s_getreg((3 << 11) | 20) & 0xFu; }
#define XB_SPIN(cond, bar) do { unsigned _sp = 0; while (cond) { __builtin_amdgcn_s_sleep(1); \
    if ((++_sp & 255u) == 0u) { if (xb_ld(&(bar)[XB_TMO])) break; if (_sp > XB_SPIN_CAP) { atomicAdd(&(bar)[XB_TMO], 1u); break; } } } } while (0)
struct XcdBarrier { unsigned* bar; unsigned x; volatile LAS unsigned* st; };
__device__ __forceinline__ XcdBarrier xcd_barrier_post(unsigned* bar, volatile LAS unsigned* st) {
    XcdBarrier b; b.bar = bar; b.x = xb_xcc_id(); b.st = st;
    if (threadIdx.x == 0) { st[2] = xb_add(&bar[XB_XCNT(b.x)], 1u); st[4] = b.x; }
    return b;
}
__device__ __forceinline__ void xcd_barrier_complete(unsigned* bar, unsigned x, unsigned& nloc, unsigned& nx, unsigned& uniform) {
    const unsigned G = gridDim.x * gridDim.y * gridDim.z;
    unsigned sum, cnt, mine, sp = 0u, uni;
    for (;;) {
        sum = 0u; cnt = 0u; mine = 0u; uni = 1u;
#pragma unroll
        for (unsigned j = 0; j < 16; ++j) { const unsigned c = xb_ld(&bar[XB_XCNT(j)]); sum += c; cnt += (c > 0u) ? 1u : 0u; mine = (j == x) ? c : mine;
            if (j < 8u ? (c != 32u) : (c != 0u)) uni = 0u; }
        if (sum == G) break;
        __builtin_amdgcn_s_sleep(1);
        if ((++sp & 255u) == 0u) { if (xb_ld(&bar[XB_TMO])) break; if (sp > XB_SPIN_CAP) { atomicAdd(&bar[XB_TMO], 1u); break; } }
    }
    nloc = mine > 0u ? mine : 1u; nx = cnt > 0u ? cnt : 1u;
    uniform = (uni != 0u && sum == G && G == 256u) ? 1u : 0u;
}
__device__ __forceinline__ void xcd_barrier(const XcdBarrier& b) {
    asm volatile("s_waitcnt vmcnt(0)" ::: "memory");
    __syncthreads();
    if (threadIdx.x == 0) {
        unsigned* bar = b.bar;
        __builtin_amdgcn_s_waitcnt(0);
        unsigned nloc = b.st[0], nx = b.st[1];
        if (nloc == 0u) { unsigned uf; xcd_barrier_complete(bar, b.x, nloc, nx, uf); b.st[0] = nloc; b.st[1] = nx; b.st[3] = uf; }
        const unsigned old = xb_add(&bar[XB_XSUB(b.x)], 1u);
        const unsigned gen = old / nloc;
        if (old + 1u == (gen + 1u) * nloc) {
            __builtin_amdgcn_fence(__ATOMIC_RELEASE, "agent");
            asm volatile("s_waitcnt vmcnt(0)" ::: "memory");
            const unsigned og = xb_add(&bar[XB_TOP], 1u);
            const unsigned tg = og / nx;
            if (og + 1u == (tg + 1u) * nx) xb_add(&bar[XB_TOPGEN], 1u);
            else XB_SPIN(xb_ld(&bar[XB_TOPGEN]) == tg, bar);
            __builtin_amdgcn_fence(__ATOMIC_ACQUIRE, "agent");
            xb_add(&bar[XB_XGEN(b.x)], 1u);
            asm volatile("s_waitcnt vmcnt(0)" ::: "memory");
        } else {
            XB_SPIN(xb_ld(&bar[XB_XGEN(b.x)]) == gen, bar);
            __builtin_amdgcn_fence(__ATOMIC_ACQUIRE, "agent");
            asm volatile("s_waitcnt vmcnt(0)" ::: "memory");
        }
    }
    __syncthreads();
}

__device__ __forceinline__ void xcd_local_barrier(const XcdBarrier& b) {
    asm volatile("s_waitcnt vmcnt(0)" ::: "memory");
    __syncthreads();
    if (threadIdx.x == 0) {
        unsigned* bar = b.bar;
        __builtin_amdgcn_s_waitcnt(0);
        const unsigned nloc = b.st[0];
        const unsigned old = xb_add(&bar[XB_LSUB(b.x)], 1u);
        const unsigned gen = old / nloc;
        if (old + 1u == (gen + 1u) * nloc) xb_add(&bar[XB_LGEN(b.x)], 1u);
        else XB_SPIN(xb_ld(&bar[XB_LGEN(b.x)]) == gen, bar);
        __builtin_amdgcn_fence(__ATOMIC_ACQUIRE, "agent");
        asm volatile("s_waitcnt vmcnt(0)" ::: "memory");
    }
    __syncthreads();
}

struct Args {
    const float *x, *c, *norm_gain, *w_ada, *b_ada, *w_a_in, *conv_w, *w_a_out, *w_qg, *q_gain, *w_o, *kv_norm_gain, *w_ada_kv, *b_ada_kv, *w_kv, *k_gain, *cmp_pe, *cmp_w1, *cmp_w2, *w_mlp1, *w_mlp2;
    float* out; unsigned char* ws; int ph_lo, ph_hi;
};

__device__ __forceinline__ void transpose_item(const float* W, int ldn, int srccol, int nvalid, int k0, bf16_t* WT, int Kd, int drow0, LAS float* scr, int lane) {
    if (nvalid == 32) {
        f32x4 t[8];
#pragma unroll
        for (int i = 0; i < 8; ++i) t[i] = __builtin_nontemporal_load((const f32x4*)(W + (size_t)(k0 + 8 * i + (lane >> 3)) * ldn + srccol + (lane & 7) * 4));
#pragma unroll
        for (int i = 0; i < 8; ++i) { LAS float* d = scr + (8 * i + (lane >> 3)) * 33 + (lane & 7) * 4; d[0] = t[i][0]; d[1] = t[i][1]; d[2] = t[i][2]; d[3] = t[i][3]; }
    } else {
#pragma unroll 8
        for (int i = 0; i < 32; ++i) { const int kk = 2 * i + (lane >> 5), n = lane & 31; scr[kk * 33 + n] = (n < nvalid) ? W[(size_t)(k0 + kk) * ldn + srccol + n] : 0.f; }
    }
    LDS_WAIT(); asm volatile("" ::: "memory");
    const int ch = lane & 7;
#pragma unroll
    for (int j = 0; j < 4; ++j) { const int n = (lane >> 3) + 8 * j; const LAS float* s = scr + (8 * ch) * 33 + n;
        u32x4 o; o.x = cvtpk(s[0 * 33], s[1 * 33]); o.y = cvtpk(s[2 * 33], s[3 * 33]); o.z = cvtpk(s[4 * 33], s[5 * 33]); o.w = cvtpk(s[6 * 33], s[7 * 33]);
        *(u32x4*)(WT + (size_t)(drow0 + n) * Kd + k0 + 8 * ch) = o; }
    LDS_WAIT(); asm volatile("" ::: "memory");
}
__device__ __forceinline__ int perm_head_cols(int d) { const int t = d >> 8, p = d & 255; return 256 * t + 64 * ((p >> 5) & 3) + 32 * (p >> 7) + (p & 31); }

constexpr int TI_AIN = 1536, TI_AOUT = 512, TI_M1 = 2048, TI_M2 = 2048, TI_KV = 768, TI_QG = 640, TI_O = 512, TI_C1 = 256, TI_C2 = 8;
constexpr int TI_TOTAL = TI_AIN + TI_AOUT + 2 * TI_M1 + 2 * TI_M2 + TI_KV + TI_QG + TI_O + 2 * TI_C1 + 2 * TI_C2;

__device__ __forceinline__ void p0_item(const Args& a, int it, LAS float* scr, int lane) {
    unsigned char* ws = a.ws;
    int r = it;
    if (r < TI_AIN) { const int kb = r / 96, nb = r % 96, d = 32 * nb; int src;
        if (d < 1024) src = d; else { const int t = (d - 1024) >> 8, p = (d - 1024) & 255; src = (p < 128) ? (1024 + 128 * t + p) : (2048 + 128 * t + (p - 128)); }
        transpose_item(a.w_a_in, 3072, src, 32, 64 * kb, (bf16_t*)(ws + WS_WAIN), 1024, d, scr, lane); return; }
    r -= TI_AIN;
    if (r < TI_AOUT) { const int kb = r / 32, nb = r % 32; transpose_item(a.w_a_out, 1024, 32 * nb, 32, 64 * kb, (bf16_t*)(ws + WS_WAOUT), 1024, 32 * nb, scr, lane); return; }
    r -= TI_AOUT;
    if (r < 2 * TI_M1) { const int L = r / TI_M1, q = r % TI_M1, kb = q / 128, nb = q % 128;
        transpose_item(a.w_mlp1 + (size_t)L * DM * FF, FF, 32 * nb, 32, 64 * kb, (bf16_t*)(ws + WS_WM1) + (size_t)L * FF * DM, DM, 32 * nb, scr, lane); return; }
    r -= 2 * TI_M1;
    if (r < 2 * TI_M2) { const int L = r / TI_M2, q = r % TI_M2, kb = q / 32, nb = q % 32;
        transpose_item(a.w_mlp2 + (size_t)L * FF * DM, DM, 32 * nb, 32, 64 * kb, (bf16_t*)(ws + WS_WM2) + (size_t)L * DM * FF, FF, 32 * nb, scr, lane); return; }
    r -= 2 * TI_M2;
    if (r < TI_KV) { const int kb = r / 48, nb = r % 48, d = 32 * nb;
        transpose_item(a.w_kv, 1536, perm_head_cols(d), 32, 64 * kb, (bf16_t*)(ws + WS_WKVQ), DM, d, scr, lane); return; }
    r -= TI_KV;
    if (r < TI_QG) { const int kb = r / 40, nb = r % 40, d = 32 * nb; int src, nv = 32;
        if (d < 1024) src = perm_head_cols(d); else { const int p = d - 1024; src = 1024 + p; nv = 48 - p; nv = nv < 0 ? 0 : (nv > 32 ? 32 : nv); if (nv == 0) src = 0; }
        transpose_item(a.w_qg, 1072, src, nv, 64 * kb, (bf16_t*)(ws + WS_WKVQ), DM, 1536 + d, scr, lane); return; }
    r -= TI_QG;
    if (r < TI_O) { const int kb = r / 32, nb = r % 32; transpose_item(a.w_o, 1024, 32 * nb, 32, 64 * kb, (bf16_t*)(ws + WS_WO), 1024, 32 * nb, scr, lane); return; }
    r -= TI_O;
    if (r < 2 * TI_C1) { const int kv = r / TI_C1, q = r % TI_C1, kb = q / 8, nb = q % 8;
        transpose_item(a.cmp_w1 + (size_t)kv * 2048 * 256, 256, 32 * nb, 32, 64 * kb, (bf16_t*)(ws + WS_WC1) + (size_t)kv * 256 * 2048, 2048, 32 * nb, scr, lane); return; }
    r -= 2 * TI_C1;
    { const int kv = r / TI_C2, q = r % TI_C2, kb = q / 2, nb = q % 2;
        transpose_item(a.cmp_w2 + (size_t)kv * 256 * 64, 64, 32 * nb, 32, 64 * kb, (bf16_t*)(ws + WS_WC2) + (size_t)kv * 64 * 256, 256, 32 * nb, scr, lane); }
}

__device__ __forceinline__ void p0_mods(const Args& a, LAS unsigned char* lds, int vblk, int G) {
    LAS float* cact = (LAS float*)lds;
    LAS float* red = (LAS float*)(lds + 32768);
    const int tid = threadIdx.x, lane = tid & 63, wave = tid >> 6;
    bool have = false;
    for (int u = vblk; u < 224; u += G) {
        if (!have) { for (int i = tid; i < 8 * DM; i += 512) { const float cv = a.c[i]; cact[i] = cv / (1.0f + __expf(-cv)); } have = true; }
        __syncthreads();
        const int col = u * 64 + lane;
        const float* W; const float* bias; float* dst; int N, c0;
        if (col < 6144) { W = a.w_ada; bias = a.b_ada; dst = (float*)(a.ws + WS_MOD0); N = 6144; c0 = col; }
        else if (col < 12288) { W = a.w_ada + (size_t)DM * 6144; bias = a.b_ada + 6144; dst = (float*)(a.ws + WS_MOD1); N = 6144; c0 = col - 6144; }
        else { W = a.w_ada_kv; bias = a.b_ada_kv; dst = (float*)(a.ws + WS_MODKV); N = 2048; c0 = col - 12288; }
        float acc[8];
#pragma unroll
        for (int b = 0; b < 8; ++b) acc[b] = 0.f;
        const float* wp = W + (size_t)(wave * 128) * N + c0;
        const LAS float* cp = cact + wave * 128;
#pragma unroll 8
        for (int k = 0; k < 128; ++k) { const float w = __builtin_nontemporal_load(wp + (size_t)k * N);
#pragma unroll
            for (int b = 0; b < 8; ++b) acc[b] += w * cp[b * DM + k]; }
#pragma unroll
        for (int b = 0; b < 8; ++b) red[(wave * 8 + b) * 64 + lane] = acc[b];
        __syncthreads();
        { const int b = wave; float sacc = bias[c0];
#pragma unroll
          for (int w = 0; w < 8; ++w) sacc += red[(w * 8 + b) * 64 + lane];
          dst[(size_t)b * N + c0] = sacc; }
        __syncthreads();
    }
    __syncthreads();
}

__device__ __forceinline__ void p1_norm_row2(const Args& a, int m0, int lane) {
    const int b = m0 >> 11;
    const float* mod0 = (const float*)(a.ws + WS_MOD0) + (size_t)b * 6144;
    const f32x4* xr = (const f32x4*)(a.x + (size_t)m0 * DM) + lane;
    f32x4 v[2][4]; float s0 = 0.f, s1 = 0.f;
#pragma unroll
    for (int j = 0; j < 4; ++j) { v[0][j] = __builtin_nontemporal_load(xr + 64 * j); v[1][j] = __builtin_nontemporal_load(xr + 256 + 64 * j); }
#pragma unroll
    for (int j = 0; j < 4; ++j) { s0 += (v[0][j][0] * v[0][j][0] + v[0][j][1] * v[0][j][1]) + (v[0][j][2] * v[0][j][2] + v[0][j][3] * v[0][j][3]);
                                  s1 += (v[1][j][0] * v[1][j][0] + v[1][j][1] * v[1][j][1]) + (v[1][j][2] * v[1][j][2] + v[1][j][3] * v[1][j][3]); }
#pragma unroll
    for (int o = 1; o < 64; o <<= 1) { s0 += __shfl_xor(s0, o); s1 += __shfl_xor(s1, o); }
    const float r0 = rsqrtf(s0 * (1.0f / DM) + EPS), r1 = rsqrtf(s1 * (1.0f / DM) + EPS);
    u32x2* o8 = (u32x2*)((bf16_t*)(a.ws + WS_A2) + (size_t)m0 * DM) + lane;
#pragma unroll
    for (int j = 0; j < 4; ++j) { const int col = 4 * lane + 256 * j;
        const f32x4 gn = *(const f32x4*)(a.norm_gain + col), sh = *(const f32x4*)(mod0 + col), sc = *(const f32x4*)(mod0 + 1024 + col) + 1.0f;
        const f32x4 h0 = (v[0][j] * r0 * gn) * sc + sh, h1 = (v[1][j] * r1 * gn) * sc + sh;
        u32x2 w; w.x = cvtpk(h0[0], h0[1]); w.y = cvtpk(h0[2], h0[3]); o8[64 * j] = w;
        w.x = cvtpk(h1[0], h1[1]); w.y = cvtpk(h1[2], h1[3]); o8[256 + 64 * j] = w; }
}
__device__ __forceinline__ void p1_bias_task(const bf16_t* Wt, int n0, const float* shift, int shift_stride, float* bias, int bias_stride, int lane) {
    const int r = lane & 15, kq = lane >> 4;
    const bf16_t* wp = Wt + (size_t)(n0 + r) * DM + 8 * kq;
    const float* sp = shift + (size_t)(r & 7) * shift_stride + 8 * kq;
    f32x4 acc = (f32x4){0.f, 0.f, 0.f, 0.f};
#pragma unroll 8
    for (int k0 = 0; k0 < DM; k0 += 32) {
        const bf16x8 bf = *(const bf16x8*)(wp + k0);
        const f32x4 s0 = *(const f32x4*)(sp + k0), s1 = *(const f32x4*)(sp + k0 + 4);
        u32x4 aw; aw.x = cvtpk(s0[0], s0[1]); aw.y = cvtpk(s0[2], s0[3]); aw.z = cvtpk(s1[0], s1[1]); aw.w = cvtpk(s1[2], s1[3]);
        if (r >= 8) aw = (u32x4){0u, 0u, 0u, 0u};
        acc = __builtin_amdgcn_mfma_f32_16x16x32_bf16(__builtin_bit_cast(bf16x8, aw), bf, acc, 0, 0, 0);
    }
    if (kq < 2) {
#pragma unroll
        for (int e = 0; e < 4; ++e) bias[(size_t)(4 * kq + e) * bias_stride + n0 + r] = acc[e];
    }
}
__device__ __forceinline__ void p1_pebias(const Args& a, int idx, int lane) {
    const int kv = idx >> 8;
    const bf16_t* wrow = (const bf16_t*)(a.ws + WS_WC1) + (size_t)idx * 2048;
    const float* pe = a.cmp_pe + (size_t)kv * 2048;
    float d = 0.f;
#pragma unroll
    for (int j = 0; j < 4; ++j) { const int k = (lane + 64 * j) * 8; const u32x4 w = *(const u32x4*)(wrow + k); const f32x4 p0 = *(const f32x4*)(pe + k), p1 = *(const f32x4*)(pe + k + 4);
        d += p0[0] * bf_lo(w.x) + p0[1] * bf_hi(w.x) + p0[2] * bf_lo(w.y) + p0[3] * bf_hi(w.y) + p1[0] * bf_lo(w.z) + p1[1] * bf_hi(w.z) + p1[2] * bf_lo(w.w) + p1[3] * bf_hi(w.w); }
    d = wave_sum(d);
    if (lane == 0) ((float*)(a.ws + WS_PEB))[idx] = d;
}

__device__ __forceinline__ void unpack8(const u32x4 w, float (&f)[8]) { f[0] = bf_lo(w.x); f[1] = bf_hi(w.x); f[2] = bf_lo(w.y); f[3] = bf_hi(w.y); f[4] = bf_lo(w.z); f[5] = bf_hi(w.z); f[6] = bf_lo(w.w); f[7] = bf_hi(w.w); }
__device__ __forceinline__ void p3_conv(const Args& a, int gtid, int nthreads) {
    for (int it0 = gtid; it0 < 128 * 2048; it0 += nthreads) {
        const int pass = it0 / nthreads, vt = it0 - pass * nthreads;
        const int it = (nthreads == 131072) ? ((vt >> 14) * 32768 + pass * 16384 + (vt & 16383)) : it0;
        const int cch = it & 127, rch = it >> 7, col = cch * 8, r0 = (rch * 8) & (SEQ - 1);
        unsigned char* slab = a.ws + WS_R + (size_t)((rch * 8) >> 11) * SLAB;
        const bf16_t* GB = (const bf16_t*)(slab + SO_GB); const bf16_t* V = (const bf16_t*)(slab + SO_V); bf16_t* Y = (bf16_t*)(slab + SO_Y);
        float w0[8], w1[8], w2[8];
        { const f32x4 t0 = *(const f32x4*)(a.conv_w + col), t1 = *(const f32x4*)(a.conv_w + col + 4); w0[0] = t0[0]; w0[1] = t0[1]; w0[2] = t0[2]; w0[3] = t0[3]; w0[4] = t1[0]; w0[5] = t1[1]; w0[6] = t1[2]; w0[7] = t1[3]; }
        { const f32x4 t0 = *(const f32x4*)(a.conv_w + 1024 + col), t1 = *(const f32x4*)(a.conv_w + 1024 + col + 4); w1[0] = t0[0]; w1[1] = t0[1]; w1[2] = t0[2]; w1[3] = t0[3]; w1[4] = t1[0]; w1[5] = t1[1]; w1[6] = t1[2]; w1[7] = t1[3]; }
        { const f32x4 t0 = *(const f32x4*)(a.conv_w + 2048 + col), t1 = *(const f32x4*)(a.conv_w + 2048 + col + 4); w2[0] = t0[0]; w2[1] = t0[1]; w2[2] = t0[2]; w2[3] = t0[3]; w2[4] = t1[0]; w2[5] = t1[1]; w2[6] = t1[2]; w2[7] = t1[3]; }
        float vm2[8], vm1[8];
        if ((r0 & (SEQ - 1)) != 0) { unpack8(*(const u32x4*)(V + (size_t)(r0 - 2) * DM + col), vm2); unpack8(*(const u32x4*)(V + (size_t)(r0 - 1) * DM + col), vm1); }
        else {
#pragma unroll
            for (int e = 0; e < 8; ++e) { vm2[e] = 0.f; vm1[e] = 0.f; } }
#pragma unroll
        for (int i = 0; i < 8; ++i) { float vc[8], gb[8], y[8];
            unpack8(*(const u32x4*)(V + (size_t)(r0 + i) * DM + col), vc); unpack8(*(const u32x4*)(GB + (size_t)(r0 + i) * DM + col), gb);
#pragma unroll
            for (int e = 0; e < 8; ++e) { y[e] = gb[e] * (w2[e] * vc[e] + w1[e] * vm1[e] + w0[e] * vm2[e]); vm2[e] = vm1[e]; vm1[e] = vc[e]; }
            u32x4 w; w.x = cvtpk(y[0], y[1]); w.y = cvtpk(y[2], y[3]); w.z = cvtpk(y[4], y[5]); w.w = cvtpk(y[6], y[7]);
            *(u32x4*)(Y + (size_t)(r0 + i) * DM + col) = w; }
    }
}

__device__ __forceinline__ float gelu_tanh(float x) {
    const float z = 0.7978845608028654f * (x + 0.044715f * x * x * x);
    const float e = __builtin_amdgcn_exp2f(z * 2.8853900817779268f);
    const float th = 1.0f - 2.0f / (e + 1.0f);
    return 0.5f * x * (1.0f + th);
}
constexpr int C_CH = 2064;
constexpr int C_RB0 = 68608;
constexpr int C_HOFF = C_RB0, C_HROW = 528;
__device__ __forceinline__ void p8_unit(const Args& a, int u, LAS unsigned char* lds) {
    const int tid = threadIdx.x, lane = tid & 63, wid = __builtin_amdgcn_readfirstlane(tid >> 6), r = lane & 31, h = lane >> 5;
    const int kv = u >> 7, bg = (u >> 2) & 31, rq = u & 3;
    unsigned char* slab = a.ws + WS_R + (size_t)(bg >> 2) * SLAB;
    const bf16_t* src = (const bf16_t*)(slab + SO_KV) + ((size_t)(kv * 4 + (bg & 3)) * SEQ + 512 * rq) * 64;
    __syncthreads();
    { u32x4 v[8];
#pragma unroll
      for (int j = 0; j < 8; ++j) v[j] = *(const u32x4*)(src + (size_t)(tid + 512 * j) * 8);
      u32x4 vl = (u32x4){0u, 0u, 0u, 0u};
      if (tid < 128 && rq != 3) vl = *(const u32x4*)(src + (size_t)32 * 1024 + tid * 8);
#pragma unroll
      for (int j = 0; j < 8; ++j) { const int idx = tid + 512 * j; *(LAS u32x4*)(lds + (idx >> 7) * C_CH + (idx & 127) * 16) = v[j]; }
      if (tid < 128) *(LAS u32x4*)(lds + 32 * C_CH + tid * 16) = vl; }
    __syncthreads();
    f32x16 acc = f32x16{};
    const unsigned lds0 = (unsigned)(size_t)lds;
    const bf16_t* Wsrc = (const bf16_t*)(a.ws + WS_WC1) + (size_t)(kv * 256) * 2048;
    const int drow = 16 * wid + (lane >> 2);
    const bf16_t* dsrc0 = Wsrc + (size_t)drow * 2048 + 8 * ((lane & 3) ^ ((drow >> 2) & 3));
    const bf16_t* dsrc1 = dsrc0 + (size_t)128 * 2048;
    const unsigned ddst0 = lds0 + C_RB0 + wid * 1024, ddst1 = ddst0 + 8192;
    const int brow = 32 * wid + r;
    const unsigned boff = C_RB0 + brow * 64, bkey = (brow >> 2) & 3;
#define P8_DMA(stg) do { att::glds16(dsrc0 + 32 * (stg), (unsigned)__builtin_amdgcn_readfirstlane(ddst0 + ((stg) & 3) * 16384)); att::glds16(dsrc1 + 32 * (stg), (unsigned)__builtin_amdgcn_readfirstlane(ddst1 + ((stg) & 3) * 16384)); } while (0)
#define P8_STEP(stg, WAITN) do { asm volatile("s_waitcnt vmcnt(" #WAITN ") lgkmcnt(0)\n\ts_barrier" ::: "memory"); \
        if ((stg) + 3 < 64) P8_DMA((stg) + 3); \
        { const LAS unsigned char* bp = lds + boff + ((stg) & 3) * 16384; \
          const LAS unsigned char* ap = lds + (r + ((stg) >> 5)) * C_CH + ((32 * (stg)) & 1023) * 2 + 16 * h; \
          const bf16x8 a0 = *(const LAS bf16x8*)ap, a1 = *(const LAS bf16x8*)(ap + 32); \
          const bf16x8 b0 = *(const LAS bf16x8*)(bp + 16 * ((unsigned)h ^ bkey)), b1 = *(const LAS bf16x8*)(bp + 16 * ((unsigned)(2 + h) ^ bkey)); \
          acc = __builtin_amdgcn_mfma_f32_32x32x16_bf16(a0, b0, acc, 0, 0, 0); acc = __builtin_amdgcn_mfma_f32_32x32x16_bf16(a1, b1, acc, 0, 0, 0); } } while (0)
    P8_DMA(0); P8_DMA(1); P8_DMA(2);
    for (int s4 = 0; s4 < 60; s4 += 4) { P8_STEP(s4, 4); P8_STEP(s4 + 1, 4); P8_STEP(s4 + 2, 4); P8_STEP(s4 + 3, 4); }
    P8_STEP(60, 4); P8_STEP(61, 4); P8_STEP(62, 2); P8_STEP(63, 0);
    asm volatile("s_waitcnt lgkmcnt(0)\n\ts_barrier" ::: "memory");
#undef P8_DMA
#undef P8_STEP
    { const float pb = ((const float*)(a.ws + WS_PEB))[kv * 256 + 32 * wid + r];
      LAS bf16_t* H = (LAS bf16_t*)(lds + C_HOFF);
#pragma unroll
      for (int rg = 0; rg < 16; ++rg) { const int row = att::crow(rg, h); H[row * (C_HROW / 2) + 32 * wid + r] = (bf16_t)(cvtpk(gelu_tanh(acc[rg] + pb), 0.f) & 0xffffu); } }
    __syncthreads();
    if (wid == 0) {
        f32x16 o0 = f32x16{}, o1 = f32x16{};
        const bf16_t* W2 = (const bf16_t*)(a.ws + WS_WC2) + (size_t)kv * 64 * 256;
#pragma unroll
        for (int s = 0; s < 16; ++s) {
            const bf16x8 af = *(const LAS bf16x8*)(lds + C_HOFF + r * C_HROW + (16 * s + 8 * h) * 2);
            const bf16x8 b0 = *(const bf16x8*)(W2 + (size_t)r * 256 + 16 * s + 8 * h), b1 = *(const bf16x8*)(W2 + (size_t)(32 + r) * 256 + 16 * s + 8 * h);
            o0 = __builtin_amdgcn_mfma_f32_32x32x16_bf16(af, b0, o0, 0, 0, 0); o1 = __builtin_amdgcn_mfma_f32_32x32x16_bf16(af, b1, o1, 0, 0, 0);
        }
        const float gk0 = a.k_gain[r], gk1 = a.k_gain[32 + r];
        bf16_t* dst = (bf16_t*)(slab + (kv == 0 ? SO_KC : SO_VC)) + (size_t)(bg & 3) * 8192;
#pragma unroll
        for (int rg = 0; rg < 16; ++rg) { float v0 = o0[rg], v1 = o1[rg];
            if (kv == 0) { float ss = v0 * v0 + v1 * v1;
#pragma unroll
                for (int sft = 1; sft < 32; sft <<= 1) ss += __shfl_xor(ss, sft);
                const float rs = rsqrtf(ss * (1.0f / 64.0f) + EPS); v0 *= rs * gk0; v1 *= rs * gk1; }
            const int n = 32 * rq + att::crow(rg, h);
            if (n == 127) { v0 = 0.f; v1 = 0.f; }
            dst[n * 64 + r] = (bf16_t)(cvtpk(v0, 0.f) & 0xffffu); dst[n * 64 + 32 + r] = (bf16_t)(cvtpk(v1, 0.f) & 0xffffu); }
    }
}

__device__ __forceinline__ void p4_fixup(const Args& a, int pm) {
    const int tid = threadIdx.x;
    if (tid < 256) {
        const int rr = tid >> 7, cc = (tid & 127) * 8, pml = pm & 7, srow = pml * 256 + rr;
        unsigned char* slab = a.ws + WS_R + (size_t)(pm >> 3) * SLAB;
        const bf16_t* V = (const bf16_t*)(slab + SO_V); const bf16_t* GBH = (const bf16_t*)(slab + SO_GB) + (size_t)pml * 2 * DM; bf16_t* Y = (bf16_t*)(slab + SO_Y);
        float gb[8], v0[8], v1[8], v2[8], y[8];
        unpack8(*(const u32x4*)(GBH + (size_t)rr * DM + cc), gb);
        unpack8(*(const u32x4*)(V + (size_t)srow * DM + cc), v0);
        if (srow >= 1) unpack8(*(const u32x4*)(V + (size_t)(srow - 1) * DM + cc), v1); else {
#pragma unroll
            for (int e = 0; e < 8; ++e) v1[e] = 0.f; }
        if (srow >= 2) unpack8(*(const u32x4*)(V + (size_t)(srow - 2) * DM + cc), v2); else {
#pragma unroll
            for (int e = 0; e < 8; ++e) v2[e] = 0.f; }
#pragma unroll
        for (int e = 0; e < 8; ++e) y[e] = gb[e] * (a.conv_w[2 * DM + cc + e] * v0[e] + a.conv_w[DM + cc + e] * v1[e] + a.conv_w[cc + e] * v2[e]);
        u32x4 w; w.x = cvtpk(y[0], y[1]); w.y = cvtpk(y[2], y[3]); w.z = cvtpk(y[4], y[5]); w.w = cvtpk(y[6], y[7]);
        *(u32x4*)(Y + (size_t)srow * DM + cc) = w;
    }
}

__global__ void __launch_bounds__(NWAVES * 64, 2) yoco_fwd(Args args) {
    extern __shared__ __attribute__((aligned(16))) unsigned char lds_raw[];
    LAS unsigned char* lds = (LAS unsigned char*)lds_raw;
    const int tid = threadIdx.x, lane = tid & 63, wave = __builtin_amdgcn_readfirstlane(tid >> 6);
    const int G = gridDim.x, bx = blockIdx.x;
    int vcu = (G % 8 == 0) ? (bx % 8) * (G / 8) + bx / 8 : bx;
    int cid = bx;
    const int gw = vcu * NWAVES + wave, NGW = G * NWAVES;
    unsigned char* ws = args.ws;
    const int lo = args.ph_lo, hi = args.ph_hi;
    volatile LAS unsigned* MISC = (volatile LAS unsigned*)(lds + LDS_BYTES - 256);
    if (tid < 8) MISC[tid] = 0u;
    __syncthreads();
    XcdBarrier bar; bar.bar = (unsigned*)(ws + WS_BAR); bar.x = 0; bar.st = MISC;
    if (hi - lo > 1) bar = xcd_barrier_post((unsigned*)(ws + WS_BAR), MISC);
#define IN(k) (lo <= (k) && (k) < hi)
#define SEAM(k) do { if (IN(k) && IN((k) + 1)) xcd_barrier(bar); } while (0)
#define LSEAM(k) do { if (IN(k) && IN((k) + 1)) { if (local_ok) xcd_local_barrier(bar); else xcd_barrier(bar); } } while (0)
    bool local_ok = false;
    float* MOD0 = (float*)(ws + WS_MOD0); float* MOD1 = (float*)(ws + WS_MOD1); float* MODKV = (float*)(ws + WS_MODKV);
    float* SS1 = (float*)(ws + WS_SS1); float* SS2 = (float*)(ws + WS_SS2); float* SS3 = (float*)(ws + WS_SS3);
    bf16_t* A1 = (bf16_t*)(ws + WS_A1); bf16_t* A2 = (bf16_t*)(ws + WS_A2);
    bf16_t* HB = (bf16_t*)(ws + WS_H);

    if (IN(0)) {
        p0_mods(args, lds, vcu, G);
        LAS float* scr = (LAS float*)(lds + wave * 16384);
        for (int it = gw; it < TI_TOTAL; it += NGW) p0_item(args, it, scr, lane);
    }
    SEAM(0);
    if (IN(1)) {
        for (int m = gw; m < M_TOK / 2; m += NGW) p1_norm_row2(args, 2 * m, lane);
        for (int it = gw; it < (2 * FF + NKVQ) / 16 + 512; it += NGW) {
            const int n = it * 16;
            if (n < FF) p1_bias_task((const bf16_t*)(ws + WS_WM1), n, MOD0 + 3072, 6144, (float*)(ws + WS_BM1L0), FF, lane);
            else if (n < 2 * FF) p1_bias_task((const bf16_t*)(ws + WS_WM1) + (size_t)FF * DM, n - FF, MOD1 + 3072, 6144, (float*)(ws + WS_BM1L1), FF, lane);
            else if (n < 2 * FF + 1536) p1_bias_task((const bf16_t*)(ws + WS_WKVQ), n - 2 * FF, MODKV, 2048, (float*)(ws + WS_BKVQ), NKVQ, lane);
            else if (n < 2 * FF + NKVQ) p1_bias_task((const bf16_t*)(ws + WS_WKVQ), n - 2 * FF, MOD1, 6144, (float*)(ws + WS_BKVQ), NKVQ, lane);
            else p1_pebias(args, it - (2 * FF + NKVQ) / 16, lane);
        }
    }
    SEAM(1);
    if (hi - lo > 1 && lo <= 1) {
        local_ok = MISC[3] != 0u;
        if (local_ok) { const int x = (int)MISC[4], rk = (int)MISC[2]; vcu = x * 32 + rk; cid = rk * 8 + x; }
    }
    if (IN(2)) {
        pg8::Gemm g{A2, A2, 1 << 30, (const bf16_t*)(ws + WS_WAIN), M_TOK, 3072, DM, (size_t)SEQ * DM * 2}; pg8::StaticOrder S; S.init_ain(G, cid);
        pg8::EpiAin E{ws + WS_R, args.conv_w};
        pg8::gemm_phase(lds, g, S, E);
    }
    LSEAM(2);
    if (IN(4)) {
        pg8::Gemm g{(const bf16_t*)(ws + WS_R + SO_Y), (const bf16_t*)(ws + WS_R + SO_Y), 1 << 30, (const bf16_t*)(ws + WS_WAOUT), M_TOK, DM, DM, SLAB}; pg8::StaticOrder S; S.init(M_TOK, DM, G, cid);
        { pg8::Unit fu; for (int i = 0; S.next(i, fu); ++i) p4_fixup(args, fu.pm); asm volatile("s_waitcnt vmcnt(0)" ::: "memory"); __syncthreads(); }
        pg8::EpiRes<1, 0, 2> E{args.x, nullptr, MOD0 + 2048, 6144, args.norm_gain + 1024, MOD0 + 4096, 6144, A1, nullptr, nullptr, 0, nullptr, SS1, nullptr, nullptr, 0};
        pg8::gemm_phase(lds, g, S, E);
    }
    LSEAM(4);
    if (IN(5)) {
        pg8::Gemm g{A1, A1, 1 << 30, (const bf16_t*)(ws + WS_WM1), M_TOK, FF, DM, (size_t)SEQ * DM * 2}; pg8::StaticOrder S; S.init(M_TOK, FF, G, cid);
        pg8::EpiMlp1 E{HB, (const float*)(ws + WS_BM1L0), SS1};
        pg8::gemm_phase(lds, g, S, E);
    }
    LSEAM(5);
    if (IN(6)) {
        pg8::Gemm g{HB, HB, 1 << 30, (const bf16_t*)(ws + WS_WM2), M_TOK, DM, FF, (size_t)SEQ * FF * 2}; pg8::StaticOrder S; S.init(M_TOK, DM, G, cid);
        pg8::EpiRes<2, 2, 2> E{A1, nullptr, MOD0 + 5120, 6144, args.kv_norm_gain, MODKV + 1024, 2048, A1, args.norm_gain + 2048, MOD1 + 1024, 6144, A2, SS2, args.norm_gain + 1024, MOD0 + 4096, 6144};
        pg8::gemm_phase(lds, g, S, E);
    }
    LSEAM(6);
    if (IN(7)) {
        pg8::Gemm g{A1, A2, 6, (const bf16_t*)(ws + WS_WKVQ), M_TOK, NKVQ, DM, (size_t)SEQ * DM * 2}; pg8::StaticOrder S; S.init(M_TOK, NKVQ, G, cid);
        pg8::EpiKVQ E{ws + WS_R, (const float*)(ws + WS_BKVQ), SS2, args.k_gain, args.q_gain};
        pg8::gemm_phase(lds, g, S, E);
    }
    LSEAM(7);
    if (IN(8)) { for (int v = vcu; v < 256; v += G) { const int rk = v & 31; p8_unit(args, ((rk >> 4) << 7) | ((((v >> 5) << 2) | ((rk >> 2) & 3)) << 2) | (rk & 3), lds); } __syncthreads(); }
    LSEAM(8);
    if (IN(9)) {
        if (wave >= 4) __builtin_amdgcn_s_setprio(1);
        for (int v = vcu; v < 256; v += G) { const int bgp = v >> 3, s = v & 7;
            for (int i = 0; i < 4; ++i) { const int qb = (i == 0) ? s : (i == 1) ? 15 - s : (i == 2) ? 16 + s : 31 - s;
                att::attn_unit(bgp >> 2, bgp & 3, qb, ws + WS_R + (size_t)(bgp >> 2) * SLAB, lds); } }
        __builtin_amdgcn_s_setprio(0);
    }
    LSEAM(9);
    if (IN(10)) {
        pg8::Gemm g{(const bf16_t*)(ws + WS_R + SO_O), (const bf16_t*)(ws + WS_R + SO_O), 1 << 30, (const bf16_t*)(ws + WS_WO), M_TOK, DM, DM, SLAB}; pg8::StaticOrder S; S.init(M_TOK, DM, G, cid);
        pg8::EpiRes<1, 2, 2> E{A2, nullptr, MOD1 + 2048, 6144, args.norm_gain + 3072, MOD1 + 4096, 6144, A1, nullptr, nullptr, 0, nullptr, SS3, args.norm_gain + 2048, MOD1 + 1024, 6144};
        pg8::gemm_phase(lds, g, S, E);
    }
    LSEAM(10);
    if (IN(11)) {
        pg8::Gemm g{A1, A1, 1 << 30, (const bf16_t*)(ws + WS_WM1) + (size_t)FF * DM, M_TOK, FF, DM, (size_t)SEQ * DM * 2}; pg8::StaticOrder S; S.init(M_TOK, FF, G, cid);
        pg8::EpiMlp1 E{HB, (const float*)(ws + WS_BM1L1), SS3};
        pg8::gemm_phase(lds, g, S, E);
    }
    LSEAM(11);
    if (IN(12)) {
        pg8::Gemm g{HB, HB, 1 << 30, (const bf16_t*)(ws + WS_WM2) + (size_t)DM * FF, M_TOK, DM, FF, (size_t)SEQ * FF * 2}; pg8::StaticOrder S; S.init(M_TOK, DM, G, cid);
        pg8::EpiRes<0, 2, 0> E{A1, args.out, MOD1 + 5120, 6144, nullptr, nullptr, 0, nullptr, nullptr, nullptr, 0, nullptr, nullptr, args.norm_gain + 3072, MOD1 + 4096, 6144};
        pg8::gemm_phase(lds, g, S, E);
    }
#undef IN
#undef SEAM
}

extern "C" void kernel_launch(void* const* d_in, const int* in_sizes, int n_in, void* d_out, int out_size, void* d_ws, size_t ws_size, hipStream_t stream) {
    static int grid = 0;
    if (grid == 0) {
        if (n_in != 21 || in_sizes[0] != M_TOK * DM || out_size != M_TOK * DM || ws_size < WS_END) { fprintf(stderr, "kernel_launch: unexpected shapes (n_in %d, in0 %d, out %d, ws %zu); nothing launched\n", n_in, n_in > 0 ? in_sizes[0] : -1, out_size, ws_size); grid = -1; return; }
        int dev = 0, cus = 0, per_cu = 0;
        if (hipGetDevice(&dev) != hipSuccess || hipDeviceGetAttribute(&cus, hipDeviceAttributeMultiprocessorCount, dev) != hipSuccess) { grid = -1; return; }
        if (hipFuncSetAttribute((const void*)yoco_fwd, hipFuncAttributeMaxDynamicSharedMemorySize, LDS_BYTES) != hipSuccess) { fprintf(stderr, "kernel_launch: hipFuncSetAttribute failed\n"); grid = -1; return; }
        if (hipOccupancyMaxActiveBlocksPerMultiprocessor(&per_cu, (const void*)yoco_fwd, NWAVES * 64, LDS_BYTES) != hipSuccess || per_cu < 1) { fprintf(stderr, "kernel_launch: occupancy query says %d blocks per CU\n", per_cu); per_cu = 1; }
        (void)hipGetLastError();
        grid = cus;
        if (grid != 256) { fprintf(stderr, "kernel_launch: this build deals the w_a_in tiles to exactly 256 workgroups (device has %d CUs); nothing launched\n", cus); grid = -1; return; }
    }
    if (grid < 0) return;
    (void)hipMemsetAsync((char*)d_ws + WS_ZERO, 0, ZERO_BYTES, stream);
    Args a{};
    a.x = (const float*)d_in[0]; a.c = (const float*)d_in[1]; a.norm_gain = (const float*)d_in[2]; a.w_ada = (const float*)d_in[3]; a.b_ada = (const float*)d_in[4];
    a.w_a_in = (const float*)d_in[5]; a.conv_w = (const float*)d_in[6]; a.w_a_out = (const float*)d_in[7]; a.w_qg = (const float*)d_in[8]; a.q_gain = (const float*)d_in[9];
    a.w_o = (const float*)d_in[10]; a.kv_norm_gain = (const float*)d_in[11]; a.w_ada_kv = (const float*)d_in[12]; a.b_ada_kv = (const float*)d_in[13]; a.w_kv = (const float*)d_in[14];
    a.k_gain = (const float*)d_in[15]; a.cmp_pe = (const float*)d_in[16]; a.cmp_w1 = (const float*)d_in[17]; a.cmp_w2 = (const float*)d_in[18]; a.w_mlp1 = (const float*)d_in[19]; a.w_mlp2 = (const float*)d_in[20];
    a.out = (float*)d_out; a.ws = (unsigned char*)d_ws;
#if MK_N_LAUNCHES == 1
    a.ph_lo = 0; a.ph_hi = N_PHASES;
    void* kargs[] = {&a};
    hipError_t e = hipLaunchCooperativeKernel((const void*)yoco_fwd, dim3(grid), dim3(NWAVES * 64), kargs, LDS_BYTES, stream);
    if (e != hipSuccess) fprintf(stderr, "kernel_launch: cooperative launch failed: %s (grid %d)\n", hipGetErrorString(e), grid);
#else
    for (int p = 0; p < N_PHASES; ++p) { a.ph_lo = p; a.ph_hi = p + 1; hipLaunchKernelGGL(yoco_fwd, dim3(grid), dim3(NWAVES * 64), LDS_BYTES, stream, a); }
#endif
}
```

```cpp
#include <hip/hip_runtime.h>
#include <cstdio>
#include <cstdint>
#include <cmath>

#ifndef MK_N_LAUNCHES
#define MK_N_LAUNCHES 1
#endif
constexpr int N_PHASES = 13;

#define LAS __attribute__((address_space(3)))
typedef unsigned short bf16_t;
typedef short bf16x8 __attribute__((ext_vector_type(8)));
typedef short s16x4 __attribute__((ext_vector_type(4)));
typedef float f32x2 __attribute__((ext_vector_type(2)));
typedef float f32x4 __attribute__((ext_vector_type(4)));
typedef float f32x16 __attribute__((ext_vector_type(16)));
typedef unsigned u32x4 __attribute__((ext_vector_type(4)));
typedef unsigned u32x2 __attribute__((ext_vector_type(2)));
typedef __bf16 bf16x2_t __attribute__((ext_vector_type(2)));

constexpr int BATCH = 8, SEQ = 2048, DM = 1024, FF = 4096, M_TOK = BATCH * SEQ;
constexpr int NKVQ = 2816;
constexpr float EPS = 1e-6f;
constexpr float QSCALE = 0.125f * 1.4426950408889634f;

constexpr size_t MiB = 1u << 20;
constexpr size_t WS_ZERO = 0, ZERO_BYTES = 1 * MiB;
constexpr size_t WS_MOD0 = 0, WS_MOD1 = 196608, WS_MODKV = 393216;
constexpr size_t WS_SS1 = 524288, WS_SS2 = 589824, WS_SS3 = 655360;
constexpr size_t WS_BAR = 786432;
constexpr size_t WS_BM1L0 = 1 * MiB, WS_BM1L1 = WS_BM1L0 + 131072, WS_BKVQ = WS_BM1L1 + 131072, WS_PEB = WS_BKVQ + 131072, WS_WC2 = WS_PEB + 4096;
constexpr size_t WS_WAIN = 2 * MiB, WS_WAOUT = 8 * MiB, WS_WM1 = 10 * MiB  , WS_WM2 = 26 * MiB  , WS_WKVQ = 42 * MiB, WS_WO = 48 * MiB, WS_WC1 = 50 * MiB;
constexpr size_t WS_R = 56 * MiB;
constexpr size_t SLAB = 16 * MiB;
constexpr size_t SO_GB = 0, SO_V = 4 * MiB, SO_Y = 8 * MiB;
constexpr size_t WS_H = WS_R;
constexpr size_t SO_Q = 0, SO_KV = 4 * MiB  , SO_O = 10 * MiB, SO_GATES = 14 * MiB  , SO_KC = 14 * MiB + 512 * 1024  , SO_VC = SO_KC + 65536;
constexpr size_t WS_A1 = 184 * MiB, WS_A2 = 216 * MiB, WS_END = 248 * MiB;

constexpr int LDS_BYTES = 147456;
constexpr int NWAVES = 8;

__device__ __forceinline__ unsigned cvtpk(float lo, float hi) { f32x2 v = {lo, hi}; bf16x2_t b = __builtin_convertvector(v, bf16x2_t); return __builtin_bit_cast(unsigned, b); }
__device__ __forceinline__ float bf_lo(unsigned u) { return __builtin_bit_cast(float, u << 16); }
__device__ __forceinline__ float bf_hi(unsigned u) { return __builtin_bit_cast(float, u & 0xffff0000u); }
__device__ __forceinline__ float wave_sum(float v) {
#pragma unroll
    for (int o = 1; o < 64; o <<= 1) v += __shfl_xor(v, o);
    return v;
}
#define LDS_WAIT() asm volatile("s_waitcnt lgkmcnt(0)" ::: "memory")
#define LAUNDER(x) asm volatile("" : "+v"(x))

namespace pg8 {
constexpr int BM = 256, BK = 64, HALF = 128, HTB = HALF * BK * 2, STAGE_BYTES = 8 * HTB, NXCD = 8, WGM = 8;
__host__ __device__ __forceinline__ int lds_byte(int r, int c) { const int st = (r >> 4) * 2 + (c >> 5), rr = r & 15, cc = c & 31, ob = rr * 64 + cc * 2; return st * 1024 + (ob ^ (((ob >> 9) & 1) << 5)); }
__host__ __device__ __forceinline__ void stage_rc(int b, int& R, int& C) { const int st = b / 1024, sb = b % 1024, swz = sb ^ (((sb >> 9) & 1) << 5); R = (st >> 1) * 16 + swz / 64; C = (st & 1) * 32 + (swz % 64) / 2; }
__host__ __device__ __forceinline__ int perm32(int rho) { const int n = rho >> 4, i = rho & 15; return 8 * (i >> 2) + 4 * n + (i & 3); }

struct Unit { int pm, pn; };
struct Gemm { const bf16_t* A; const bf16_t* A2; int pn_split; const bf16_t* Bt; int M, N, K; size_t abatch; };

struct StaticOrder {
    int nM, nN, nwg, G, c, ain;
    __device__ void init(int M, int N, int G_, int c_) { nM = M / BM; nN = N / BM; nwg = nM * nN; G = G_; c = c_; ain = 0; }
    __device__ void init_ain(int G_, int c_) { init(M_TOK, 3072, G_, c_); ain = 1; }
    __device__ bool next(int i, Unit& u) const {
        if (ain) { if (i >= 3) return false; const int x = c & 7, rk = c >> 3, p = rk >> 3; u.pm = 8 * x + (rk & 7); u.pn = (i == 2) ? p : 4 + 2 * p + i; return true; }
        const long L = (long)i * G + c; if (L >= nwg) return false;
        int wgid = (int)L; { const int q = nwg / NXCD, r = nwg % NXCD, xcd = wgid % NXCD, off = wgid / NXCD; wgid = (xcd < r ? xcd * (q + 1) : r * (q + 1) + (xcd - r) * q) + off; }
        const int nig = WGM * nN, gid = wgid / nig, fm = gid * WGM, gsz = (nM - fm) < WGM ? (nM - fm) : WGM;
        u.pm = fm + ((wgid % nig) % gsz); u.pn = (wgid % nig) / gsz; return true;
    }
};

template <class Epi>
__device__ __forceinline__ void gemm_phase(LAS unsigned char* lds, const Gemm g, const StaticOrder& S, const Epi& E) {
    const int tid = threadIdx.x, wid = __builtin_amdgcn_readfirstlane(tid >> 6), lane = tid & 63, wr = wid >> 2, wc = wid & 3, fr = lane & 15, fq = lane >> 4;
    const int K = g.K, nt = K / BK;
    unsigned voffA[2], voffB[2];
#pragma unroll
    for (int i = 0; i < 2; ++i) { int R, C; stage_rc(tid * 16 + i * 8192, R, C); const int Rb = Epi::PERM ? ((R & ~31) + perm32(R & 31)) : R;
        voffA[i] = (unsigned)(R * K + C) * 2u; voffB[i] = (unsigned)(Rb * K + C) * 2u; }
    const size_t kstep = (size_t)(BK * 2);
    const size_t hstep = (size_t)HALF * K * 2;
    const size_t tstep = 2 * hstep;
    const unsigned ldsw = (unsigned)wid * 1024u;
    const int aoff = lds_byte(wr * 64 + fr, fq * 8), boff = lds_byte(wc * 32 + fr, fq * 8);
#define PG8_SA(b, h) (((b) * 2 + (h)) * HTB)
#define PG8_SB(b, h) ((4 + (b) * 2 + (h)) * HTB)
#define PG8_STAGE(bufoff, gbase, voff) do { _Pragma("unroll") for (int _i = 0; _i < 2; ++_i) \
        __builtin_amdgcn_global_load_lds((const unsigned*)((const char*)(gbase) + (voff)[_i]), (LAS unsigned*)(lds + (bufoff) + ldsw + _i * 8192), 16, 0, 0); } while (0)
#define PG8_LDA(dst, b, h) do { _Pragma("unroll") for (int m = 0; m < 4; ++m) _Pragma("unroll") for (int k = 0; k < 2; ++k) dst[m][k] = *(const LAS bf16x8*)(lds + PG8_SA(b, h) + aoff + m * 2048 + k * 1024); } while (0)
#define PG8_LDB(dst, b, h) do { _Pragma("unroll") for (int n = 0; n < 2; ++n) _Pragma("unroll") for (int k = 0; k < 2; ++k) dst[n][k] = *(const LAS bf16x8*)(lds + PG8_SB(b, h) + boff + n * 2048 + k * 1024); } while (0)
#define PG8_MMA(ai, bj, At, Bt) do { __builtin_amdgcn_s_setprio(1); _Pragma("unroll") for (int m = 0; m < 4; ++m) _Pragma("unroll") for (int n = 0; n < 2; ++n) _Pragma("unroll") for (int k = 0; k < 2; ++k) \
        acc[ai][bj][m][n] = __builtin_amdgcn_mfma_f32_16x16x32_bf16(Bt[n][k], At[m][k], acc[ai][bj][m][n], 0, 0, 0); __builtin_amdgcn_s_setprio(0); } while (0)
#define PG8_WAIT_V(n) asm volatile("s_waitcnt vmcnt(" #n ")" ::: "memory")
#define PG8_WAIT_L(n) asm volatile("s_waitcnt lgkmcnt(" #n ")" ::: "memory")
#define PG8_BAR __builtin_amdgcn_s_barrier()
#define PG8_SCHED __builtin_amdgcn_sched_barrier(0)
#define PG8_ABASE(u) ((const char*)((u).pn < g.pn_split ? g.A : g.A2) + (size_t)((u).pm >> 3) * g.abatch + (size_t)((u).pm & 7) * tstep)
    Unit cur, nxt; int ui = 0;
    if (!S.next(0, cur)) return;
    f32x4 acc[2][2][4][2];
#pragma unroll
    for (int a = 0; a < 2; ++a)
#pragma unroll
        for (int b = 0; b < 2; ++b)
#pragma unroll
            for (int m = 0; m < 4; ++m)
#pragma unroll
                for (int n = 0; n < 2; ++n) acc[a][b][m][n] = (f32x4){0.f, 0.f, 0.f, 0.f};
    bf16x8 At[4][2], B0[2][2], B1[2][2];
    const char* cA = PG8_ABASE(cur); const char* cB = (const char*)g.Bt + (size_t)cur.pn * tstep;
    PG8_STAGE(PG8_SB(0, 0), cB, voffB); PG8_STAGE(PG8_SB(0, 1), cB + hstep, voffB); PG8_STAGE(PG8_SA(0, 0), cA, voffA); PG8_STAGE(PG8_SA(0, 1), cA + hstep, voffA);
    if (wr == 1) PG8_BAR;
    PG8_WAIT_V(2); PG8_BAR;
    PG8_STAGE(PG8_SB(1, 0), cB + kstep, voffB); PG8_STAGE(PG8_SA(1, 0), cA + kstep, voffA); PG8_STAGE(PG8_SB(1, 1), cB + hstep + kstep, voffB);
    PG8_WAIT_V(6); PG8_BAR;
    for (;;) {
        const bool has_next = S.next(ui + 1, nxt);
        const char* nA = has_next ? PG8_ABASE(nxt) : cA; const char* nB = has_next ? (const char*)g.Bt + (size_t)nxt.pn * tstep : cB;
        for (int t = 0; t < nt; t += 2) {
            const bool last = (t == nt - 2);
            const char* a1 = cA + (size_t)(t + 1) * kstep;
            const char* a2 = last ? nA : cA + (size_t)(t + 2) * kstep; const char* b2 = last ? nB : cB + (size_t)(t + 2) * kstep;
            const char* a3 = a2 + kstep; const char* b3 = b2 + kstep;
            PG8_LDB(B0, 0, 0); PG8_LDB(B1, 0, 1); PG8_SCHED; PG8_LDA(At, 0, 0); PG8_STAGE(PG8_SA(1, 1), a1 + hstep, voffA);
            PG8_WAIT_V(8); PG8_WAIT_L(0); PG8_BAR; PG8_MMA(0, 0, At, B0); PG8_MMA(0, 1, At, B1); PG8_BAR; PG8_SCHED;
            PG8_LDA(At, 0, 1); PG8_STAGE(PG8_SB(0, 0), b2, voffB); PG8_STAGE(PG8_SB(0, 1), b2 + hstep, voffB); PG8_STAGE(PG8_SA(0, 0), a2, voffA);
            PG8_WAIT_V(8); PG8_WAIT_L(0); PG8_BAR; PG8_MMA(1, 0, At, B0); PG8_MMA(1, 1, At, B1); PG8_BAR; PG8_SCHED;
            PG8_LDB(B0, 1, 0); PG8_LDB(B1, 1, 1); PG8_SCHED; PG8_LDA(At, 1, 0); PG8_STAGE(PG8_SA(0, 1), a2 + hstep, voffA);
            PG8_WAIT_V(8); PG8_WAIT_L(0); PG8_BAR; PG8_MMA(0, 0, At, B0); PG8_MMA(0, 1, At, B1); PG8_BAR; PG8_SCHED;
            PG8_LDA(At, 1, 1); PG8_STAGE(PG8_SB(1, 0), b3, voffB); PG8_STAGE(PG8_SB(1, 1), b3 + hstep, voffB); PG8_STAGE(PG8_SA(1, 0), a3, voffA);
            PG8_WAIT_V(8); PG8_WAIT_L(0); PG8_BAR; PG8_MMA(1, 0, At, B0); PG8_MMA(1, 1, At, B1); PG8_BAR; PG8_SCHED;
        }
        if (wr == 0) PG8_BAR;
        E(acc, cur, wr, wc, fr, fq);
        if (!has_next) break;
#pragma unroll
        for (int a = 0; a < 2; ++a)
#pragma unroll
            for (int b = 0; b < 2; ++b)
#pragma unroll
                for (int m = 0; m < 4; ++m)
#pragma unroll
                    for (int n = 0; n < 2; ++n) acc[a][b][m][n] = (f32x4){0.f, 0.f, 0.f, 0.f};
        cur = nxt; cA = nA; cB = nB; ++ui;
        if (wr == 1) PG8_BAR;
    }
    PG8_WAIT_V(0);
    PG8_BAR;
#undef PG8_SA
#undef PG8_SB
#undef PG8_STAGE
#undef PG8_LDA
#undef PG8_LDB
#undef PG8_MMA
#undef PG8_WAIT_V
#undef PG8_WAIT_L
#undef PG8_BAR
#undef PG8_SCHED
#undef PG8_ABASE
}

typedef f32x4 Acc[2][2][4][2];

struct EpiAin {
    static constexpr bool PERM = true;
    static constexpr bool HAS_PRE = false; struct Pre {};
    unsigned char* slab0;
    const float* conv_w;
    __device__ __forceinline__ void operator()(const Acc& acc, const Unit& u, int wr, int wc, int fr, int fq) const {
        const int rip0 = wr * 64 + fr;
        const int row0 = (u.pm & 7) * BM + rip0;
        unsigned char* slab = slab0 + (size_t)(u.pm >> 3) * SLAB;
        bf16_t* V = (bf16_t*)(slab + SO_V);
        if (u.pn < 4) {
            bf16_t* Y = (bf16_t*)(slab + SO_Y); bf16_t* GBH = (bf16_t*)(slab + SO_GB) + (size_t)(u.pm & 7) * 2 * DM;
            const int col0 = u.pn * BM + wc * 32 + 8 * fq;
#pragma unroll
            for (int bj = 0; bj < 2; ++bj) { const int cw = col0 + bj * HALF;
                f32x4 w0[2], w1[2], w2[2];
#pragma unroll
                for (int n = 0; n < 2; ++n) { w0[n] = *(const f32x4*)(conv_w + cw + 4 * n); w1[n] = *(const f32x4*)(conv_w + DM + cw + 4 * n); w2[n] = *(const f32x4*)(conv_w + 2 * DM + cw + 4 * n); }
#pragma unroll
                for (int ai = 0; ai < 2; ++ai)
#pragma unroll
                    for (int mp = 0; mp < 2; ++mp) {
                        u32x4 vr[2][3];
#pragma unroll
                        for (int mm = 0; mm < 2; ++mm) { const int rip = rip0 + ai * HALF + (2 * mp + mm) * 16; const bf16_t* vp = V + (size_t)(row0 + ai * HALF + (2 * mp + mm) * 16) * DM + cw;
#pragma unroll
                            for (int k = 0; k < 3; ++k) vr[mm][k] = (rip >= 2) ? *(const u32x4*)(vp - (size_t)k * DM) : (u32x4){0u, 0u, 0u, 0u}; }
                        asm volatile("" : "+v"(vr[0][0]), "+v"(vr[0][1]), "+v"(vr[0][2]), "+v"(vr[1][0]), "+v"(vr[1][1]), "+v"(vr[1][2]));
#pragma unroll
                        for (int mm = 0; mm < 2; ++mm) { const int m = 2 * mp + mm; const int rip = rip0 + ai * HALF + m * 16;
                            const f32x4 g0 = acc[ai][bj][m][0], g1 = acc[ai][bj][m][1];
                            u32x4 w;
                            if (rip >= 2) {
                                const u32x4 a = vr[mm][0], b1 = vr[mm][1], b2 = vr[mm][2];
                                const f32x4 v0a = (f32x4){bf_lo(a.x), bf_hi(a.x), bf_lo(a.y), bf_hi(a.y)}, v0b = (f32x4){bf_lo(a.z), bf_hi(a.z), bf_lo(a.w), bf_hi(a.w)};
                                const f32x4 v1a = (f32x4){bf_lo(b1.x), bf_hi(b1.x), bf_lo(b1.y), bf_hi(b1.y)}, v1b = (f32x4){bf_lo(b1.z), bf_hi(b1.z), bf_lo(b1.w), bf_hi(b1.w)};
                                const f32x4 v2a = (f32x4){bf_lo(b2.x), bf_hi(b2.x), bf_lo(b2.y), bf_hi(b2.y)}, v2b = (f32x4){bf_lo(b2.z), bf_hi(b2.z), bf_lo(b2.w), bf_hi(b2.w)};
                                const f32x4 ya = g0 * (w2[0] * v0a + w1[0] * v1a + w0[0] * v2a), yb = g1 * (w2[1] * v0b + w1[1] * v1b + w0[1] * v2b);
                                w.x = cvtpk(ya[0], ya[1]); w.y = cvtpk(ya[2], ya[3]); w.z = cvtpk(yb[0], yb[1]); w.w = cvtpk(yb[2], yb[3]);
                                *(u32x4*)(Y + (size_t)(row0 + ai * HALF + m * 16) * DM + cw) = w;
                            } else {
                                w.x = cvtpk(g0[0], g0[1]); w.y = cvtpk(g0[2], g0[3]); w.z = cvtpk(g1[0], g1[1]); w.w = cvtpk(g1[2], g1[3]);
                                *(u32x4*)(GBH + (size_t)rip * DM + cw) = w;
                            } } }
            }
        } else {
            const int col0 = (u.pn - 4) * HALF + wc * 32 + 8 * fq;
#pragma unroll
            for (int ai = 0; ai < 2; ++ai)
#pragma unroll
                for (int m = 0; m < 4; ++m) { bf16_t* rowp = V + (size_t)(row0 + ai * HALF + m * 16) * DM + col0;
                    const f32x4 v0 = acc[ai][0][m][0] * acc[ai][1][m][0], v1 = acc[ai][0][m][1] * acc[ai][1][m][1];
                    u32x4 w; w.x = cvtpk(v0[0], v0[1]); w.y = cvtpk(v0[2], v0[3]); w.z = cvtpk(v1[0], v1[1]); w.w = cvtpk(v1[2], v1[3]);
                    *(u32x4*)rowp = w; }
        }
    }
};

constexpr int RB_F32 = 2, RB_NA2 = 2, RB_NA1 = 4, RB_NA0 = 8;
template <int NA, int INM, int OUTM> struct EpiRes {
    static constexpr bool PERM = true;
    const void* xin; void* xout; const float* gate; int gate_stride;
    const float* gain0; const float* sc0; int sc0_stride; bf16_t* A0;
    const float* gain1; const float* sc1; int sc1_stride; bf16_t* A1;
    float* sumsq;
    const float* gain_in; const float* sc_in; int sc_in_stride;
    __device__ __forceinline__ void operator()(const Acc& acc, const Unit& u, int wr, int wc, int fr, int fq) const {
        constexpr bool IN16 = INM != 0;
        constexpr int RB = !IN16 ? RB_F32 : (NA >= 2 ? RB_NA2 : (NA == 1 ? RB_NA1 : RB_NA0));
        const int b = u.pm >> 3;
        const int row0 = u.pm * BM + wr * 64 + fr, col0 = u.pn * BM + wc * 32 + 8 * fq;
        const size_t tbase = (size_t)u.pm * BM * DM + (size_t)u.pn * BM;
        const unsigned loff = (unsigned)((wr * 64 + fr) * DM + wc * 32 + 8 * fq);
        f32x4 gv[2][2], a0[2][2], a1[2][2], ia[2][2];
#pragma unroll
        for (int h = 0; h < 8 / RB; ++h) {
            f32x4 xr[IN16 ? 1 : RB][2][2]; u32x4 xh[IN16 ? RB : 1][2];
#pragma unroll
            for (int qq = 0; qq < RB; ++qq)
#pragma unroll
                for (int bj = 0; bj < 2; ++bj) { const int q = h * RB + qq; const size_t o = tbase + (size_t)(((q >> 2) * HALF + (q & 3) * 16) * DM + bj * HALF);
                    if constexpr (IN16) xh[qq][bj] = __builtin_nontemporal_load((const u32x4*)(((const bf16_t*)xin + o) + loff));
                    else { xr[qq][bj][0] = __builtin_nontemporal_load((const f32x4*)(((const float*)xin + o) + loff)); xr[qq][bj][1] = __builtin_nontemporal_load((const f32x4*)(((const float*)xin + o + 4) + loff)); } }
            if (h == 0) {
#pragma unroll
                for (int bj = 0; bj < 2; ++bj)
#pragma unroll
                    for (int n = 0; n < 2; ++n) { const int c = col0 + bj * HALF + 4 * n;
                        gv[bj][n] = *(const f32x4*)(gate + (size_t)b * gate_stride + c);
                        if (NA >= 1) a0[bj][n] = *(const f32x4*)(gain0 + c) * (*(const f32x4*)(sc0 + (size_t)b * sc0_stride + c) + 1.0f);
                        if (NA >= 2) a1[bj][n] = *(const f32x4*)(gain1 + c) * (*(const f32x4*)(sc1 + (size_t)b * sc1_stride + c) + 1.0f);
                        if (INM == 2) { const f32x4 t = *(const f32x4*)(gain_in + c) * (*(const f32x4*)(sc_in + (size_t)b * sc_in_stride + c) + 1.0f); ia[bj][n] = (f32x4){1.0f / t[0], 1.0f / t[1], 1.0f / t[2], 1.0f / t[3]}; } }
            }
#pragma unroll
            for (int qq = 0; qq < RB; ++qq)
#pragma unroll
                for (int bj = 0; bj < 2; ++bj) {
                    if constexpr (IN16) asm volatile("" : "+v"(xh[qq][bj]));
                    else asm volatile("" : "+v"(xr[qq][bj][0]), "+v"(xr[qq][bj][1])); }
#pragma unroll
            for (int qq = 0; qq < RB; ++qq) { const int q = h * RB + qq, ai = q >> 2, m = q & 3; const int row = row0 + ai * HALF + m * 16; const size_t off = tbase + (size_t)((ai * HALF + m * 16) * DM); float ss = 0.f;
#pragma unroll
                for (int bj = 0; bj < 2; ++bj) { const size_t o = off + bj * HALF;
                    f32x4 x0, x1;
                    if constexpr (IN16) { const u32x4 w = xh[qq][bj]; x0 = (f32x4){bf_lo(w.x), bf_hi(w.x), bf_lo(w.y), bf_hi(w.y)}; x1 = (f32x4){bf_lo(w.z), bf_hi(w.z), bf_lo(w.w), bf_hi(w.w)}; }
                    else { x0 = xr[qq][bj][0]; x1 = xr[qq][bj][1]; }
                    if (INM == 2) { x0 = x0 * ia[bj][0]; x1 = x1 * ia[bj][1]; }
                    x0 = x0 + gv[bj][0] * acc[ai][bj][m][0]; x1 = x1 + gv[bj][1] * acc[ai][bj][m][1];
                    if (OUTM == 0) { *(f32x4*)(((float*)xout + o) + loff) = x0; *(f32x4*)(((float*)xout + o + 4) + loff) = x1; }
                    if (NA >= 1) { ss += ((x0[0] * x0[0] + x0[1] * x0[1]) + (x0[2] * x0[2] + x0[3] * x0[3])) + ((x1[0] * x1[0] + x1[1] * x1[1]) + (x1[2] * x1[2] + x1[3] * x1[3]));
                        const f32x4 t0 = x0 * a0[bj][0], t1 = x1 * a0[bj][1]; u32x4 w; w.x = cvtpk(t0[0], t0[1]); w.y = cvtpk(t0[2], t0[3]); w.z = cvtpk(t1[0], t1[1]); w.w = cvtpk(t1[2], t1[3]); *(u32x4*)((A0 + o) + loff) = w; }
                    if (NA >= 2) { const f32x4 t0 = x0 * a1[bj][0], t1 = x1 * a1[bj][1]; u32x4 w; w.x = cvtpk(t0[0], t0[1]); w.y = cvtpk(t0[2], t0[3]); w.z = cvtpk(t1[0], t1[1]); w.w = cvtpk(t1[2], t1[3]); *(u32x4*)((A1 + o) + loff) = w; } }
                if (NA >= 1) { ss += __shfl_xor(ss, 16); ss += __shfl_xor(ss, 32); if (fq == 0) unsafeAtomicAdd(sumsq + row, ss); } }
        }
    }
};

struct EpiMlp1 {
    static constexpr bool PERM = true;
    bf16_t* H; const float* bias; const float* sumsq;
    __device__ __forceinline__ void operator()(const Acc& acc, const Unit& u, int wr, int wc, int fr, int fq) const {
        const int b = u.pm >> 3;
        const int row0 = u.pm * BM + wr * 64 + fr, col0 = u.pn * BM + wc * 32 + 8 * fq;
        f32x4 bv[2][2];
#pragma unroll
        for (int bj = 0; bj < 2; ++bj)
#pragma unroll
            for (int n = 0; n < 2; ++n) bv[bj][n] = *(const f32x4*)(bias + (size_t)b * FF + col0 + bj * HALF + 4 * n);
        float ssv[8];
#pragma unroll
        for (int q = 0; q < 8; ++q) ssv[q] = sumsq[row0 + (q >> 2) * HALF + (q & 3) * 16];
        asm volatile("" : "+v"(ssv[0]), "+v"(ssv[1]), "+v"(ssv[2]), "+v"(ssv[3]), "+v"(ssv[4]), "+v"(ssv[5]), "+v"(ssv[6]), "+v"(ssv[7]));
#pragma unroll
        for (int ai = 0; ai < 2; ++ai)
#pragma unroll
            for (int m = 0; m < 4; ++m) { const int row = row0 + ai * HALF + m * 16; const float rs = rsqrtf(ssv[ai * 4 + m] * (1.0f / DM) + EPS);
                bf16_t* rowp = H + (size_t)row * FF + col0;
#pragma unroll
                for (int bj = 0; bj < 2; ++bj) { f32x4 v0 = acc[ai][bj][m][0] * rs + bv[bj][0], v1 = acc[ai][bj][m][1] * rs + bv[bj][1];
#pragma unroll
                    for (int e = 0; e < 4; ++e) { const float r0 = fmaxf(v0[e], 0.f), r1 = fmaxf(v1[e], 0.f); v0[e] = r0 * r0; v1[e] = r1 * r1; }
                    u32x4 w; w.x = cvtpk(v0[0], v0[1]); w.y = cvtpk(v0[2], v0[3]); w.z = cvtpk(v1[0], v1[1]); w.w = cvtpk(v1[2], v1[3]);
                    *(u32x4*)(rowp + bj * HALF) = w; } }
    }
};

struct EpiKVQ {
    static constexpr bool PERM = true;
    unsigned char* slab0; const float* bias; const float* sumsq; const float* k_gain; const float* q_gain;
    __device__ __forceinline__ void operator()(const Acc& acc, const Unit& u, int wr, int wc, int fr, int fq) const {
        const int b = u.pm >> 3, pn = u.pn;
        const int row0 = u.pm * BM + wr * 64 + fr;
        unsigned char* slab = slab0 + (size_t)b * SLAB;
        bf16_t* KV = (bf16_t*)(slab + SO_KV); bf16_t* Q = (bf16_t*)(slab + SO_Q); float* gates = (float*)(slab + SO_GATES);
        f32x4 bv[2][2];
#pragma unroll
        for (int bj = 0; bj < 2; ++bj)
#pragma unroll
            for (int n = 0; n < 2; ++n) bv[bj][n] = *(const f32x4*)(bias + (size_t)b * NKVQ + pn * BM + bj * HALF + wc * 32 + 8 * fq + 4 * n);
        float ssv[8];
#pragma unroll
        for (int q = 0; q < 8; ++q) ssv[q] = sumsq[row0 + (q >> 2) * HALF + (q & 3) * 16];
        asm volatile("" : "+v"(ssv[0]), "+v"(ssv[1]), "+v"(ssv[2]), "+v"(ssv[3]), "+v"(ssv[4]), "+v"(ssv[5]), "+v"(ssv[6]), "+v"(ssv[7]));
        if (pn == 10) {
            if (wc < 2) {
#pragma unroll
                for (int ai = 0; ai < 2; ++ai)
#pragma unroll
                    for (int m = 0; m < 4; ++m) { const int row = row0 + ai * HALF + m * 16; const float rs = rsqrtf(ssv[ai * 4 + m] * (1.0f / DM) + EPS);
#pragma unroll
                        for (int n = 0; n < 2; ++n) { const int c = wc * 32 + 8 * fq + 4 * n;
                            if (c < 48) { const f32x4 v = acc[ai][0][m][n] * rs + bv[0][n]; f32x4 o;
#pragma unroll
                                for (int e = 0; e < 4; ++e) o[e] = 1.0f / (1.0f + __expf(-v[e]));
                                *(f32x4*)(gates + (size_t)(row & (SEQ - 1)) * 48 + c) = o; } } }
            }
            return;
        }
        const bool is_q = pn >= 6;
        const bool do_norm = is_q || pn == 2 || pn == 4;
        f32x4 gn[2][2];
        { const float* gp = is_q ? q_gain : (k_gain + (pn == 2 ? 64 : 128)); const float sc = is_q ? QSCALE : 1.0f;
#pragma unroll
          for (int bj = 0; bj < 2; ++bj)
#pragma unroll
              for (int n = 0; n < 2; ++n) gn[bj][n] = do_norm ? *(const f32x4*)(gp + 32 * bj + 8 * fq + 4 * n) * sc : (f32x4){1.f, 1.f, 1.f, 1.f}; }
#pragma unroll
        for (int ai = 0; ai < 2; ++ai)
#pragma unroll
            for (int m = 0; m < 4; ++m) { const int row = row0 + ai * HALF + m * 16; const float rs = rsqrtf(ssv[ai * 4 + m] * (1.0f / DM) + EPS);
                f32x4 v[2][2]; float ss = 0.f;
#pragma unroll
                for (int bj = 0; bj < 2; ++bj)
#pragma unroll
                    for (int n = 0; n < 2; ++n) { v[bj][n] = acc[ai][bj][m][n] * rs + bv[bj][n]; const f32x4 t = v[bj][n]; ss += (t[0] * t[0] + t[1] * t[1]) + (t[2] * t[2] + t[3] * t[3]); }
                float hs = 1.0f;
                if (do_norm) { ss += __shfl_xor(ss, 16); ss += __shfl_xor(ss, 32); hs = rsqrtf(ss * (1.0f / 64.0f) + EPS); }
                bf16_t* rowp;
                if (is_q) rowp = Q + (size_t)(row & (SEQ - 1)) * DM + ((pn - 6) * 4 + wc) * 64 + 8 * fq;
                else rowp = KV + ((size_t)(pn * 4 + wc) * SEQ + (row & (SEQ - 1))) * 64 + 8 * fq;
#pragma unroll
                for (int bj = 0; bj < 2; ++bj) { const f32x4 v0 = v[bj][0] * hs * gn[bj][0], v1 = v[bj][1] * hs * gn[bj][1];
                    u32x4 w; w.x = cvtpk(v0[0], v0[1]); w.y = cvtpk(v0[2], v0[3]); w.z = cvtpk(v1[0], v1[1]); w.w = cvtpk(v1[2], v1[3]);
                    *(u32x4*)(rowp + 32 * bj) = w; } }
    }
};
}

namespace att {
constexpr int SLOTB = 8192;
constexpr int L_K = 0, L_V = 3 * SLOTB, L_WS = 6 * SLOTB, L_SEL = L_WS + 4096, L_NIB = L_SEL + 256, L_SC = L_NIB + 768, L_IA = L_SC + 8704, L_IB = L_IA + 33792, L_END = L_IB + 33792, L_OST = L_IA;
static_assert(L_END <= 131072 && (L_IA % 16) == 0 && (L_SC % 16) == 0, "attention LDS map");
#define SBAR() __builtin_amdgcn_sched_barrier(0)
#define ATT_WAIT_BAR(N) asm volatile("s_waitcnt vmcnt(" #N ") lgkmcnt(0)\n\ts_barrier" ::: "memory")
__device__ __forceinline__ int crow(int r, int hi) { return (r & 3) + 8 * (r >> 2) + 4 * hi; }
__device__ __forceinline__ void glds16(const void* gsrc, unsigned lds_dst) { unsigned keep;
    asm volatile("s_mov_b32 %0, m0\n\ts_mov_b32 m0, %2\n\ts_nop 0\n\tglobal_load_lds_dwordx4 %1, off\n\ts_mov_b32 m0, %0" : "=&s"(keep) : "v"(gsrc), "s"(lds_dst) : "memory"); }

__device__ __forceinline__ void qkt_c(f32x16& p0, f32x16& p1, const LAS unsigned char* Kslot, const bf16x8* qr, const f32x16& ci, int r32, int hi) {
    const LAS unsigned char* kb = Kslot + hi * 1024 + r32 * 16;
    bf16x8 kf[8];
#pragma unroll
    for (int i = 0; i < 8; ++i) kf[i] = *(const LAS bf16x8*)(kb + (i >> 1) * 2048 + (i & 1) * 512);
    asm volatile("" : "+v"(kf[0]), "+v"(kf[1]), "+v"(kf[2]), "+v"(kf[3]), "+v"(kf[4]), "+v"(kf[5]), "+v"(kf[6]), "+v"(kf[7]));
    p0 = __builtin_amdgcn_mfma_f32_32x32x16_bf16(kf[0], qr[0], ci, 0, 0, 0); p1 = __builtin_amdgcn_mfma_f32_32x32x16_bf16(kf[1], qr[0], ci, 0, 0, 0);
#pragma unroll
    for (int d0 = 1; d0 < 4; ++d0) { p0 = __builtin_amdgcn_mfma_f32_32x32x16_bf16(kf[2 * d0], qr[d0], p0, 0, 0, 0); p1 = __builtin_amdgcn_mfma_f32_32x32x16_bf16(kf[2 * d0 + 1], qr[d0], p1, 0, 0, 0); }
}
__device__ __forceinline__ void qkt(f32x16& p0, f32x16& p1, const LAS unsigned char* Kslot, const bf16x8* qr, int r32, int hi) {
    const LAS unsigned char* kb = Kslot + hi * 1024 + r32 * 16;
    bf16x8 kf[8];
#pragma unroll
    for (int i = 0; i < 8; ++i) kf[i] = *(const LAS bf16x8*)(kb + (i >> 1) * 2048 + (i & 1) * 512);
    asm volatile("" : "+v"(kf[0]), "+v"(kf[1]), "+v"(kf[2]), "+v"(kf[3]), "+v"(kf[4]), "+v"(kf[5]), "+v"(kf[6]), "+v"(kf[7]));
    const f32x16 z = f32x16{};
    p0 = __builtin_amdgcn_mfma_f32_32x32x16_bf16(kf[0], qr[0], z, 0, 0, 0); p1 = __builtin_amdgcn_mfma_f32_32x32x16_bf16(kf[1], qr[0], z, 0, 0, 0);
#pragma unroll
    for (int d0 = 1; d0 < 4; ++d0) { p0 = __builtin_amdgcn_mfma_f32_32x32x16_bf16(kf[2 * d0], qr[d0], p0, 0, 0, 0); p1 = __builtin_amdgcn_mfma_f32_32x32x16_bf16(kf[2 * d0 + 1], qr[d0], p1, 0, 0, 0); }
}
__device__ __forceinline__ void range_mask(f32x16& p0, f32x16& p1, int lo, int hv, int hi) {
    const int lo2 = lo - 4 * hi, hv2 = hv - 4 * hi;
#pragma unroll
    for (int r = 0; r < 16; ++r) { const int kc = (r & 3) + 8 * (r >> 2); if (kc < lo2 || kc > hv2) p0[r] = -INFINITY; if (kc + 32 < lo2 || kc + 32 > hv2) p1[r] = -INFINITY; }
}
__device__ __forceinline__ float max3f(float a, float b, float c) { float r; asm("v_max3_f32 %0, %1, %2, %3" : "=v"(r) : "v"(a), "v"(b), "v"(c)); return r; }
__device__ __forceinline__ float max2f(float a, float b) { float r; asm("v_max_f32_e32 %0, %1, %2" : "=v"(r) : "v"(a), "v"(b)); return r; }
__device__ __forceinline__ float rowmax(const f32x16& p0, const f32x16& p1) {
    float a = max3f(p0[0], p0[1], p1[0]), b = max3f(p0[2], p0[3], p1[1]); a = max3f(a, p1[2], p1[3]);
#pragma unroll
    for (int r = 4; r < 16; r += 4) { a = max3f(a, p0[r], p0[r + 1]); b = max3f(b, p0[r + 2], p0[r + 3]); a = max3f(a, p1[r], p1[r + 1]); b = max3f(b, p1[r + 2], p1[r + 3]); }
    const float m = max2f(a, b);
    auto rr = __builtin_amdgcn_permlane32_swap(__float_as_uint(m), __float_as_uint(m), false, false);
    return max2f(__uint_as_float(rr[0]), __uint_as_float(rr[1]));
}
__device__ __forceinline__ float halfsum(float a) {
    auto rr = __builtin_amdgcn_permlane32_swap(__float_as_uint(a), __float_as_uint(a), false, false);
    return __uint_as_float(rr[0]) + __uint_as_float(rr[1]);
}
__device__ __forceinline__ void pv(f32x16* o, int vb, bf16x8 pa0, bf16x8 pa1, bf16x8 pa2, bf16x8 pa3) {
    s16x4 lo[8], hi4[8];
#pragma unroll
    for (int q = 0; q < 8; ++q) {
        asm volatile("ds_read_b64_tr_b16 %0,%1 offset:%c2" : "=&v"(lo[q]) : "v"(vb), "i"((q >> 2) * 4096 + (q & 3) * 1024) : "memory");
        asm volatile("ds_read_b64_tr_b16 %0,%1 offset:%c2" : "=&v"(hi4[q]) : "v"(vb), "i"((q >> 2) * 4096 + (q & 3) * 1024 + 512) : "memory"); }
    asm volatile("s_waitcnt lgkmcnt(0)" ::: "memory"); SBAR();
#define PK(k) (bf16x8){lo[k][0], lo[k][1], lo[k][2], lo[k][3], hi4[k][0], hi4[k][1], hi4[k][2], hi4[k][3]}
    o[0] = __builtin_amdgcn_mfma_f32_32x32x16_bf16(pa0, PK(0), o[0], 0, 0, 0);
    o[1] = __builtin_amdgcn_mfma_f32_32x32x16_bf16(pa0, PK(4), o[1], 0, 0, 0);
    o[0] = __builtin_amdgcn_mfma_f32_32x32x16_bf16(pa1, PK(1), o[0], 0, 0, 0);
    o[1] = __builtin_amdgcn_mfma_f32_32x32x16_bf16(pa1, PK(5), o[1], 0, 0, 0);
    o[0] = __builtin_amdgcn_mfma_f32_32x32x16_bf16(pa2, PK(2), o[0], 0, 0, 0);
    o[1] = __builtin_amdgcn_mfma_f32_32x32x16_bf16(pa2, PK(6), o[1], 0, 0, 0);
    o[0] = __builtin_amdgcn_mfma_f32_32x32x16_bf16(pa3, PK(3), o[0], 0, 0, 0);
    o[1] = __builtin_amdgcn_mfma_f32_32x32x16_bf16(pa3, PK(7), o[1], 0, 0, 0);
#undef PK
}
__device__ __forceinline__ bf16x8 pack8(const f32x16& p, int base) {
    u32x4 w; w.x = cvtpk(p[base], p[base + 1]); w.y = cvtpk(p[base + 2], p[base + 3]); w.z = cvtpk(p[base + 4], p[base + 5]); w.w = cvtpk(p[base + 6], p[base + 7]);
    return __builtin_bit_cast(bf16x8, w);
}
__device__ __forceinline__ void row_bcast(float v, float (&out)[16], LAS float* wsf, int r32, int hi) {
    if (hi == 0) wsf[r32] = v;
#pragma unroll
    for (int i = 0; i < 4; ++i) { const f32x4 t = *(const LAS f32x4*)(wsf + 8 * i + 4 * hi); out[4 * i] = t[0]; out[4 * i + 1] = t[1]; out[4 * i + 2] = t[2]; out[4 * i + 3] = t[3]; }
}

struct Ctx {
    int lane, r32, hi, wid, ql, qb; unsigned lds0; LAS unsigned char* shm; LAS float* wsf; int koff, voff; unsigned kdst, vdst; int vb0;
};
__device__ __forceinline__ void dma_k(const Ctx& c, const bf16_t* base, int tile, int slot) { glds16(base + (size_t)tile * 4096 + c.koff, (unsigned)__builtin_amdgcn_readfirstlane(c.kdst + slot * SLOTB)); }
__device__ __forceinline__ void dma_v(const Ctx& c, const bf16_t* base, int tile, int slot) { glds16(base + (size_t)tile * 4096 + c.voff, (unsigned)__builtin_amdgcn_readfirstlane(c.vdst + slot * SLOTB)); }

constexpr float THR = 8.0f;
struct BrState { float mhat, l; f32x16 negm; f32x16 o[2]; };
__device__ __forceinline__ void br_reset(BrState& st) { st.mhat = 0.f; st.l = 0.f; st.negm = f32x16{}; st.o[0] = f32x16{}; st.o[1] = f32x16{}; }
__device__ __forceinline__ void stream_step(const Ctx& c, int slot, const bf16x8* qr, bool row_on, bool use_range, int lo, int hv, bool first, BrState& st) {
    f32x16 p0, p1;
    if (__any(!row_on)) { f32x16 ci;
#pragma unroll
        for (int r = 0; r < 16; ++r) ci[r] = row_on ? st.negm[r] : -INFINITY;
        qkt_c(p0, p1, c.shm + L_K + slot * SLOTB, qr, ci, c.r32, c.hi);
    } else qkt_c(p0, p1, c.shm + L_K + slot * SLOTB, qr, st.negm, c.r32, c.hi);
    if (use_range) range_mask(p0, p1, lo, hv, c.hi);
    const float rm = rowmax(p0, p1);
    if (first || __any(rm > THR)) {
        float dl = first ? rm : fmaxf(rm, 0.f);
        if (dl == -INFINITY) dl = 0.f;
        st.mhat += dl;
#pragma unroll
        for (int r = 0; r < 16; ++r) { p0[r] -= dl; p1[r] -= dl; st.negm[r] = -st.mhat; }
        if (!first) { const float f = __builtin_amdgcn_exp2f(-dl); st.l *= f; float al[16]; row_bcast(f, al, c.wsf, c.r32, c.hi);
#pragma unroll
            for (int r = 0; r < 16; ++r) { st.o[0][r] *= al[r]; st.o[1][r] *= al[r]; } }
    }
#pragma unroll
    for (int r = 0; r < 16; ++r) { p0[r] = __builtin_amdgcn_exp2f(p0[r]); p1[r] = __builtin_amdgcn_exp2f(p1[r]); }
    { const f32x16 sv = p0 + p1; st.l += ((sv[0] + sv[1]) + (sv[2] + sv[3])) + ((sv[4] + sv[5]) + (sv[6] + sv[7])) + ((sv[8] + sv[9]) + (sv[10] + sv[11])) + ((sv[12] + sv[13]) + (sv[14] + sv[15])); }
    pv(st.o, c.vb0 + slot * SLOTB, pack8(p0, 0), pack8(p0, 8), pack8(p1, 0), pack8(p1, 8));
}
struct Cursor { unsigned sm, wm; };
__device__ __forceinline__ int cur_pop(Cursor& k, int& br) {
    if (k.sm) { const int t = __builtin_ctz(k.sm); k.sm &= k.sm - 1u; br = 1; return t; }
    const int t = 31 - __builtin_clz(k.wm); k.wm &= ~(1u << t); br = 2; return t;
}

typedef __attribute__((address_space(3))) const char* lds_cptr;
typedef short v4i16_t __attribute__((ext_vector_type(4)));
__device__ __forceinline__ void kload8(bf16x8* kf, lds_cptr kp) {
    kf[0] = *(const LAS bf16x8*)(kp);        kf[1] = *(const LAS bf16x8*)(kp + 512);
    kf[2] = *(const LAS bf16x8*)(kp + 2048); kf[3] = *(const LAS bf16x8*)(kp + 2560);
    kf[4] = *(const LAS bf16x8*)(kp + 4096); kf[5] = *(const LAS bf16x8*)(kp + 4608);
    kf[6] = *(const LAS bf16x8*)(kp + 6144); kf[7] = *(const LAS bf16x8*)(kp + 6656);
}
__device__ __forceinline__ void kload2(bf16x8* kf, lds_cptr kp, int j) { kf[2 * j] = *(const LAS bf16x8*)(kp + j * 2048); kf[2 * j + 1] = *(const LAS bf16x8*)(kp + j * 2048 + 512); }
__device__ __forceinline__ s16x4 vtr(lds_cptr p) { return __builtin_bit_cast(s16x4, __builtin_amdgcn_ds_read_tr16_b64_v4i16((LAS v4i16_t*)p)); }
__device__ __forceinline__ float fadd_s(float a, float b) { float r; asm("v_add_f32_e32 %0, %1, %2" : "=v"(r) : "v"(a), "v"(b)); return r; }
__device__ __forceinline__ float fsub_s(float a, float b) { float r; asm("v_sub_f32_e32 %0, %1, %2" : "=v"(r) : "v"(a), "v"(b)); return r; }
template <int THRL>
__device__ __forceinline__ void sel_stream(const Ctx& c, const bf16_t* Kb, const bf16_t* Vb, const bf16x8* qr, unsigned msel, int qb, f32x16* o, float& l_out) {
  const int lane = c.lane, r32 = c.r32, hi = c.hi;
  LAS float* wsf = c.wsf;
  const lds_cptr shm3 = (lds_cptr)c.shm;
  const lds_cptr kp0 = shm3 + L_K + hi * 1024 + r32 * 16;
  const lds_cptr vp0 = shm3 + L_V + ((lane >> 4) & 1) * 32 + (lane & 3) * 8 + (4 * hi + ((lane & 15) >> 2)) * 64;
  const int NTr = qb + 1, NT = NTr < 4 ? 4 : ((NTr + 1) & ~1);
  #define WAIT_BAR(N) asm volatile("s_waitcnt vmcnt(" #N ") lgkmcnt(0)\n\ts_barrier":::"memory")
  #define TILE_OF(t) (((t) < NTr) ? (t) : qb)
  #define DMA_K(t, slotb) glds16(Kb + (size_t)TILE_OF(t) * 4096 + c.koff, (unsigned)__builtin_amdgcn_readfirstlane(c.kdst + (slotb)))
  #define DMA_V(t, slotb) glds16(Vb + (size_t)TILE_OF(t) * 4096 + c.voff, (unsigned)__builtin_amdgcn_readfirstlane(c.vdst + (slotb)))
  #define CMASK(P0, P1, t) do { const bool on_ = ((t) < NTr) && (((msel >> ((t) & 31)) & 1u) != 0u); \
      if (__any(!on_)) { const float ng_ = on_ ? 0.f : -INFINITY; _Pragma("unroll") for (int r = 0; r < 16; ++r) { P0[r] += ng_; P1[r] += ng_; } } \
      if ((t) == qb) range_mask(P0, P1, 0, c.ql, hi); } while (0)
  float mhat = 0.f, l_reg = 0.f; o[0] = f32x16{}; o[1] = f32x16{}; f32x16 negm = f32x16{}; asm volatile("" : "+v"(negm));
  bf16x8 kf[8];
  bool resc = false;
  #define START(P0,P1) do{ const float rm=rowmax(P0,P1); resc=false; \
    { const float dl=rm; mhat=fadd_s(mhat,dl); \
      _Pragma("unroll") for(int r=0;r<16;++r){P0[r]=fsub_s(P0[r],dl);P1[r]=fsub_s(P1[r],dl);} \
      _Pragma("unroll") for(int r=0;r<16;++r)negm[r]=-mhat; asm volatile("":"+v"(negm)); } \
    _Pragma("unroll") for(int r=0;r<16;++r)P0[r]=__builtin_amdgcn_exp2f(P0[r]); }while(0)
  #define RESC() do{ if(resc){ asm volatile("s_waitcnt lgkmcnt(0)":::"memory"); \
      _Pragma("unroll") for(int d_=0;d_<2;++d_) _Pragma("unroll") for(int r=0;r<16;++r)o[d_][r]*=wsf[crow(r,hi)]; } }while(0)
  f32x16 pA0,pA1,pB0,pB1;
  int sl_prev=SLOTB,sl_cur=2*SLOTB,sl_next=0;
  #define ROT() do{sl_prev=sl_cur;sl_cur=sl_next;sl_next=(sl_next==2*SLOTB)?0:sl_next+SLOTB;}while(0)
  DMA_K(1,0); DMA_K(2,SLOTB);
  { const f32x16 z = f32x16{}; qkt_c(pA0,pA1,c.shm+L_K+2*SLOTB,qr,z,r32,hi); }
  asm volatile("s_nop 15\n\ts_nop 7":"+v"(pA0),"+v"(pA1)); CMASK(pA0,pA1,0);
  START(pA0,pA1);
  _Pragma("unroll") for(int r=0;r<16;++r)pA1[r]=__builtin_amdgcn_exp2f(pA1[r]);
  WAIT_BAR(0);
  DMA_K(3,2*SLOTB);DMA_V(1,0);
  ROT();
  kload8(kf,kp0+sl_cur);
  WAIT_BAR(2);
  s16x4 vlo[8],vhi[8]; u32x4 pw0,pw1,pw2,pw3;
  #define PKW(P,B) cvtpk(P[B],P[B+1])
  #define PAF(k) __builtin_bit_cast(bf16x8,pw##k)
  #define VFR(i) (bf16x8){vlo[i][0],vlo[i][1],vlo[i][2],vlo[i][3],vhi[i][0],vhi[i][1],vhi[i][2],vhi[i][3]}
  #define PIN(x) asm volatile("":"+v"(x))
  #define MX3(a,b,c) __builtin_fmaxf(__builtin_fmaxf((a),(b)),(c))
  #define GAPA(MF,A0,A1,A2,A3,W0,W1,PW) do{ MF; sacc+=A0; sacc+=A1; sacc+=A2; sacc+=A3; PIN(sacc); W0; W1; PIN(PW); SBAR(); }while(0)
  #define EX(v) __builtin_amdgcn_exp2f(v)
  #define GAPB(MF,X,B) do{ MF; X[B]=EX(X[B]); X[B+1]=EX(X[B+1]); X[B+2]=EX(X[B+2]); X[B+3]=EX(X[B+3]); PIN(X); SBAR(); }while(0)
  #define VRD(i) do{ vlo[i]=vtr(vp_+(((i)>>2)*4096+((i)&3)*1024)); vhi[i]=vtr(vp_+(((i)>>2)*4096+((i)&3)*1024+512)); }while(0)
  #define KRD(G,j) do{ if(G){ kload2(kf,kp0+sl_next,j); SBAR(); } }while(0)
  #define STEP(C0,C1,P0,P1,t,GK,GV,GL) do{ SBAR(); \
    const lds_cptr vp_=vp0+sl_prev; \
    VRD(0); SBAR(); float sacc=(P0[0]+P0[1]); \
    GAPA(C0=__builtin_amdgcn_mfma_f32_32x32x16_bf16(kf[0],qr[0],negm,0,0,0), P0[2],P0[3],P0[4],P0[5],     pw0[0]=PKW(P0,0), pw0[1]=PKW(P0,2), pw0); \
    VRD(4); SBAR(); GAPA(C1=__builtin_amdgcn_mfma_f32_32x32x16_bf16(kf[1],qr[0],negm,0,0,0), P0[6],P0[7],P0[8],P0[9],     pw0[2]=PKW(P0,4), pw0[3]=PKW(P0,6), pw0); \
    VRD(1); SBAR(); GAPA(C0=__builtin_amdgcn_mfma_f32_32x32x16_bf16(kf[2],qr[1],C0,0,0,0),   P0[10],P0[11],P0[12],P0[13], pw1[0]=PKW(P0,8), pw1[1]=PKW(P0,10), pw1); \
    VRD(5); SBAR(); GAPA(C1=__builtin_amdgcn_mfma_f32_32x32x16_bf16(kf[3],qr[1],C1,0,0,0),   P0[14],P0[15],P1[0],P1[1],   pw1[2]=PKW(P0,12),pw1[3]=PKW(P0,14), pw1); \
    VRD(2); SBAR(); GAPA(C0=__builtin_amdgcn_mfma_f32_32x32x16_bf16(kf[4],qr[2],C0,0,0,0),   P1[2],P1[3],P1[4],P1[5],     pw2[0]=PKW(P1,0), pw2[1]=PKW(P1,2), pw2); \
    VRD(6); SBAR(); GAPA(C1=__builtin_amdgcn_mfma_f32_32x32x16_bf16(kf[5],qr[2],C1,0,0,0),   P1[6],P1[7],P1[8],P1[9],     pw2[2]=PKW(P1,4), pw2[3]=PKW(P1,6), pw2); \
    VRD(3); SBAR(); GAPA(C0=__builtin_amdgcn_mfma_f32_32x32x16_bf16(kf[6],qr[3],C0,0,0,0),   P1[10],P1[11],P1[12],P1[13], pw3[0]=PKW(P1,8), pw3[1]=PKW(P1,10), pw3); \
    VRD(7); SBAR(); GAPA(C1=__builtin_amdgcn_mfma_f32_32x32x16_bf16(kf[7],qr[3],C1,0,0,0),   P1[14],P1[15],0.f,0.f,       pw3[2]=PKW(P1,12),pw3[3]=PKW(P1,14), pw3); \
    l_reg+=sacc; \
    if(GK){DMA_K((t)+3,sl_cur);} if(GV){DMA_V((t)+1,sl_next);} \
    CMASK(C0,C1,t); \
    { float a=MX3(C0[0],C0[1],C1[0]),b=MX3(C0[2],C0[3],C1[1]); a=MX3(a,C1[2],C1[3]); \
      _Pragma("unroll") for(int r=4;r<16;r+=4){a=MX3(a,C0[r],C0[r+1]);b=MX3(b,C0[r+2],C0[r+3]);a=MX3(a,C1[r],C1[r+1]);b=MX3(b,C1[r+2],C1[r+3]);} \
      float rm=__builtin_fmaxf(a,b); { auto rr=__builtin_amdgcn_permlane32_swap(__float_as_uint(rm),__float_as_uint(rm),false,false); rm=__builtin_fmaxf(__uint_as_float(rr[0]),__uint_as_float(rr[1])); } \
      resc=false; \
      if(__builtin_expect(__any(rm>(float)THRL),0)){ const float dl=__builtin_fmaxf(rm,0.f); mhat+=dl; \
        _Pragma("unroll") for(int r=0;r<16;++r){C0[r]-=dl;C1[r]-=dl;} \
        _Pragma("unroll") for(int r=0;r<16;++r)negm[r]=-mhat; asm volatile("":"+v"(negm)); \
        const float f=__builtin_amdgcn_exp2f(-dl); l_reg*=f; if(hi==0)wsf[r32]=f; resc=true; } } \
    SBAR(); \
    GAPB(o[0]=__builtin_amdgcn_mfma_f32_32x32x16_bf16(PAF(0),VFR(0),o[0],0,0,0), C0,0); \
    GAPB(o[1]=__builtin_amdgcn_mfma_f32_32x32x16_bf16(PAF(0),VFR(4),o[1],0,0,0), C0,4); \
    KRD(GL,0); GAPB(o[0]=__builtin_amdgcn_mfma_f32_32x32x16_bf16(PAF(1),VFR(1),o[0],0,0,0), C0,8); \
    KRD(GL,1); GAPB(o[1]=__builtin_amdgcn_mfma_f32_32x32x16_bf16(PAF(1),VFR(5),o[1],0,0,0), C0,12); \
    KRD(GL,2); GAPB(o[0]=__builtin_amdgcn_mfma_f32_32x32x16_bf16(PAF(2),VFR(2),o[0],0,0,0), C1,0); \
    KRD(GL,3); GAPB(o[1]=__builtin_amdgcn_mfma_f32_32x32x16_bf16(PAF(2),VFR(6),o[1],0,0,0), C1,4); \
    GAPB(o[0]=__builtin_amdgcn_mfma_f32_32x32x16_bf16(PAF(3),VFR(3),o[0],0,0,0), C1,8); \
    GAPB(o[1]=__builtin_amdgcn_mfma_f32_32x32x16_bf16(PAF(3),VFR(7),o[1],0,0,0), C1,12); \
    }while(0)
  #define ENDW(tt) do{ if((tt)+3<NT){WAIT_BAR(2);} else if((tt)+2<NT){WAIT_BAR(1);} else {WAIT_BAR(0);} }while(0)
  int t=1;
  for(;t+1<NT;t+=2){
    STEP(pB0,pB1,pA0,pA1,t,(t+3<NT),(t+1<NT),(t+1<NT));       ENDW(t);   RESC(); ROT();
    STEP(pA0,pA1,pB0,pB1,t+1,(t+4<NT),(t+2<NT),(t+2<NT));     ENDW(t+1); RESC(); ROT();
  }
  STEP(pB0,pB1,pA0,pA1,NT-1,false,false,false); RESC();
  { float sacc=pB0[0]+pB0[1]; _Pragma("unroll") for(int r=2;r<16;++r)sacc+=pB0[r]; _Pragma("unroll") for(int r=0;r<16;++r)sacc+=pB1[r]; l_reg+=sacc;
    SBAR(); pv(o, c.vb0 + sl_cur, pack8(pB0,0), pack8(pB0,8), pack8(pB1,0), pack8(pB1,8)); }
  l_out = l_reg;
  asm volatile("s_waitcnt lgkmcnt(0)\n\ts_barrier":::"memory");
  #undef WAIT_BAR
  #undef TILE_OF
  #undef DMA_K
  #undef DMA_V
  #undef CMASK
  #undef START
  #undef RESC
  #undef ROT
  #undef PKW
  #undef PAF
  #undef VFR
  #undef PIN
  #undef MX3
  #undef GAPA
  #undef EX
  #undef GAPB
  #undef VRD
  #undef KRD
  #undef STEP
  #undef ENDW
}

__device__ __forceinline__ void attn_unit(int b, int g, int qb, unsigned char* slab, LAS unsigned char* shm) {
    const bf16_t* Q = (const bf16_t*)(slab + SO_Q); const bf16_t* KV = (const bf16_t*)(slab + SO_KV); const bf16_t* KC = (const bf16_t*)(slab + SO_KC); const bf16_t* VC = (const bf16_t*)(slab + SO_VC);
    const float* gates = (const float*)(slab + SO_GATES); bf16_t* O = (bf16_t*)(slab + SO_O);
    Ctx c;
    const int tid = threadIdx.x;
    c.lane = tid & 63; c.r32 = c.lane & 31; c.hi = c.lane >> 5; c.wid = __builtin_amdgcn_readfirstlane(tid >> 6);
    const int kh = c.wid >> 1, qh = c.wid & 1, head = g * 4 + kh;
    c.ql = qh * 32 + c.r32; c.qb = qb; c.shm = shm; c.lds0 = (unsigned)(size_t)shm;
    c.wsf = (LAS float*)(shm + L_WS) + c.wid * 128;
    c.koff = c.lane * 64 + c.wid * 8;
    c.voff = (16 * (c.wid & 3) + (c.lane >> 2)) * 64 + (c.wid >> 2) * 32 + (c.lane & 3) * 8;
    c.kdst = c.lds0 + L_K + c.wid * 1024; c.vdst = c.lds0 + L_V + c.wid * 1024;
    c.vb0 = (int)(c.lds0 + L_V) + ((c.lane >> 4) & 1) * 32 + (c.lane & 3) * 8 + (4 * c.hi + ((c.lane & 15) >> 2)) * 64;
    const int t = qb * 64 + c.ql;
    const size_t mrow = (size_t)t;
    const size_t bg = (size_t)g;
    const bf16_t* KSb = KV + ((size_t)2 * 4 + g) * (SEQ * 64);
    const bf16_t* VSb = KV + ((size_t)3 * 4 + g) * (SEQ * 64);
    const bf16_t* KWb = KV + ((size_t)4 * 4 + g) * (SEQ * 64);
    const bf16_t* VWb = KV + ((size_t)5 * 4 + g) * (SEQ * 64);
    const bf16_t* KCb = KC + bg * 8192; const bf16_t* VCb = VC + bg * 8192;
    dma_k(c, KCb, 0, 0); dma_k(c, KCb, 1, 1); dma_v(c, VCb, 0, 0); dma_v(c, VCb, 1, 1);
    dma_k(c, KSb, 0, 2); dma_v(c, VSb, 0, 2);
    bf16x8 qr[4];
    { const bf16_t* Qw = Q + mrow * DM + head * 64 + c.hi * 8;
#pragma unroll
      for (int d0 = 0; d0 < 4; ++d0) qr[d0] = *(const bf16x8*)(Qw + d0 * 16); }
    const float* gp = gates + mrow * 48 + head * 3;
    const float g0 = gp[0], g1 = gp[1], g2 = gp[2];
    f32x16 ot[2];
    f32x16 o[2];
    const bool two = qb >= 16;
    ATT_WAIT_BAR(2);
    {
        f32x16 a0, a1, b0, b1;
        qkt(a0, a1, shm + L_K, qr, c.r32, c.hi);
        const int nmax = (t >= 31) ? ((t - 31) >> 4) : -1;
        range_mask(a0, a1, 0, nmax, c.hi);
        float rm = rowmax(a0, a1);
        if (two) { qkt(b0, b1, shm + L_K + SLOTB, qr, c.r32, c.hi); range_mask(b0, b1, 0, nmax - 64, c.hi); rm = fmaxf(rm, rowmax(b0, b1)); }
        const float mu = (rm == -INFINITY) ? 0.f : rm;
        float s = 0.f;
#pragma unroll
        for (int r = 0; r < 16; ++r) { a0[r] = __builtin_amdgcn_exp2f(a0[r] - mu); a1[r] = __builtin_amdgcn_exp2f(a1[r] - mu); s += a0[r] + a1[r]; }
        if (two) {
#pragma unroll
            for (int r = 0; r < 16; ++r) { b0[r] = __builtin_amdgcn_exp2f(b0[r] - mu); b1[r] = __builtin_amdgcn_exp2f(b1[r] - mu); s += b0[r] + b1[r]; }
        }
        s = halfsum(s);
        const float inv = (s > 0.f) ? 1.0f / s : 0.f;
#pragma unroll
        for (int r = 0; r < 16; ++r) { a0[r] *= inv; a1[r] *= inv; }
        if (two) {
#pragma unroll
            for (int r = 0; r < 16; ++r) { b0[r] *= inv; b1[r] *= inv; }
            int qlx = c.ql; LAUNDER(qlx);
            LAS float* IA = (LAS float*)(shm + L_IA) + (kh * 64 + qlx) * 33;
            LAS float* IB = (LAS float*)(shm + L_IB) + (kh * 64 + qlx) * 33;
#pragma unroll
            for (int i = 0; i < 4; ++i) {
                const int j = 2 * i + c.hi;
                IA[j]      = a0[4 * i] + a0[4 * i + 1] + a0[4 * i + 2] + 0.5f * a0[4 * i + 3]; IB[j + 1]  = 0.5f * a0[4 * i + 3];
                IA[j + 8]  = a1[4 * i] + a1[4 * i + 1] + a1[4 * i + 2] + 0.5f * a1[4 * i + 3]; IB[j + 9]  = 0.5f * a1[4 * i + 3];
                IA[j + 16] = b0[4 * i] + b0[4 * i + 1] + b0[4 * i + 2] + 0.5f * b0[4 * i + 3]; IB[j + 17] = 0.5f * b0[4 * i + 3];
                IA[j + 24] = b1[4 * i] + b1[4 * i + 1] + b1[4 * i + 2] + 0.5f * b1[4 * i + 3]; IB[j + 25] = 0.5f * b1[4 * i + 3];
            }
        }
        o[0] = f32x16{}; o[1] = f32x16{};
        pv(o, c.vb0, pack8(a0, 0), pack8(a0, 8), pack8(a1, 0), pack8(a1, 8));
        if (two) pv(o, c.vb0 + SLOTB, pack8(b0, 0), pack8(b0, 8), pack8(b1, 0), pack8(b1, 8));
        float cf[16]; row_bcast(g0, cf, c.wsf, c.r32, c.hi);
#pragma unroll
        for (int r = 0; r < 16; ++r) { ot[0][r] = o[0][r] * cf[r]; ot[1][r] = o[1][r] * cf[r]; }
    }
    ATT_WAIT_BAR(0);
    LAS unsigned* SEL = (LAS unsigned*)(shm + L_SEL);
    if (two) {
        int q = tid & 63, jg = tid >> 6; LAUNDER(q); LAUNDER(jg);
        LAS float* SC = (LAS float*)(shm + L_SC);
        const LAS float* IA = (const LAS float*)(shm + L_IA); const LAS float* IB = (const LAS float*)(shm + L_IB);
#pragma unroll
        for (int jj = 0; jj < 4; ++jj) { const int j = 4 * jg + jj; float sc = 0.f;
#pragma unroll
            for (int k = 0; k < 4; ++k) { sc += IA[(k * 64 + q) * 33 + j]; if (j > 0) sc += IB[(k * 64 + q) * 33 + j]; }
            const bool forced = (j == 0) || (j == qb) || (j == qb - 1);
            SC[q * 33 + j] = forced ? 1e30f : ((j <= qb) ? sc : -1e30f); }
        ATT_WAIT_BAR(0);
        unsigned nib = 0u;
        float sj[4];
#pragma unroll
        for (int jj = 0; jj < 4; ++jj) sj[jj] = SC[q * 33 + 4 * jg + jj];
        int rank[4] = {0, 0, 0, 0};
        for (int i = 0; i < 32; ++i) { const float si = SC[q * 33 + i];
#pragma unroll
            for (int jj = 0; jj < 4; ++jj) { const int j = 4 * jg + jj; rank[jj] += (si > sj[jj] || (si == sj[jj] && i < j)) ? 1 : 0; } }
#pragma unroll
        for (int jj = 0; jj < 4; ++jj) nib |= (rank[jj] < 16 ? 1u : 0u) << jj;
        ((LAS unsigned char*)(shm + L_NIB))[q * 8 + jg] = (unsigned char)nib;
        ATT_WAIT_BAR(0);
        if (tid < 64) { unsigned mk = 0u; int tq = tid; LAUNDER(tq);
#pragma unroll
            for (int k = 0; k < 8; ++k) mk |= (unsigned)((LAS unsigned char*)(shm + L_NIB))[tq * 8 + k] << (4 * k);
            SEL[tq] = mk; }
        ATT_WAIT_BAR(0);
    } else {
        if (tid < 64) SEL[tid] = (1u << (qb + 1)) - 1u;
        ATT_WAIT_BAR(0);
    }
    int lnx = c.lane, qlx2 = c.ql; LAUNDER(lnx); LAUNDER(qlx2);
    LAS float* accp = (LAS float*)(shm + L_IA) + c.wid * 2048 + lnx;
#pragma unroll
    for (int r = 0; r < 16; ++r) { accp[r * 64] = ot[0][r]; accp[(16 + r) * 64] = ot[1][r]; }
    unsigned um = SEL[lnx];
#pragma unroll
    for (int sft = 1; sft < 64; sft <<= 1) um |= (unsigned)__shfl_xor((int)um, sft);
    um = (unsigned)__builtin_amdgcn_readfirstlane((int)um);
    um &= (qb == 31) ? 0xffffffffu : ((1u << (qb + 1)) - 1u);
    const unsigned msel = SEL[qlx2];
    (void)um;
    {
        float l_sel; f32x16 osel[2];
        sel_stream<8>(c, KSb, VSb, qr, msel, qb, osel, l_sel);
        const float lt = halfsum(l_sel);
        float cf[16]; row_bcast((lt > 0.f) ? g1 / lt : 0.f, cf, c.wsf, c.r32, c.hi);
#pragma unroll
        for (int r = 0; r < 16; ++r) { accp[r * 64] += osel[0][r] * cf[r]; accp[(16 + r) * 64] += osel[1][r] * cf[r]; }
    }
    {
        const int lo_t = qb >= 8 ? qb - 8 : 0, nw = qb - lo_t + 1;
        dma_k(c, KWb, qb, 0); dma_v(c, VWb, qb, 0);
        if (nw > 1) { dma_k(c, KWb, qb - 1, 1); dma_v(c, VWb, qb - 1, 1); }
        BrState st; br_reset(st);
        int slot = 0;
        for (int j = 0; j < nw; ++j) {
            if (j + 1 < nw) ATT_WAIT_BAR(2); else ATT_WAIT_BAR(0);
            if (j + 2 < nw) { const int ps = (slot == 0) ? 2 : slot - 1; dma_k(c, KWb, qb - j - 2, ps); dma_v(c, VWb, qb - j - 2, ps); }
            const int tc = qb - j;
            bool use_range = false; int lo = 0, hv = 63;
            if (j == 0) { use_range = true; hv = c.ql; }
            else if (tc == qb - 8) { use_range = true; lo = c.ql + 1; }
            stream_step(c, slot, qr, true, use_range, lo, hv, j == 0, st);
            slot = (slot == 2) ? 0 : slot + 1;
        }
        const float lt = halfsum(st.l);
        float cf[16]; row_bcast((lt > 0.f) ? g2 / lt : 0.f, cf, c.wsf, c.r32, c.hi);
#pragma unroll
        for (int r = 0; r < 16; ++r) { ot[0][r] = accp[r * 64] + st.o[0][r] * cf[r]; ot[1][r] = accp[(16 + r) * 64] + st.o[1][r] * cf[r]; }
        LDS_WAIT();
    }
    {
        LAS bf16_t* stg = (LAS bf16_t*)(shm + L_IA) + c.wid * 4096;
        int lny = c.lane; LAUNDER(lny);
        LAS bf16_t* stw = stg + ((lny >> 5) * 4) * 64 + (lny & 31);
#pragma unroll
        for (int r = 0; r < 16; ++r) { const int orow = (r & 3) + 8 * (r >> 2);
#pragma unroll
            for (int d0 = 0; d0 < 2; ++d0) stw[orow * 64 + d0 * 32] = (bf16_t)(cvtpk(ot[d0][r], 0.f) & 0xffffu); }
        LDS_WAIT();
        bf16_t* Ow = O + ((size_t)qb * 64 + qh * 32) * DM + head * 64;
#pragma unroll
        for (int i = 0; i < 4; ++i) { const int row = i * 8 + (lny >> 3), chn = lny & 7; const u32x4 v = *(const LAS u32x4*)(stg + row * 64 + chn * 8); *(u32x4*)(Ow + (size_t)row * DM + chn * 8) = v; }
    }
    ATT_WAIT_BAR(0);
}
#undef SBAR
}

#define XB_TMO      128
#define XB_XCNT(j)  (256  + 64 * (j))
#define XB_XSUB(j)  (1280 + 64 * (j))
#define XB_XGEN(j)  (2304 + 64 * (j))
#define XB_TOP      3328
#define XB_TOPGEN   3392
#define XB_LSUB(j)  (3456 + 64 * (j))
#define XB_LGEN(j)  (4480 + 64 * (j))
#define XCD_BAR_WORDS 5504
#define XB_SPIN_CAP (1u << 18)
__device__ __forceinline__ unsigned xb_ld(unsigned* p)              { return __hip_atomic_load(p, __ATOMIC_RELAXED, __HIP_MEMORY_SCOPE_AGENT); }
__device__ __forceinline__ unsigned xb_add(unsigned* p, unsigned v) { return __hip_atomic_fetch_add(p, v, __ATOMIC_RELAXED, __HIP_MEMORY_SCOPE_AGENT); }
__device__ __forceinline__ unsigned xb_xcc_id() { return (unsigned)__builtin_amdgcn_s_getreg((3 << 11) | 20) & 0xFu; }
#define XB_SPIN(cond, bar) do { unsigned _sp = 0; while (cond) { __builtin_amdgcn_s_sleep(1); \
    if ((++_sp & 255u) == 0u) { if (xb_ld(&(bar)[XB_TMO])) break; if (_sp > XB_SPIN_CAP) { atomicAdd(&(bar)[XB_TMO], 1u); break; } } } } while (0)
struct XcdBarrier { unsigned* bar; unsigned x; volatile LAS unsigned* st; };
__device__ __forceinline__ XcdBarrier xcd_barrier_post(unsigned* bar, volatile LAS unsigned* st) {
    XcdBarrier b; b.bar = bar; b.x = xb_xcc_id(); b.st = st;
    if (threadIdx.x == 0) { st[2] = xb_add(&bar[XB_XCNT(b.x)], 1u); st[4] = b.x; }
    return b;
}
__device__ __forceinline__ void xcd_barrier_complete(unsigned* bar, unsigned x, unsigned& nloc, unsigned& nx, unsigned& uniform) {
    const unsigned G = gridDim.x * gridDim.y * gridDim.z;
    unsigned sum, cnt, mine, sp = 0u, uni;
    for (;;) {
        sum = 0u; cnt = 0u; mine = 0u; uni = 1u;
#pragma unroll
        for (unsigned j = 0; j < 16; ++j) { const unsigned c = xb_ld(&bar[XB_XCNT(j)]); sum += c; cnt += (c > 0u) ? 1u : 0u; mine = (j == x) ? c : mine;
            if (j < 8u ? (c != 32u) : (c != 0u)) uni = 0u; }
        if (sum == G) break;
        __builtin_amdgcn_s_sleep(1);
        if ((++sp & 255u) == 0u) { if (xb_ld(&bar[XB_TMO])) break; if (sp > XB_SPIN_CAP) { atomicAdd(&bar[XB_TMO], 1u); break; } }
    }
    nloc = mine > 0u ? mine : 1u; nx = cnt > 0u ? cnt : 1u;
    uniform = (uni != 0u && sum == G && G == 256u) ? 1u : 0u;
}
__device__ __forceinline__ void xcd_barrier(const XcdBarrier& b) {
    asm volatile("s_waitcnt vmcnt(0)" ::: "memory");
    __syncthreads();
    if (threadIdx.x == 0) {
        unsigned* bar = b.bar;
        __builtin_amdgcn_s_waitcnt(0);
        unsigned nloc = b.st[0], nx = b.st[1];
        if (nloc == 0u) { unsigned uf; xcd_barrier_complete(bar, b.x, nloc, nx, uf); b.st[0] = nloc; b.st[1] = nx; b.st[3] = uf; }
        const unsigned old = xb_add(&bar[XB_XSUB(b.x)], 1u);
        const unsigned gen = old / nloc;
        if (old + 1u == (gen + 1u) * nloc) {
            __builtin_amdgcn_fence(__ATOMIC_RELEASE, "agent");
            asm volatile("s_waitcnt vmcnt(0)" ::: "memory");
            const unsigned og = xb_add(&bar[XB_TOP], 1u);
            const unsigned tg = og / nx;
            if (og + 1u == (tg + 1u) * nx) xb_add(&bar[XB_TOPGEN], 1u);
            else XB_SPIN(xb_ld(&bar[XB_TOPGEN]) == tg, bar);
            __builtin_amdgcn_fence(__ATOMIC_ACQUIRE, "agent");
            xb_add(&bar[XB_XGEN(b.x)], 1u);
            asm volatile("s_waitcnt vmcnt(0)" ::: "memory");
        } else {
            XB_SPIN(xb_ld(&bar[XB_XGEN(b.x)]) == gen, bar);
            __builtin_amdgcn_fence(__ATOMIC_ACQUIRE, "agent");
            asm volatile("s_waitcnt vmcnt(0)" ::: "memory");
        }
    }
    __syncthreads();
}

__device__ __forceinline__ void xcd_local_barrier(const XcdBarrier& b) {
    asm volatile("s_waitcnt vmcnt(0)" ::: "memory");
    __syncthreads();
    if (threadIdx.x == 0) {
        unsigned* bar = b.bar;
        __builtin_amdgcn_s_waitcnt(0);
        const unsigned nloc = b.st[0];
        const unsigned old = xb_add(&bar[XB_LSUB(b.x)], 1u);
        const unsigned gen = old / nloc;
        if (old + 1u == (gen + 1u) * nloc) xb_add(&bar[XB_LGEN(b.x)], 1u);
        else XB_SPIN(xb_ld(&bar[XB_LGEN(b.x)]) == gen, bar);
        __builtin_amdgcn_fence(__ATOMIC_ACQUIRE, "agent");
        asm volatile("s_waitcnt vmcnt(0)" ::: "memory");
    }
    __syncthreads();
}

struct Args {
    const float *x, *c, *norm_gain, *w_ada, *b_ada, *w_a_in, *conv_w, *w_a_out, *w_qg, *q_gain, *w_o, *kv_norm_gain, *w_ada_kv, *b_ada_kv, *w_kv, *k_gain, *cmp_pe, *cmp_w1, *cmp_w2, *w_mlp1, *w_mlp2;
    float* out; unsigned char* ws; int ph_lo, ph_hi;
};

__device__ __forceinline__ void transpose_item(const float* W, int ldn, int srccol, int nvalid, int k0, bf16_t* WT, int Kd, int drow0, LAS float* scr, int lane) {
    if (nvalid == 32) {
        f32x4 t[8];
#pragma unroll
        for (int i = 0; i < 8; ++i) t[i] = __builtin_nontemporal_load((const f32x4*)(W + (size_t)(k0 + 8 * i + (lane >> 3)) * ldn + srccol + (lane & 7) * 4));
#pragma unroll
        for (int i = 0; i < 8; ++i) { LAS float* d = scr + (8 * i + (lane >> 3)) * 33 + (lane & 7) * 4; d[0] = t[i][0]; d[1] = t[i][1]; d[2] = t[i][2]; d[3] = t[i][3]; }
    } else {
#pragma unroll 8
        for (int i = 0; i < 32; ++i) { const int kk = 2 * i + (lane >> 5), n = lane & 31; scr[kk * 33 + n] = (n < nvalid) ? W[(size_t)(k0 + kk) * ldn + srccol + n] : 0.f; }
    }
    LDS_WAIT(); asm volatile("" ::: "memory");
    const int ch = lane & 7;
#pragma unroll
    for (int j = 0; j < 4; ++j) { const int n = (lane >> 3) + 8 * j; const LAS float* s = scr + (8 * ch) * 33 + n;
        u32x4 o; o.x = cvtpk(s[0 * 33], s[1 * 33]); o.y = cvtpk(s[2 * 33], s[3 * 33]); o.z = cvtpk(s[4 * 33], s[5 * 33]); o.w = cvtpk(s[6 * 33], s[7 * 33]);
        *(u32x4*)(WT + (size_t)(drow0 + n) * Kd + k0 + 8 * ch) = o; }
    LDS_WAIT(); asm volatile("" ::: "memory");
}
__device__ __forceinline__ int perm_head_cols(int d) { const int t = d >> 8, p = d & 255; return 256 * t + 64 * ((p >> 5) & 3) + 32 * (p >> 7) + (p & 31); }

constexpr int TI_AIN = 1536, TI_AOUT = 512, TI_M1 = 2048, TI_M2 = 2048, TI_KV = 768, TI_QG = 640, TI_O = 512, TI_C1 = 256, TI_C2 = 8;
constexpr int TI_TOTAL = TI_AIN + TI_AOUT + 2 * TI_M1 + 2 * TI_M2 + TI_KV + TI_QG + TI_O + 2 * TI_C1 + 2 * TI_C2;

__device__ __forceinline__ void p0_item(const Args& a, int it, LAS float* scr, int lane) {
    unsigned char* ws = a.ws;
    int r = it;
    if (r < TI_AIN) { const int kb = r / 96, nb = r % 96, d = 32 * nb; int src;
        if (d < 1024) src = d; else { const int t = (d - 1024) >> 8, p = (d - 1024) & 255; src = (p < 128) ? (1024 + 128 * t + p) : (2048 + 128 * t + (p - 128)); }
        transpose_item(a.w_a_in, 3072, src, 32, 64 * kb, (bf16_t*)(ws + WS_WAIN), 1024, d, scr, lane); return; }
    r -= TI_AIN;
    if (r < TI_AOUT) { const int kb = r / 32, nb = r % 32; transpose_item(a.w_a_out, 1024, 32 * nb, 32, 64 * kb, (bf16_t*)(ws + WS_WAOUT), 1024, 32 * nb, scr, lane); return; }
    r -= TI_AOUT;
    if (r < 2 * TI_M1) { const int L = r / TI_M1, q = r % TI_M1, kb = q / 128, nb = q % 128;
        transpose_item(a.w_mlp1 + (size_t)L * DM * FF, FF, 32 * nb, 32, 64 * kb, (bf16_t*)(ws + WS_WM1) + (size_t)L * FF * DM, DM, 32 * nb, scr, lane); return; }
    r -= 2 * TI_M1;
    if (r < 2 * TI_M2) { const int L = r / TI_M2, q = r % TI_M2, kb = q / 32, nb = q % 32;
        transpose_item(a.w_mlp2 + (size_t)L * FF * DM, DM, 32 * nb, 32, 64 * kb, (bf16_t*)(ws + WS_WM2) + (size_t)L * DM * FF, FF, 32 * nb, scr, lane); return; }
    r -= 2 * TI_M2;
    if (r < TI_KV) { const int kb = r / 48, nb = r % 48, d = 32 * nb;
        transpose_item(a.w_kv, 1536, perm_head_cols(d), 32, 64 * kb, (bf16_t*)(ws + WS_WKVQ), DM, d, scr, lane); return; }
    r -= TI_KV;
    if (r < TI_QG) { const int kb = r / 40, nb = r % 40, d = 32 * nb; int src, nv = 32;
        if (d < 1024) src = perm_head_cols(d); else { const int p = d - 1024; src = 1024 + p; nv = 48 - p; nv = nv < 0 ? 0 : (nv > 32 ? 32 : nv); if (nv == 0) src = 0; }
        transpose_item(a.w_qg, 1072, src, nv, 64 * kb, (bf16_t*)(ws + WS_WKVQ), DM, 1536 + d, scr, lane); return; }
    r -= TI_QG;
    if (r < TI_O) { const int kb = r / 32, nb = r % 32; transpose_item(a.w_o, 1024, 32 * nb, 32, 64 * kb, (bf16_t*)(ws + WS_WO), 1024, 32 * nb, scr, lane); return; }
    r -= TI_O;
    if (r < 2 * TI_C1) { const int kv = r / TI_C1, q = r % TI_C1, kb = q / 8, nb = q % 8;
        transpose_item(a.cmp_w1 + (size_t)kv * 2048 * 256, 256, 32 * nb, 32, 64 * kb, (bf16_t*)(ws + WS_WC1) + (size_t)kv * 256 * 2048, 2048, 32 * nb, scr, lane); return; }
    r -= 2 * TI_C1;
    { const int kv = r / TI_C2, q = r % TI_C2, kb = q / 2, nb = q % 2;
        transpose_item(a.cmp_w2 + (size_t)kv * 256 * 64, 64, 32 * nb, 32, 64 * kb, (bf16_t*)(ws + WS_WC2) + (size_t)kv * 64 * 256, 256, 32 * nb, scr, lane); }
}

__device__ __forceinline__ void p0_mods(const Args& a, LAS unsigned char* lds, int vblk, int G) {
    LAS float* cact = (LAS float*)lds;
    LAS float* red = (LAS float*)(lds + 32768);
    const int tid = threadIdx.x, lane = tid & 63, wave = tid >> 6;
    bool have = false;
    for (int u = vblk; u < 224; u += G) {
        if (!have) { for (int i = tid; i < 8 * DM; i += 512) { const float cv = a.c[i]; cact[i] = cv / (1.0f + __expf(-cv)); } have = true; }
        __syncthreads();
        const int col = u * 64 + lane;
        const float* W; const float* bias; float* dst; int N, c0;
        if (col < 6144) { W = a.w_ada; bias = a.b_ada; dst = (float*)(a.ws + WS_MOD0); N = 6144; c0 = col; }
        else if (col < 12288) { W = a.w_ada + (size_t)DM * 6144; bias = a.b_ada + 6144; dst = (float*)(a.ws + WS_MOD1); N = 6144; c0 = col - 6144; }
        else { W = a.w_ada_kv; bias = a.b_ada_kv; dst = (float*)(a.ws + WS_MODKV); N = 2048; c0 = col - 12288; }
        float acc[8];
#pragma unroll
        for (int b = 0; b < 8; ++b) acc[b] = 0.f;
        const float* wp = W + (size_t)(wave * 128) * N + c0;
        const LAS float* cp = cact + wave * 128;
#pragma unroll 8
        for (int k = 0; k < 128; ++k) { const float w = __builtin_nontemporal_load(wp + (size_t)k * N);
#pragma unroll
            for (int b = 0; b < 8; ++b) acc[b] += w * cp[b * DM + k]; }
#pragma unroll
        for (int b = 0; b < 8; ++b) red[(wave * 8 + b) * 64 + lane] = acc[b];
        __syncthreads();
        { const int b = wave; float sacc = bias[c0];
#pragma unroll
          for (int w = 0; w < 8; ++w) sacc += red[(w * 8 + b) * 64 + lane];
          dst[(size_t)b * N + c0] = sacc; }
        __syncthreads();
    }
    __syncthreads();
}

__device__ __forceinline__ void p1_norm_row2(const Args& a, int m0, int lane) {
    const int b = m0 >> 11;
    const float* mod0 = (const float*)(a.ws + WS_MOD0) + (size_t)b * 6144;
    const f32x4* xr = (const f32x4*)(a.x + (size_t)m0 * DM) + lane;
    f32x4 v[2][4]; float s0 = 0.f, s1 = 0.f;
#pragma unroll
    for (int j = 0; j < 4; ++j) { v[0][j] = __builtin_nontemporal_load(xr + 64 * j); v[1][j] = __builtin_nontemporal_load(xr + 256 + 64 * j); }
#pragma unroll
    for (int j = 0; j < 4; ++j) { s0 += (v[0][j][0] * v[0][j][0] + v[0][j][1] * v[0][j][1]) + (v[0][j][2] * v[0][j][2] + v[0][j][3] * v[0][j][3]);
                                  s1 += (v[1][j][0] * v[1][j][0] + v[1][j][1] * v[1][j][1]) + (v[1][j][2] * v[1][j][2] + v[1][j][3] * v[1][j][3]); }
#pragma unroll
    for (int o = 1; o < 64; o <<= 1) { s0 += __shfl_xor(s0, o); s1 += __shfl_xor(s1, o); }
    const float r0 = rsqrtf(s0 * (1.0f / DM) + EPS), r1 = rsqrtf(s1 * (1.0f / DM) + EPS);
    u32x2* o8 = (u32x2*)((bf16_t*)(a.ws + WS_A2) + (size_t)m0 * DM) + lane;
#pragma unroll
    for (int j = 0; j < 4; ++j) { const int col = 4 * lane + 256 * j;
        const f32x4 gn = *(const f32x4*)(a.norm_gain + col), sh = *(const f32x4*)(mod0 + col), sc = *(const f32x4*)(mod0 + 1024 + col) + 1.0f;
        const f32x4 h0 = (v[0][j] * r0 * gn) * sc + sh, h1 = (v[1][j] * r1 * gn) * sc + sh;
        u32x2 w; w.x = cvtpk(h0[0], h0[1]); w.y = cvtpk(h0[2], h0[3]); o8[64 * j] = w;
        w.x = cvtpk(h1[0], h1[1]); w.y = cvtpk(h1[2], h1[3]); o8[256 + 64 * j] = w; }
}
__device__ __forceinline__ void p1_bias_task(const bf16_t* Wt, int n0, const float* shift, int shift_stride, float* bias, int bias_stride, int lane) {
    const int r = lane & 15, kq = lane >> 4;
    const bf16_t* wp = Wt + (size_t)(n0 + r) * DM + 8 * kq;
    const float* sp = shift + (size_t)(r & 7) * shift_stride + 8 * kq;
    f32x4 acc = (f32x4){0.f, 0.f, 0.f, 0.f};
#pragma unroll 8
    for (int k0 = 0; k0 < DM; k0 += 32) {
        const bf16x8 bf = *(const bf16x8*)(wp + k0);
        const f32x4 s0 = *(const f32x4*)(sp + k0), s1 = *(const f32x4*)(sp + k0 + 4);
        u32x4 aw; aw.x = cvtpk(s0[0], s0[1]); aw.y = cvtpk(s0[2], s0[3]); aw.z = cvtpk(s1[0], s1[1]); aw.w = cvtpk(s1[2], s1[3]);
        if (r >= 8) aw = (u32x4){0u, 0u, 0u, 0u};
        acc = __builtin_amdgcn_mfma_f32_16x16x32_bf16(__builtin_bit_cast(bf16x8, aw), bf, acc, 0, 0, 0);
    }
    if (kq < 2) {
#pragma unroll
        for (int e = 0; e < 4; ++e) bias[(size_t)(4 * kq + e) * bias_stride + n0 + r] = acc[e];
    }
}
__device__ __forceinline__ void p1_pebias(const Args& a, int idx, int lane) {
    const int kv = idx >> 8;
    const bf16_t* wrow = (const bf16_t*)(a.ws + WS_WC1) + (size_t)idx * 2048;
    const float* pe = a.cmp_pe + (size_t)kv * 2048;
    float d = 0.f;
#pragma unroll
    for (int j = 0; j < 4; ++j) { const int k = (lane + 64 * j) * 8; const u32x4 w = *(const u32x4*)(wrow + k); const f32x4 p0 = *(const f32x4*)(pe + k), p1 = *(const f32x4*)(pe + k + 4);
        d += p0[0] * bf_lo(w.x) + p0[1] * bf_hi(w.x) + p0[2] * bf_lo(w.y) + p0[3] * bf_hi(w.y) + p1[0] * bf_lo(w.z) + p1[1] * bf_hi(w.z) + p1[2] * bf_lo(w.w) + p1[3] * bf_hi(w.w); }
    d = wave_sum(d);
    if (lane == 0) ((float*)(a.ws + WS_PEB))[idx] = d;
}

__device__ __forceinline__ void unpack8(const u32x4 w, float (&f)[8]) { f[0] = bf_lo(w.x); f[1] = bf_hi(w.x); f[2] = bf_lo(w.y); f[3] = bf_hi(w.y); f[4] = bf_lo(w.z); f[5] = bf_hi(w.z); f[6] = bf_lo(w.w); f[7] = bf_hi(w.w); }
__device__ __forceinline__ void p3_conv(const Args& a, int gtid, int nthreads) {
    for (int it0 = gtid; it0 < 128 * 2048; it0 += nthreads) {
        const int pass = it0 / nthreads, vt = it0 - pass * nthreads;
        const int it = (nthreads == 131072) ? ((vt >> 14) * 32768 + pass * 16384 + (vt & 16383)) : it0;
        const int cch = it & 127, rch = it >> 7, col = cch * 8, r0 = (rch * 8) & (SEQ - 1);
        unsigned char* slab = a.ws + WS_R + (size_t)((rch * 8) >> 11) * SLAB;
        const bf16_t* GB = (const bf16_t*)(slab + SO_GB); const bf16_t* V = (const bf16_t*)(slab + SO_V); bf16_t* Y = (bf16_t*)(slab + SO_Y);
        float w0[8], w1[8], w2[8];
        { const f32x4 t0 = *(const f32x4*)(a.conv_w + col), t1 = *(const f32x4*)(a.conv_w + col + 4); w0[0] = t0[0]; w0[1] = t0[1]; w0[2] = t0[2]; w0[3] = t0[3]; w0[4] = t1[0]; w0[5] = t1[1]; w0[6] = t1[2]; w0[7] = t1[3]; }
        { const f32x4 t0 = *(const f32x4*)(a.conv_w + 1024 + col), t1 = *(const f32x4*)(a.conv_w + 1024 + col + 4); w1[0] = t0[0]; w1[1] = t0[1]; w1[2] = t0[2]; w1[3] = t0[3]; w1[4] = t1[0]; w1[5] = t1[1]; w1[6] = t1[2]; w1[7] = t1[3]; }
        { const f32x4 t0 = *(const f32x4*)(a.conv_w + 2048 + col), t1 = *(const f32x4*)(a.conv_w + 2048 + col + 4); w2[0] = t0[0]; w2[1] = t0[1]; w2[2] = t0[2]; w2[3] = t0[3]; w2[4] = t1[0]; w2[5] = t1[1]; w2[6] = t1[2]; w2[7] = t1[3]; }
        float vm2[8], vm1[8];
        if ((r0 & (SEQ - 1)) != 0) { unpack8(*(const u32x4*)(V + (size_t)(r0 - 2) * DM + col), vm2); unpack8(*(const u32x4*)(V + (size_t)(r0 - 1) * DM + col), vm1); }
        else {
#pragma unroll
            for (int e = 0; e < 8; ++e) { vm2[e] = 0.f; vm1[e] = 0.f; } }
#pragma unroll
        for (int i = 0; i < 8; ++i) { float vc[8], gb[8], y[8];
            unpack8(*(const u32x4*)(V + (size_t)(r0 + i) * DM + col), vc); unpack8(*(const u32x4*)(GB + (size_t)(r0 + i) * DM + col), gb);
#pragma unroll
            for (int e = 0; e < 8; ++e) { y[e] = gb[e] * (w2[e] * vc[e] + w1[e] * vm1[e] + w0[e] * vm2[e]); vm2[e] = vm1[e]; vm1[e] = vc[e]; }
            u32x4 w; w.x = cvtpk(y[0], y[1]); w.y = cvtpk(y[2], y[3]); w.z = cvtpk(y[4], y[5]); w.w = cvtpk(y[6], y[7]);
            *(u32x4*)(Y + (size_t)(r0 + i) * DM + col) = w; }
    }
}

__device__ __forceinline__ float gelu_tanh(float x) {
    const float z = 0.7978845608028654f * (x + 0.044715f * x * x * x);
    const float e = __builtin_amdgcn_exp2f(z * 2.8853900817779268f);
    const float th = 1.0f - 2.0f / (e + 1.0f);
    return 0.5f * x * (1.0f + th);
}
constexpr int C_CH = 2064;
constexpr int C_RB0 = 68608;
constexpr int C_HOFF = C_RB0, C_HROW = 528;
__device__ __forceinline__ void p8_unit(const Args& a, int u, LAS unsigned char* lds) {
    const int tid = threadIdx.x, lane = tid & 63, wid = __builtin_amdgcn_readfirstlane(tid >> 6), r = lane & 31, h = lane >> 5;
    const int kv = u >> 7, bg = (u >> 2) & 31, rq = u & 3;
    unsigned char* slab = a.ws + WS_R + (size_t)(bg >> 2) * SLAB;
    const bf16_t* src = (const bf16_t*)(slab + SO_KV) + ((size_t)(kv * 4 + (bg & 3)) * SEQ + 512 * rq) * 64;
    __syncthreads();
    { u32x4 v[8];
#pragma unroll
      for (int j = 0; j < 8; ++j) v[j] = *(const u32x4*)(src + (size_t)(tid + 512 * j) * 8);
      u32x4 vl = (u32x4){0u, 0u, 0u, 0u};
      if (tid < 128 && rq != 3) vl = *(const u32x4*)(src + (size_t)32 * 1024 + tid * 8);
#pragma unroll
      for (int j = 0; j < 8; ++j) { const int idx = tid + 512 * j; *(LAS u32x4*)(lds + (idx >> 7) * C_CH + (idx & 127) * 16) = v[j]; }
      if (tid < 128) *(LAS u32x4*)(lds + 32 * C_CH + tid * 16) = vl; }
    __syncthreads();
    f32x16 acc = f32x16{};
    const unsigned lds0 = (unsigned)(size_t)lds;
    const bf16_t* Wsrc = (const bf16_t*)(a.ws + WS_WC1) + (size_t)(kv * 256) * 2048;
    const int drow = 16 * wid + (lane >> 2);
    const bf16_t* dsrc0 = Wsrc + (size_t)drow * 2048 + 8 * ((lane & 3) ^ ((drow >> 2) & 3));
    const bf16_t* dsrc1 = dsrc0 + (size_t)128 * 2048;
    const unsigned ddst0 = lds0 + C_RB0 + wid * 1024, ddst1 = ddst0 + 8192;
    const int brow = 32 * wid + r;
    const unsigned boff = C_RB0 + brow * 64, bkey = (brow >> 2) & 3;
#define P8_DMA(stg) do { att::glds16(dsrc0 + 32 * (stg), (unsigned)__builtin_amdgcn_readfirstlane(ddst0 + ((stg) & 3) * 16384)); att::glds16(dsrc1 + 32 * (stg), (unsigned)__builtin_amdgcn_readfirstlane(ddst1 + ((stg) & 3) * 16384)); } while (0)
#define P8_STEP(stg, WAITN) do { asm volatile("s_waitcnt vmcnt(" #WAITN ") lgkmcnt(0)\n\ts_barrier" ::: "memory"); \
        if ((stg) + 3 < 64) P8_DMA((stg) + 3); \
        { const LAS unsigned char* bp = lds + boff + ((stg) & 3) * 16384; \
          const LAS unsigned char* ap = lds + (r + ((stg) >> 5)) * C_CH + ((32 * (stg)) & 1023) * 2 + 16 * h; \
          const bf16x8 a0 = *(const LAS bf16x8*)ap, a1 = *(const LAS bf16x8*)(ap + 32); \
          const bf16x8 b0 = *(const LAS bf16x8*)(bp + 16 * ((unsigned)h ^ bkey)), b1 = *(const LAS bf16x8*)(bp + 16 * ((unsigned)(2 + h) ^ bkey)); \
          acc = __builtin_amdgcn_mfma_f32_32x32x16_bf16(a0, b0, acc, 0, 0, 0); acc = __builtin_amdgcn_mfma_f32_32x32x16_bf16(a1, b1, acc, 0, 0, 0); } } while (0)
    P8_DMA(0); P8_DMA(1); P8_DMA(2);
    for (int s4 = 0; s4 < 60; s4 += 4) { P8_STEP(s4, 4); P8_STEP(s4 + 1, 4); P8_STEP(s4 + 2, 4); P8_STEP(s4 + 3, 4); }
    P8_STEP(60, 4); P8_STEP(61, 4); P8_STEP(62, 2); P8_STEP(63, 0);
    asm volatile("s_waitcnt lgkmcnt(0)\n\ts_barrier" ::: "memory");
#undef P8_DMA
#undef P8_STEP
    { const float pb = ((const float*)(a.ws + WS_PEB))[kv * 256 + 32 * wid + r];
      LAS bf16_t* H = (LAS bf16_t*)(lds + C_HOFF);
#pragma unroll
      for (int rg = 0; rg < 16; ++rg) { const int row = att::crow(rg, h); H[row * (C_HROW / 2) + 32 * wid + r] = (bf16_t)(cvtpk(gelu_tanh(acc[rg] + pb), 0.f) & 0xffffu); } }
    __syncthreads();
    if (wid == 0) {
        f32x16 o0 = f32x16{}, o1 = f32x16{};
        const bf16_t* W2 = (const bf16_t*)(a.ws + WS_WC2) + (size_t)kv * 64 * 256;
#pragma unroll
        for (int s = 0; s < 16; ++s) {
            const bf16x8 af = *(const LAS bf16x8*)(lds + C_HOFF + r * C_HROW + (16 * s + 8 * h) * 2);
            const bf16x8 b0 = *(const bf16x8*)(W2 + (size_t)r * 256 + 16 * s + 8 * h), b1 = *(const bf16x8*)(W2 + (size_t)(32 + r) * 256 + 16 * s + 8 * h);
            o0 = __builtin_amdgcn_mfma_f32_32x32x16_bf16(af, b0, o0, 0, 0, 0); o1 = __builtin_amdgcn_mfma_f32_32x32x16_bf16(af, b1, o1, 0, 0, 0);
        }
        const float gk0 = a.k_gain[r], gk1 = a.k_gain[32 + r];
        bf16_t* dst = (bf16_t*)(slab + (kv == 0 ? SO_KC : SO_VC)) + (size_t)(bg & 3) * 8192;
#pragma unroll
        for (int rg = 0; rg < 16; ++rg) { float v0 = o0[rg], v1 = o1[rg];
            if (kv == 0) { float ss = v0 * v0 + v1 * v1;
#pragma unroll
                for (int sft = 1; sft < 32; sft <<= 1) ss += __shfl_xor(ss, sft);
                const float rs = rsqrtf(ss * (1.0f / 64.0f) + EPS); v0 *= rs * gk0; v1 *= rs * gk1; }
            const int n = 32 * rq + att::crow(rg, h);
            if (n == 127) { v0 = 0.f; v1 = 0.f; }
            dst[n * 64 + r] = (bf16_t)(cvtpk(v0, 0.f) & 0xffffu); dst[n * 64 + 32 + r] = (bf16_t)(cvtpk(v1, 0.f) & 0xffffu); }
    }
}

__device__ __forceinline__ void p4_fixup(const Args& a, int pm) {
    const int tid = threadIdx.x;
    if (tid < 256) {
        const int rr = tid >> 7, cc = (tid & 127) * 8, pml = pm & 7, srow = pml * 256 + rr;
        unsigned char* slab = a.ws + WS_R + (size_t)(pm >> 3) * SLAB;
        const bf16_t* V = (const bf16_t*)(slab + SO_V); const bf16_t* GBH = (const bf16_t*)(slab + SO_GB) + (size_t)pml * 2 * DM; bf16_t* Y = (bf16_t*)(slab + SO_Y);
        float gb[8], v0[8], v1[8], v2[8], y[8];
        unpack8(*(const u32x4*)(GBH + (size_t)rr * DM + cc), gb);
        unpack8(*(const u32x4*)(V + (size_t)srow * DM + cc), v0);
        if (srow >= 1) unpack8(*(const u32x4*)(V + (size_t)(srow - 1) * DM + cc), v1); else {
#pragma unroll
            for (int e = 0; e < 8; ++e) v1[e] = 0.f; }
        if (srow >= 2) unpack8(*(const u32x4*)(V + (size_t)(srow - 2) * DM + cc), v2); else {
#pragma unroll
            for (int e = 0; e < 8; ++e) v2[e] = 0.f; }
#pragma unroll
        for (int e = 0; e < 8; ++e) y[e] = gb[e] * (a.conv_w[2 * DM + cc + e] * v0[e] + a.conv_w[DM + cc + e] * v1[e] + a.conv_w[cc + e] * v2[e]);
        u32x4 w; w.x = cvtpk(y[0], y[1]); w.y = cvtpk(y[2], y[3]); w.z = cvtpk(y[4], y[5]); w.w = cvtpk(y[6], y[7]);
        *(u32x4*)(Y + (size_t)srow * DM + cc) = w;
    }
}

__global__ void __launch_bounds__(NWAVES * 64, 2) yoco_fwd(Args args) {
    extern __shared__ __attribute__((aligned(16))) unsigned char lds_raw[];
    LAS unsigned char* lds = (LAS unsigned char*)lds_raw;
    const int tid = threadIdx.x, lane = tid & 63, wave = __builtin_amdgcn_readfirstlane(tid >> 6);
    const int G = gridDim.x, bx = blockIdx.x;
    int vcu = (G % 8 == 0) ? (bx % 8) * (G / 8) + bx / 8 : bx;
    int cid = bx;
    const int gw = vcu * NWAVES + wave, NGW = G * NWAVES;
    unsigned char* ws = args.ws;
    const int lo = args.ph_lo, hi = args.ph_hi;
    volatile LAS unsigned* MISC = (volatile LAS unsigned*)(lds + LDS_BYTES - 256);
    if (tid < 8) MISC[tid] = 0u;
    __syncthreads();
    XcdBarrier bar; bar.bar = (unsigned*)(ws + WS_BAR); bar.x = 0; bar.st = MISC;
    if (hi - lo > 1) bar = xcd_barrier_post((unsigned*)(ws + WS_BAR), MISC);
#define IN(k) (lo <= (k) && (k) < hi)
#define SEAM(k) do { if (IN(k) && IN((k) + 1)) xcd_barrier(bar); } while (0)
#define LSEAM(k) do { if (IN(k) && IN((k) + 1)) { if (local_ok) xcd_local_barrier(bar); else xcd_barrier(bar); } } while (0)
    bool local_ok = false;
    float* MOD0 = (float*)(ws + WS_MOD0); float* MOD1 = (float*)(ws + WS_MOD1); float* MODKV = (float*)(ws + WS_MODKV);
    float* SS1 = (float*)(ws + WS_SS1); float* SS2 = (float*)(ws + WS_SS2); float* SS3 = (float*)(ws + WS_SS3);
    bf16_t* A1 = (bf16_t*)(ws + WS_A1); bf16_t* A2 = (bf16_t*)(ws + WS_A2);
    bf16_t* HB = (bf16_t*)(ws + WS_H);

    if (IN(0)) {
        p0_mods(args, lds, vcu, G);
        LAS float* scr = (LAS float*)(lds + wave * 16384);
        for (int it = gw; it < TI_TOTAL; it += NGW) p0_item(args, it, scr, lane);
    }
    SEAM(0);
    if (IN(1)) {
        for (int m = gw; m < M_TOK / 2; m += NGW) p1_norm_row2(args, 2 * m, lane);
        for (int it = gw; it < (2 * FF + NKVQ) / 16 + 512; it += NGW) {
            const int n = it * 16;
            if (n < FF) p1_bias_task((const bf16_t*)(ws + WS_WM1), n, MOD0 + 3072, 6144, (float*)(ws + WS_BM1L0), FF, lane);
            else if (n < 2 * FF) p1_bias_task((const bf16_t*)(ws + WS_WM1) + (size_t)FF * DM, n - FF, MOD1 + 3072, 6144, (float*)(ws + WS_BM1L1), FF, lane);
            else if (n < 2 * FF + 1536) p1_bias_task((const bf16_t*)(ws + WS_WKVQ), n - 2 * FF, MODKV, 2048, (float*)(ws + WS_BKVQ), NKVQ, lane);
            else if (n < 2 * FF + NKVQ) p1_bias_task((const bf16_t*)(ws + WS_WKVQ), n - 2 * FF, MOD1, 6144, (float*)(ws + WS_BKVQ), NKVQ, lane);
            else p1_pebias(args, it - (2 * FF + NKVQ) / 16, lane);
        }
    }
    SEAM(1);
    if (hi - lo > 1 && lo <= 1) {
        local_ok = MISC[3] != 0u;
        if (local_ok) { const int x = (int)MISC[4], rk = (int)MISC[2]; vcu = x * 32 + rk; cid = rk * 8 + x; }
    }
    if (IN(2)) {
        pg8::Gemm g{A2, A2, 1 << 30, (const bf16_t*)(ws + WS_WAIN), M_TOK, 3072, DM, (size_t)SEQ * DM * 2}; pg8::StaticOrder S; S.init_ain(G, cid);
        pg8::EpiAin E{ws + WS_R, args.conv_w};
        pg8::gemm_phase(lds, g, S, E);
    }
    LSEAM(2);
    if (IN(4)) {
        pg8::Gemm g{(const bf16_t*)(ws + WS_R + SO_Y), (const bf16_t*)(ws + WS_R + SO_Y), 1 << 30, (const bf16_t*)(ws + WS_WAOUT), M_TOK, DM, DM, SLAB}; pg8::StaticOrder S; S.init(M_TOK, DM, G, cid);
        { pg8::Unit fu; for (int i = 0; S.next(i, fu); ++i) p4_fixup(args, fu.pm); asm volatile("s_waitcnt vmcnt(0)" ::: "memory"); __syncthreads(); }
        pg8::EpiRes<1, 0, 2> E{args.x, nullptr, MOD0 + 2048, 6144, args.norm_gain + 1024, MOD0 + 4096, 6144, A1, nullptr, nullptr, 0, nullptr, SS1, nullptr, nullptr, 0};
        pg8::gemm_phase(lds, g, S, E);
    }
    LSEAM(4);
    if (IN(5)) {
        pg8::Gemm g{A1, A1, 1 << 30, (const bf16_t*)(ws + WS_WM1), M_TOK, FF, DM, (size_t)SEQ * DM * 2}; pg8::StaticOrder S; S.init(M_TOK, FF, G, cid);
        pg8::EpiMlp1 E{HB, (const float*)(ws + WS_BM1L0), SS1};
        pg8::gemm_phase(lds, g, S, E);
    }
    LSEAM(5);
    if (IN(6)) {
        pg8::Gemm g{HB, HB, 1 << 30, (const bf16_t*)(ws + WS_WM2), M_TOK, DM, FF, (size_t)SEQ * FF * 2}; pg8::StaticOrder S; S.init(M_TOK, DM, G, cid);
        pg8::EpiRes<2, 2, 2> E{A1, nullptr, MOD0 + 5120, 6144, args.kv_norm_gain, MODKV + 1024, 2048, A1, args.norm_gain + 2048, MOD1 + 1024, 6144, A2, SS2, args.norm_gain + 1024, MOD0 + 4096, 6144};
        pg8::gemm_phase(lds, g, S, E);
    }
    LSEAM(6);
    if (IN(7)) {
        pg8::Gemm g{A1, A2, 6, (const bf16_t*)(ws + WS_WKVQ), M_TOK, NKVQ, DM, (size_t)SEQ * DM * 2}; pg8::StaticOrder S; S.init(M_TOK, NKVQ, G, cid);
        pg8::EpiKVQ E{ws + WS_R, (const float*)(ws + WS_BKVQ), SS2, args.k_gain, args.q_gain};
        pg8::gemm_phase(lds, g, S, E);
    }
    LSEAM(7);
    if (IN(8)) { for (int v = vcu; v < 256; v += G) { const int rk = v & 31; p8_unit(args, ((rk >> 4) << 7) | ((((v >> 5) << 2) | ((rk >> 2) & 3)) << 2) | (rk & 3), lds); } __syncthreads(); }
    LSEAM(8);
    if (IN(9)) {
        for (int v = vcu; v < 256; v += G) { const int bgp = v >> 3, s = v & 7;
            for (int i = 0; i < 4; ++i) { const int qb = (i == 0) ? s : (i == 1) ? 15 - s : (i == 2) ? 16 + s : 31 - s;
                att::attn_unit(bgp >> 2, bgp & 3, qb, ws + WS_R + (size_t)(bgp >> 2) * SLAB, lds); } }
    }
    LSEAM(9);
    if (IN(10)) {
        pg8::Gemm g{(const bf16_t*)(ws + WS_R + SO_O), (const bf16_t*)(ws + WS_R + SO_O), 1 << 30, (const bf16_t*)(ws + WS_WO), M_TOK, DM, DM, SLAB}; pg8::StaticOrder S; S.init(M_TOK, DM, G, cid);
        pg8::EpiRes<1, 2, 2> E{A2, nullptr, MOD1 + 2048, 6144, args.norm_gain + 3072, MOD1 + 4096, 6144, A1, nullptr, nullptr, 0, nullptr, SS3, args.norm_gain + 2048, MOD1 + 1024, 6144};
        pg8::gemm_phase(lds, g, S, E);
    }
    LSEAM(10);
    if (IN(11)) {
        pg8::Gemm g{A1, A1, 1 << 30, (const bf16_t*)(ws + WS_WM1) + (size_t)FF * DM, M_TOK, FF, DM, (size_t)SEQ * DM * 2}; pg8::StaticOrder S; S.init(M_TOK, FF, G, cid);
        pg8::EpiMlp1 E{HB, (const float*)(ws + WS_BM1L1), SS3};
        pg8::gemm_phase(lds, g, S, E);
    }
    LSEAM(11);
    if (IN(12)) {
        pg8::Gemm g{HB, HB, 1 << 30, (const bf16_t*)(ws + WS_WM2) + (size_t)DM * FF, M_TOK, DM, FF, (size_t)SEQ * FF * 2}; pg8::StaticOrder S; S.init(M_TOK, DM, G, cid);
        pg8::EpiRes<0, 2, 0> E{A1, args.out, MOD1 + 5120, 6144, nullptr, nullptr, 0, nullptr, nullptr, nullptr, 0, nullptr, nullptr, args.norm_gain + 3072, MOD1 + 4096, 6144};
        pg8::gemm_phase(lds, g, S, E);
    }
#undef IN
#undef SEAM
}

extern "C" void kernel_launch(void* const* d_in, const int* in_sizes, int n_in, void* d_out, int out_size, void* d_ws, size_t ws_size, hipStream_t stream) {
    static int grid = 0;
    if (grid == 0) {
        if (n_in != 21 || in_sizes[0] != M_TOK * DM || out_size != M_TOK * DM || ws_size < WS_END) { fprintf(stderr, "kernel_launch: unexpected shapes (n_in %d, in0 %d, out %d, ws %zu); nothing launched\n", n_in, n_in > 0 ? in_sizes[0] : -1, out_size, ws_size); grid = -1; return; }
        int dev = 0, cus = 0, per_cu = 0;
        if (hipGetDevice(&dev) != hipSuccess || hipDeviceGetAttribute(&cus, hipDeviceAttributeMultiprocessorCount, dev) != hipSuccess) { grid = -1; return; }
        if (hipFuncSetAttribute((const void*)yoco_fwd, hipFuncAttributeMaxDynamicSharedMemorySize, LDS_BYTES) != hipSuccess) { fprintf(stderr, "kernel_launch: hipFuncSetAttribute failed\n"); grid = -1; return; }
        if (hipOccupancyMaxActiveBlocksPerMultiprocessor(&per_cu, (const void*)yoco_fwd, NWAVES * 64, LDS_BYTES) != hipSuccess || per_cu < 1) { fprintf(stderr, "kernel_launch: occupancy query says %d blocks per CU\n", per_cu); per_cu = 1; }
        (void)hipGetLastError();
        grid = cus;
        if (grid != 256) { fprintf(stderr, "kernel_launch: this build deals the w_a_in tiles to exactly 256 workgroups (device has %d CUs); nothing launched\n", cus); grid = -1; return; }
    }
    if (grid < 0) return;
    (void)hipMemsetAsync((char*)d_ws + WS_ZERO, 0, ZERO_BYTES, stream);
    Args a{};
    a.x = (const float*)d_in[0]; a.c = (const float*)d_in[1]; a.norm_gain = (const float*)d_in[2]; a.w_ada = (const float*)d_in[3]; a.b_ada = (const float*)d_in[4];
    a.w_a_in = (const float*)d_in[5]; a.conv_w = (const float*)d_in[6]; a.w_a_out = (const float*)d_in[7]; a.w_qg = (const float*)d_in[8]; a.q_gain = (const float*)d_in[9];
    a.w_o = (const float*)d_in[10]; a.kv_norm_gain = (const float*)d_in[11]; a.w_ada_kv = (const float*)d_in[12]; a.b_ada_kv = (const float*)d_in[13]; a.w_kv = (const float*)d_in[14];
    a.k_gain = (const float*)d_in[15]; a.cmp_pe = (const float*)d_in[16]; a.cmp_w1 = (const float*)d_in[17]; a.cmp_w2 = (const float*)d_in[18]; a.w_mlp1 = (const float*)d_in[19]; a.w_mlp2 = (const float*)d_in[20];
    a.out = (float*)d_out; a.ws = (unsigned char*)d_ws;
#if MK_N_LAUNCHES == 1
    a.ph_lo = 0; a.ph_hi = N_PHASES;
    void* kargs[] = {&a};
    hipError_t e = hipLaunchCooperativeKernel((const void*)yoco_fwd, dim3(grid), dim3(NWAVES * 64), kargs, LDS_BYTES, stream);
    if (e != hipSuccess) fprintf(stderr, "kernel_launch: cooperative launch failed: %s (grid %d)\n", hipGetErrorString(e), grid);
#else
    for (int p = 0; p < N_PHASES; ++p) { a.ph_lo = p; a.ph_hi = p + 1; hipLaunchKernelGGL(yoco_fwd, dim3(grid), dim3(NWAVES * 64), LDS_BYTES, stream, a); }
#endif
}
```

```cpp
#include <hip/hip_runtime.h>
#include <cstdio>
#include <cstdint>
#include <cmath>

#ifndef MK_N_LAUNCHES
#define MK_N_LAUNCHES 1
#endif
constexpr int N_PHASES = 13;

#define LAS __attribute__((address_space(3)))
typedef unsigned short bf16_t;
typedef short bf16x8 __attribute__((ext_vector_type(8)));
typedef short s16x4 __attribute__((ext_vector_type(4)));
typedef float f32x2 __attribute__((ext_vector_type(2)));
typedef float f32x4 __attribute__((ext_vector_type(4)));
typedef float f32x16 __attribute__((ext_vector_type(16)));
typedef unsigned u32x4 __attribute__((ext_vector_type(4)));
typedef unsigned u32x2 __attribute__((ext_vector_type(2)));
typedef __bf16 bf16x2_t __attribute__((ext_vector_type(2)));

constexpr int BATCH = 8, SEQ = 2048, DM = 1024, FF = 4096, M_TOK = BATCH * SEQ;
constexpr int NKVQ = 2816;
constexpr float EPS = 1e-6f;
constexpr float QSCALE = 0.125f * 1.4426950408889634f;

constexpr size_t MiB = 1u << 20;
constexpr size_t WS_ZERO = 0, ZERO_BYTES = 1 * MiB;
constexpr size_t WS_MOD0 = 0, WS_MOD1 = 196608, WS_MODKV = 393216;
constexpr size_t WS_SS1 = 524288, WS_SS2 = 589824, WS_SS3 = 655360;
constexpr size_t WS_BAR = 786432;
constexpr size_t WS_BM1L0 = 1 * MiB, WS_BM1L1 = WS_BM1L0 + 131072, WS_BKVQ = WS_BM1L1 + 131072, WS_PEB = WS_BKVQ + 131072, WS_WC2 = WS_PEB + 4096;
constexpr size_t WS_WAIN = 2 * MiB, WS_WAOUT = 8 * MiB, WS_WM1 = 10 * MiB  , WS_WM2 = 26 * MiB  , WS_WKVQ = 42 * MiB, WS_WO = 48 * MiB, WS_WC1 = 50 * MiB;
constexpr size_t WS_R = 56 * MiB;
constexpr size_t SLAB = 16 * MiB;
constexpr size_t SO_GB = 0, SO_V = 4 * MiB, SO_Y = 8 * MiB;
constexpr size_t WS_H = WS_R;
constexpr size_t SO_Q = 0, SO_KV = 4 * MiB  , SO_O = 10 * MiB, SO_GATES = 14 * MiB  , SO_KC = 14 * MiB + 512 * 1024  , SO_VC = SO_KC + 65536;
constexpr size_t WS_A1 = 184 * MiB, WS_A2 = 216 * MiB, WS_END = 248 * MiB;

constexpr int LDS_BYTES = 147456;
constexpr int NWAVES = 8;

__device__ __forceinline__ unsigned cvtpk(float lo, float hi) { f32x2 v = {lo, hi}; bf16x2_t b = __builtin_convertvector(v, bf16x2_t); return __builtin_bit_cast(unsigned, b); }
__device__ __forceinline__ float bf_lo(unsigned u) { return __builtin_bit_cast(float, u << 16); }
__device__ __forceinline__ float bf_hi(unsigned u) { return __builtin_bit_cast(float, u & 0xffff0000u); }
__device__ __forceinline__ float wave_sum(float v) {
#pragma unroll
    for (int o = 1; o < 64; o <<= 1) v += __shfl_xor(v, o);
    return v;
}
#define LDS_WAIT() asm volatile("s_waitcnt lgkmcnt(0)" ::: "memory")
#define LAUNDER(x) asm volatile("" : "+v"(x))

namespace pg8 {
constexpr int BM = 256, BK = 64, HALF = 128, HTB = HALF * BK * 2, STAGE_BYTES = 8 * HTB, NXCD = 8, WGM = 8;
__host__ __device__ __forceinline__ int lds_byte(int r, int c) { const int st = (r >> 4) * 2 + (c >> 5), rr = r & 15, cc = c & 31, ob = rr * 64 + cc * 2; return st * 1024 + (ob ^ (((ob >> 9) & 1) << 5)); }
__host__ __device__ __forceinline__ void stage_rc(int b, int& R, int& C) { const int st = b / 1024, sb = b % 1024, swz = sb ^ (((sb >> 9) & 1) << 5); R = (st >> 1) * 16 + swz / 64; C = (st & 1) * 32 + (swz % 64) / 2; }
__host__ __device__ __forceinline__ int perm32(int rho) { const int n = rho >> 4, i = rho & 15; return 8 * (i >> 2) + 4 * n + (i & 3); }

struct Unit { int pm, pn; };
struct Gemm { const bf16_t* A; const bf16_t* A2; int pn_split; const bf16_t* Bt; int M, N, K; size_t abatch; };

struct StaticOrder {
    int nM, nN, nwg, G, c, ain;
    __device__ void init(int M, int N, int G_, int c_) { nM = M / BM; nN = N / BM; nwg = nM * nN; G = G_; c = c_; ain = 0; }
    __device__ void init_ain(int G_, int c_) { init(M_TOK, 3072, G_, c_); ain = 1; }
    __device__ bool next(int i, Unit& u) const {
        if (ain) { if (i >= 3) return false; const int x = c & 7, rk = c >> 3, p = rk >> 3; u.pm = 8 * x + (rk & 7); u.pn = (i == 2) ? p : 4 + 2 * p + i; return true; }
        const long L = (long)i * G + c; if (L >= nwg) return false;
        int wgid = (int)L; { const int q = nwg / NXCD, r = nwg % NXCD, xcd = wgid % NXCD, off = wgid / NXCD; wgid = (xcd < r ? xcd * (q + 1) : r * (q + 1) + (xcd - r) * q) + off; }
        const int nig = WGM * nN, gid = wgid / nig, fm = gid * WGM, gsz = (nM - fm) < WGM ? (nM - fm) : WGM;
        u.pm = fm + ((wgid % nig) % gsz); u.pn = (wgid % nig) / gsz; return true;
    }
};

template <class Epi>
__device__ __forceinline__ void gemm_phase(LAS unsigned char* lds, const Gemm g, const StaticOrder& S, const Epi& E) {
    const int tid = threadIdx.x, wid = __builtin_amdgcn_readfirstlane(tid >> 6), lane = tid & 63, wr = wid >> 2, wc = wid & 3, fr = lane & 15, fq = lane >> 4;
    const int K = g.K, nt = K / BK;
    unsigned voffA[2], voffB[2];
#pragma unroll
    for (int i = 0; i < 2; ++i) { int R, C; stage_rc(tid * 16 + i * 8192, R, C); const int Rb = Epi::PERM ? ((R & ~31) + perm32(R & 31)) : R;
        voffA[i] = (unsigned)(R * K + C) * 2u; voffB[i] = (unsigned)(Rb * K + C) * 2u; }
    const size_t kstep = (size_t)(BK * 2);
    const size_t hstep = (size_t)HALF * K * 2;
    const size_t tstep = 2 * hstep;
    const unsigned ldsw = (unsigned)wid * 1024u;
    const int aoff = lds_byte(wr * 64 + fr, fq * 8), boff = lds_byte(wc * 32 + fr, fq * 8);
#define PG8_SA(b, h) (((b) * 2 + (h)) * HTB)
#define PG8_SB(b, h) ((4 + (b) * 2 + (h)) * HTB)
#define PG8_STAGE(bufoff, gbase, voff) do { _Pragma("unroll") for (int _i = 0; _i < 2; ++_i) \
        __builtin_amdgcn_global_load_lds((const unsigned*)((const char*)(gbase) + (voff)[_i]), (LAS unsigned*)(lds + (bufoff) + ldsw + _i * 8192), 16, 0, 0); } while (0)
#define PG8_LDA(dst, b, h) do { _Pragma("unroll") for (int m = 0; m < 4; ++m) _Pragma("unroll") for (int k = 0; k < 2; ++k) dst[m][k] = *(const LAS bf16x8*)(lds + PG8_SA(b, h) + aoff + m * 2048 + k * 1024); } while (0)
#define PG8_LDB(dst, b, h) do { _Pragma("unroll") for (int n = 0; n < 2; ++n) _Pragma("unroll") for (int k = 0; k < 2; ++k) dst[n][k] = *(const LAS bf16x8*)(lds + PG8_SB(b, h) + boff + n * 2048 + k * 1024); } while (0)
#define PG8_MMA(ai, bj, At, Bt) do { __builtin_amdgcn_s_setprio(1); _Pragma("unroll") for (int m = 0; m < 4; ++m) _Pragma("unroll") for (int n = 0; n < 2; ++n) _Pragma("unroll") for (int k = 0; k < 2; ++k) \
        acc[ai][bj][m][n] = __builtin_amdgcn_mfma_f32_16x16x32_bf16(Bt[n][k], At[m][k], acc[ai][bj][m][n], 0, 0, 0); __builtin_amdgcn_s_setprio(0); } while (0)
#define PG8_WAIT_V(n) asm volatile("s_waitcnt vmcnt(" #n ")" ::: "memory")
#define PG8_WAIT_L(n) asm volatile("s_waitcnt lgkmcnt(" #n ")" ::: "memory")
#define PG8_BAR __builtin_amdgcn_s_barrier()
#define PG8_SCHED __builtin_amdgcn_sched_barrier(0)
#define PG8_ABASE(u) ((const char*)((u).pn < g.pn_split ? g.A : g.A2) + (size_t)((u).pm >> 3) * g.abatch + (size_t)((u).pm & 7) * tstep)
    Unit cur, nxt; int ui = 0;
    if (!S.next(0, cur)) return;
    f32x4 acc[2][2][4][2];
#pragma unroll
    for (int a = 0; a < 2; ++a)
#pragma unroll
        for (int b = 0; b < 2; ++b)
#pragma unroll
            for (int m = 0; m < 4; ++m)
#pragma unroll
                for (int n = 0; n < 2; ++n) acc[a][b][m][n] = (f32x4){0.f, 0.f, 0.f, 0.f};
    bf16x8 At[4][2], B0[2][2], B1[2][2];
    const char* cA = PG8_ABASE(cur); const char* cB = (const char*)g.Bt + (size_t)cur.pn * tstep;
    PG8_STAGE(PG8_SB(0, 0), cB, voffB); PG8_STAGE(PG8_SB(0, 1), cB + hstep, voffB); PG8_STAGE(PG8_SA(0, 0), cA, voffA); PG8_STAGE(PG8_SA(0, 1), cA + hstep, voffA);
    if (wr == 1) PG8_BAR;
    PG8_WAIT_V(2); PG8_BAR;
    PG8_STAGE(PG8_SB(1, 0), cB + kstep, voffB); PG8_STAGE(PG8_SA(1, 0), cA + kstep, voffA); PG8_STAGE(PG8_SB(1, 1), cB + hstep + kstep, voffB);
    PG8_WAIT_V(6); PG8_BAR;
    for (;;) {
        const bool has_next = S.next(ui + 1, nxt);
        const char* nA = has_next ? PG8_ABASE(nxt) : cA; const char* nB = has_next ? (const char*)g.Bt + (size_t)nxt.pn * tstep : cB;
        for (int t = 0; t < nt; t += 2) {
            const bool last = (t == nt - 2);
            const char* a1 = cA + (size_t)(t + 1) * kstep;
            const char* a2 = last ? nA : cA + (size_t)(t + 2) * kstep; const char* b2 = last ? nB : cB + (size_t)(t + 2) * kstep;
            const char* a3 = a2 + kstep; const char* b3 = b2 + kstep;
            PG8_LDB(B0, 0, 0); PG8_LDB(B1, 0, 1); PG8_SCHED; PG8_LDA(At, 0, 0); PG8_STAGE(PG8_SA(1, 1), a1 + hstep, voffA);
            PG8_WAIT_V(8); PG8_WAIT_L(0); PG8_BAR; PG8_MMA(0, 0, At, B0); PG8_MMA(0, 1, At, B1); PG8_BAR; PG8_SCHED;
            PG8_LDA(At, 0, 1); PG8_STAGE(PG8_SB(0, 0), b2, voffB); PG8_STAGE(PG8_SB(0, 1), b2 + hstep, voffB); PG8_STAGE(PG8_SA(0, 0), a2, voffA);
            PG8_WAIT_V(8); PG8_WAIT_L(0); PG8_BAR; PG8_MMA(1, 0, At, B0); PG8_MMA(1, 1, At, B1); PG8_BAR; PG8_SCHED;
            PG8_LDB(B0, 1, 0); PG8_LDB(B1, 1, 1); PG8_SCHED; PG8_LDA(At, 1, 0); PG8_STAGE(PG8_SA(0, 1), a2 + hstep, voffA);
            PG8_WAIT_V(8); PG8_WAIT_L(0); PG8_BAR; PG8_MMA(0, 0, At, B0); PG8_MMA(0, 1, At, B1); PG8_BAR; PG8_SCHED;
            PG8_LDA(At, 1, 1); PG8_STAGE(PG8_SB(1, 0), b3, voffB); PG8_STAGE(PG8_SB(1, 1), b3 + hstep, voffB); PG8_STAGE(PG8_SA(1, 0), a3, voffA);
            PG8_WAIT_V(8); PG8_WAIT_L(0); PG8_BAR; PG8_MMA(1, 0, At, B0); PG8_MMA(1, 1, At, B1); PG8_BAR; PG8_SCHED;
        }
        if (wr == 0) PG8_BAR;
        E(acc, cur, wr, wc, fr, fq);
        if (!has_next) break;
#pragma unroll
        for (int a = 0; a < 2; ++a)
#pragma unroll
            for (int b = 0; b < 2; ++b)
#pragma unroll
                for (int m = 0; m < 4; ++m)
#pragma unroll
                    for (int n = 0; n < 2; ++n) acc[a][b][m][n] = (f32x4){0.f, 0.f, 0.f, 0.f};
        cur = nxt; cA = nA; cB = nB; ++ui;
        if (wr == 1) PG8_BAR;
    }
    PG8_WAIT_V(0);
    PG8_BAR;
#undef PG8_SA
#undef PG8_SB
#undef PG8_STAGE
#undef PG8_LDA
#undef PG8_LDB
#undef PG8_MMA
#undef PG8_WAIT_V
#undef PG8_WAIT_L
#undef PG8_BAR
#undef PG8_SCHED
#undef PG8_ABASE
}

typedef f32x4 Acc[2][2][4][2];

struct EpiAin {
    static constexpr bool PERM = true;
    static constexpr bool HAS_PRE = false; struct Pre {};
    unsigned char* slab0;
    const float* conv_w;
    __device__ __forceinline__ void operator()(const Acc& acc, const Unit& u, int wr, int wc, int fr, int fq) const {
        const int rip0 = wr * 64 + fr;
        const int row0 = (u.pm & 7) * BM + rip0;
        unsigned char* slab = slab0 + (size_t)(u.pm >> 3) * SLAB;
        bf16_t* V = (bf16_t*)(slab + SO_V);
        if (u.pn < 4) {
            bf16_t* Y = (bf16_t*)(slab + SO_Y); bf16_t* GBH = (bf16_t*)(slab + SO_GB) + (size_t)(u.pm & 7) * 2 * DM;
            const int col0 = u.pn * BM + wc * 32 + 8 * fq;
#pragma unroll
            for (int bj = 0; bj < 2; ++bj) { const int cw = col0 + bj * HALF;
                f32x4 w0[2], w1[2], w2[2];
#pragma unroll
                for (int n = 0; n < 2; ++n) { w0[n] = *(const f32x4*)(conv_w + cw + 4 * n); w1[n] = *(const f32x4*)(conv_w + DM + cw + 4 * n); w2[n] = *(const f32x4*)(conv_w + 2 * DM + cw + 4 * n); }
#pragma unroll
                for (int ai = 0; ai < 2; ++ai)
#pragma unroll
                    for (int mp = 0; mp < 2; ++mp) {
                        u32x4 vr[2][3];
#pragma unroll
                        for (int mm = 0; mm < 2; ++mm) { const int rip = rip0 + ai * HALF + (2 * mp + mm) * 16; const bf16_t* vp = V + (size_t)(row0 + ai * HALF + (2 * mp + mm) * 16) * DM + cw;
#pragma unroll
                            for (int k = 0; k < 3; ++k) vr[mm][k] = (rip >= 2) ? *(const u32x4*)(vp - (size_t)k * DM) : (u32x4){0u, 0u, 0u, 0u}; }
                        asm volatile("" : "+v"(vr[0][0]), "+v"(vr[0][1]), "+v"(vr[0][2]), "+v"(vr[1][0]), "+v"(vr[1][1]), "+v"(vr[1][2]));
#pragma unroll
                        for (int mm = 0; mm < 2; ++mm) { const int m = 2 * mp + mm; const int rip = rip0 + ai * HALF + m * 16;
                            const f32x4 g0 = acc[ai][bj][m][0], g1 = acc[ai][bj][m][1];
                            u32x4 w;
                            if (rip >= 2) {
                                const u32x4 a = vr[mm][0], b1 = vr[mm][1], b2 = vr[mm][2];
                                const f32x4 v0a = (f32x4){bf_lo(a.x), bf_hi(a.x), bf_lo(a.y), bf_hi(a.y)}, v0b = (f32x4){bf_lo(a.z), bf_hi(a.z), bf_lo(a.w), bf_hi(a.w)};
                                const f32x4 v1a = (f32x4){bf_lo(b1.x), bf_hi(b1.x), bf_lo(b1.y), bf_hi(b1.y)}, v1b = (f32x4){bf_lo(b1.z), bf_hi(b1.z), bf_lo(b1.w), bf_hi(b1.w)};
                                const f32x4 v2a = (f32x4){bf_lo(b2.x), bf_hi(b2.x), bf_lo(b2.y), bf_hi(b2.y)}, v2b = (f32x4){bf_lo(b2.z), bf_hi(b2.z), bf_lo(b2.w), bf_hi(b2.w)};
                                const f32x4 ya = g0 * (w2[0] * v0a + w1[0] * v1a + w0[0] * v2a), yb = g1 * (w2[1] * v0b + w1[1] * v1b + w0[1] * v2b);
                                w.x = cvtpk(ya[0], ya[1]); w.y = cvtpk(ya[2], ya[3]); w.z = cvtpk(yb[0], yb[1]); w.w = cvtpk(yb[2], yb[3]);
                                *(u32x4*)(Y + (size_t)(row0 + ai * HALF + m * 16) * DM + cw) = w;
                            } else {
                                w.x = cvtpk(g0[0], g0[1]); w.y = cvtpk(g0[2], g0[3]); w.z = cvtpk(g1[0], g1[1]); w.w = cvtpk(g1[2], g1[3]);
                                *(u32x4*)(GBH + (size_t)rip * DM + cw) = w;
                            } } }
            }
        } else {
            const int col0 = (u.pn - 4) * HALF + wc * 32 + 8 * fq;
#pragma unroll
            for (int ai = 0; ai < 2; ++ai)
#pragma unroll
                for (int m = 0; m < 4; ++m) { bf16_t* rowp = V + (size_t)(row0 + ai * HALF + m * 16) * DM + col0;
                    const f32x4 v0 = acc[ai][0][m][0] * acc[ai][1][m][0], v1 = acc[ai][0][m][1] * acc[ai][1][m][1];
                    u32x4 w; w.x = cvtpk(v0[0], v0[1]); w.y = cvtpk(v0[2], v0[3]); w.z = cvtpk(v1[0], v1[1]); w.w = cvtpk(v1[2], v1[3]);
                    *(u32x4*)rowp = w; }
        }
    }
};

constexpr int RB_F32 = 1, RB_NA2 = 1, RB_NA1 = 2, RB_NA0 = 4;
template <int NA, int INM, int OUTM> struct EpiRes {
    static constexpr bool PERM = true;
    const void* xin; void* xout; const float* gate; int gate_stride;
    const float* gain0; const float* sc0; int sc0_stride; bf16_t* A0;
    const float* gain1; const float* sc1; int sc1_stride; bf16_t* A1;
    float* sumsq;
    const float* gain_in; const float* sc_in; int sc_in_stride;
    LAS unsigned char* lds = nullptr;
    __device__ __forceinline__ void operator()(const Acc& acc, const Unit& u, int wr, int wc, int fr, int fq) const {
        constexpr bool IN16 = INM != 0;
        constexpr int RB = !IN16 ? RB_F32 : (NA >= 2 ? RB_NA2 : (NA == 1 ? RB_NA1 : RB_NA0));
        constexpr int NB = 8 / RB;
        const int b = u.pm >> 3;
        const int row0 = u.pm * BM + wr * 64 + fr, col0 = u.pn * BM + wc * 32 + 8 * fq;
        const size_t tbase = (size_t)u.pm * BM * DM + (size_t)u.pn * BM;
        const unsigned loff = (unsigned)((wr * 64 + fr) * DM + wc * 32 + 8 * fq);
        f32x4 gv[2][2], a0[2][2], a1[2][2], ia[2][2];
        f32x4 xr[2][IN16 ? 1 : RB][2][2]; u32x4 xh[2][IN16 ? RB : 1][2];
#define EPR_ISSUE(h_) do { _Pragma("unroll") for (int qq = 0; qq < RB; ++qq) _Pragma("unroll") for (int bj = 0; bj < 2; ++bj) { const int q = (h_) * RB + qq; \
            const size_t o = tbase + (size_t)(((q >> 2) * HALF + (q & 3) * 16) * DM + bj * HALF); \
            if constexpr (IN16) xh[(h_) & 1][qq][bj] = __builtin_nontemporal_load((const u32x4*)(((const bf16_t*)xin + o) + loff)); \
            else { xr[(h_) & 1][qq][bj][0] = __builtin_nontemporal_load((const f32x4*)(((const float*)xin + o) + loff)); xr[(h_) & 1][qq][bj][1] = __builtin_nontemporal_load((const f32x4*)(((const float*)xin + o + 4) + loff)); } } } while (0)
        if constexpr (IN16) {
            asm volatile("s_waitcnt vmcnt(0)\n\ts_barrier" ::: "memory");
            const int lane_ = threadIdx.x & 63, wid_ = __builtin_amdgcn_readfirstlane(threadIdx.x >> 6);
            const bf16_t* gsrc = (const bf16_t*)xin + tbase + (size_t)(32 * wid_) * DM;
            const int rl_ = lane_ >> 5, cp_ = lane_ & 31;
            unsigned vo_[4];
#pragma unroll
            for (int k = 0; k < 4; ++k) vo_[k] = (unsigned)(rl_ * DM + ((cp_ ^ (((2 * k + rl_) & 7) << 2)) << 3));
#pragma unroll
            for (int i = 0; i < 16; ++i)
                __builtin_amdgcn_global_load_lds((const unsigned*)((gsrc + (size_t)(2 * i) * DM) + vo_[i & 3]), (LAS unsigned*)(lds + (32 * wid_ + 2 * i) * 512), 16, 0, 0);
        } else EPR_ISSUE(0);
#pragma unroll
        for (int bj = 0; bj < 2; ++bj)
#pragma unroll
            for (int n = 0; n < 2; ++n) { const int c = col0 + bj * HALF + 4 * n;
                gv[bj][n] = *(const f32x4*)(gate + (size_t)b * gate_stride + c);
                if (NA >= 1) a0[bj][n] = *(const f32x4*)(gain0 + c) * (*(const f32x4*)(sc0 + (size_t)b * sc0_stride + c) + 1.0f);
                if (NA >= 2) a1[bj][n] = *(const f32x4*)(gain1 + c) * (*(const f32x4*)(sc1 + (size_t)b * sc1_stride + c) + 1.0f);
                if (INM == 2) { const f32x4 t = *(const f32x4*)(gain_in + c) * (*(const f32x4*)(sc_in + (size_t)b * sc_in_stride + c) + 1.0f); ia[bj][n] = (f32x4){1.0f / t[0], 1.0f / t[1], 1.0f / t[2], 1.0f / t[3]}; } }
        if constexpr (IN16) asm volatile("s_waitcnt vmcnt(0)\n\ts_barrier" ::: "memory");
        const LAS unsigned char* ldr = lds + (wr * 64 + fr) * 512;
        const int lsw = (fr & 7) << 2;
#pragma unroll
        for (int h = 0; h < NB; ++h) {
            if constexpr (!IN16) {
                if (h + 1 < NB) EPR_ISSUE(h + 1);
#pragma unroll
                for (int qq = 0; qq < RB; ++qq)
#pragma unroll
                    for (int bj = 0; bj < 2; ++bj) asm volatile("" : "+v"(xr[h & 1][qq][bj][0]), "+v"(xr[h & 1][qq][bj][1]));
            } else {
#pragma unroll
                for (int qq = 0; qq < RB; ++qq)
#pragma unroll
                    for (int bj = 0; bj < 2; ++bj) { const int q = h * RB + qq; xh[h & 1][qq][bj] = *(const LAS u32x4*)(ldr + ((q >> 2) * HALF + (q & 3) * 16) * 512 + (((16 * bj + 4 * wc + fq) ^ lsw) << 4)); }
            }
#pragma unroll
            for (int qq = 0; qq < RB; ++qq) { const int q = h * RB + qq, ai = q >> 2, m = q & 3; const int row = row0 + ai * HALF + m * 16; const size_t off = tbase + (size_t)((ai * HALF + m * 16) * DM); float ss = 0.f;
#pragma unroll
                for (int bj = 0; bj < 2; ++bj) { const size_t o = off + bj * HALF;
                    f32x4 x0, x1;
                    if constexpr (IN16) { const u32x4 w = xh[h & 1][qq][bj]; x0 = (f32x4){bf_lo(w.x), bf_hi(w.x), bf_lo(w.y), bf_hi(w.y)}; x1 = (f32x4){bf_lo(w.z), bf_hi(w.z), bf_lo(w.w), bf_hi(w.w)}; }
                    else { x0 = xr[h & 1][qq][bj][0]; x1 = xr[h & 1][qq][bj][1]; }
                    if (INM == 2) { x0 = x0 * ia[bj][0]; x1 = x1 * ia[bj][1]; }
                    x0 = x0 + gv[bj][0] * acc[ai][bj][m][0]; x1 = x1 + gv[bj][1] * acc[ai][bj][m][1];
                    if (OUTM == 0) { *(f32x4*)(((float*)xout + o) + loff) = x0; *(f32x4*)(((float*)xout + o + 4) + loff) = x1; }
                    if (NA >= 1) { ss += ((x0[0] * x0[0] + x0[1] * x0[1]) + (x0[2] * x0[2] + x0[3] * x0[3])) + ((x1[0] * x1[0] + x1[1] * x1[1]) + (x1[2] * x1[2] + x1[3] * x1[3]));
                        const f32x4 t0 = x0 * a0[bj][0], t1 = x1 * a0[bj][1]; u32x4 w; w.x = cvtpk(t0[0], t0[1]); w.y = cvtpk(t0[2], t0[3]); w.z = cvtpk(t1[0], t1[1]); w.w = cvtpk(t1[2], t1[3]); *(u32x4*)((A0 + o) + loff) = w; }
                    if (NA >= 2) { const f32x4 t0 = x0 * a1[bj][0], t1 = x1 * a1[bj][1]; u32x4 w; w.x = cvtpk(t0[0], t0[1]); w.y = cvtpk(t0[2], t0[3]); w.z = cvtpk(t1[0], t1[1]); w.w = cvtpk(t1[2], t1[3]); *(u32x4*)((A1 + o) + loff) = w; } }
                if (NA >= 1) { ss += __shfl_xor(ss, 16); ss += __shfl_xor(ss, 32); if (fq == 0) unsafeAtomicAdd(sumsq + row, ss); } }
        }
#undef EPR_ISSUE
    }
};

struct EpiMlp1 {
    static constexpr bool PERM = true;
    bf16_t* H; const float* bias; const float* sumsq;
    __device__ __forceinline__ void operator()(const Acc& acc, const Unit& u, int wr, int wc, int fr, int fq) const {
        const int b = u.pm >> 3;
        const int row0 = u.pm * BM + wr * 64 + fr, col0 = u.pn * BM + wc * 32 + 8 * fq;
        f32x4 bv[2][2];
#pragma unroll
        for (int bj = 0; bj < 2; ++bj)
#pragma unroll
            for (int n = 0; n < 2; ++n) bv[bj][n] = *(const f32x4*)(bias + (size_t)b * FF + col0 + bj * HALF + 4 * n);
        float ssv[8];
#pragma unroll
        for (int q = 0; q < 8; ++q) ssv[q] = sumsq[row0 + (q >> 2) * HALF + (q & 3) * 16];
        asm volatile("" : "+v"(ssv[0]), "+v"(ssv[1]), "+v"(ssv[2]), "+v"(ssv[3]), "+v"(ssv[4]), "+v"(ssv[5]), "+v"(ssv[6]), "+v"(ssv[7]));
#pragma unroll
        for (int ai = 0; ai < 2; ++ai)
#pragma unroll
            for (int m = 0; m < 4; ++m) { const int row = row0 + ai * HALF + m * 16; const float rs = rsqrtf(ssv[ai * 4 + m] * (1.0f / DM) + EPS);
                bf16_t* rowp = H + (size_t)row * FF + col0;
#pragma unroll
                for (int bj = 0; bj < 2; ++bj) { f32x4 v0 = acc[ai][bj][m][0] * rs + bv[bj][0], v1 = acc[ai][bj][m][1] * rs + bv[bj][1];
#pragma unroll
                    for (int e = 0; e < 4; ++e) { const float r0 = fmaxf(v0[e], 0.f), r1 = fmaxf(v1[e], 0.f); v0[e] = r0 * r0; v1[e] = r1 * r1; }
                    u32x4 w; w.x = cvtpk(v0[0], v0[1]); w.y = cvtpk(v0[2], v0[3]); w.z = cvtpk(v1[0], v1[1]); w.w = cvtpk(v1[2], v1[3]);
                    *(u32x4*)(rowp + bj * HALF) = w; } }
    }
};

struct EpiKVQ {
    static constexpr bool PERM = true;
    unsigned char* slab0; const float* bias; const float* sumsq; const float* k_gain; const float* q_gain;
    __device__ __forceinline__ void operator()(const Acc& acc, const Unit& u, int wr, int wc, int fr, int fq) const {
        const int b = u.pm >> 3, pn = u.pn;
        const int row0 = u.pm * BM + wr * 64 + fr;
        unsigned char* slab = slab0 + (size_t)b * SLAB;
        bf16_t* KV = (bf16_t*)(slab + SO_KV); bf16_t* Q = (bf16_t*)(slab + SO_Q); float* gates = (float*)(slab + SO_GATES);
        f32x4 bv[2][2];
#pragma unroll
        for (int bj = 0; bj < 2; ++bj)
#pragma unroll
            for (int n = 0; n < 2; ++n) bv[bj][n] = *(const f32x4*)(bias + (size_t)b * NKVQ + pn * BM + bj * HALF + wc * 32 + 8 * fq + 4 * n);
        float ssv[8];
#pragma unroll
        for (int q = 0; q < 8; ++q) ssv[q] = sumsq[row0 + (q >> 2) * HALF + (q & 3) * 16];
        asm volatile("" : "+v"(ssv[0]), "+v"(ssv[1]), "+v"(ssv[2]), "+v"(ssv[3]), "+v"(ssv[4]), "+v"(ssv[5]), "+v"(ssv[6]), "+v"(ssv[7]));
        if (pn == 10) {
            if (wc < 2) {
#pragma unroll
                for (int ai = 0; ai < 2; ++ai)
#pragma unroll
                    for (int m = 0; m < 4; ++m) { const int row = row0 + ai * HALF + m * 16; const float rs = rsqrtf(ssv[ai * 4 + m] * (1.0f / DM) + EPS);
#pragma unroll
                        for (int n = 0; n < 2; ++n) { const int c = wc * 32 + 8 * fq + 4 * n;
                            if (c < 48) { const f32x4 v = acc[ai][0][m][n] * rs + bv[0][n]; f32x4 o;
#pragma unroll
                                for (int e = 0; e < 4; ++e) o[e] = 1.0f / (1.0f + __expf(-v[e]));
                                *(f32x4*)(gates + (size_t)(row & (SEQ - 1)) * 48 + c) = o; } } }
            }
            return;
        }
        const bool is_q = pn >= 6;
        const bool do_norm = is_q || pn == 2 || pn == 4;
        f32x4 gn[2][2];
        { const float* gp = is_q ? q_gain : (k_gain + (pn == 2 ? 64 : 128)); const float sc = is_q ? QSCALE : 1.0f;
#pragma unroll
          for (int bj = 0; bj < 2; ++bj)
#pragma unroll
              for (int n = 0; n < 2; ++n) gn[bj][n] = do_norm ? *(const f32x4*)(gp + 32 * bj + 8 * fq + 4 * n) * sc : (f32x4){1.f, 1.f, 1.f, 1.f}; }
#pragma unroll
        for (int ai = 0; ai < 2; ++ai)
#pragma unroll
            for (int m = 0; m < 4; ++m) { const int row = row0 + ai * HALF + m * 16; const float rs = rsqrtf(ssv[ai * 4 + m] * (1.0f / DM) + EPS);
                f32x4 v[2][2]; float ss = 0.f;
#pragma unroll
                for (int bj = 0; bj < 2; ++bj)
#pragma unroll
                    for (int n = 0; n < 2; ++n) { v[bj][n] = acc[ai][bj][m][n] * rs + bv[bj][n]; const f32x4 t = v[bj][n]; ss += (t[0] * t[0] + t[1] * t[1]) + (t[2] * t[2] + t[3] * t[3]); }
                float hs = 1.0f;
                if (do_norm) { ss += __shfl_xor(ss, 16); ss += __shfl_xor(ss, 32); hs = rsqrtf(ss * (1.0f / 64.0f) + EPS); }
                bf16_t* rowp;
                if (is_q) rowp = Q + (size_t)(row & (SEQ - 1)) * DM + ((pn - 6) * 4 + wc) * 64 + 8 * fq;
                else rowp = KV + ((size_t)(pn * 4 + wc) * SEQ + (row & (SEQ - 1))) * 64 + 8 * fq;
#pragma unroll
                for (int bj = 0; bj < 2; ++bj) { const f32x4 v0 = v[bj][0] * hs * gn[bj][0], v1 = v[bj][1] * hs * gn[bj][1];
                    u32x4 w; w.x = cvtpk(v0[0], v0[1]); w.y = cvtpk(v0[2], v0[3]); w.z = cvtpk(v1[0], v1[1]); w.w = cvtpk(v1[2], v1[3]);
                    *(u32x4*)(rowp + 32 * bj) = w; } }
    }
};
}

namespace att {
constexpr int SLOTB = 8192;
constexpr int L_K = 0, L_V = 3 * SLOTB, L_WS = 6 * SLOTB, L_SEL = L_WS + 4096, L_NIB = L_SEL + 256, L_SC = L_NIB + 768, L_IA = L_SC + 8704, L_IB = L_IA + 33792, L_END = L_IB + 33792, L_OST = L_IA;
static_assert(L_END <= 131072 && (L_IA % 16) == 0 && (L_SC % 16) == 0, "attention LDS map");
#define SBAR() __builtin_amdgcn_sched_barrier(0)
#define ATT_WAIT_BAR(N) asm volatile("s_waitcnt vmcnt(" #N ") lgkmcnt(0)\n\ts_barrier" ::: "memory")
__device__ __forceinline__ int crow(int r, int hi) { return (r & 3) + 8 * (r >> 2) + 4 * hi; }
__device__ __forceinline__ void glds16(const void* gsrc, unsigned lds_dst) { unsigned keep;
    asm volatile("s_mov_b32 %0, m0\n\ts_mov_b32 m0, %2\n\ts_nop 0\n\tglobal_load_lds_dwordx4 %1, off\n\ts_mov_b32 m0, %0" : "=&s"(keep) : "v"(gsrc), "s"(lds_dst) : "memory"); }

__device__ __forceinline__ void qkt_c(f32x16& p0, f32x16& p1, const LAS unsigned char* Kslot, const bf16x8* qr, const f32x16& ci, int r32, int hi) {
    const LAS unsigned char* kb = Kslot + hi * 1024 + r32 * 16;
    bf16x8 kf[8];
#pragma unroll
    for (int i = 0; i < 8; ++i) kf[i] = *(const LAS bf16x8*)(kb + (i >> 1) * 2048 + (i & 1) * 512);
    asm volatile("" : "+v"(kf[0]), "+v"(kf[1]), "+v"(kf[2]), "+v"(kf[3]), "+v"(kf[4]), "+v"(kf[5]), "+v"(kf[6]), "+v"(kf[7]));
    p0 = __builtin_amdgcn_mfma_f32_32x32x16_bf16(kf[0], qr[0], ci, 0, 0, 0); p1 = __builtin_amdgcn_mfma_f32_32x32x16_bf16(kf[1], qr[0], ci, 0, 0, 0);
#pragma unroll
    for (int d0 = 1; d0 < 4; ++d0) { p0 = __builtin_amdgcn_mfma_f32_32x32x16_bf16(kf[2 * d0], qr[d0], p0, 0, 0, 0); p1 = __builtin_amdgcn_mfma_f32_32x32x16_bf16(kf[2 * d0 + 1], qr[d0], p1, 0, 0, 0); }
}
__device__ __forceinline__ void qkt(f32x16& p0, f32x16& p1, const LAS unsigned char* Kslot, const bf16x8* qr, int r32, int hi) {
    const LAS unsigned char* kb = Kslot + hi * 1024 + r32 * 16;
    bf16x8 kf[8];
#pragma unroll
    for (int i = 0; i < 8; ++i) kf[i] = *(const LAS bf16x8*)(kb + (i >> 1) * 2048 + (i & 1) * 512);
    asm volatile("" : "+v"(kf[0]), "+v"(kf[1]), "+v"(kf[2]), "+v"(kf[3]), "+v"(kf[4]), "+v"(kf[5]), "+v"(kf[6]), "+v"(kf[7]));
    const f32x16 z = f32x16{};
    p0 = __builtin_amdgcn_mfma_f32_32x32x16_bf16(kf[0], qr[0], z, 0, 0, 0); p1 = __builtin_amdgcn_mfma_f32_32x32x16_bf16(kf[1], qr[0], z, 0, 0, 0);
#pragma unroll
    for (int d0 = 1; d0 < 4; ++d0) { p0 = __builtin_amdgcn_mfma_f32_32x32x16_bf16(kf[2 * d0], qr[d0], p0, 0, 0, 0); p1 = __builtin_amdgcn_mfma_f32_32x32x16_bf16(kf[2 * d0 + 1], qr[d0], p1, 0, 0, 0); }
}
__device__ __forceinline__ void range_mask(f32x16& p0, f32x16& p1, int lo, int hv, int hi) {
    const int lo2 = lo - 4 * hi, hv2 = hv - 4 * hi;
#pragma unroll
    for (int r = 0; r < 16; ++r) { const int kc = (r & 3) + 8 * (r >> 2); if (kc < lo2 || kc > hv2) p0[r] = -INFINITY; if (kc + 32 < lo2 || kc + 32 > hv2) p1[r] = -INFINITY; }
}
__device__ __forceinline__ float max3f(float a, float b, float c) { float r; asm("v_max3_f32 %0, %1, %2, %3" : "=v"(r) : "v"(a), "v"(b), "v"(c)); return r; }
__device__ __forceinline__ float max2f(float a, float b) { float r; asm("v_max_f32_e32 %0, %1, %2" : "=v"(r) : "v"(a), "v"(b)); return r; }
__device__ __forceinline__ float rowmax(const f32x16& p0, const f32x16& p1) {
    float a = max3f(p0[0], p0[1], p1[0]), b = max3f(p0[2], p0[3], p1[1]); a = max3f(a, p1[2], p1[3]);
#pragma unroll
    for (int r = 4; r < 16; r += 4) { a = max3f(a, p0[r], p0[r + 1]); b = max3f(b, p0[r + 2], p0[r + 3]); a = max3f(a, p1[r], p1[r + 1]); b = max3f(b, p1[r + 2], p1[r + 3]); }
    const float m = max2f(a, b);
    auto rr = __builtin_amdgcn_permlane32_swap(__float_as_uint(m), __float_as_uint(m), false, false);
    return max2f(__uint_as_float(rr[0]), __uint_as_float(rr[1]));
}
__device__ __forceinline__ float halfsum(float a) {
    auto rr = __builtin_amdgcn_permlane32_swap(__float_as_uint(a), __float_as_uint(a), false, false);
    return __uint_as_float(rr[0]) + __uint_as_float(rr[1]);
}
__device__ __forceinline__ void pv(f32x16* o, int vb, bf16x8 pa0, bf16x8 pa1, bf16x8 pa2, bf16x8 pa3) {
    s16x4 lo[8], hi4[8];
#pragma unroll
    for (int q = 0; q < 8; ++q) {
        asm volatile("ds_read_b64_tr_b16 %0,%1 offset:%c2" : "=&v"(lo[q]) : "v"(vb), "i"((q >> 2) * 4096 + (q & 3) * 1024) : "memory");
        asm volatile("ds_read_b64_tr_b16 %0,%1 offset:%c2" : "=&v"(hi4[q]) : "v"(vb), "i"((q >> 2) * 4096 + (q & 3) * 1024 + 512) : "memory"); }
    asm volatile("s_waitcnt lgkmcnt(0)" ::: "memory"); SBAR();
#define PK(k) (bf16x8){lo[k][0], lo[k][1], lo[k][2], lo[k][3], hi4[k][0], hi4[k][1], hi4[k][2], hi4[k][3]}
    o[0] = __builtin_amdgcn_mfma_f32_32x32x16_bf16(pa0, PK(0), o[0], 0, 0, 0);
    o[1] = __builtin_amdgcn_mfma_f32_32x32x16_bf16(pa0, PK(4), o[1], 0, 0, 0);
    o[0] = __builtin_amdgcn_mfma_f32_32x32x16_bf16(pa1, PK(1), o[0], 0, 0, 0);
    o[1] = __builtin_amdgcn_mfma_f32_32x32x16_bf16(pa1, PK(5), o[1], 0, 0, 0);
    o[0] = __builtin_amdgcn_mfma_f32_32x32x16_bf16(pa2, PK(2), o[0], 0, 0, 0);
    o[1] = __builtin_amdgcn_mfma_f32_32x32x16_bf16(pa2, PK(6), o[1], 0, 0, 0);
    o[0] = __builtin_amdgcn_mfma_f32_32x32x16_bf16(pa3, PK(3), o[0], 0, 0, 0);
    o[1] = __builtin_amdgcn_mfma_f32_32x32x16_bf16(pa3, PK(7), o[1], 0, 0, 0);
#undef PK
}
__device__ __forceinline__ bf16x8 pack8(const f32x16& p, int base) {
    u32x4 w; w.x = cvtpk(p[base], p[base + 1]); w.y = cvtpk(p[base + 2], p[base + 3]); w.z = cvtpk(p[base + 4], p[base + 5]); w.w = cvtpk(p[base + 6], p[base + 7]);
    return __builtin_bit_cast(bf16x8, w);
}
__device__ __forceinline__ void row_bcast(float v, float (&out)[16], LAS float* wsf, int r32, int hi) {
    if (hi == 0) wsf[r32] = v;
#pragma unroll
    for (int i = 0; i < 4; ++i) { const f32x4 t = *(const LAS f32x4*)(wsf + 8 * i + 4 * hi); out[4 * i] = t[0]; out[4 * i + 1] = t[1]; out[4 * i + 2] = t[2]; out[4 * i + 3] = t[3]; }
}

struct Ctx {
    int lane, r32, hi, wid, ql, qb; unsigned lds0; LAS unsigned char* shm; LAS float* wsf; int koff, voff; unsigned kdst, vdst; int vb0;
};
__device__ __forceinline__ void dma_k(const Ctx& c, const bf16_t* base, int tile, int slot) { glds16(base + (size_t)tile * 4096 + c.koff, (unsigned)__builtin_amdgcn_readfirstlane(c.kdst + slot * SLOTB)); }
__device__ __forceinline__ void dma_v(const Ctx& c, const bf16_t* base, int tile, int slot) { glds16(base + (size_t)tile * 4096 + c.voff, (unsigned)__builtin_amdgcn_readfirstlane(c.vdst + slot * SLOTB)); }

constexpr float THR = 8.0f;
struct BrState { float mhat, l; f32x16 negm; f32x16 o[2]; };
__device__ __forceinline__ void br_reset(BrState& st) { st.mhat = 0.f; st.l = 0.f; st.negm = f32x16{}; st.o[0] = f32x16{}; st.o[1] = f32x16{}; }
__device__ __forceinline__ void stream_step(const Ctx& c, int slot, const bf16x8* qr, bool row_on, bool use_range, int lo, int hv, bool first, BrState& st) {
    f32x16 p0, p1;
    if (__any(!row_on)) { f32x16 ci;
#pragma unroll
        for (int r = 0; r < 16; ++r) ci[r] = row_on ? st.negm[r] : -INFINITY;
        qkt_c(p0, p1, c.shm + L_K + slot * SLOTB, qr, ci, c.r32, c.hi);
    } else qkt_c(p0, p1, c.shm + L_K + slot * SLOTB, qr, st.negm, c.r32, c.hi);
    if (use_range) range_mask(p0, p1, lo, hv, c.hi);
    const float rm = rowmax(p0, p1);
    if (first || __any(rm > THR)) {
        float dl = first ? rm : fmaxf(rm, 0.f);
        if (dl == -INFINITY) dl = 0.f;
        st.mhat += dl;
#pragma unroll
        for (int r = 0; r < 16; ++r) { p0[r] -= dl; p1[r] -= dl; st.negm[r] = -st.mhat; }
        if (!first) { const float f = __builtin_amdgcn_exp2f(-dl); st.l *= f; float al[16]; row_bcast(f, al, c.wsf, c.r32, c.hi);
#pragma unroll
            for (int r = 0; r < 16; ++r) { st.o[0][r] *= al[r]; st.o[1][r] *= al[r]; } }
    }
#pragma unroll
    for (int r = 0; r < 16; ++r) { p0[r] = __builtin_amdgcn_exp2f(p0[r]); p1[r] = __builtin_amdgcn_exp2f(p1[r]); }
    { const f32x16 sv = p0 + p1; st.l += ((sv[0] + sv[1]) + (sv[2] + sv[3])) + ((sv[4] + sv[5]) + (sv[6] + sv[7])) + ((sv[8] + sv[9]) + (sv[10] + sv[11])) + ((sv[12] + sv[13]) + (sv[14] + sv[15])); }
    pv(st.o, c.vb0 + slot * SLOTB, pack8(p0, 0), pack8(p0, 8), pack8(p1, 0), pack8(p1, 8));
}
struct Cursor { unsigned sm, wm; };
__device__ __forceinline__ int cur_pop(Cursor& k, int& br) {
    if (k.sm) { const int t = __builtin_ctz(k.sm); k.sm &= k.sm - 1u; br = 1; return t; }
    const int t = 31 - __builtin_clz(k.wm); k.wm &= ~(1u << t); br = 2; return t;
}

typedef __attribute__((address_space(3))) const char* lds_cptr;
typedef short v4i16_t __attribute__((ext_vector_type(4)));
__device__ __forceinline__ void kload8(bf16x8* kf, lds_cptr kp) {
    kf[0] = *(const LAS bf16x8*)(kp);        kf[1] = *(const LAS bf16x8*)(kp + 512);
    kf[2] = *(const LAS bf16x8*)(kp + 2048); kf[3] = *(const LAS bf16x8*)(kp + 2560);
    kf[4] = *(const LAS bf16x8*)(kp + 4096); kf[5] = *(const LAS bf16x8*)(kp + 4608);
    kf[6] = *(const LAS bf16x8*)(kp + 6144); kf[7] = *(const LAS bf16x8*)(kp + 6656);
}
__device__ __forceinline__ void kload2(bf16x8* kf, lds_cptr kp, int j) { kf[2 * j] = *(const LAS bf16x8*)(kp + j * 2048); kf[2 * j + 1] = *(const LAS bf16x8*)(kp + j * 2048 + 512); }
__device__ __forceinline__ s16x4 vtr(lds_cptr p) { return __builtin_bit_cast(s16x4, __builtin_amdgcn_ds_read_tr16_b64_v4i16((LAS v4i16_t*)p)); }
__device__ __forceinline__ float fadd_s(float a, float b) { float r; asm("v_add_f32_e32 %0, %1, %2" : "=v"(r) : "v"(a), "v"(b)); return r; }
__device__ __forceinline__ float fsub_s(float a, float b) { float r; asm("v_sub_f32_e32 %0, %1, %2" : "=v"(r) : "v"(a), "v"(b)); return r; }
template <int THRL>
__device__ __forceinline__ void sel_stream(const Ctx& c, const bf16_t* Kb, const bf16_t* Vb, const bf16x8* qr, unsigned msel, int qb, f32x16* o, float& l_out) {
  const int lane = c.lane, r32 = c.r32, hi = c.hi;
  LAS float* wsf = c.wsf;
  const lds_cptr shm3 = (lds_cptr)c.shm;
  const lds_cptr kp0 = shm3 + L_K + hi * 1024 + r32 * 16;
  const lds_cptr vp0 = shm3 + L_V + ((lane >> 4) & 1) * 32 + (lane & 3) * 8 + (4 * hi + ((lane & 15) >> 2)) * 64;
  const int NTr = qb + 1, NT = NTr < 4 ? 4 : ((NTr + 1) & ~1);
  #define WAIT_BAR(N) asm volatile("s_waitcnt vmcnt(" #N ") lgkmcnt(0)\n\ts_barrier":::"memory")
  #define TILE_OF(t) (((t) < NTr) ? (t) : qb)
  #define DMA_K(t, slotb) glds16(Kb + (size_t)TILE_OF(t) * 4096 + c.koff, (unsigned)__builtin_amdgcn_readfirstlane(c.kdst + (slotb)))
  #define DMA_V(t, slotb) glds16(Vb + (size_t)TILE_OF(t) * 4096 + c.voff, (unsigned)__builtin_amdgcn_readfirstlane(c.vdst + (slotb)))
  #define CMASK(P0, P1, t) do { const bool on_ = ((t) < NTr) && (((msel >> ((t) & 31)) & 1u) != 0u); \
      if (__any(!on_)) { const float ng_ = on_ ? 0.f : -INFINITY; _Pragma("unroll") for (int r = 0; r < 16; ++r) { P0[r] += ng_; P1[r] += ng_; } } \
      if ((t) == qb) range_mask(P0, P1, 0, c.ql, hi); } while (0)
  float mhat = 0.f, l_reg = 0.f; o[0] = f32x16{}; o[1] = f32x16{}; f32x16 negm = f32x16{}; asm volatile("" : "+v"(negm));
  bf16x8 kf[8];
  bool resc = false;
  #define START(P0,P1) do{ const float rm=rowmax(P0,P1); resc=false; \
    { const float dl=rm; mhat=fadd_s(mhat,dl); \
      _Pragma("unroll") for(int r=0;r<16;++r){P0[r]=fsub_s(P0[r],dl);P1[r]=fsub_s(P1[r],dl);} \
      _Pragma("unroll") for(int r=0;r<16;++r)negm[r]=-mhat; asm volatile("":"+v"(negm)); } \
    _Pragma("unroll") for(int r=0;r<16;++r)P0[r]=__builtin_amdgcn_exp2f(P0[r]); }while(0)
  #define RESC() do{ if(resc){ asm volatile("s_waitcnt lgkmcnt(0)":::"memory"); \
      _Pragma("unroll") for(int d_=0;d_<2;++d_) _Pragma("unroll") for(int r=0;r<16;++r)o[d_][r]*=wsf[crow(r,hi)]; } }while(0)
  f32x16 pA0,pA1,pB0,pB1;
  int sl_prev=SLOTB,sl_cur=2*SLOTB,sl_next=0;
  #define ROT() do{sl_prev=sl_cur;sl_cur=sl_next;sl_next=(sl_next==2*SLOTB)?0:sl_next+SLOTB;}while(0)
  DMA_K(1,0); DMA_K(2,SLOTB);
  { const f32x16 z = f32x16{}; qkt_c(pA0,pA1,c.shm+L_K+2*SLOTB,qr,z,r32,hi); }
  asm volatile("s_nop 15\n\ts_nop 7":"+v"(pA0),"+v"(pA1)); CMASK(pA0,pA1,0);
  START(pA0,pA1);
  _Pragma("unroll") for(int r=0;r<16;++r)pA1[r]=__builtin_amdgcn_exp2f(pA1[r]);
  WAIT_BAR(0);
  DMA_K(3,2*SLOTB);DMA_V(1,0);
  ROT();
  kload8(kf,kp0+sl_cur);
  WAIT_BAR(2);
  s16x4 vlo[8],vhi[8]; u32x4 pw0,pw1,pw2,pw3;
  #define PKW(P,B) cvtpk(P[B],P[B+1])
  #define PAF(k) __builtin_bit_cast(bf16x8,pw##k)
  #define VFR(i) (bf16x8){vlo[i][0],vlo[i][1],vlo[i][2],vlo[i][3],vhi[i][0],vhi[i][1],vhi[i][2],vhi[i][3]}
  #define PIN(x) asm volatile("":"+v"(x))
  #define MX3(a,b,c) __builtin_fmaxf(__builtin_fmaxf((a),(b)),(c))
  #define GAPA(MF,A0,A1,A2,A3,W0,W1,PW) do{ MF; sacc+=A0; sacc+=A1; sacc+=A2; sacc+=A3; PIN(sacc); W0; W1; PIN(PW); SBAR(); }while(0)
  #define EX(v) __builtin_amdgcn_exp2f(v)
  #define GAPB(MF,X,B) do{ MF; X[B]=EX(X[B]); X[B+1]=EX(X[B+1]); X[B+2]=EX(X[B+2]); X[B+3]=EX(X[B+3]); PIN(X); SBAR(); }while(0)
  #define VRD(i) do{ vlo[i]=vtr(vp_+(((i)>>2)*4096+((i)&3)*1024)); vhi[i]=vtr(vp_+(((i)>>2)*4096+((i)&3)*1024+512)); }while(0)
  #define KRD(G,j) do{ if(G){ kload2(kf,kp0+sl_next,j); SBAR(); } }while(0)
  #define STEP(C0,C1,P0,P1,t,GK,GV,GL) do{ SBAR(); \
    const lds_cptr vp_=vp0+sl_prev; \
    VRD(0); SBAR(); float sacc=(P0[0]+P0[1]); \
    GAPA(C0=__builtin_amdgcn_mfma_f32_32x32x16_bf16(kf[0],qr[0],negm,0,0,0), P0[2],P0[3],P0[4],P0[5],     pw0[0]=PKW(P0,0), pw0[1]=PKW(P0,2), pw0); \
    VRD(4); SBAR(); GAPA(C1=__builtin_amdgcn_mfma_f32_32x32x16_bf16(kf[1],qr[0],negm,0,0,0), P0[6],P0[7],P0[8],P0[9],     pw0[2]=PKW(P0,4), pw0[3]=PKW(P0,6), pw0); \
    VRD(1); SBAR(); GAPA(C0=__builtin_amdgcn_mfma_f32_32x32x16_bf16(kf[2],qr[1],C0,0,0,0),   P0[10],P0[11],P0[12],P0[13], pw1[0]=PKW(P0,8), pw1[1]=PKW(P0,10), pw1); \
    VRD(5); SBAR(); GAPA(C1=__builtin_amdgcn_mfma_f32_32x32x16_bf16(kf[3],qr[1],C1,0,0,0),   P0[14],P0[15],P1[0],P1[1],   pw1[2]=PKW(P0,12),pw1[3]=PKW(P0,14), pw1); \
    VRD(2); SBAR(); GAPA(C0=__builtin_amdgcn_mfma_f32_32x32x16_bf16(kf[4],qr[2],C0,0,0,0),   P1[2],P1[3],P1[4],P1[5],     pw2[0]=PKW(P1,0), pw2[1]=PKW(P1,2), pw2); \
    VRD(6); SBAR(); GAPA(C1=__builtin_amdgcn_mfma_f32_32x32x16_bf16(kf[5],qr[2],C1,0,0,0),   P1[6],P1[7],P1[8],P1[9],     pw2[2]=PKW(P1,4), pw2[3]=PKW(P1,6), pw2); \
    VRD(3); SBAR(); GAPA(C0=__builtin_amdgcn_mfma_f32_32x32x16_bf16(kf[6],qr[3],C0,0,0,0),   P1[10],P1[11],P1[12],P1[13], pw3[0]=PKW(P1,8), pw3[1]=PKW(P1,10), pw3); \
    VRD(7); SBAR(); GAPA(C1=__builtin_amdgcn_mfma_f32_32x32x16_bf16(kf[7],qr[3],C1,0,0,0),   P1[14],P1[15],0.f,0.f,       pw3[2]=PKW(P1,12),pw3[3]=PKW(P1,14), pw3); \
    l_reg+=sacc; \
    if(GK){DMA_K((t)+3,sl_cur);} if(GV){DMA_V((t)+1,sl_next);} \
    CMASK(C0,C1,t); \
    { float a=MX3(C0[0],C0[1],C1[0]),b=MX3(C0[2],C0[3],C1[1]); a=MX3(a,C1[2],C1[3]); \
      _Pragma("unroll") for(int r=4;r<16;r+=4){a=MX3(a,C0[r],C0[r+1]);b=MX3(b,C0[r+2],C0[r+3]);a=MX3(a,C1[r],C1[r+1]);b=MX3(b,C1[r+2],C1[r+3]);} \
      float rm=__builtin_fmaxf(a,b); { auto rr=__builtin_amdgcn_permlane32_swap(__float_as_uint(rm),__float_as_uint(rm),false,false); rm=__builtin_fmaxf(__uint_as_float(rr[0]),__uint_as_float(rr[1])); } \
      resc=false; \
      if(__builtin_expect(__any(rm>(float)THRL),0)){ const float dl=__builtin_fmaxf(rm,0.f); mhat+=dl; \
        _Pragma("unroll") for(int r=0;r<16;++r){C0[r]-=dl;C1[r]-=dl;} \
        _Pragma("unroll") for(int r=0;r<16;++r)negm[r]=-mhat; asm volatile("":"+v"(negm)); \
        const float f=__builtin_amdgcn_exp2f(-dl); l_reg*=f; if(hi==0)wsf[r32]=f; resc=true; } } \
    SBAR(); \
    GAPB(o[0]=__builtin_amdgcn_mfma_f32_32x32x16_bf16(PAF(0),VFR(0),o[0],0,0,0), C0,0); \
    GAPB(o[1]=__builtin_amdgcn_mfma_f32_32x32x16_bf16(PAF(0),VFR(4),o[1],0,0,0), C0,4); \
    KRD(GL,0); GAPB(o[0]=__builtin_amdgcn_mfma_f32_32x32x16_bf16(PAF(1),VFR(1),o[0],0,0,0), C0,8); \
    KRD(GL,1); GAPB(o[1]=__builtin_amdgcn_mfma_f32_32x32x16_bf16(PAF(1),VFR(5),o[1],0,0,0), C0,12); \
    KRD(GL,2); GAPB(o[0]=__builtin_amdgcn_mfma_f32_32x32x16_bf16(PAF(2),VFR(2),o[0],0,0,0), C1,0); \
    KRD(GL,3); GAPB(o[1]=__builtin_amdgcn_mfma_f32_32x32x16_bf16(PAF(2),VFR(6),o[1],0,0,0), C1,4); \
    GAPB(o[0]=__builtin_amdgcn_mfma_f32_32x32x16_bf16(PAF(3),VFR(3),o[0],0,0,0), C1,8); \
    GAPB(o[1]=__builtin_amdgcn_mfma_f32_32x32x16_bf16(PAF(3),VFR(7),o[1],0,0,0), C1,12); \
    }while(0)
  #define ENDW(tt) do{ if((tt)+3<NT){WAIT_BAR(2);} else if((tt)+2<NT){WAIT_BAR(1);} else {WAIT_BAR(0);} }while(0)
  int t=1;
  for(;t+1<NT;t+=2){
    STEP(pB0,pB1,pA0,pA1,t,(t+3<NT),(t+1<NT),(t+1<NT));       ENDW(t);   RESC(); ROT();
    STEP(pA0,pA1,pB0,pB1,t+1,(t+4<NT),(t+2<NT),(t+2<NT));     ENDW(t+1); RESC(); ROT();
  }
  STEP(pB0,pB1,pA0,pA1,NT-1,false,false,false); RESC();
  { float sacc=pB0[0]+pB0[1]; _Pragma("unroll") for(int r=2;r<16;++r)sacc+=pB0[r]; _Pragma("unroll") for(int r=0;r<16;++r)sacc+=pB1[r]; l_reg+=sacc;
    SBAR(); pv(o, c.vb0 + sl_cur, pack8(pB0,0), pack8(pB0,8), pack8(pB1,0), pack8(pB1,8)); }
  l_out = l_reg;
  asm volatile("s_waitcnt lgkmcnt(0)\n\ts_barrier":::"memory");
  #undef WAIT_BAR
  #undef TILE_OF
  #undef DMA_K
  #undef DMA_V
  #undef CMASK
  #undef START
  #undef RESC
  #undef ROT
  #undef PKW
  #undef PAF
  #undef VFR
  #undef PIN
  #undef MX3
  #undef GAPA
  #undef EX
  #undef GAPB
  #undef VRD
  #undef KRD
  #undef STEP
  #undef ENDW
}

__device__ __forceinline__ void attn_unit(int b, int g, int qb, unsigned char* slab, LAS unsigned char* shm) {
    const bf16_t* Q = (const bf16_t*)(slab + SO_Q); const bf16_t* KV = (const bf16_t*)(slab + SO_KV); const bf16_t* KC = (const bf16_t*)(slab + SO_KC); const bf16_t* VC = (const bf16_t*)(slab + SO_VC);
    const float* gates = (const float*)(slab + SO_GATES); bf16_t* O = (bf16_t*)(slab + SO_O);
    Ctx c;
    const int tid = threadIdx.x;
    c.lane = tid & 63; c.r32 = c.lane & 31; c.hi = c.lane >> 5; c.wid = __builtin_amdgcn_readfirstlane(tid >> 6);
    const int kh = c.wid >> 1, qh = c.wid & 1, head = g * 4 + kh;
    c.ql = qh * 32 + c.r32; c.qb = qb; c.shm = shm; c.lds0 = (unsigned)(size_t)shm;
    c.wsf = (LAS float*)(shm + L_WS) + c.wid * 128;
    c.koff = c.lane * 64 + c.wid * 8;
    c.voff = (16 * (c.wid & 3) + (c.lane >> 2)) * 64 + (c.wid >> 2) * 32 + (c.lane & 3) * 8;
    c.kdst = c.lds0 + L_K + c.wid * 1024; c.vdst = c.lds0 + L_V + c.wid * 1024;
    c.vb0 = (int)(c.lds0 + L_V) + ((c.lane >> 4) & 1) * 32 + (c.lane & 3) * 8 + (4 * c.hi + ((c.lane & 15) >> 2)) * 64;
    const int t = qb * 64 + c.ql;
    const size_t mrow = (size_t)t;
    const size_t bg = (size_t)g;
    const bf16_t* KSb = KV + ((size_t)2 * 4 + g) * (SEQ * 64);
    const bf16_t* VSb = KV + ((size_t)3 * 4 + g) * (SEQ * 64);
    const bf16_t* KWb = KV + ((size_t)4 * 4 + g) * (SEQ * 64);
    const bf16_t* VWb = KV + ((size_t)5 * 4 + g) * (SEQ * 64);
    const bf16_t* KCb = KC + bg * 8192; const bf16_t* VCb = VC + bg * 8192;
    dma_k(c, KCb, 0, 0); dma_k(c, KCb, 1, 1); dma_v(c, VCb, 0, 0); dma_v(c, VCb, 1, 1);
    dma_k(c, KSb, 0, 2); dma_v(c, VSb, 0, 2);
    bf16x8 qr[4];
    { const bf16_t* Qw = Q + mrow * DM + head * 64 + c.hi * 8;
#pragma unroll
      for (int d0 = 0; d0 < 4; ++d0) qr[d0] = *(const bf16x8*)(Qw + d0 * 16); }
    const float* gp = gates + mrow * 48 + head * 3;
    const float g0 = gp[0], g1 = gp[1], g2 = gp[2];
    f32x16 ot[2];
    f32x16 o[2];
    const bool two = qb >= 16;
    ATT_WAIT_BAR(2);
    {
        f32x16 a0, a1, b0, b1;
        qkt(a0, a1, shm + L_K, qr, c.r32, c.hi);
        const int nmax = (t >= 31) ? ((t - 31) >> 4) : -1;
        range_mask(a0, a1, 0, nmax, c.hi);
        float rm = rowmax(a0, a1);
        if (two) { qkt(b0, b1, shm + L_K + SLOTB, qr, c.r32, c.hi); range_mask(b0, b1, 0, nmax - 64, c.hi); rm = fmaxf(rm, rowmax(b0, b1)); }
        const float mu = (rm == -INFINITY) ? 0.f : rm;
        float s = 0.f;
#pragma unroll
        for (int r = 0; r < 16; ++r) { a0[r] = __builtin_amdgcn_exp2f(a0[r] - mu); a1[r] = __builtin_amdgcn_exp2f(a1[r] - mu); s += a0[r] + a1[r]; }
        if (two) {
#pragma unroll
            for (int r = 0; r < 16; ++r) { b0[r] = __builtin_amdgcn_exp2f(b0[r] - mu); b1[r] = __builtin_amdgcn_exp2f(b1[r] - mu); s += b0[r] + b1[r]; }
        }
        s = halfsum(s);
        const float inv = (s > 0.f) ? 1.0f / s : 0.f;
#pragma unroll
        for (int r = 0; r < 16; ++r) { a0[r] *= inv; a1[r] *= inv; }
        if (two) {
#pragma unroll
            for (int r = 0; r < 16; ++r) { b0[r] *= inv; b1[r] *= inv; }
            int qlx = c.ql; LAUNDER(qlx);
            LAS float* IA = (LAS float*)(shm + L_IA) + (kh * 64 + qlx) * 33;
            LAS float* IB = (LAS float*)(shm + L_IB) + (kh * 64 + qlx) * 33;
#pragma unroll
            for (int i = 0; i < 4; ++i) {
                const int j = 2 * i + c.hi;
                IA[j]      = a0[4 * i] + a0[4 * i + 1] + a0[4 * i + 2] + 0.5f * a0[4 * i + 3]; IB[j + 1]  = 0.5f * a0[4 * i + 3];
                IA[j + 8]  = a1[4 * i] + a1[4 * i + 1] + a1[4 * i + 2] + 0.5f * a1[4 * i + 3]; IB[j + 9]  = 0.5f * a1[4 * i + 3];
                IA[j + 16] = b0[4 * i] + b0[4 * i + 1] + b0[4 * i + 2] + 0.5f * b0[4 * i + 3]; IB[j + 17] = 0.5f * b0[4 * i + 3];
                IA[j + 24] = b1[4 * i] + b1[4 * i + 1] + b1[4 * i + 2] + 0.5f * b1[4 * i + 3]; IB[j + 25] = 0.5f * b1[4 * i + 3];
            }
        }
        o[0] = f32x16{}; o[1] = f32x16{};
        pv(o, c.vb0, pack8(a0, 0), pack8(a0, 8), pack8(a1, 0), pack8(a1, 8));
        if (two) pv(o, c.vb0 + SLOTB, pack8(b0, 0), pack8(b0, 8), pack8(b1, 0), pack8(b1, 8));
        float cf[16]; row_bcast(g0, cf, c.wsf, c.r32, c.hi);
#pragma unroll
        for (int r = 0; r < 16; ++r) { ot[0][r] = o[0][r] * cf[r]; ot[1][r] = o[1][r] * cf[r]; }
    }
    ATT_WAIT_BAR(0);
    LAS unsigned* SEL = (LAS unsigned*)(shm + L_SEL);
    if (two) {
        int q = tid & 63, jg = tid >> 6; LAUNDER(q); LAUNDER(jg);
        LAS float* SC = (LAS float*)(shm + L_SC);
        const LAS float* IA = (const LAS float*)(shm + L_IA); const LAS float* IB = (const LAS float*)(shm + L_IB);
#pragma unroll
        for (int jj = 0; jj < 4; ++jj) { const int j = 4 * jg + jj; float sc = 0.f;
#pragma unroll
            for (int k = 0; k < 4; ++k) { sc += IA[(k * 64 + q) * 33 + j]; if (j > 0) sc += IB[(k * 64 + q) * 33 + j]; }
            const bool forced = (j == 0) || (j == qb) || (j == qb - 1);
            SC[q * 33 + j] = forced ? 1e30f : ((j <= qb) ? sc : -1e30f); }
        ATT_WAIT_BAR(0);
        unsigned nib = 0u;
        float sj[4];
#pragma unroll
        for (int jj = 0; jj < 4; ++jj) sj[jj] = SC[q * 33 + 4 * jg + jj];
        int rank[4] = {0, 0, 0, 0};
        for (int i = 0; i < 32; ++i) { const float si = SC[q * 33 + i];
#pragma unroll
            for (int jj = 0; jj < 4; ++jj) { const int j = 4 * jg + jj; rank[jj] += (si > sj[jj] || (si == sj[jj] && i < j)) ? 1 : 0; } }
#pragma unroll
        for (int jj = 0; jj < 4; ++jj) nib |= (rank[jj] < 16 ? 1u : 0u) << jj;
        ((LAS unsigned char*)(shm + L_NIB))[q * 8 + jg] = (unsigned char)nib;
        ATT_WAIT_BAR(0);
        if (tid < 64) { unsigned mk = 0u; int tq = tid; LAUNDER(tq);
#pragma unroll
            for (int k = 0; k < 8; ++k) mk |= (unsigned)((LAS unsigned char*)(shm + L_NIB))[tq * 8 + k] << (4 * k);
            SEL[tq] = mk; }
        ATT_WAIT_BAR(0);
    } else {
        if (tid < 64) SEL[tid] = (1u << (qb + 1)) - 1u;
        ATT_WAIT_BAR(0);
    }
    int lnx = c.lane, qlx2 = c.ql; LAUNDER(lnx); LAUNDER(qlx2);
    LAS float* accp = (LAS float*)(shm + L_IA) + c.wid * 2048 + lnx;
#pragma unroll
    for (int r = 0; r < 16; ++r) { accp[r * 64] = ot[0][r]; accp[(16 + r) * 64] = ot[1][r]; }
    unsigned um = SEL[lnx];
#pragma unroll
    for (int sft = 1; sft < 64; sft <<= 1) um |= (unsigned)__shfl_xor((int)um, sft);
    um = (unsigned)__builtin_amdgcn_readfirstlane((int)um);
    um &= (qb == 31) ? 0xffffffffu : ((1u << (qb + 1)) - 1u);
    const unsigned msel = SEL[qlx2];
    (void)um;
    {
        float l_sel; f32x16 osel[2];
        sel_stream<8>(c, KSb, VSb, qr, msel, qb, osel, l_sel);
        const float lt = halfsum(l_sel);
        float cf[16]; row_bcast((lt > 0.f) ? g1 / lt : 0.f, cf, c.wsf, c.r32, c.hi);
#pragma unroll
        for (int r = 0; r < 16; ++r) { accp[r * 64] += osel[0][r] * cf[r]; accp[(16 + r) * 64] += osel[1][r] * cf[r]; }
    }
    {
        const int lo_t = qb >= 8 ? qb - 8 : 0, nw = qb - lo_t + 1;
        dma_k(c, KWb, qb, 0); dma_v(c, VWb, qb, 0);
        if (nw > 1) { dma_k(c, KWb, qb - 1, 1); dma_v(c, VWb, qb - 1, 1); }
        BrState st; br_reset(st);
        int slot = 0;
        for (int j = 0; j < nw; ++j) {
            if (j + 1 < nw) ATT_WAIT_BAR(2); else ATT_WAIT_BAR(0);
            if (j + 2 < nw) { const int ps = (slot == 0) ? 2 : slot - 1; dma_k(c, KWb, qb - j - 2, ps); dma_v(c, VWb, qb - j - 2, ps); }
            const int tc = qb - j;
            bool use_range = false; int lo = 0, hv = 63;
            if (j == 0) { use_range = true; hv = c.ql; }
            else if (tc == qb - 8) { use_range = true; lo = c.ql + 1; }
            stream_step(c, slot, qr, true, use_range, lo, hv, j == 0, st);
            slot = (slot == 2) ? 0 : slot + 1;
        }
        const float lt = halfsum(st.l);
        float cf[16]; row_bcast((lt > 0.f) ? g2 / lt : 0.f, cf, c.wsf, c.r32, c.hi);
#pragma unroll
        for (int r = 0; r < 16; ++r) { ot[0][r] = accp[r * 64] + st.o[0][r] * cf[r]; ot[1][r] = accp[(16 + r) * 64] + st.o[1][r] * cf[r]; }
        LDS_WAIT();
    }
    {
        LAS bf16_t* stg = (LAS bf16_t*)(shm + L_IA) + c.wid * 4096;
        int lny = c.lane; LAUNDER(lny);
        LAS bf16_t* stw = stg + ((lny >> 5) * 4) * 64 + (lny & 31);
#pragma unroll
        for (int r = 0; r < 16; ++r) { const int orow = (r & 3) + 8 * (r >> 2);
#pragma unroll
            for (int d0 = 0; d0 < 2; ++d0) stw[orow * 64 + d0 * 32] = (bf16_t)(cvtpk(ot[d0][r], 0.f) & 0xffffu); }
        LDS_WAIT();
        bf16_t* Ow = O + ((size_t)qb * 64 + qh * 32) * DM + head * 64;
#pragma unroll
        for (int i = 0; i < 4; ++i) { const int row = i * 8 + (lny >> 3), chn = lny & 7; const u32x4 v = *(const LAS u32x4*)(stg + row * 64 + chn * 8); *(u32x4*)(Ow + (size_t)row * DM + chn * 8) = v; }
    }
    ATT_WAIT_BAR(0);
}
#undef SBAR
}

#define XB_TMO      128
#define XB_XCNT(j)  (256  + 64 * (j))
#define XB_XSUB(j)  (1280 + 64 * (j))
#define XB_XGEN(j)  (2304 + 64 * (j))
#define XB_TOP      3328
#define XB_TOPGEN   3392
#define XB_LSUB(j)  (3456 + 64 * (j))
#define XB_LGEN(j)  (4480 + 64 * (j))
#define XCD_BAR_WORDS 5504
#define XB_SPIN_CAP (1u << 18)
__device__ __forceinline__ unsigned xb_ld(unsigned* p)              { return __hip_atomic_load(p, __ATOMIC_RELAXED, __HIP_MEMORY_SCOPE_AGENT); }
__device__ __forceinline__ unsigned xb_add(unsigned* p, unsigned v) { return __hip_atomic_fetch_add(p, v, __ATOMIC_RELAXED, __HIP_MEMORY_SCOPE_AGENT); }
__device__ __forceinline__ unsigned xb_xcc_id() { return (unsigned)__builtin_amdgcn_s_getreg((3 << 11) | 20) & 0xFu; }
#define XB_SPIN(cond, bar) do { unsigned _sp = 0; while (cond) { __builtin_amdgcn_s_sleep(1); \
    if ((++_sp & 255u) == 0u) { if (xb_ld(&(bar)[XB_TMO])) break; if (_sp > XB_SPIN_CAP) { atomicAdd(&(bar)[XB_TMO], 1u); break; } } } } while (0)
struct XcdBarrier { unsigned* bar; unsigned x; volatile LAS unsigned* st; };
__device__ __forceinline__ XcdBarrier xcd_barrier_post(unsigned* bar, volatile LAS unsigned* st) {
    XcdBarrier b; b.bar = bar; b.x = xb_xcc_id(); b.st = st;
    if (threadIdx.x == 0) { st[2] = xb_add(&bar[XB_XCNT(b.x)], 1u); st[4] = b.x; }
    return b;
}
__device__ __forceinline__ void xcd_barrier_complete(unsigned* bar, unsigned x, unsigned& nloc, unsigned& nx, unsigned& uniform) {
    const unsigned G = gridDim.x * gridDim.y * gridDim.z;
    unsigned sum, cnt, mine, sp = 0u, uni;
    for (;;) {
        sum = 0u; cnt = 0u; mine = 0u; uni = 1u;
#pragma unroll
        for (unsigned j = 0; j < 16; ++j) { const unsigned c = xb_ld(&bar[XB_XCNT(j)]); sum += c; cnt += (c > 0u) ? 1u : 0u; mine = (j == x) ? c : mine;
            if (j < 8u ? (c != 32u) : (c != 0u)) uni = 0u; }
        if (sum == G) break;
        __builtin_amdgcn_s_sleep(1);
        if ((++sp & 255u) == 0u) { if (xb_ld(&bar[XB_TMO])) break; if (sp > XB_SPIN_CAP) { atomicAdd(&bar[XB_TMO], 1u); break; } }
    }
    nloc = mine > 0u ? mine : 1u; nx = cnt > 0u ? cnt : 1u;
    uniform = (uni != 0u && sum == G && G == 256u) ? 1u : 0u;
}
__device__ __forceinline__ void xcd_barrier(const XcdBarrier& b) {
    asm volatile("s_waitcnt vmcnt(0)" ::: "memory");
    __syncthreads();
    if (threadIdx.x == 0) {
        unsigned* bar = b.bar;
        __builtin_amdgcn_s_waitcnt(0);
        unsigned nloc = b.st[0], nx = b.st[1];
        if (nloc == 0u) { unsigned uf; xcd_barrier_complete(bar, b.x, nloc, nx, uf); b.st[0] = nloc; b.st[1] = nx; b.st[3] = uf; }
        const unsigned old = xb_add(&bar[XB_XSUB(b.x)], 1u);
        const unsigned gen = old / nloc;
        if (old + 1u == (gen + 1u) * nloc) {
            __builtin_amdgcn_fence(__ATOMIC_RELEASE, "agent");
            asm volatile("s_waitcnt vmcnt(0)" ::: "memory");
            const unsigned og = xb_add(&bar[XB_TOP], 1u);
            const unsigned tg = og / nx;
            if (og + 1u == (tg + 1u) * nx) xb_add(&bar[XB_TOPGEN], 1u);
            else XB_SPIN(xb_ld(&bar[XB_TOPGEN]) == tg, bar);
            __builtin_amdgcn_fence(__ATOMIC_ACQUIRE, "agent");
            xb_add(&bar[XB_XGEN(b.x)], 1u);
            asm volatile("s_waitcnt vmcnt(0)" ::: "memory");
        } else {
            XB_SPIN(xb_ld(&bar[XB_XGEN(b.x)]) == gen, bar);
            __builtin_amdgcn_fence(__ATOMIC_ACQUIRE, "agent");
            asm volatile("s_waitcnt vmcnt(0)" ::: "memory");
        }
    }
    __syncthreads();
}

__device__ __forceinline__ void xcd_local_barrier(const XcdBarrier& b) {
    asm volatile("s_waitcnt vmcnt(0)" ::: "memory");
    __syncthreads();
    if (threadIdx.x == 0) {
        unsigned* bar = b.bar;
        __builtin_amdgcn_s_waitcnt(0);
        const unsigned nloc = b.st[0];
        const unsigned old = xb_add(&bar[XB_LSUB(b.x)], 1u);
        const unsigned gen = old / nloc;
        if (old + 1u == (gen + 1u) * nloc) xb_add(&bar[XB_LGEN(b.x)], 1u);
        else XB_SPIN(xb_ld(&bar[XB_LGEN(b.x)]) == gen, bar);
        __builtin_amdgcn_fence(__ATOMIC_ACQUIRE, "agent");
        asm volatile("s_waitcnt vmcnt(0)" ::: "memory");
    }
    __syncthreads();
}

struct Args {
    const float *x, *c, *norm_gain, *w_ada, *b_ada, *w_a_in, *conv_w, *w_a_out, *w_qg, *q_gain, *w_o, *kv_norm_gain, *w_ada_kv, *b_ada_kv, *w_kv, *k_gain, *cmp_pe, *cmp_w1, *cmp_w2, *w_mlp1, *w_mlp2;
    float* out; unsigned char* ws; int ph_lo, ph_hi;
};

__device__ __forceinline__ void transpose_item(const float* W, int ldn, int srccol, int nvalid, int k0, bf16_t* WT, int Kd, int drow0, LAS float* scr, int lane) {
    if (nvalid == 32) {
        f32x4 t[8];
#pragma unroll
        for (int i = 0; i < 8; ++i) t[i] = __builtin_nontemporal_load((const f32x4*)(W + (size_t)(k0 + 8 * i + (lane >> 3)) * ldn + srccol + (lane & 7) * 4));
#pragma unroll
        for (int i = 0; i < 8; ++i) { LAS float* d = scr + (8 * i + (lane >> 3)) * 33 + (lane & 7) * 4; d[0] = t[i][0]; d[1] = t[i][1]; d[2] = t[i][2]; d[3] = t[i][3]; }
    } else {
#pragma unroll 8
        for (int i = 0; i < 32; ++i) { const int kk = 2 * i + (lane >> 5), n = lane & 31; scr[kk * 33 + n] = (n < nvalid) ? W[(size_t)(k0 + kk) * ldn + srccol + n] : 0.f; }
    }
    LDS_WAIT(); asm volatile("" ::: "memory");
    const int ch = lane & 7;
#pragma unroll
    for (int j = 0; j < 4; ++j) { const int n = (lane >> 3) + 8 * j; const LAS float* s = scr + (8 * ch) * 33 + n;
        u32x4 o; o.x = cvtpk(s[0 * 33], s[1 * 33]); o.y = cvtpk(s[2 * 33], s[3 * 33]); o.z = cvtpk(s[4 * 33], s[5 * 33]); o.w = cvtpk(s[6 * 33], s[7 * 33]);
        *(u32x4*)(WT + (size_t)(drow0 + n) * Kd + k0 + 8 * ch) = o; }
    LDS_WAIT(); asm volatile("" ::: "memory");
}
__device__ __forceinline__ int perm_head_cols(int d) { const int t = d >> 8, p = d & 255; return 256 * t + 64 * ((p >> 5) & 3) + 32 * (p >> 7) + (p & 31); }

constexpr int TI_AIN = 1536, TI_AOUT = 512, TI_M1 = 2048, TI_M2 = 2048, TI_KV = 768, TI_QG = 640, TI_O = 512, TI_C1 = 256, TI_C2 = 8;
constexpr int TI_TOTAL = TI_AIN + TI_AOUT + 2 * TI_M1 + 2 * TI_M2 + TI_KV + TI_QG + TI_O + 2 * TI_C1 + 2 * TI_C2;

__device__ __forceinline__ void p0_item(const Args& a, int it, LAS float* scr, int lane) {
    unsigned char* ws = a.ws;
    int r = it;
    if (r < TI_AIN) { const int kb = r / 96, nb = r % 96, d = 32 * nb; int src;
        if (d < 1024) src = d; else { const int t = (d - 1024) >> 8, p = (d - 1024) & 255; src = (p < 128) ? (1024 + 128 * t + p) : (2048 + 128 * t + (p - 128)); }
        transpose_item(a.w_a_in, 3072, src, 32, 64 * kb, (bf16_t*)(ws + WS_WAIN), 1024, d, scr, lane); return; }
    r -= TI_AIN;
    if (r < TI_AOUT) { const int kb = r / 32, nb = r % 32; transpose_item(a.w_a_out, 1024, 32 * nb, 32, 64 * kb, (bf16_t*)(ws + WS_WAOUT), 1024, 32 * nb, scr, lane); return; }
    r -= TI_AOUT;
    if (r < 2 * TI_M1) { const int L = r / TI_M1, q = r % TI_M1, kb = q / 128, nb = q % 128;
        transpose_item(a.w_mlp1 + (size_t)L * DM * FF, FF, 32 * nb, 32, 64 * kb, (bf16_t*)(ws + WS_WM1) + (size_t)L * FF * DM, DM, 32 * nb, scr, lane); return; }
    r -= 2 * TI_M1;
    if (r < 2 * TI_M2) { const int L = r / TI_M2, q = r % TI_M2, kb = q / 32, nb = q % 32;
        transpose_item(a.w_mlp2 + (size_t)L * FF * DM, DM, 32 * nb, 32, 64 * kb, (bf16_t*)(ws + WS_WM2) + (size_t)L * DM * FF, FF, 32 * nb, scr, lane); return; }
    r -= 2 * TI_M2;
    if (r < TI_KV) { const int kb = r / 48, nb = r % 48, d = 32 * nb;
        transpose_item(a.w_kv, 1536, perm_head_cols(d), 32, 64 * kb, (bf16_t*)(ws + WS_WKVQ), DM, d, scr, lane); return; }
    r -= TI_KV;
    if (r < TI_QG) { const int kb = r / 40, nb = r % 40, d = 32 * nb; int src, nv = 32;
        if (d < 1024) src = perm_head_cols(d); else { const int p = d - 1024; src = 1024 + p; nv = 48 - p; nv = nv < 0 ? 0 : (nv > 32 ? 32 : nv); if (nv == 0) src = 0; }
        transpose_item(a.w_qg, 1072, src, nv, 64 * kb, (bf16_t*)(ws + WS_WKVQ), DM, 1536 + d, scr, lane); return; }
    r -= TI_QG;
    if (r < TI_O) { const int kb = r / 32, nb = r % 32; transpose_item(a.w_o, 1024, 32 * nb, 32, 64 * kb, (bf16_t*)(ws + WS_WO), 1024, 32 * nb, scr, lane); return; }
    r -= TI_O;
    if (r < 2 * TI_C1) { const int kv = r / TI_C1, q = r % TI_C1, kb = q / 8, nb = q % 8;
        transpose_item(a.cmp_w1 + (size_t)kv * 2048 * 256, 256, 32 * nb, 32, 64 * kb, (bf16_t*)(ws + WS_WC1) + (size_t)kv * 256 * 2048, 2048, 32 * nb, scr, lane); return; }
    r -= 2 * TI_C1;
    { const int kv = r / TI_C2, q = r % TI_C2, kb = q / 2, nb = q % 2;
        transpose_item(a.cmp_w2 + (size_t)kv * 256 * 64, 64, 32 * nb, 32, 64 * kb, (bf16_t*)(ws + WS_WC2) + (size_t)kv * 64 * 256, 256, 32 * nb, scr, lane); }
}

__device__ __forceinline__ void p0_mods(const Args& a, LAS unsigned char* lds, int vblk, int G) {
    LAS float* cact = (LAS float*)lds;
    LAS float* red = (LAS float*)(lds + 32768);
    const int tid = threadIdx.x, lane = tid & 63, wave = tid >> 6;
    bool have = false;
    for (int u = vblk; u < 224; u += G) {
        if (!have) { for (int i = tid; i < 8 * DM; i += 512) { const float cv = a.c[i]; cact[i] = cv / (1.0f + __expf(-cv)); } have = true; }
        __syncthreads();
        const int col = u * 64 + lane;
        const float* W; const float* bias; float* dst; int N, c0;
        if (col < 6144) { W = a.w_ada; bias = a.b_ada; dst = (float*)(a.ws + WS_MOD0); N = 6144; c0 = col; }
        else if (col < 12288) { W = a.w_ada + (size_t)DM * 6144; bias = a.b_ada + 6144; dst = (float*)(a.ws + WS_MOD1); N = 6144; c0 = col - 6144; }
        else { W = a.w_ada_kv; bias = a.b_ada_kv; dst = (float*)(a.ws + WS_MODKV); N = 2048; c0 = col - 12288; }
        float acc[8];
#pragma unroll
        for (int b = 0; b < 8; ++b) acc[b] = 0.f;
        const float* wp = W + (size_t)(wave * 128) * N + c0;
        const LAS float* cp = cact + wave * 128;
#pragma unroll 8
        for (int k = 0; k < 128; ++k) { const float w = __builtin_nontemporal_load(wp + (size_t)k * N);
#pragma unroll
            for (int b = 0; b < 8; ++b) acc[b] += w * cp[b * DM + k]; }
#pragma unroll
        for (int b = 0; b < 8; ++b) red[(wave * 8 + b) * 64 + lane] = acc[b];
        __syncthreads();
        { const int b = wave; float sacc = bias[c0];
#pragma unroll
          for (int w = 0; w < 8; ++w) sacc += red[(w * 8 + b) * 64 + lane];
          dst[(size_t)b * N + c0] = sacc; }
        __syncthreads();
    }
    __syncthreads();
}

__device__ __forceinline__ void p1_norm_row2(const Args& a, int m0, int lane) {
    const int b = m0 >> 11;
    const float* mod0 = (const float*)(a.ws + WS_MOD0) + (size_t)b * 6144;
    const f32x4* xr = (const f32x4*)(a.x + (size_t)m0 * DM) + lane;
    f32x4 v[2][4]; float s0 = 0.f, s1 = 0.f;
#pragma unroll
    for (int j = 0; j < 4; ++j) { v[0][j] = __builtin_nontemporal_load(xr + 64 * j); v[1][j] = __builtin_nontemporal_load(xr + 256 + 64 * j); }
#pragma unroll
    for (int j = 0; j < 4; ++j) { s0 += (v[0][j][0] * v[0][j][0] + v[0][j][1] * v[0][j][1]) + (v[0][j][2] * v[0][j][2] + v[0][j][3] * v[0][j][3]);
                                  s1 += (v[1][j][0] * v[1][j][0] + v[1][j][1] * v[1][j][1]) + (v[1][j][2] * v[1][j][2] + v[1][j][3] * v[1][j][3]); }
#pragma unroll
    for (int o = 1; o < 64; o <<= 1) { s0 += __shfl_xor(s0, o); s1 += __shfl_xor(s1, o); }
    const float r0 = rsqrtf(s0 * (1.0f / DM) + EPS), r1 = rsqrtf(s1 * (1.0f / DM) + EPS);
    u32x2* o8 = (u32x2*)((bf16_t*)(a.ws + WS_A2) + (size_t)m0 * DM) + lane;
#pragma unroll
    for (int j = 0; j < 4; ++j) { const int col = 4 * lane + 256 * j;
        const f32x4 gn = *(const f32x4*)(a.norm_gain + col), sh = *(const f32x4*)(mod0 + col), sc = *(const f32x4*)(mod0 + 1024 + col) + 1.0f;
        const f32x4 h0 = (v[0][j] * r0 * gn) * sc + sh, h1 = (v[1][j] * r1 * gn) * sc + sh;
        u32x2 w; w.x = cvtpk(h0[0], h0[1]); w.y = cvtpk(h0[2], h0[3]); o8[64 * j] = w;
        w.x = cvtpk(h1[0], h1[1]); w.y = cvtpk(h1[2], h1[3]); o8[256 + 64 * j] = w; }
}
__device__ __forceinline__ void p1_bias_task(const bf16_t* Wt, int n0, const float* shift, int shift_stride, float* bias, int bias_stride, int lane) {
    const int r = lane & 15, kq = lane >> 4;
    const bf16_t* wp = Wt + (size_t)(n0 + r) * DM + 8 * kq;
    const float* sp = shift + (size_t)(r & 7) * shift_stride + 8 * kq;
    f32x4 acc = (f32x4){0.f, 0.f, 0.f, 0.f};
#pragma unroll 8
    for (int k0 = 0; k0 < DM; k0 += 32) {
        const bf16x8 bf = *(const bf16x8*)(wp + k0);
        const f32x4 s0 = *(const f32x4*)(sp + k0), s1 = *(const f32x4*)(sp + k0 + 4);
        u32x4 aw; aw.x = cvtpk(s0[0], s0[1]); aw.y = cvtpk(s0[2], s0[3]); aw.z = cvtpk(s1[0], s1[1]); aw.w = cvtpk(s1[2], s1[3]);
        if (r >= 8) aw = (u32x4){0u, 0u, 0u, 0u};
        acc = __builtin_amdgcn_mfma_f32_16x16x32_bf16(__builtin_bit_cast(bf16x8, aw), bf, acc, 0, 0, 0);
    }
    if (kq < 2) {
#pragma unroll
        for (int e = 0; e < 4; ++e) bias[(size_t)(4 * kq + e) * bias_stride + n0 + r] = acc[e];
    }
}
__device__ __forceinline__ void p1_pebias(const Args& a, int idx, int lane) {
    const int kv = idx >> 8;
    const bf16_t* wrow = (const bf16_t*)(a.ws + WS_WC1) + (size_t)idx * 2048;
    const float* pe = a.cmp_pe + (size_t)kv * 2048;
    float d = 0.f;
#pragma unroll
    for (int j = 0; j < 4; ++j) { const int k = (lane + 64 * j) * 8; const u32x4 w = *(const u32x4*)(wrow + k); const f32x4 p0 = *(const f32x4*)(pe + k), p1 = *(const f32x4*)(pe + k + 4);
        d += p0[0] * bf_lo(w.x) + p0[1] * bf_hi(w.x) + p0[2] * bf_lo(w.y) + p0[3] * bf_hi(w.y) + p1[0] * bf_lo(w.z) + p1[1] * bf_hi(w.z) + p1[2] * bf_lo(w.w) + p1[3] * bf_hi(w.w); }
    d = wave_sum(d);
    if (lane == 0) ((float*)(a.ws + WS_PEB))[idx] = d;
}

__device__ __forceinline__ void unpack8(const u32x4 w, float (&f)[8]) { f[0] = bf_lo(w.x); f[1] = bf_hi(w.x); f[2] = bf_lo(w.y); f[3] = bf_hi(w.y); f[4] = bf_lo(w.z); f[5] = bf_hi(w.z); f[6] = bf_lo(w.w); f[7] = bf_hi(w.w); }
__device__ __forceinline__ void p3_conv(const Args& a, int gtid, int nthreads) {
    for (int it0 = gtid; it0 < 128 * 2048; it0 += nthreads) {
        const int pass = it0 / nthreads, vt = it0 - pass * nthreads;
        const int it = (nthreads == 131072) ? ((vt >> 14) * 32768 + pass * 16384 + (vt & 16383)) : it0;
        const int cch = it & 127, rch = it >> 7, col = cch * 8, r0 = (rch * 8) & (SEQ - 1);
        unsigned char* slab = a.ws + WS_R + (size_t)((rch * 8) >> 11) * SLAB;
        const bf16_t* GB = (const bf16_t*)(slab + SO_GB); const bf16_t* V = (const bf16_t*)(slab + SO_V); bf16_t* Y = (bf16_t*)(slab + SO_Y);
        float w0[8], w1[8], w2[8];
        { const f32x4 t0 = *(const f32x4*)(a.conv_w + col), t1 = *(const f32x4*)(a.conv_w + col + 4); w0[0] = t0[0]; w0[1] = t0[1]; w0[2] = t0[2]; w0[3] = t0[3]; w0[4] = t1[0]; w0[5] = t1[1]; w0[6] = t1[2]; w0[7] = t1[3]; }
        { const f32x4 t0 = *(const f32x4*)(a.conv_w + 1024 + col), t1 = *(const f32x4*)(a.conv_w + 1024 + col + 4); w1[0] = t0[0]; w1[1] = t0[1]; w1[2] = t0[2]; w1[3] = t0[3]; w1[4] = t1[0]; w1[5] = t1[1]; w1[6] = t1[2]; w1[7] = t1[3]; }
        { const f32x4 t0 = *(const f32x4*)(a.conv_w + 2048 + col), t1 = *(const f32x4*)(a.conv_w + 2048 + col + 4); w2[0] = t0[0]; w2[1] = t0[1]; w2[2] = t0[2]; w2[3] = t0[3]; w2[4] = t1[0]; w2[5] = t1[1]; w2[6] = t1[2]; w2[7] = t1[3]; }
        float vm2[8], vm1[8];
        if ((r0 & (SEQ - 1)) != 0) { unpack8(*(const u32x4*)(V + (size_t)(r0 - 2) * DM + col), vm2); unpack8(*(const u32x4*)(V + (size_t)(r0 - 1) * DM + col), vm1); }
        else {
#pragma unroll
            for (int e = 0; e < 8; ++e) { vm2[e] = 0.f; vm1[e] = 0.f; } }
#pragma unroll
        for (int i = 0; i < 8; ++i) { float vc[8], gb[8], y[8];
            unpack8(*(const u32x4*)(V + (size_t)(r0 + i) * DM + col), vc); unpack8(*(const u32x4*)(GB + (size_t)(r0 + i) * DM + col), gb);
#pragma unroll
            for (int e = 0; e < 8; ++e) { y[e] = gb[e] * (w2[e] * vc[e] + w1[e] * vm1[e] + w0[e] * vm2[e]); vm2[e] = vm1[e]; vm1[e] = vc[e]; }
            u32x4 w; w.x = cvtpk(y[0], y[1]); w.y = cvtpk(y[2], y[3]); w.z = cvtpk(y[4], y[5]); w.w = cvtpk(y[6], y[7]);
            *(u32x4*)(Y + (size_t)(r0 + i) * DM + col) = w; }
    }
}

__device__ __forceinline__ float gelu_tanh(float x) {
    const float z = 0.7978845608028654f * (x + 0.044715f * x * x * x);
    const float e = __builtin_amdgcn_exp2f(z * 2.8853900817779268f);
    const float th = 1.0f - 2.0f / (e + 1.0f);
    return 0.5f * x * (1.0f + th);
}
constexpr int C_CH = 2064;
constexpr int C_RB0 = 68608;
constexpr int C_HOFF = C_RB0, C_HROW = 528;
__device__ __forceinline__ void p8_unit(const Args& a, int u, LAS unsigned char* lds) {
    const int tid = threadIdx.x, lane = tid & 63, wid = __builtin_amdgcn_readfirstlane(tid >> 6), r = lane & 31, h = lane >> 5;
    const int kv = u >> 7, bg = (u >> 2) & 31, rq = u & 3;
    unsigned char* slab = a.ws + WS_R + (size_t)(bg >> 2) * SLAB;
    const bf16_t* src = (const bf16_t*)(slab + SO_KV) + ((size_t)(kv * 4 + (bg & 3)) * SEQ + 512 * rq) * 64;
    __syncthreads();
    { u32x4 v[8];
#pragma unroll
      for (int j = 0; j < 8; ++j) v[j] = *(const u32x4*)(src + (size_t)(tid + 512 * j) * 8);
      u32x4 vl = (u32x4){0u, 0u, 0u, 0u};
      if (tid < 128 && rq != 3) vl = *(const u32x4*)(src + (size_t)32 * 1024 + tid * 8);
#pragma unroll
      for (int j = 0; j < 8; ++j) { const int idx = tid + 512 * j; *(LAS u32x4*)(lds + (idx >> 7) * C_CH + (idx & 127) * 16) = v[j]; }
      if (tid < 128) *(LAS u32x4*)(lds + 32 * C_CH + tid * 16) = vl; }
    __syncthreads();
    f32x16 acc = f32x16{};
    const unsigned lds0 = (unsigned)(size_t)lds;
    const bf16_t* Wsrc = (const bf16_t*)(a.ws + WS_WC1) + (size_t)(kv * 256) * 2048;
    const int drow = 16 * wid + (lane >> 2);
    const bf16_t* dsrc0 = Wsrc + (size_t)drow * 2048 + 8 * ((lane & 3) ^ ((drow >> 2) & 3));
    const bf16_t* dsrc1 = dsrc0 + (size_t)128 * 2048;
    const unsigned ddst0 = lds0 + C_RB0 + wid * 1024, ddst1 = ddst0 + 8192;
    const int brow = 32 * wid + r;
    const unsigned boff = C_RB0 + brow * 64, bkey = (brow >> 2) & 3;
#define P8_DMA(stg) do { att::glds16(dsrc0 + 32 * (stg), (unsigned)__builtin_amdgcn_readfirstlane(ddst0 + ((stg) & 3) * 16384)); att::glds16(dsrc1 + 32 * (stg), (unsigned)__builtin_amdgcn_readfirstlane(ddst1 + ((stg) & 3) * 16384)); } while (0)
#define P8_STEP(stg, WAITN) do { asm volatile("s_waitcnt vmcnt(" #WAITN ") lgkmcnt(0)\n\ts_barrier" ::: "memory"); \
        if ((stg) + 3 < 64) P8_DMA((stg) + 3); \
        { const LAS unsigned char* bp = lds + boff + ((stg) & 3) * 16384; \
          const LAS unsigned char* ap = lds + (r + ((stg) >> 5)) * C_CH + ((32 * (stg)) & 1023) * 2 + 16 * h; \
          const bf16x8 a0 = *(const LAS bf16x8*)ap, a1 = *(const LAS bf16x8*)(ap + 32); \
          const bf16x8 b0 = *(const LAS bf16x8*)(bp + 16 * ((unsigned)h ^ bkey)), b1 = *(const LAS bf16x8*)(bp + 16 * ((unsigned)(2 + h) ^ bkey)); \
          acc = __builtin_amdgcn_mfma_f32_32x32x16_bf16(a0, b0, acc, 0, 0, 0); acc = __builtin_amdgcn_mfma_f32_32x32x16_bf16(a1, b1, acc, 0, 0, 0); } } while (0)
    P8_DMA(0); P8_DMA(1); P8_DMA(2);
    for (int s4 = 0; s4 < 60; s4 += 4) { P8_STEP(s4, 4); P8_STEP(s4 + 1, 4); P8_STEP(s4 + 2, 4); P8_STEP(s4 + 3, 4); }
    P8_STEP(60, 4); P8_STEP(61, 4); P8_STEP(62, 2); P8_STEP(63, 0);
    asm volatile("s_waitcnt lgkmcnt(0)\n\ts_barrier" ::: "memory");
#undef P8_DMA
#undef P8_STEP
    { const float pb = ((const float*)(a.ws + WS_PEB))[kv * 256 + 32 * wid + r];
      LAS bf16_t* H = (LAS bf16_t*)(lds + C_HOFF);
#pragma unroll
      for (int rg = 0; rg < 16; ++rg) { const int row = att::crow(rg, h); H[row * (C_HROW / 2) + 32 * wid + r] = (bf16_t)(cvtpk(gelu_tanh(acc[rg] + pb), 0.f) & 0xffffu); } }
    __syncthreads();
    if (wid == 0) {
        f32x16 o0 = f32x16{}, o1 = f32x16{};
        const bf16_t* W2 = (const bf16_t*)(a.ws + WS_WC2) + (size_t)kv * 64 * 256;
#pragma unroll
        for (int s = 0; s < 16; ++s) {
            const bf16x8 af = *(const LAS bf16x8*)(lds + C_HOFF + r * C_HROW + (16 * s + 8 * h) * 2);
            const bf16x8 b0 = *(const bf16x8*)(W2 + (size_t)r * 256 + 16 * s + 8 * h), b1 = *(const bf16x8*)(W2 + (size_t)(32 + r) * 256 + 16 * s + 8 * h);
            o0 = __builtin_amdgcn_mfma_f32_32x32x16_bf16(af, b0, o0, 0, 0, 0); o1 = __builtin_amdgcn_mfma_f32_32x32x16_bf16(af, b1, o1, 0, 0, 0);
        }
        const float gk0 = a.k_gain[r], gk1 = a.k_gain[32 + r];
        bf16_t* dst = (bf16_t*)(slab + (kv == 0 ? SO_KC : SO_VC)) + (size_t)(bg & 3) * 8192;
#pragma unroll
        for (int rg = 0; rg < 16; ++rg) { float v0 = o0[rg], v1 = o1[rg];
            if (kv == 0) { float ss = v0 * v0 + v1 * v1;
#pragma unroll
                for (int sft = 1; sft < 32; sft <<= 1) ss += __shfl_xor(ss, sft);
                const float rs = rsqrtf(ss * (1.0f / 64.0f) + EPS); v0 *= rs * gk0; v1 *= rs * gk1; }
            const int n = 32 * rq + att::crow(rg, h);
            if (n == 127) { v0 = 0.f; v1 = 0.f; }
            dst[n * 64 + r] = (bf16_t)(cvtpk(v0, 0.f) & 0xffffu); dst[n * 64 + 32 + r] = (bf16_t)(cvtpk(v1, 0.f) & 0xffffu); }
    }
}

__device__ __forceinline__ void p4_fixup(const Args& a, int pm) {
    const int tid = threadIdx.x;
    if (tid < 256) {
        const int rr = tid >> 7, cc = (tid & 127) * 8, pml = pm & 7, srow = pml * 256 + rr;
        unsigned char* slab = a.ws + WS_R + (size_t)(pm >> 3) * SLAB;
        const bf16_t* V = (const bf16_t*)(slab + SO_V); const bf16_t* GBH = (const bf16_t*)(slab + SO_GB) + (size_t)pml * 2 * DM; bf16_t* Y = (bf16_t*)(slab + SO_Y);
        float gb[8], v0[8], v1[8], v2[8], y[8];
        unpack8(*(const u32x4*)(GBH + (size_t)rr * DM + cc), gb);
        unpack8(*(const u32x4*)(V + (size_t)srow * DM + cc), v0);
        if (srow >= 1) unpack8(*(const u32x4*)(V + (size_t)(srow - 1) * DM + cc), v1); else {
#pragma unroll
            for (int e = 0; e < 8; ++e) v1[e] = 0.f; }
        if (srow >= 2) unpack8(*(const u32x4*)(V + (size_t)(srow - 2) * DM + cc), v2); else {
#pragma unroll
            for (int e = 0; e < 8; ++e) v2[e] = 0.f; }
#pragma unroll
        for (int e = 0; e < 8; ++e) y[e] = gb[e] * (a.conv_w[2 * DM + cc + e] * v0[e] + a.conv_w[DM + cc + e] * v1[e] + a.conv_w[cc + e] * v2[e]);
        u32x4 w; w.x = cvtpk(y[0], y[1]); w.y = cvtpk(y[2], y[3]); w.z = cvtpk(y[4], y[5]); w.w = cvtpk(y[6], y[7]);
        *(u32x4*)(Y + (size_t)srow * DM + cc) = w;
    }
}

__global__ void __launch_bounds__(NWAVES * 64, 2) yoco_fwd(Args args) {
    extern __shared__ __attribute__((aligned(16))) unsigned char lds_raw[];
    LAS unsigned char* lds = (LAS unsigned char*)lds_raw;
    const int tid = threadIdx.x, lane = tid & 63, wave = __builtin_amdgcn_readfirstlane(tid >> 6);
    const int G = gridDim.x, bx = blockIdx.x;
    int vcu = (G % 8 == 0) ? (bx % 8) * (G / 8) + bx / 8 : bx;
    int cid = bx;
    const int gw = vcu * NWAVES + wave, NGW = G * NWAVES;
    unsigned char* ws = args.ws;
    const int lo = args.ph_lo, hi = args.ph_hi;
    volatile LAS unsigned* MISC = (volatile LAS unsigned*)(lds + LDS_BYTES - 256);
    if (tid < 8) MISC[tid] = 0u;
    __syncthreads();
    XcdBarrier bar; bar.bar = (unsigned*)(ws + WS_BAR); bar.x = 0; bar.st = MISC;
    if (hi - lo > 1) bar = xcd_barrier_post((unsigned*)(ws + WS_BAR), MISC);
#define IN(k) (lo <= (k) && (k) < hi)
#define SEAM(k) do { if (IN(k) && IN((k) + 1)) xcd_barrier(bar); } while (0)
#define LSEAM(k) do { if (IN(k) && IN((k) + 1)) { if (local_ok) xcd_local_barrier(bar); else xcd_barrier(bar); } } while (0)
    bool local_ok = false;
    float* MOD0 = (float*)(ws + WS_MOD0); float* MOD1 = (float*)(ws + WS_MOD1); float* MODKV = (float*)(ws + WS_MODKV);
    float* SS1 = (float*)(ws + WS_SS1); float* SS2 = (float*)(ws + WS_SS2); float* SS3 = (float*)(ws + WS_SS3);
    bf16_t* A1 = (bf16_t*)(ws + WS_A1); bf16_t* A2 = (bf16_t*)(ws + WS_A2);
    bf16_t* HB = (bf16_t*)(ws + WS_H);

    if (IN(0)) {
        p0_mods(args, lds, vcu, G);
        LAS float* scr = (LAS float*)(lds + wave * 16384);
        for (int it = gw; it < TI_TOTAL; it += NGW) p0_item(args, it, scr, lane);
    }
    SEAM(0);
    if (IN(1)) {
        for (int m = gw; m < M_TOK / 2; m += NGW) p1_norm_row2(args, 2 * m, lane);
        for (int it = gw; it < (2 * FF + NKVQ) / 16 + 512; it += NGW) {
            const int n = it * 16;
            if (n < FF) p1_bias_task((const bf16_t*)(ws + WS_WM1), n, MOD0 + 3072, 6144, (float*)(ws + WS_BM1L0), FF, lane);
            else if (n < 2 * FF) p1_bias_task((const bf16_t*)(ws + WS_WM1) + (size_t)FF * DM, n - FF, MOD1 + 3072, 6144, (float*)(ws + WS_BM1L1), FF, lane);
            else if (n < 2 * FF + 1536) p1_bias_task((const bf16_t*)(ws + WS_WKVQ), n - 2 * FF, MODKV, 2048, (float*)(ws + WS_BKVQ), NKVQ, lane);
            else if (n < 2 * FF + NKVQ) p1_bias_task((const bf16_t*)(ws + WS_WKVQ), n - 2 * FF, MOD1, 6144, (float*)(ws + WS_BKVQ), NKVQ, lane);
            else p1_pebias(args, it - (2 * FF + NKVQ) / 16, lane);
        }
    }
    SEAM(1);
    if (hi - lo > 1 && lo <= 1) {
        local_ok = MISC[3] != 0u;
        if (local_ok) { const int x = (int)MISC[4], rk = (int)MISC[2]; vcu = x * 32 + rk; cid = rk * 8 + x; }
    }
    if (IN(2)) {
        pg8::Gemm g{A2, A2, 1 << 30, (const bf16_t*)(ws + WS_WAIN), M_TOK, 3072, DM, (size_t)SEQ * DM * 2}; pg8::StaticOrder S; S.init_ain(G, cid);
        pg8::EpiAin E{ws + WS_R, args.conv_w};
        pg8::gemm_phase(lds, g, S, E);
    }
    LSEAM(2);
    if (IN(4)) {
        pg8::Gemm g{(const bf16_t*)(ws + WS_R + SO_Y), (const bf16_t*)(ws + WS_R + SO_Y), 1 << 30, (const bf16_t*)(ws + WS_WAOUT), M_TOK, DM, DM, SLAB}; pg8::StaticOrder S; S.init(M_TOK, DM, G, cid);
        { pg8::Unit fu; for (int i = 0; S.next(i, fu); ++i) p4_fixup(args, fu.pm); asm volatile("s_waitcnt vmcnt(0)" ::: "memory"); __syncthreads(); }
        pg8::EpiRes<1, 0, 2> E{args.x, nullptr, MOD0 + 2048, 6144, args.norm_gain + 1024, MOD0 + 4096, 6144, A1, nullptr, nullptr, 0, nullptr, SS1, nullptr, nullptr, 0};
        pg8::gemm_phase(lds, g, S, E);
    }
    LSEAM(4);
    if (IN(5)) {
        pg8::Gemm g{A1, A1, 1 << 30, (const bf16_t*)(ws + WS_WM1), M_TOK, FF, DM, (size_t)SEQ * DM * 2}; pg8::StaticOrder S; S.init(M_TOK, FF, G, cid);
        pg8::EpiMlp1 E{HB, (const float*)(ws + WS_BM1L0), SS1};
        pg8::gemm_phase(lds, g, S, E);
    }
    LSEAM(5);
    if (IN(6)) {
        pg8::Gemm g{HB, HB, 1 << 30, (const bf16_t*)(ws + WS_WM2), M_TOK, DM, FF, (size_t)SEQ * FF * 2}; pg8::StaticOrder S; S.init(M_TOK, DM, G, cid);
        pg8::EpiRes<2, 2, 2> E{A1, nullptr, MOD0 + 5120, 6144, args.kv_norm_gain, MODKV + 1024, 2048, A1, args.norm_gain + 2048, MOD1 + 1024, 6144, A2, SS2, args.norm_gain + 1024, MOD0 + 4096, 6144, lds};
        pg8::gemm_phase(lds, g, S, E);
    }
    LSEAM(6);
    if (IN(7)) {
        pg8::Gemm g{A1, A2, 6, (const bf16_t*)(ws + WS_WKVQ), M_TOK, NKVQ, DM, (size_t)SEQ * DM * 2}; pg8::StaticOrder S; S.init(M_TOK, NKVQ, G, cid);
        pg8::EpiKVQ E{ws + WS_R, (const float*)(ws + WS_BKVQ), SS2, args.k_gain, args.q_gain};
        pg8::gemm_phase(lds, g, S, E);
    }
    LSEAM(7);
    if (IN(8)) { for (int v = vcu; v < 256; v += G) { const int rk = v & 31; p8_unit(args, ((rk >> 4) << 7) | ((((v >> 5) << 2) | ((rk >> 2) & 3)) << 2) | (rk & 3), lds); } __syncthreads(); }
    LSEAM(8);
    if (IN(9)) {
        for (int v = vcu; v < 256; v += G) { const int bgp = v >> 3, s = v & 7;
            for (int i = 0; i < 4; ++i) { const int qb = (i == 0) ? s : (i == 1) ? 15 - s : (i == 2) ? 16 + s : 31 - s;
                att::attn_unit(bgp >> 2, bgp & 3, qb, ws + WS_R + (size_t)(bgp >> 2) * SLAB, lds); } }
    }
    LSEAM(9);
    if (IN(10)) {
        pg8::Gemm g{(const bf16_t*)(ws + WS_R + SO_O), (const bf16_t*)(ws + WS_R + SO_O), 1 << 30, (const bf16_t*)(ws + WS_WO), M_TOK, DM, DM, SLAB}; pg8::StaticOrder S; S.init(M_TOK, DM, G, cid);
        pg8::EpiRes<1, 2, 2> E{A2, nullptr, MOD1 + 2048, 6144, args.norm_gain + 3072, MOD1 + 4096, 6144, A1, nullptr, nullptr, 0, nullptr, SS3, args.norm_gain + 2048, MOD1 + 1024, 6144, lds};
        pg8::gemm_phase(lds, g, S, E);
    }
    LSEAM(10);
    if (IN(11)) {
        pg8::Gemm g{A1, A1, 1 << 30, (const bf16_t*)(ws + WS_WM1) + (size_t)FF * DM, M_TOK, FF, DM, (size_t)SEQ * DM * 2}; pg8::StaticOrder S; S.init(M_TOK, FF, G, cid);
        pg8::EpiMlp1 E{HB, (const float*)(ws + WS_BM1L1), SS3};
        pg8::gemm_phase(lds, g, S, E);
    }
    LSEAM(11);
    if (IN(12)) {
        pg8::Gemm g{HB, HB, 1 << 30, (const bf16_t*)(ws + WS_WM2) + (size_t)DM * FF, M_TOK, DM, FF, (size_t)SEQ * FF * 2}; pg8::StaticOrder S; S.init(M_TOK, DM, G, cid);
        pg8::EpiRes<0, 2, 0> E{A1, args.out, MOD1 + 5120, 6144, nullptr, nullptr, 0, nullptr, nullptr, nullptr, 0, nullptr, nullptr, args.norm_gain + 3072, MOD1 + 4096, 6144, lds};
        pg8::gemm_phase(lds, g, S, E);
    }
#undef IN
#undef SEAM
}

extern "C" void kernel_launch(void* const* d_in, const int* in_sizes, int n_in, void* d_out, int out_size, void* d_ws, size_t ws_size, hipStream_t stream) {
    static int grid = 0;
    if (grid == 0) {
        if (n_in != 21 || in_sizes[0] != M_TOK * DM || out_size != M_TOK * DM || ws_size < WS_END) { fprintf(stderr, "kernel_launch: unexpected shapes (n_in %d, in0 %d, out %d, ws %zu); nothing launched\n", n_in, n_in > 0 ? in_sizes[0] : -1, out_size, ws_size); grid = -1; return; }
        int dev = 0, cus = 0, per_cu = 0;
        if (hipGetDevice(&dev) != hipSuccess || hipDeviceGetAttribute(&cus, hipDeviceAttributeMultiprocessorCount, dev) != hipSuccess) { grid = -1; return; }
        if (hipFuncSetAttribute((const void*)yoco_fwd, hipFuncAttributeMaxDynamicSharedMemorySize, LDS_BYTES) != hipSuccess) { fprintf(stderr, "kernel_launch: hipFuncSetAttribute failed\n"); grid = -1; return; }
        if (hipOccupancyMaxActiveBlocksPerMultiprocessor(&per_cu, (const void*)yoco_fwd, NWAVES * 64, LDS_BYTES) != hipSuccess || per_cu < 1) { fprintf(stderr, "kernel_launch: occupancy query says %d blocks per CU\n", per_cu); per_cu = 1; }
        (void)hipGetLastError();
        grid = cus;
        if (grid != 256) { fprintf(stderr, "kernel_launch: this build deals the w_a_in tiles to exactly 256 workgroups (device has %d CUs); nothing launched\n", cus); grid = -1; return; }
    }
    if (grid < 0) return;
    (void)hipMemsetAsync((char*)d_ws + WS_ZERO, 0, ZERO_BYTES, stream);
    Args a{};
    a.x = (const float*)d_in[0]; a.c = (const float*)d_in[1]; a.norm_gain = (const float*)d_in[2]; a.w_ada = (const float*)d_in[3]; a.b_ada = (const float*)d_in[4];
    a.w_a_in = (const float*)d_in[5]; a.conv_w = (const float*)d_in[6]; a.w_a_out = (const float*)d_in[7]; a.w_qg = (const float*)d_in[8]; a.q_gain = (const float*)d_in[9];
    a.w_o = (const float*)d_in[10]; a.kv_norm_gain = (const float*)d_in[11]; a.w_ada_kv = (const float*)d_in[12]; a.b_ada_kv = (const float*)d_in[13]; a.w_kv = (const float*)d_in[14];
    a.k_gain = (const float*)d_in[15]; a.cmp_pe = (const float*)d_in[16]; a.cmp_w1 = (const float*)d_in[17]; a.cmp_w2 = (const float*)d_in[18]; a.w_mlp1 = (const float*)d_in[19]; a.w_mlp2 = (const float*)d_in[20];
    a.out = (float*)d_out; a.ws = (unsigned char*)d_ws;
#if MK_N_LAUNCHES == 1
    a.ph_lo = 0; a.ph_hi = N_PHASES;
    void* kargs[] = {&a};
    hipError_t e = hipLaunchCooperativeKernel((const void*)yoco_fwd, dim3(grid), dim3(NWAVES * 64), kargs, LDS_BYTES, stream);
    if (e != hipSuccess) fprintf(stderr, "kernel_launch: cooperative launch failed: %s (grid %d)\n", hipGetErrorString(e), grid);
#else
    for (int p = 0; p < N_PHASES; ++p) { a.ph_lo = p; a.ph_hi = p + 1; hipLaunchKernelGGL(yoco_fwd, dim3(grid), dim3(NWAVES * 64), LDS_BYTES, stream, a); }
#endif
}
```

```cpp
#include <hip/hip_runtime.h>
#include <cstdio>
#include <cstdint>
#include <cmath>

#ifndef MK_N_LAUNCHES
#define MK_N_LAUNCHES 1
#endif
constexpr int N_PHASES = 13;

#define LAS __attribute__((address_space(3)))
typedef unsigned short bf16_t;
typedef short bf16x8 __attribute__((ext_vector_type(8)));
typedef short s16x4 __attribute__((ext_vector_type(4)));
typedef float f32x2 __attribute__((ext_vector_type(2)));
typedef float f32x4 __attribute__((ext_vector_type(4)));
typedef float f32x16 __attribute__((ext_vector_type(16)));
typedef unsigned u32x4 __attribute__((ext_vector_type(4)));
typedef unsigned u32x2 __attribute__((ext_vector_type(2)));
typedef __bf16 bf16x2_t __attribute__((ext_vector_type(2)));

constexpr int BATCH = 8, SEQ = 2048, DM = 1024, FF = 4096, M_TOK = BATCH * SEQ;
constexpr int NKVQ = 2816;
constexpr float EPS = 1e-6f;
constexpr float QSCALE = 0.125f * 1.4426950408889634f;

constexpr size_t MiB = 1u << 20;
constexpr size_t WS_ZERO = 0, ZERO_BYTES = 1 * MiB;
constexpr size_t WS_MOD0 = 0, WS_MOD1 = 196608, WS_MODKV = 393216;
constexpr size_t WS_SS1 = 524288, WS_SS2 = 589824, WS_SS3 = 655360;
constexpr size_t WS_BAR = 786432;
constexpr size_t WS_BM1L0 = 1 * MiB, WS_BM1L1 = WS_BM1L0 + 131072, WS_BKVQ = WS_BM1L1 + 131072, WS_PEB = WS_BKVQ + 131072, WS_WC2 = WS_PEB + 4096;
constexpr size_t WS_WAIN = 2 * MiB, WS_WAOUT = 8 * MiB, WS_WM1 = 10 * MiB  , WS_WM2 = 26 * MiB  , WS_WKVQ = 42 * MiB, WS_WO = 48 * MiB, WS_WC1 = 50 * MiB;
constexpr size_t WS_R = 56 * MiB;
constexpr size_t SLAB = 16 * MiB;
constexpr size_t SO_GB = 0, SO_V = 4 * MiB, SO_Y = 8 * MiB;
constexpr size_t WS_H = WS_R;
constexpr size_t SO_Q = 0, SO_KV = 4 * MiB  , SO_O = 10 * MiB, SO_GATES = 14 * MiB  , SO_KC = 14 * MiB + 512 * 1024  , SO_VC = SO_KC + 65536;
constexpr size_t WS_A1 = 184 * MiB, WS_A2 = 216 * MiB, WS_END = 248 * MiB;

constexpr int LDS_BYTES = 147456;
constexpr int NWAVES = 8;

__device__ __forceinline__ unsigned cvtpk(float lo, float hi) { f32x2 v = {lo, hi}; bf16x2_t b = __builtin_convertvector(v, bf16x2_t); return __builtin_bit_cast(unsigned, b); }
__device__ __forceinline__ float bf_lo(unsigned u) { return __builtin_bit_cast(float, u << 16); }
__device__ __forceinline__ float bf_hi(unsigned u) { return __builtin_bit_cast(float, u & 0xffff0000u); }
__device__ __forceinline__ float wave_sum(float v) {
#pragma unroll
    for (int o = 1; o < 64; o <<= 1) v += __shfl_xor(v, o);
    return v;
}
#define LDS_WAIT() asm volatile("s_waitcnt lgkmcnt(0)" ::: "memory")
#define LAUNDER(x) asm volatile("" : "+v"(x))

namespace pg8 {
constexpr int BM = 256, BK = 64, HALF = 128, HTB = HALF * BK * 2, STAGE_BYTES = 8 * HTB, NXCD = 8, WGM = 8;
__host__ __device__ __forceinline__ int lds_byte(int r, int c) { const int st = (r >> 4) * 2 + (c >> 5), rr = r & 15, cc = c & 31, ob = rr * 64 + cc * 2; return st * 1024 + (ob ^ (((ob >> 9) & 1) << 5)); }
__host__ __device__ __forceinline__ void stage_rc(int b, int& R, int& C) { const int st = b / 1024, sb = b % 1024, swz = sb ^ (((sb >> 9) & 1) << 5); R = (st >> 1) * 16 + swz / 64; C = (st & 1) * 32 + (swz % 64) / 2; }
__host__ __device__ __forceinline__ int perm32(int rho) { const int n = rho >> 4, i = rho & 15; return 8 * (i >> 2) + 4 * n + (i & 3); }

struct Unit { int pm, pn; };
struct Gemm { const bf16_t* A; const bf16_t* A2; int pn_split; const bf16_t* Bt; int M, N, K; size_t abatch; };

struct StaticOrder {
    int nM, nN, nwg, G, c, ain;
    __device__ void init(int M, int N, int G_, int c_) { nM = M / BM; nN = N / BM; nwg = nM * nN; G = G_; c = c_; ain = 0; }
    __device__ void init_ain(int G_, int c_) { init(M_TOK, 3072, G_, c_); ain = 1; }
    __device__ bool next(int i, Unit& u) const {
        if (ain) { if (i >= 3) return false; const int x = c & 7, rk = c >> 3, p = rk >> 3; u.pm = 8 * x + (rk & 7); u.pn = (i == 2) ? p : 4 + 2 * p + i; return true; }
        const long L = (long)i * G + c; if (L >= nwg) return false;
        int wgid = (int)L; { const int q = nwg / NXCD, r = nwg % NXCD, xcd = wgid % NXCD, off = wgid / NXCD; wgid = (xcd < r ? xcd * (q + 1) : r * (q + 1) + (xcd - r) * q) + off; }
        const int nig = WGM * nN, gid = wgid / nig, fm = gid * WGM, gsz = (nM - fm) < WGM ? (nM - fm) : WGM;
        u.pm = fm + ((wgid % nig) % gsz); u.pn = (wgid % nig) / gsz; return true;
    }
};

template <class Epi>
__device__ __forceinline__ void gemm_phase(LAS unsigned char* lds, const Gemm g, const StaticOrder& S, const Epi& E) {
    const int tid = threadIdx.x, wid = __builtin_amdgcn_readfirstlane(tid >> 6), lane = tid & 63, wr = wid >> 2, wc = wid & 3, fr = lane & 15, fq = lane >> 4;
    const int K = g.K, nt = K / BK;
    unsigned voffA[2], voffB[2];
#pragma unroll
    for (int i = 0; i < 2; ++i) { int R, C; stage_rc(tid * 16 + i * 8192, R, C); const int Rb = Epi::PERM ? ((R & ~31) + perm32(R & 31)) : R;
        voffA[i] = (unsigned)(R * K + C) * 2u; voffB[i] = (unsigned)(Rb * K + C) * 2u; }
    const size_t kstep = (size_t)(BK * 2);
    const size_t hstep = (size_t)HALF * K * 2;
    const size_t tstep = 2 * hstep;
    const unsigned ldsw = (unsigned)wid * 1024u;
    const int aoff = lds_byte(wr * 64 + fr, fq * 8), boff = lds_byte(wc * 32 + fr, fq * 8);
#define PG8_SA(b, h) (((b) * 2 + (h)) * HTB)
#define PG8_SB(b, h) ((4 + (b) * 2 + (h)) * HTB)
#define PG8_STAGE(bufoff, gbase, voff) do { _Pragma("unroll") for (int _i = 0; _i < 2; ++_i) \
        __builtin_amdgcn_global_load_lds((const unsigned*)((const char*)(gbase) + (voff)[_i]), (LAS unsigned*)(lds + (bufoff) + ldsw + _i * 8192), 16, 0, 0); } while (0)
#define PG8_LDA(dst, b, h) do { _Pragma("unroll") for (int m = 0; m < 4; ++m) _Pragma("unroll") for (int k = 0; k < 2; ++k) dst[m][k] = *(const LAS bf16x8*)(lds + PG8_SA(b, h) + aoff + m * 2048 + k * 1024); } while (0)
#define PG8_LDB(dst, b, h) do { _Pragma("unroll") for (int n = 0; n < 2; ++n) _Pragma("unroll") for (int k = 0; k < 2; ++k) dst[n][k] = *(const LAS bf16x8*)(lds + PG8_SB(b, h) + boff + n * 2048 + k * 1024); } while (0)
#define PG8_MMA(ai, bj, At, Bt) do { __builtin_amdgcn_s_setprio(1); _Pragma("unroll") for (int m = 0; m < 4; ++m) _Pragma("unroll") for (int n = 0; n < 2; ++n) _Pragma("unroll") for (int k = 0; k < 2; ++k) \
        acc[ai][bj][m][n] = __builtin_amdgcn_mfma_f32_16x16x32_bf16(Bt[n][k], At[m][k], acc[ai][bj][m][n], 0, 0, 0); __builtin_amdgcn_s_setprio(0); } while (0)
#define PG8_WAIT_V(n) asm volatile("s_waitcnt vmcnt(" #n ")" ::: "memory")
#define PG8_WAIT_L(n) asm volatile("s_waitcnt lgkmcnt(" #n ")" ::: "memory")
#define PG8_BAR __builtin_amdgcn_s_barrier()
#define PG8_SCHED __builtin_amdgcn_sched_barrier(0)
#define PG8_ABASE(u) ((const char*)((u).pn < g.pn_split ? g.A : g.A2) + (size_t)((u).pm >> 3) * g.abatch + (size_t)((u).pm & 7) * tstep)
    Unit cur, nxt; int ui = 0;
    if (!S.next(0, cur)) return;
    f32x4 acc[2][2][4][2];
#pragma unroll
    for (int a = 0; a < 2; ++a)
#pragma unroll
        for (int b = 0; b < 2; ++b)
#pragma unroll
            for (int m = 0; m < 4; ++m)
#pragma unroll
                for (int n = 0; n < 2; ++n) acc[a][b][m][n] = (f32x4){0.f, 0.f, 0.f, 0.f};
    bf16x8 At[4][2], B0[2][2], B1[2][2];
    const char* cA = PG8_ABASE(cur); const char* cB = (const char*)g.Bt + (size_t)cur.pn * tstep;
    PG8_STAGE(PG8_SB(0, 0), cB, voffB); PG8_STAGE(PG8_SB(0, 1), cB + hstep, voffB); PG8_STAGE(PG8_SA(0, 0), cA, voffA); PG8_STAGE(PG8_SA(0, 1), cA + hstep, voffA);
    if (wr == 1) PG8_BAR;
    PG8_WAIT_V(2); PG8_BAR;
    PG8_STAGE(PG8_SB(1, 0), cB + kstep, voffB); PG8_STAGE(PG8_SA(1, 0), cA + kstep, voffA); PG8_STAGE(PG8_SB(1, 1), cB + hstep + kstep, voffB);
    PG8_WAIT_V(6); PG8_BAR;
    for (;;) {
        const bool has_next = S.next(ui + 1, nxt);
        const char* nA = has_next ? PG8_ABASE(nxt) : cA; const char* nB = has_next ? (const char*)g.Bt + (size_t)nxt.pn * tstep : cB;
        for (int t = 0; t < nt; t += 2) {
            const bool last = (t == nt - 2);
            const char* a1 = cA + (size_t)(t + 1) * kstep;
            const char* a2 = last ? nA : cA + (size_t)(t + 2) * kstep; const char* b2 = last ? nB : cB + (size_t)(t + 2) * kstep;
            const char* a3 = a2 + kstep; const char* b3 = b2 + kstep;
            PG8_LDB(B0, 0, 0); PG8_LDB(B1, 0, 1); PG8_SCHED; PG8_LDA(At, 0, 0); PG8_STAGE(PG8_SA(1, 1), a1 + hstep, voffA);
            PG8_WAIT_V(8); PG8_WAIT_L(0); PG8_BAR; PG8_MMA(0, 0, At, B0); PG8_MMA(0, 1, At, B1); PG8_BAR; PG8_SCHED;
            PG8_LDA(At, 0, 1); PG8_STAGE(PG8_SB(0, 0), b2, voffB); PG8_STAGE(PG8_SB(0, 1), b2 + hstep, voffB); PG8_STAGE(PG8_SA(0, 0), a2, voffA);
            PG8_WAIT_V(8); PG8_WAIT_L(0); PG8_BAR; PG8_MMA(1, 0, At, B0); PG8_MMA(1, 1, At, B1); PG8_BAR; PG8_SCHED;
            PG8_LDB(B0, 1, 0); PG8_LDB(B1, 1, 1); PG8_SCHED; PG8_LDA(At, 1, 0); PG8_STAGE(PG8_SA(0, 1), a2 + hstep, voffA);
            PG8_WAIT_V(8); PG8_WAIT_L(0); PG8_BAR; PG8_MMA(0, 0, At, B0); PG8_MMA(0, 1, At, B1); PG8_BAR; PG8_SCHED;
            PG8_LDA(At, 1, 1); PG8_STAGE(PG8_SB(1, 0), b3, voffB); PG8_STAGE(PG8_SB(1, 1), b3 + hstep, voffB); PG8_STAGE(PG8_SA(1, 0), a3, voffA);
            PG8_WAIT_V(8); PG8_WAIT_L(0); PG8_BAR; PG8_MMA(1, 0, At, B0); PG8_MMA(1, 1, At, B1); PG8_BAR; PG8_SCHED;
        }
        if (wr == 0) PG8_BAR;
        E(acc, cur, wr, wc, fr, fq);
        if (!has_next) break;
#pragma unroll
        for (int a = 0; a < 2; ++a)
#pragma unroll
            for (int b = 0; b < 2; ++b)
#pragma unroll
                for (int m = 0; m < 4; ++m)
#pragma unroll
                    for (int n = 0; n < 2; ++n) acc[a][b][m][n] = (f32x4){0.f, 0.f, 0.f, 0.f};
        cur = nxt; cA = nA; cB = nB; ++ui;
        if (wr == 1) PG8_BAR;
    }
    PG8_WAIT_V(0);
    PG8_BAR;
#undef PG8_SA
#undef PG8_SB
#undef PG8_STAGE
#undef PG8_LDA
#undef PG8_LDB
#undef PG8_MMA
#undef PG8_WAIT_V
#undef PG8_WAIT_L
#undef PG8_BAR
#undef PG8_SCHED
#undef PG8_ABASE
}

typedef f32x4 Acc[2][2][4][2];

struct EpiAin {
    static constexpr bool PERM = true;
    static constexpr bool HAS_PRE = false; struct Pre {};
    unsigned char* slab0;
    const float* conv_w;
    __device__ __forceinline__ void operator()(const Acc& acc, const Unit& u, int wr, int wc, int fr, int fq) const {
        const int rip0 = wr * 64 + fr;
        const int row0 = (u.pm & 7) * BM + rip0;
        unsigned char* slab = slab0 + (size_t)(u.pm >> 3) * SLAB;
        bf16_t* V = (bf16_t*)(slab + SO_V);
        if (u.pn < 4) {
            bf16_t* Y = (bf16_t*)(slab + SO_Y); bf16_t* GBH = (bf16_t*)(slab + SO_GB) + (size_t)(u.pm & 7) * 2 * DM;
            const int col0 = u.pn * BM + wc * 32 + 8 * fq;
#pragma unroll
            for (int bj = 0; bj < 2; ++bj) { const int cw = col0 + bj * HALF;
                f32x4 w0[2], w1[2], w2[2];
#pragma unroll
                for (int n = 0; n < 2; ++n) { w0[n] = *(const f32x4*)(conv_w + cw + 4 * n); w1[n] = *(const f32x4*)(conv_w + DM + cw + 4 * n); w2[n] = *(const f32x4*)(conv_w + 2 * DM + cw + 4 * n); }
#pragma unroll
                for (int ai = 0; ai < 2; ++ai)
#pragma unroll
                    for (int mp = 0; mp < 2; ++mp) {
                        u32x4 vr[2][3];
#pragma unroll
                        for (int mm = 0; mm < 2; ++mm) { const int rip = rip0 + ai * HALF + (2 * mp + mm) * 16; const bf16_t* vp = V + (size_t)(row0 + ai * HALF + (2 * mp + mm) * 16) * DM + cw;
#pragma unroll
                            for (int k = 0; k < 3; ++k) vr[mm][k] = (rip >= 2) ? *(const u32x4*)(vp - (size_t)k * DM) : (u32x4){0u, 0u, 0u, 0u}; }
                        asm volatile("" : "+v"(vr[0][0]), "+v"(vr[0][1]), "+v"(vr[0][2]), "+v"(vr[1][0]), "+v"(vr[1][1]), "+v"(vr[1][2]));
#pragma unroll
                        for (int mm = 0; mm < 2; ++mm) { const int m = 2 * mp + mm; const int rip = rip0 + ai * HALF + m * 16;
                            const f32x4 g0 = acc[ai][bj][m][0], g1 = acc[ai][bj][m][1];
                            u32x4 w;
                            if (rip >= 2) {
                                const u32x4 a = vr[mm][0], b1 = vr[mm][1], b2 = vr[mm][2];
                                const f32x4 v0a = (f32x4){bf_lo(a.x), bf_hi(a.x), bf_lo(a.y), bf_hi(a.y)}, v0b = (f32x4){bf_lo(a.z), bf_hi(a.z), bf_lo(a.w), bf_hi(a.w)};
                                const f32x4 v1a = (f32x4){bf_lo(b1.x), bf_hi(b1.x), bf_lo(b1.y), bf_hi(b1.y)}, v1b = (f32x4){bf_lo(b1.z), bf_hi(b1.z), bf_lo(b1.w), bf_hi(b1.w)};
                                const f32x4 v2a = (f32x4){bf_lo(b2.x), bf_hi(b2.x), bf_lo(b2.y), bf_hi(b2.y)}, v2b = (f32x4){bf_lo(b2.z), bf_hi(b2.z), bf_lo(b2.w), bf_hi(b2.w)};
                                const f32x4 ya = g0 * (w2[0] * v0a + w1[0] * v1a + w0[0] * v2a), yb = g1 * (w2[1] * v0b + w1[1] * v1b + w0[1] * v2b);
                                w.x = cvtpk(ya[0], ya[1]); w.y = cvtpk(ya[2], ya[3]); w.z = cvtpk(yb[0], yb[1]); w.w = cvtpk(yb[2], yb[3]);
                                *(u32x4*)(Y + (size_t)(row0 + ai * HALF + m * 16) * DM + cw) = w;
                            } else {
                                w.x = cvtpk(g0[0], g0[1]); w.y = cvtpk(g0[2], g0[3]); w.z = cvtpk(g1[0], g1[1]); w.w = cvtpk(g1[2], g1[3]);
                                *(u32x4*)(GBH + (size_t)rip * DM + cw) = w;
                            } } }
            }
        } else {
            const int col0 = (u.pn - 4) * HALF + wc * 32 + 8 * fq;
#pragma unroll
            for (int ai = 0; ai < 2; ++ai)
#pragma unroll
                for (int m = 0; m < 4; ++m) { bf16_t* rowp = V + (size_t)(row0 + ai * HALF + m * 16) * DM + col0;
                    const f32x4 v0 = acc[ai][0][m][0] * acc[ai][1][m][0], v1 = acc[ai][0][m][1] * acc[ai][1][m][1];
                    u32x4 w; w.x = cvtpk(v0[0], v0[1]); w.y = cvtpk(v0[2], v0[3]); w.z = cvtpk(v1[0], v1[1]); w.w = cvtpk(v1[2], v1[3]);
                    *(u32x4*)rowp = w; }
        }
    }
};

constexpr int RB_F32 = 1, RB_NA2 = 1, RB_NA1 = 2, RB_NA0 = 4;
template <int NA, int INM, int OUTM> struct EpiRes {
    static constexpr bool PERM = true;
    const void* xin; void* xout; const float* gate; int gate_stride;
    const float* gain0; const float* sc0; int sc0_stride; bf16_t* A0;
    const float* gain1; const float* sc1; int sc1_stride; bf16_t* A1;
    float* sumsq;
    const float* gain_in; const float* sc_in; int sc_in_stride;
    LAS unsigned char* lds = nullptr;
    __device__ __forceinline__ void operator()(const Acc& acc, const Unit& u, int wr, int wc, int fr, int fq) const {
        constexpr bool IN16 = INM != 0;
        constexpr int RB = !IN16 ? RB_F32 : (NA >= 2 ? RB_NA2 : (NA == 1 ? RB_NA1 : RB_NA0));
        constexpr int NB = 8 / RB;
        const int b = u.pm >> 3;
        const int row0 = u.pm * BM + wr * 64 + fr, col0 = u.pn * BM + wc * 32 + 8 * fq;
        const size_t tbase = (size_t)u.pm * BM * DM + (size_t)u.pn * BM;
        const unsigned loff = (unsigned)((wr * 64 + fr) * DM + wc * 32 + 8 * fq);
        f32x4 gv[2][2], a0[2][2], a1[2][2], ia[2][2];
        f32x4 xr[2][IN16 ? 1 : RB][2][2]; u32x4 xh[2][IN16 ? RB : 1][2];
#define EPR_ISSUE(h_) do { _Pragma("unroll") for (int qq = 0; qq < RB; ++qq) _Pragma("unroll") for (int bj = 0; bj < 2; ++bj) { const int q = (h_) * RB + qq; \
            const size_t o = tbase + (size_t)(((q >> 2) * HALF + (q & 3) * 16) * DM + bj * HALF); \
            if constexpr (IN16) xh[(h_) & 1][qq][bj] = __builtin_nontemporal_load((const u32x4*)(((const bf16_t*)xin + o) + loff)); \
            else { xr[(h_) & 1][qq][bj][0] = __builtin_nontemporal_load((const f32x4*)(((const float*)xin + o) + loff)); xr[(h_) & 1][qq][bj][1] = __builtin_nontemporal_load((const f32x4*)(((const float*)xin + o + 4) + loff)); } } } while (0)
        if constexpr (IN16) {
            asm volatile("s_waitcnt vmcnt(0)\n\ts_barrier" ::: "memory");
            const int lane_ = threadIdx.x & 63, wid_ = __builtin_amdgcn_readfirstlane(threadIdx.x >> 6);
            const bf16_t* gsrc = (const bf16_t*)xin + tbase + (size_t)(32 * wid_) * DM;
            const int rl_ = lane_ >> 5, cp_ = lane_ & 31;
            unsigned vo_[4];
#pragma unroll
            for (int k = 0; k < 4; ++k) vo_[k] = (unsigned)(rl_ * DM + ((cp_ ^ (((2 * k + rl_) & 7) << 2)) << 3));
#pragma unroll
            for (int i = 0; i < 16; ++i)
                __builtin_amdgcn_global_load_lds((const unsigned*)((gsrc + (size_t)(2 * i) * DM) + vo_[i & 3]), (LAS unsigned*)(lds + (32 * wid_ + 2 * i) * 512), 16, 0, 0);
        } else EPR_ISSUE(0);
#pragma unroll
        for (int bj = 0; bj < 2; ++bj)
#pragma unroll
            for (int n = 0; n < 2; ++n) { const int c = col0 + bj * HALF + 4 * n;
                gv[bj][n] = *(const f32x4*)(gate + (size_t)b * gate_stride + c);
                if (NA >= 1) a0[bj][n] = *(const f32x4*)(gain0 + c) * (*(const f32x4*)(sc0 + (size_t)b * sc0_stride + c) + 1.0f);
                if (NA >= 2) a1[bj][n] = *(const f32x4*)(gain1 + c) * (*(const f32x4*)(sc1 + (size_t)b * sc1_stride + c) + 1.0f);
                if (INM == 2) { const f32x4 t = *(const f32x4*)(gain_in + c) * (*(const f32x4*)(sc_in + (size_t)b * sc_in_stride + c) + 1.0f); ia[bj][n] = (f32x4){1.0f / t[0], 1.0f / t[1], 1.0f / t[2], 1.0f / t[3]}; } }
        if constexpr (IN16) asm volatile("s_waitcnt vmcnt(0)\n\ts_barrier" ::: "memory");
        const LAS unsigned char* ldr = lds + (wr * 64 + fr) * 512;
        const int lsw = (fr & 7) << 2;
#pragma unroll
        for (int h = 0; h < NB; ++h) {
            if constexpr (!IN16) {
                if (h + 1 < NB) EPR_ISSUE(h + 1);
#pragma unroll
                for (int qq = 0; qq < RB; ++qq)
#pragma unroll
                    for (int bj = 0; bj < 2; ++bj) asm volatile("" : "+v"(xr[h & 1][qq][bj][0]), "+v"(xr[h & 1][qq][bj][1]));
            } else {
#pragma unroll
                for (int qq = 0; qq < RB; ++qq)
#pragma unroll
                    for (int bj = 0; bj < 2; ++bj) { const int q = h * RB + qq; xh[h & 1][qq][bj] = *(const LAS u32x4*)(ldr + ((q >> 2) * HALF + (q & 3) * 16) * 512 + (((16 * bj + 4 * wc + fq) ^ lsw) << 4)); }
            }
#pragma unroll
            for (int qq = 0; qq < RB; ++qq) { const int q = h * RB + qq, ai = q >> 2, m = q & 3; const int row = row0 + ai * HALF + m * 16; const size_t off = tbase + (size_t)((ai * HALF + m * 16) * DM); float ss = 0.f;
#pragma unroll
                for (int bj = 0; bj < 2; ++bj) { const size_t o = off + bj * HALF;
                    f32x4 x0, x1;
                    if constexpr (IN16) { const u32x4 w = xh[h & 1][qq][bj]; x0 = (f32x4){bf_lo(w.x), bf_hi(w.x), bf_lo(w.y), bf_hi(w.y)}; x1 = (f32x4){bf_lo(w.z), bf_hi(w.z), bf_lo(w.w), bf_hi(w.w)}; }
                    else { x0 = xr[h & 1][qq][bj][0]; x1 = xr[h & 1][qq][bj][1]; }
                    if (INM == 2) { x0 = x0 * ia[bj][0]; x1 = x1 * ia[bj][1]; }
                    x0 = x0 + gv[bj][0] * acc[ai][bj][m][0]; x1 = x1 + gv[bj][1] * acc[ai][bj][m][1];
                    if (OUTM == 0) {
                        f32x4 s0 = x0, s1 = x1;
#pragma unroll
                        for (int e = 0; e < 4; ++e) { auto rr = __builtin_amdgcn_permlane16_swap(__float_as_uint(s0[e]), __float_as_uint(s1[e]), false, false);
                            rr = __builtin_amdgcn_permlane32_swap(rr[0], rr[1], false, false); s0[e] = __uint_as_float(rr[0]); s1[e] = __uint_as_float(rr[1]); }
                        const int adj0 = -4 * fq, adj1 = 16 - 4 * fq;
                        *(f32x4*)(((float*)xout + o) + (loff + adj0)) = s0; *(f32x4*)(((float*)xout + o) + (loff + adj1)) = s1; }
                    if (NA >= 1) { ss += ((x0[0] * x0[0] + x0[1] * x0[1]) + (x0[2] * x0[2] + x0[3] * x0[3])) + ((x1[0] * x1[0] + x1[1] * x1[1]) + (x1[2] * x1[2] + x1[3] * x1[3]));
                        const f32x4 t0 = x0 * a0[bj][0], t1 = x1 * a0[bj][1]; u32x4 w; w.x = cvtpk(t0[0], t0[1]); w.y = cvtpk(t0[2], t0[3]); w.z = cvtpk(t1[0], t1[1]); w.w = cvtpk(t1[2], t1[3]); *(u32x4*)((A0 + o) + loff) = w; }
                    if (NA >= 2) { const f32x4 t0 = x0 * a1[bj][0], t1 = x1 * a1[bj][1]; u32x4 w; w.x = cvtpk(t0[0], t0[1]); w.y = cvtpk(t0[2], t0[3]); w.z = cvtpk(t1[0], t1[1]); w.w = cvtpk(t1[2], t1[3]); *(u32x4*)((A1 + o) + loff) = w; } }
                if (NA >= 1) { ss += __shfl_xor(ss, 16); ss += __shfl_xor(ss, 32); if (fq == 0) unsafeAtomicAdd(sumsq + row, ss); } }
        }
#undef EPR_ISSUE
    }
};

struct EpiMlp1 {
    static constexpr bool PERM = true;
    bf16_t* H; const float* bias; const float* sumsq;
    __device__ __forceinline__ void operator()(const Acc& acc, const Unit& u, int wr, int wc, int fr, int fq) const {
        const int b = u.pm >> 3;
        const int row0 = u.pm * BM + wr * 64 + fr, col0 = u.pn * BM + wc * 32 + 8 * fq;
        f32x4 bv[2][2];
#pragma unroll
        for (int bj = 0; bj < 2; ++bj)
#pragma unroll
            for (int n = 0; n < 2; ++n) bv[bj][n] = *(const f32x4*)(bias + (size_t)b * FF + col0 + bj * HALF + 4 * n);
        float ssv[8];
#pragma unroll
        for (int q = 0; q < 8; ++q) ssv[q] = sumsq[row0 + (q >> 2) * HALF + (q & 3) * 16];
        asm volatile("" : "+v"(ssv[0]), "+v"(ssv[1]), "+v"(ssv[2]), "+v"(ssv[3]), "+v"(ssv[4]), "+v"(ssv[5]), "+v"(ssv[6]), "+v"(ssv[7]));
#pragma unroll
        for (int ai = 0; ai < 2; ++ai)
#pragma unroll
            for (int m = 0; m < 4; ++m) { const int row = row0 + ai * HALF + m * 16; const float rs = rsqrtf(ssv[ai * 4 + m] * (1.0f / DM) + EPS);
                bf16_t* rowp = H + (size_t)row * FF + col0;
#pragma unroll
                for (int bj = 0; bj < 2; ++bj) { f32x4 v0 = acc[ai][bj][m][0] * rs + bv[bj][0], v1 = acc[ai][bj][m][1] * rs + bv[bj][1];
#pragma unroll
                    for (int e = 0; e < 4; ++e) { const float r0 = fmaxf(v0[e], 0.f), r1 = fmaxf(v1[e], 0.f); v0[e] = r0 * r0; v1[e] = r1 * r1; }
                    u32x4 w; w.x = cvtpk(v0[0], v0[1]); w.y = cvtpk(v0[2], v0[3]); w.z = cvtpk(v1[0], v1[1]); w.w = cvtpk(v1[2], v1[3]);
                    *(u32x4*)(rowp + bj * HALF) = w; } }
    }
};

struct EpiKVQ {
    static constexpr bool PERM = true;
    unsigned char* slab0; const float* bias; const float* sumsq; const float* k_gain; const float* q_gain;
    __device__ __forceinline__ void operator()(const Acc& acc, const Unit& u, int wr, int wc, int fr, int fq) const {
        const int b = u.pm >> 3, pn = u.pn;
        const int row0 = u.pm * BM + wr * 64 + fr;
        unsigned char* slab = slab0 + (size_t)b * SLAB;
        bf16_t* KV = (bf16_t*)(slab + SO_KV); bf16_t* Q = (bf16_t*)(slab + SO_Q); float* gates = (float*)(slab + SO_GATES);
        f32x4 bv[2][2];
#pragma unroll
        for (int bj = 0; bj < 2; ++bj)
#pragma unroll
            for (int n = 0; n < 2; ++n) bv[bj][n] = *(const f32x4*)(bias + (size_t)b * NKVQ + pn * BM + bj * HALF + wc * 32 + 8 * fq + 4 * n);
        float ssv[8];
#pragma unroll
        for (int q = 0; q < 8; ++q) ssv[q] = sumsq[row0 + (q >> 2) * HALF + (q & 3) * 16];
        asm volatile("" : "+v"(ssv[0]), "+v"(ssv[1]), "+v"(ssv[2]), "+v"(ssv[3]), "+v"(ssv[4]), "+v"(ssv[5]), "+v"(ssv[6]), "+v"(ssv[7]));
        if (pn == 10) {
            if (wc < 2) {
#pragma unroll
                for (int ai = 0; ai < 2; ++ai)
#pragma unroll
                    for (int m = 0; m < 4; ++m) { const int row = row0 + ai * HALF + m * 16; const float rs = rsqrtf(ssv[ai * 4 + m] * (1.0f / DM) + EPS);
#pragma unroll
                        for (int n = 0; n < 2; ++n) { const int c = wc * 32 + 8 * fq + 4 * n;
                            if (c < 48) { const f32x4 v = acc[ai][0][m][n] * rs + bv[0][n]; f32x4 o;
#pragma unroll
                                for (int e = 0; e < 4; ++e) o[e] = 1.0f / (1.0f + __expf(-v[e]));
                                *(f32x4*)(gates + (size_t)(row & (SEQ - 1)) * 48 + c) = o; } } }
            }
            return;
        }
        const bool is_q = pn >= 6;
        const bool do_norm = is_q || pn == 2 || pn == 4;
        f32x4 gn[2][2];
        { const float* gp = is_q ? q_gain : (k_gain + (pn == 2 ? 64 : 128)); const float sc = is_q ? QSCALE : 1.0f;
#pragma unroll
          for (int bj = 0; bj < 2; ++bj)
#pragma unroll
              for (int n = 0; n < 2; ++n) gn[bj][n] = do_norm ? *(const f32x4*)(gp + 32 * bj + 8 * fq + 4 * n) * sc : (f32x4){1.f, 1.f, 1.f, 1.f}; }
#pragma unroll
        for (int ai = 0; ai < 2; ++ai)
#pragma unroll
            for (int m = 0; m < 4; ++m) { const int row = row0 + ai * HALF + m * 16; const float rs = rsqrtf(ssv[ai * 4 + m] * (1.0f / DM) + EPS);
                f32x4 v[2][2]; float ss = 0.f;
#pragma unroll
                for (int bj = 0; bj < 2; ++bj)
#pragma unroll
                    for (int n = 0; n < 2; ++n) { v[bj][n] = acc[ai][bj][m][n] * rs + bv[bj][n]; const f32x4 t = v[bj][n]; ss += (t[0] * t[0] + t[1] * t[1]) + (t[2] * t[2] + t[3] * t[3]); }
                float hs = 1.0f;
                if (do_norm) { ss += __shfl_xor(ss, 16); ss += __shfl_xor(ss, 32); hs = rsqrtf(ss * (1.0f / 64.0f) + EPS); }
                bf16_t* rowp;
                if (is_q) rowp = Q + (size_t)(row & (SEQ - 1)) * DM + ((pn - 6) * 4 + wc) * 64 + 8 * fq;
                else rowp = KV + ((size_t)(pn * 4 + wc) * SEQ + (row & (SEQ - 1))) * 64 + 8 * fq;
#pragma unroll
                for (int bj = 0; bj < 2; ++bj) { const f32x4 v0 = v[bj][0] * hs * gn[bj][0], v1 = v[bj][1] * hs * gn[bj][1];
                    u32x4 w; w.x = cvtpk(v0[0], v0[1]); w.y = cvtpk(v0[2], v0[3]); w.z = cvtpk(v1[0], v1[1]); w.w = cvtpk(v1[2], v1[3]);
                    *(u32x4*)(rowp + 32 * bj) = w; } }
    }
};
}

namespace att {
constexpr int SLOTB = 8192;
constexpr int L_K = 0, L_V = 3 * SLOTB, L_WS = 6 * SLOTB, L_SEL = L_WS + 4096, L_NIB = L_SEL + 256, L_SC = L_NIB + 768, L_IA = L_SC + 8704, L_IB = L_IA + 33792, L_END = L_IB + 33792, L_OST = L_IA;
static_assert(L_END <= 131072 && (L_IA % 16) == 0 && (L_SC % 16) == 0, "attention LDS map");
#define SBAR() __builtin_amdgcn_sched_barrier(0)
#define ATT_WAIT_BAR(N) asm volatile("s_waitcnt vmcnt(" #N ") lgkmcnt(0)\n\ts_barrier" ::: "memory")
__device__ __forceinline__ int crow(int r, int hi) { return (r & 3) + 8 * (r >> 2) + 4 * hi; }
__device__ __forceinline__ void glds16(const void* gsrc, unsigned lds_dst) { unsigned keep;
    asm volatile("s_mov_b32 %0, m0\n\ts_mov_b32 m0, %2\n\ts_nop 0\n\tglobal_load_lds_dwordx4 %1, off\n\ts_mov_b32 m0, %0" : "=&s"(keep) : "v"(gsrc), "s"(lds_dst) : "memory"); }

__device__ __forceinline__ void qkt_c(f32x16& p0, f32x16& p1, const LAS unsigned char* Kslot, const bf16x8* qr, const f32x16& ci, int r32, int hi) {
    const LAS unsigned char* kb = Kslot + hi * 1024 + r32 * 16;
    bf16x8 kf[8];
#pragma unroll
    for (int i = 0; i < 8; ++i) kf[i] = *(const LAS bf16x8*)(kb + (i >> 1) * 2048 + (i & 1) * 512);
    asm volatile("" : "+v"(kf[0]), "+v"(kf[1]), "+v"(kf[2]), "+v"(kf[3]), "+v"(kf[4]), "+v"(kf[5]), "+v"(kf[6]), "+v"(kf[7]));
    p0 = __builtin_amdgcn_mfma_f32_32x32x16_bf16(kf[0], qr[0], ci, 0, 0, 0); p1 = __builtin_amdgcn_mfma_f32_32x32x16_bf16(kf[1], qr[0], ci, 0, 0, 0);
#pragma unroll
    for (int d0 = 1; d0 < 4; ++d0) { p0 = __builtin_amdgcn_mfma_f32_32x32x16_bf16(kf[2 * d0], qr[d0], p0, 0, 0, 0); p1 = __builtin_amdgcn_mfma_f32_32x32x16_bf16(kf[2 * d0 + 1], qr[d0], p1, 0, 0, 0); }
}
__device__ __forceinline__ void qkt(f32x16& p0, f32x16& p1, const LAS unsigned char* Kslot, const bf16x8* qr, int r32, int hi) {
    const LAS unsigned char* kb = Kslot + hi * 1024 + r32 * 16;
    bf16x8 kf[8];
#pragma unroll
    for (int i = 0; i < 8; ++i) kf[i] = *(const LAS bf16x8*)(kb + (i >> 1) * 2048 + (i & 1) * 512);
    asm volatile("" : "+v"(kf[0]), "+v"(kf[1]), "+v"(kf[2]), "+v"(kf[3]), "+v"(kf[4]), "+v"(kf[5]), "+v"(kf[6]), "+v"(kf[7]));
    const f32x16 z = f32x16{};
    p0 = __builtin_amdgcn_mfma_f32_32x32x16_bf16(kf[0], qr[0], z, 0, 0, 0); p1 = __builtin_amdgcn_mfma_f32_32x32x16_bf16(kf[1], qr[0], z, 0, 0, 0);
#pragma unroll
    for (int d0 = 1; d0 < 4; ++d0) { p0 = __builtin_amdgcn_mfma_f32_32x32x16_bf16(kf[2 * d0], qr[d0], p0, 0, 0, 0); p1 = __builtin_amdgcn_mfma_f32_32x32x16_bf16(kf[2 * d0 + 1], qr[d0], p1, 0, 0, 0); }
}
__device__ __forceinline__ void range_mask(f32x16& p0, f32x16& p1, int lo, int hv, int hi) {
    const int lo2 = lo - 4 * hi, hv2 = hv - 4 * hi;
#pragma unroll
    for (int r = 0; r < 16; ++r) { const int kc = (r & 3) + 8 * (r >> 2); if (kc < lo2 || kc > hv2) p0[r] = -INFINITY; if (kc + 32 < lo2 || kc + 32 > hv2) p1[r] = -INFINITY; }
}
__device__ __forceinline__ float max3f(float a, float b, float c) { float r; asm("v_max3_f32 %0, %1, %2, %3" : "=v"(r) : "v"(a), "v"(b), "v"(c)); return r; }
__device__ __forceinline__ float max2f(float a, float b) { float r; asm("v_max_f32_e32 %0, %1, %2" : "=v"(r) : "v"(a), "v"(b)); return r; }
__device__ __forceinline__ float rowmax(const f32x16& p0, const f32x16& p1) {
    float a = max3f(p0[0], p0[1], p1[0]), b = max3f(p0[2], p0[3], p1[1]); a = max3f(a, p1[2], p1[3]);
#pragma unroll
    for (int r = 4; r < 16; r += 4) { a = max3f(a, p0[r], p0[r + 1]); b = max3f(b, p0[r + 2], p0[r + 3]); a = max3f(a, p1[r], p1[r + 1]); b = max3f(b, p1[r + 2], p1[r + 3]); }
    const float m = max2f(a, b);
    auto rr = __builtin_amdgcn_permlane32_swap(__float_as_uint(m), __float_as_uint(m), false, false);
    return max2f(__uint_as_float(rr[0]), __uint_as_float(rr[1]));
}
__device__ __forceinline__ float halfsum(float a) {
    auto rr = __builtin_amdgcn_permlane32_swap(__float_as_uint(a), __float_as_uint(a), false, false);
    return __uint_as_float(rr[0]) + __uint_as_float(rr[1]);
}
__device__ __forceinline__ void pv(f32x16* o, int vb, bf16x8 pa0, bf16x8 pa1, bf16x8 pa2, bf16x8 pa3) {
    s16x4 lo[8], hi4[8];
#pragma unroll
    for (int q = 0; q < 8; ++q) {
        asm volatile("ds_read_b64_tr_b16 %0,%1 offset:%c2" : "=&v"(lo[q]) : "v"(vb), "i"((q >> 2) * 4096 + (q & 3) * 1024) : "memory");
        asm volatile("ds_read_b64_tr_b16 %0,%1 offset:%c2" : "=&v"(hi4[q]) : "v"(vb), "i"((q >> 2) * 4096 + (q & 3) * 1024 + 512) : "memory"); }
    asm volatile("s_waitcnt lgkmcnt(0)" ::: "memory"); SBAR();
#define PK(k) (bf16x8){lo[k][0], lo[k][1], lo[k][2], lo[k][3], hi4[k][0], hi4[k][1], hi4[k][2], hi4[k][3]}
    o[0] = __builtin_amdgcn_mfma_f32_32x32x16_bf16(pa0, PK(0), o[0], 0, 0, 0);
    o[1] = __builtin_amdgcn_mfma_f32_32x32x16_bf16(pa0, PK(4), o[1], 0, 0, 0);
    o[0] = __builtin_amdgcn_mfma_f32_32x32x16_bf16(pa1, PK(1), o[0], 0, 0, 0);
    o[1] = __builtin_amdgcn_mfma_f32_32x32x16_bf16(pa1, PK(5), o[1], 0, 0, 0);
    o[0] = __builtin_amdgcn_mfma_f32_32x32x16_bf16(pa2, PK(2), o[0], 0, 0, 0);
    o[1] = __builtin_amdgcn_mfma_f32_32x32x16_bf16(pa2, PK(6), o[1], 0, 0, 0);
    o[0] = __builtin_amdgcn_mfma_f32_32x32x16_bf16(pa3, PK(3), o[0], 0, 0, 0);
    o[1] = __builtin_amdgcn_mfma_f32_32x32x16_bf16(pa3, PK(7), o[1], 0, 0, 0);
#undef PK
}
__device__ __forceinline__ bf16x8 pack8(const f32x16& p, int base) {
    u32x4 w; w.x = cvtpk(p[base], p[base + 1]); w.y = cvtpk(p[base + 2], p[base + 3]); w.z = cvtpk(p[base + 4], p[base + 5]); w.w = cvtpk(p[base + 6], p[base + 7]);
    return __builtin_bit_cast(bf16x8, w);
}
__device__ __forceinline__ void row_bcast(float v, float (&out)[16], LAS float* wsf, int r32, int hi) {
    if (hi == 0) wsf[r32] = v;
#pragma unroll
    for (int i = 0; i < 4; ++i) { const f32x4 t = *(const LAS f32x4*)(wsf + 8 * i + 4 * hi); out[4 * i] = t[0]; out[4 * i + 1] = t[1]; out[4 * i + 2] = t[2]; out[4 * i + 3] = t[3]; }
}

struct Ctx {
    int lane, r32, hi, wid, ql, qb; unsigned lds0; LAS unsigned char* shm; LAS float* wsf; int koff, voff; unsigned kdst, vdst; int vb0;
};
__device__ __forceinline__ void dma_k(const Ctx& c, const bf16_t* base, int tile, int slot) { glds16(base + (size_t)tile * 4096 + c.koff, (unsigned)__builtin_amdgcn_readfirstlane(c.kdst + slot * SLOTB)); }
__device__ __forceinline__ void dma_v(const Ctx& c, const bf16_t* base, int tile, int slot) { glds16(base + (size_t)tile * 4096 + c.voff, (unsigned)__builtin_amdgcn_readfirstlane(c.vdst + slot * SLOTB)); }

constexpr float THR = 8.0f;
struct BrState { float mhat, l; f32x16 negm; f32x16 o[2]; };
__device__ __forceinline__ void br_reset(BrState& st) { st.mhat = 0.f; st.l = 0.f; st.negm = f32x16{}; st.o[0] = f32x16{}; st.o[1] = f32x16{}; }
__device__ __forceinline__ void stream_step(const Ctx& c, int slot, const bf16x8* qr, bool row_on, bool use_range, int lo, int hv, bool first, BrState& st) {
    f32x16 p0, p1;
    if (__any(!row_on)) { f32x16 ci;
#pragma unroll
        for (int r = 0; r < 16; ++r) ci[r] = row_on ? st.negm[r] : -INFINITY;
        qkt_c(p0, p1, c.shm + L_K + slot * SLOTB, qr, ci, c.r32, c.hi);
    } else qkt_c(p0, p1, c.shm + L_K + slot * SLOTB, qr, st.negm, c.r32, c.hi);
    if (use_range) range_mask(p0, p1, lo, hv, c.hi);
    const float rm = rowmax(p0, p1);
    if (first || __any(rm > THR)) {
        float dl = first ? rm : fmaxf(rm, 0.f);
        if (dl == -INFINITY) dl = 0.f;
        st.mhat += dl;
#pragma unroll
        for (int r = 0; r < 16; ++r) { p0[r] -= dl; p1[r] -= dl; st.negm[r] = -st.mhat; }
        if (!first) { const float f = __builtin_amdgcn_exp2f(-dl); st.l *= f; float al[16]; row_bcast(f, al, c.wsf, c.r32, c.hi);
#pragma unroll
            for (int r = 0; r < 16; ++r) { st.o[0][r] *= al[r]; st.o[1][r] *= al[r]; } }
    }
#pragma unroll
    for (int r = 0; r < 16; ++r) { p0[r] = __builtin_amdgcn_exp2f(p0[r]); p1[r] = __builtin_amdgcn_exp2f(p1[r]); }
    { const f32x16 sv = p0 + p1; st.l += ((sv[0] + sv[1]) + (sv[2] + sv[3])) + ((sv[4] + sv[5]) + (sv[6] + sv[7])) + ((sv[8] + sv[9]) + (sv[10] + sv[11])) + ((sv[12] + sv[13]) + (sv[14] + sv[15])); }
    pv(st.o, c.vb0 + slot * SLOTB, pack8(p0, 0), pack8(p0, 8), pack8(p1, 0), pack8(p1, 8));
}
struct Cursor { unsigned sm, wm; };
__device__ __forceinline__ int cur_pop(Cursor& k, int& br) {
    if (k.sm) { const int t = __builtin_ctz(k.sm); k.sm &= k.sm - 1u; br = 1; return t; }
    const int t = 31 - __builtin_clz(k.wm); k.wm &= ~(1u << t); br = 2; return t;
}

typedef __attribute__((address_space(3))) const char* lds_cptr;
typedef short v4i16_t __attribute__((ext_vector_type(4)));
__device__ __forceinline__ void kload8(bf16x8* kf, lds_cptr kp) {
    kf[0] = *(const LAS bf16x8*)(kp);        kf[1] = *(const LAS bf16x8*)(kp + 512);
    kf[2] = *(const LAS bf16x8*)(kp + 2048); kf[3] = *(const LAS bf16x8*)(kp + 2560);
    kf[4] = *(const LAS bf16x8*)(kp + 4096); kf[5] = *(const LAS bf16x8*)(kp + 4608);
    kf[6] = *(const LAS bf16x8*)(kp + 6144); kf[7] = *(const LAS bf16x8*)(kp + 6656);
}
__device__ __forceinline__ void kload2(bf16x8* kf, lds_cptr kp, int j) { kf[2 * j] = *(const LAS bf16x8*)(kp + j * 2048); kf[2 * j + 1] = *(const LAS bf16x8*)(kp + j * 2048 + 512); }
__device__ __forceinline__ s16x4 vtr(lds_cptr p) { return __builtin_bit_cast(s16x4, __builtin_amdgcn_ds_read_tr16_b64_v4i16((LAS v4i16_t*)p)); }
__device__ __forceinline__ float fadd_s(float a, float b) { float r; asm("v_add_f32_e32 %0, %1, %2" : "=v"(r) : "v"(a), "v"(b)); return r; }
__device__ __forceinline__ float fsub_s(float a, float b) { float r; asm("v_sub_f32_e32 %0, %1, %2" : "=v"(r) : "v"(a), "v"(b)); return r; }
template <int THRL>
__device__ __forceinline__ void sel_stream(const Ctx& c, const bf16_t* Kb, const bf16_t* Vb, const bf16x8* qr, unsigned msel, int qb, f32x16* o, float& l_out) {
  const int lane = c.lane, r32 = c.r32, hi = c.hi;
  LAS float* wsf = c.wsf;
  const lds_cptr shm3 = (lds_cptr)c.shm;
  const lds_cptr kp0 = shm3 + L_K + hi * 1024 + r32 * 16;
  const lds_cptr vp0 = shm3 + L_V + ((lane >> 4) & 1) * 32 + (lane & 3) * 8 + (4 * hi + ((lane & 15) >> 2)) * 64;
  const int NTr = qb + 1, NT = NTr < 4 ? 4 : ((NTr + 1) & ~1);
  #define WAIT_BAR(N) asm volatile("s_waitcnt vmcnt(" #N ") lgkmcnt(0)\n\ts_barrier":::"memory")
  #define TILE_OF(t) (((t) < NTr) ? (t) : qb)
  #define DMA_K(t, slotb) glds16(Kb + (size_t)TILE_OF(t) * 4096 + c.koff, (unsigned)__builtin_amdgcn_readfirstlane(c.kdst + (slotb)))
  #define DMA_V(t, slotb) glds16(Vb + (size_t)TILE_OF(t) * 4096 + c.voff, (unsigned)__builtin_amdgcn_readfirstlane(c.vdst + (slotb)))
  #define CMASK(P0, P1, t) do { const bool on_ = ((t) < NTr) && (((msel >> ((t) & 31)) & 1u) != 0u); \
      if (__any(!on_)) { const float ng_ = on_ ? 0.f : -INFINITY; _Pragma("unroll") for (int r = 0; r < 16; ++r) { P0[r] += ng_; P1[r] += ng_; } } \
      if ((t) == qb) range_mask(P0, P1, 0, c.ql, hi); } while (0)
  float mhat = 0.f, l_reg = 0.f; o[0] = f32x16{}; o[1] = f32x16{}; f32x16 negm = f32x16{}; asm volatile("" : "+v"(negm));
  bf16x8 kf[8];
  bool resc = false;
  #define START(P0,P1) do{ const float rm=rowmax(P0,P1); resc=false; \
    { const float dl=rm; mhat=fadd_s(mhat,dl); \
      _Pragma("unroll") for(int r=0;r<16;++r){P0[r]=fsub_s(P0[r],dl);P1[r]=fsub_s(P1[r],dl);} \
      _Pragma("unroll") for(int r=0;r<16;++r)negm[r]=-mhat; asm volatile("":"+v"(negm)); } \
    _Pragma("unroll") for(int r=0;r<16;++r)P0[r]=__builtin_amdgcn_exp2f(P0[r]); }while(0)
  #define RESC() do{ if(resc){ asm volatile("s_waitcnt lgkmcnt(0)":::"memory"); \
      _Pragma("unroll") for(int d_=0;d_<2;++d_) _Pragma("unroll") for(int r=0;r<16;++r)o[d_][r]*=wsf[crow(r,hi)]; } }while(0)
  f32x16 pA0,pA1,pB0,pB1;
  int sl_prev=SLOTB,sl_cur=2*SLOTB,sl_next=0;
  #define ROT() do{sl_prev=sl_cur;sl_cur=sl_next;sl_next=(sl_next==2*SLOTB)?0:sl_next+SLOTB;}while(0)
  DMA_K(1,0); DMA_K(2,SLOTB);
  { const f32x16 z = f32x16{}; qkt_c(pA0,pA1,c.shm+L_K+2*SLOTB,qr,z,r32,hi); }
  asm volatile("s_nop 15\n\ts_nop 7":"+v"(pA0),"+v"(pA1)); CMASK(pA0,pA1,0);
  START(pA0,pA1);
  _Pragma("unroll") for(int r=0;r<16;++r)pA1[r]=__builtin_amdgcn_exp2f(pA1[r]);
  WAIT_BAR(0);
  DMA_K(3,2*SLOTB);DMA_V(1,0);
  ROT();
  kload8(kf,kp0+sl_cur);
  WAIT_BAR(2);
  s16x4 vlo[8],vhi[8]; u32x4 pw0,pw1,pw2,pw3;
  #define PKW(P,B) cvtpk(P[B],P[B+1])
  #define PAF(k) __builtin_bit_cast(bf16x8,pw##k)
  #define VFR(i) (bf16x8){vlo[i][0],vlo[i][1],vlo[i][2],vlo[i][3],vhi[i][0],vhi[i][1],vhi[i][2],vhi[i][3]}
  #define PIN(x) asm volatile("":"+v"(x))
  #define MX3(a,b,c) __builtin_fmaxf(__builtin_fmaxf((a),(b)),(c))
  #define GAPA(MF,A0,A1,A2,A3,W0,W1,PW) do{ MF; sacc+=A0; sacc+=A1; sacc+=A2; sacc+=A3; PIN(sacc); W0; W1; PIN(PW); SBAR(); }while(0)
  #define EX(v) __builtin_amdgcn_exp2f(v)
  #define GAPB(MF,X,B) do{ MF; X[B]=EX(X[B]); X[B+1]=EX(X[B+1]); X[B+2]=EX(X[B+2]); X[B+3]=EX(X[B+3]); PIN(X); SBAR(); }while(0)
  #define VRD(i) do{ vlo[i]=vtr(vp_+(((i)>>2)*4096+((i)&3)*1024)); vhi[i]=vtr(vp_+(((i)>>2)*4096+((i)&3)*1024+512)); }while(0)
  #define KRD(G,j) do{ if(G){ kload2(kf,kp0+sl_next,j); SBAR(); } }while(0)
  #define STEP(C0,C1,P0,P1,t,GK,GV,GL) do{ SBAR(); \
    const lds_cptr vp_=vp0+sl_prev; \
    VRD(0); SBAR(); float sacc=(P0[0]+P0[1]); \
    GAPA(C0=__builtin_amdgcn_mfma_f32_32x32x16_bf16(kf[0],qr[0],negm,0,0,0), P0[2],P0[3],P0[4],P0[5],     pw0[0]=PKW(P0,0), pw0[1]=PKW(P0,2), pw0); \
    VRD(4); SBAR(); GAPA(C1=__builtin_amdgcn_mfma_f32_32x32x16_bf16(kf[1],qr[0],negm,0,0,0), P0[6],P0[7],P0[8],P0[9],     pw0[2]=PKW(P0,4), pw0[3]=PKW(P0,6), pw0); \
    VRD(1); SBAR(); GAPA(C0=__builtin_amdgcn_mfma_f32_32x32x16_bf16(kf[2],qr[1],C0,0,0,0),   P0[10],P0[11],P0[12],P0[13], pw1[0]=PKW(P0,8), pw1[1]=PKW(P0,10), pw1); \
    VRD(5); SBAR(); GAPA(C1=__builtin_amdgcn_mfma_f32_32x32x16_bf16(kf[3],qr[1],C1,0,0,0),   P0[14],P0[15],P1[0],P1[1],   pw1[2]=PKW(P0,12),pw1[3]=PKW(P0,14), pw1); \
    VRD(2); SBAR(); GAPA(C0=__builtin_amdgcn_mfma_f32_32x32x16_bf16(kf[4],qr[2],C0,0,0,0),   P1[2],P1[3],P1[4],P1[5],     pw2[0]=PKW(P1,0), pw2[1]=PKW(P1,2), pw2); \
    VRD(6); SBAR(); GAPA(C1=__builtin_amdgcn_mfma_f32_32x32x16_bf16(kf[5],qr[2],C1,0,0,0),   P1[6],P1[7],P1[8],P1[9],     pw2[2]=PKW(P1,4), pw2[3]=PKW(P1,6), pw2); \
    VRD(3); SBAR(); GAPA(C0=__builtin_amdgcn_mfma_f32_32x32x16_bf16(kf[6],qr[3],C0,0,0,0),   P1[10],P1[11],P1[12],P1[13], pw3[0]=PKW(P1,8), pw3[1]=PKW(P1,10), pw3); \
    VRD(7); SBAR(); GAPA(C1=__builtin_amdgcn_mfma_f32_32x32x16_bf16(kf[7],qr[3],C1,0,0,0),   P1[14],P1[15],0.f,0.f,       pw3[2]=PKW(P1,12),pw3[3]=PKW(P1,14), pw3); \
    l_reg+=sacc; \
    if(GK){DMA_K((t)+3,sl_cur);} if(GV){DMA_V((t)+1,sl_next);} \
    CMASK(C0,C1,t); \
    { float a=MX3(C0[0],C0[1],C1[0]),b=MX3(C0[2],C0[3],C1[1]); a=MX3(a,C1[2],C1[3]); \
      _Pragma("unroll") for(int r=4;r<16;r+=4){a=MX3(a,C0[r],C0[r+1]);b=MX3(b,C0[r+2],C0[r+3]);a=MX3(a,C1[r],C1[r+1]);b=MX3(b,C1[r+2],C1[r+3]);} \
      float rm=__builtin_fmaxf(a,b); { auto rr=__builtin_amdgcn_permlane32_swap(__float_as_uint(rm),__float_as_uint(rm),false,false); rm=__builtin_fmaxf(__uint_as_float(rr[0]),__uint_as_float(rr[1])); } \
      resc=false; \
      if(__builtin_expect(__any(rm>(float)THRL),0)){ const float dl=__builtin_fmaxf(rm,0.f); mhat+=dl; \
        _Pragma("unroll") for(int r=0;r<16;++r){C0[r]-=dl;C1[r]-=dl;} \
        _Pragma("unroll") for(int r=0;r<16;++r)negm[r]=-mhat; asm volatile("":"+v"(negm)); \
        const float f=__builtin_amdgcn_exp2f(-dl); l_reg*=f; if(hi==0)wsf[r32]=f; resc=true; } } \
    SBAR(); \
    GAPB(o[0]=__builtin_amdgcn_mfma_f32_32x32x16_bf16(PAF(0),VFR(0),o[0],0,0,0), C0,0); \
    GAPB(o[1]=__builtin_amdgcn_mfma_f32_32x32x16_bf16(PAF(0),VFR(4),o[1],0,0,0), C0,4); \
    KRD(GL,0); GAPB(o[0]=__builtin_amdgcn_mfma_f32_32x32x16_bf16(PAF(1),VFR(1),o[0],0,0,0), C0,8); \
    KRD(GL,1); GAPB(o[1]=__builtin_amdgcn_mfma_f32_32x32x16_bf16(PAF(1),VFR(5),o[1],0,0,0), C0,12); \
    KRD(GL,2); GAPB(o[0]=__builtin_amdgcn_mfma_f32_32x32x16_bf16(PAF(2),VFR(2),o[0],0,0,0), C1,0); \
    KRD(GL,3); GAPB(o[1]=__builtin_amdgcn_mfma_f32_32x32x16_bf16(PAF(2),VFR(6),o[1],0,0,0), C1,4); \
    GAPB(o[0]=__builtin_amdgcn_mfma_f32_32x32x16_bf16(PAF(3),VFR(3),o[0],0,0,0), C1,8); \
    GAPB(o[1]=__builtin_amdgcn_mfma_f32_32x32x16_bf16(PAF(3),VFR(7),o[1],0,0,0), C1,12); \
    }while(0)
  #define ENDW(tt) do{ if((tt)+3<NT){WAIT_BAR(2);} else if((tt)+2<NT){WAIT_BAR(1);} else {WAIT_BAR(0);} }while(0)
  int t=1;
  for(;t+1<NT;t+=2){
    STEP(pB0,pB1,pA0,pA1,t,(t+3<NT),(t+1<NT),(t+1<NT));       ENDW(t);   RESC(); ROT();
    STEP(pA0,pA1,pB0,pB1,t+1,(t+4<NT),(t+2<NT),(t+2<NT));     ENDW(t+1); RESC(); ROT();
  }
  STEP(pB0,pB1,pA0,pA1,NT-1,false,false,false); RESC();
  { float sacc=pB0[0]+pB0[1]; _Pragma("unroll") for(int r=2;r<16;++r)sacc+=pB0[r]; _Pragma("unroll") for(int r=0;r<16;++r)sacc+=pB1[r]; l_reg+=sacc;
    SBAR(); pv(o, c.vb0 + sl_cur, pack8(pB0,0), pack8(pB0,8), pack8(pB1,0), pack8(pB1,8)); }
  l_out = l_reg;
  asm volatile("s_waitcnt lgkmcnt(0)\n\ts_barrier":::"memory");
  #undef WAIT_BAR
  #undef TILE_OF
  #undef DMA_K
  #undef DMA_V
  #undef CMASK
  #undef START
  #undef RESC
  #undef ROT
  #undef PKW
  #undef PAF
  #undef VFR
  #undef PIN
  #undef MX3
  #undef GAPA
  #undef EX
  #undef GAPB
  #undef VRD
  #undef KRD
  #undef STEP
  #undef ENDW
}

__device__ __forceinline__ void attn_unit(int b, int g, int qb, unsigned char* slab, LAS unsigned char* shm) {
    const bf16_t* Q = (const bf16_t*)(slab + SO_Q); const bf16_t* KV = (const bf16_t*)(slab + SO_KV); const bf16_t* KC = (const bf16_t*)(slab + SO_KC); const bf16_t* VC = (const bf16_t*)(slab + SO_VC);
    const float* gates = (const float*)(slab + SO_GATES); bf16_t* O = (bf16_t*)(slab + SO_O);
    Ctx c;
    const int tid = threadIdx.x;
    c.lane = tid & 63; c.r32 = c.lane & 31; c.hi = c.lane >> 5; c.wid = __builtin_amdgcn_readfirstlane(tid >> 6);
    const int kh = c.wid >> 1, qh = c.wid & 1, head = g * 4 + kh;
    c.ql = qh * 32 + c.r32; c.qb = qb; c.shm = shm; c.lds0 = (unsigned)(size_t)shm;
    c.wsf = (LAS float*)(shm + L_WS) + c.wid * 128;
    c.koff = c.lane * 64 + c.wid * 8;
    c.voff = (16 * (c.wid & 3) + (c.lane >> 2)) * 64 + (c.wid >> 2) * 32 + (c.lane & 3) * 8;
    c.kdst = c.lds0 + L_K + c.wid * 1024; c.vdst = c.lds0 + L_V + c.wid * 1024;
    c.vb0 = (int)(c.lds0 + L_V) + ((c.lane >> 4) & 1) * 32 + (c.lane & 3) * 8 + (4 * c.hi + ((c.lane & 15) >> 2)) * 64;
    const int t = qb * 64 + c.ql;
    const size_t mrow = (size_t)t;
    const size_t bg = (size_t)g;
    const bf16_t* KSb = KV + ((size_t)2 * 4 + g) * (SEQ * 64);
    const bf16_t* VSb = KV + ((size_t)3 * 4 + g) * (SEQ * 64);
    const bf16_t* KWb = KV + ((size_t)4 * 4 + g) * (SEQ * 64);
    const bf16_t* VWb = KV + ((size_t)5 * 4 + g) * (SEQ * 64);
    const bf16_t* KCb = KC + bg * 8192; const bf16_t* VCb = VC + bg * 8192;
    dma_k(c, KCb, 0, 0); dma_k(c, KCb, 1, 1); dma_v(c, VCb, 0, 0); dma_v(c, VCb, 1, 1);
    dma_k(c, KSb, 0, 2); dma_v(c, VSb, 0, 2);
    bf16x8 qr[4];
    { const bf16_t* Qw = Q + mrow * DM + head * 64 + c.hi * 8;
#pragma unroll
      for (int d0 = 0; d0 < 4; ++d0) qr[d0] = *(const bf16x8*)(Qw + d0 * 16); }
    const float* gp = gates + mrow * 48 + head * 3;
    const float g0 = gp[0], g1 = gp[1], g2 = gp[2];
    f32x16 ot[2];
    f32x16 o[2];
    const bool two = qb >= 16;
    ATT_WAIT_BAR(2);
    {
        f32x16 a0, a1, b0, b1;
        qkt(a0, a1, shm + L_K, qr, c.r32, c.hi);
        const int nmax = (t >= 31) ? ((t - 31) >> 4) : -1;
        range_mask(a0, a1, 0, nmax, c.hi);
        float rm = rowmax(a0, a1);
        if (two) { qkt(b0, b1, shm + L_K + SLOTB, qr, c.r32, c.hi); range_mask(b0, b1, 0, nmax - 64, c.hi); rm = fmaxf(rm, rowmax(b0, b1)); }
        const float mu = (rm == -INFINITY) ? 0.f : rm;
        float s = 0.f;
#pragma unroll
        for (int r = 0; r < 16; ++r) { a0[r] = __builtin_amdgcn_exp2f(a0[r] - mu); a1[r] = __builtin_amdgcn_exp2f(a1[r] - mu); s += a0[r] + a1[r]; }
        if (two) {
#pragma unroll
            for (int r = 0; r < 16; ++r) { b0[r] = __builtin_amdgcn_exp2f(b0[r] - mu); b1[r] = __builtin_amdgcn_exp2f(b1[r] - mu); s += b0[r] + b1[r]; }
        }
        s = halfsum(s);
        const float inv = (s > 0.f) ? 1.0f / s : 0.f;
#pragma unroll
        for (int r = 0; r < 16; ++r) { a0[r] *= inv; a1[r] *= inv; }
        if (two) {
#pragma unroll
            for (int r = 0; r < 16; ++r) { b0[r] *= inv; b1[r] *= inv; }
            int qlx = c.ql; LAUNDER(qlx);
            LAS float* IA = (LAS float*)(shm + L_IA) + (kh * 64 + qlx) * 33;
            LAS float* IB = (LAS float*)(shm + L_IB) + (kh * 64 + qlx) * 33;
#pragma unroll
            for (int i = 0; i < 4; ++i) {
                const int j = 2 * i + c.hi;
                IA[j]      = a0[4 * i] + a0[4 * i + 1] + a0[4 * i + 2] + 0.5f * a0[4 * i + 3]; IB[j + 1]  = 0.5f * a0[4 * i + 3];
                IA[j + 8]  = a1[4 * i] + a1[4 * i + 1] + a1[4 * i + 2] + 0.5f * a1[4 * i + 3]; IB[j + 9]  = 0.5f * a1[4 * i + 3];
                IA[j + 16] = b0[4 * i] + b0[4 * i + 1] + b0[4 * i + 2] + 0.5f * b0[4 * i + 3]; IB[j + 17] = 0.5f * b0[4 * i + 3];
                IA[j + 24] = b1[4 * i] + b1[4 * i + 1] + b1[4 * i + 2] + 0.5f * b1[4 * i + 3]; IB[j + 25] = 0.5f * b1[4 * i + 3];
            }
        }
        o[0] = f32x16{}; o[1] = f32x16{};
        pv(o, c.vb0, pack8(a0, 0), pack8(a0, 8), pack8(a1, 0), pack8(a1, 8));
        if (two) pv(o, c.vb0 + SLOTB, pack8(b0, 0), pack8(b0, 8), pack8(b1, 0), pack8(b1, 8));
        float cf[16]; row_bcast(g0, cf, c.wsf, c.r32, c.hi);
#pragma unroll
        for (int r = 0; r < 16; ++r) { ot[0][r] = o[0][r] * cf[r]; ot[1][r] = o[1][r] * cf[r]; }
    }
    ATT_WAIT_BAR(0);
    LAS unsigned* SEL = (LAS unsigned*)(shm + L_SEL);
    if (two) {
        int q = tid & 63, jg = tid >> 6; LAUNDER(q); LAUNDER(jg);
        LAS float* SC = (LAS float*)(shm + L_SC);
        const LAS float* IA = (const LAS float*)(shm + L_IA); const LAS float* IB = (const LAS float*)(shm + L_IB);
#pragma unroll
        for (int jj = 0; jj < 4; ++jj) { const int j = 4 * jg + jj; float sc = 0.f;
#pragma unroll
            for (int k = 0; k < 4; ++k) { sc += IA[(k * 64 + q) * 33 + j]; if (j > 0) sc += IB[(k * 64 + q) * 33 + j]; }
            const bool forced = (j == 0) || (j == qb) || (j == qb - 1);
            SC[q * 33 + j] = forced ? 1e30f : ((j <= qb) ? sc : -1e30f); }
        ATT_WAIT_BAR(0);
        unsigned nib = 0u;
        float sj[4];
#pragma unroll
        for (int jj = 0; jj < 4; ++jj) sj[jj] = SC[q * 33 + 4 * jg + jj];
        int rank[4] = {0, 0, 0, 0};
        for (int i = 0; i < 32; ++i) { const float si = SC[q * 33 + i];
#pragma unroll
            for (int jj = 0; jj < 4; ++jj) { const int j = 4 * jg + jj; rank[jj] += (si > sj[jj] || (si == sj[jj] && i < j)) ? 1 : 0; } }
#pragma unroll
        for (int jj = 0; jj < 4; ++jj) nib |= (rank[jj] < 16 ? 1u : 0u) << jj;
        ((LAS unsigned char*)(shm + L_NIB))[q * 8 + jg] = (unsigned char)nib;
        ATT_WAIT_BAR(0);
        if (tid < 64) { unsigned mk = 0u; int tq = tid; LAUNDER(tq);
#pragma unroll
            for (int k = 0; k < 8; ++k) mk |= (unsigned)((LAS unsigned char*)(shm + L_NIB))[tq * 8 + k] << (4 * k);
            SEL[tq] = mk; }
        ATT_WAIT_BAR(0);
    } else {
        if (tid < 64) SEL[tid] = (1u << (qb + 1)) - 1u;
        ATT_WAIT_BAR(0);
    }
    int lnx = c.lane, qlx2 = c.ql; LAUNDER(lnx); LAUNDER(qlx2);
    LAS float* accp = (LAS float*)(shm + L_IA) + c.wid * 2048 + lnx;
#pragma unroll
    for (int r = 0; r < 16; ++r) { accp[r * 64] = ot[0][r]; accp[(16 + r) * 64] = ot[1][r]; }
    unsigned um = SEL[lnx];
#pragma unroll
    for (int sft = 1; sft < 64; sft <<= 1) um |= (unsigned)__shfl_xor((int)um, sft);
    um = (unsigned)__builtin_amdgcn_readfirstlane((int)um);
    um &= (qb == 31) ? 0xffffffffu : ((1u << (qb + 1)) - 1u);
    const unsigned msel = SEL[qlx2];
    (void)um;
    {
        float l_sel; f32x16 osel[2];
        sel_stream<8>(c, KSb, VSb, qr, msel, qb, osel, l_sel);
        const float lt = halfsum(l_sel);
        float cf[16]; row_bcast((lt > 0.f) ? g1 / lt : 0.f, cf, c.wsf, c.r32, c.hi);
#pragma unroll
        for (int r = 0; r < 16; ++r) { accp[r * 64] += osel[0][r] * cf[r]; accp[(16 + r) * 64] += osel[1][r] * cf[r]; }
    }
    {
        const int lo_t = qb >= 8 ? qb - 8 : 0, nw = qb - lo_t + 1;
        dma_k(c, KWb, qb, 0); dma_v(c, VWb, qb, 0);
        if (nw > 1) { dma_k(c, KWb, qb - 1, 1); dma_v(c, VWb, qb - 1, 1); }
        BrState st; br_reset(st);
        int slot = 0;
        for (int j = 0; j < nw; ++j) {
            if (j + 1 < nw) ATT_WAIT_BAR(2); else ATT_WAIT_BAR(0);
            if (j + 2 < nw) { const int ps = (slot == 0) ? 2 : slot - 1; dma_k(c, KWb, qb - j - 2, ps); dma_v(c, VWb, qb - j - 2, ps); }
            const int tc = qb - j;
            bool use_range = false; int lo = 0, hv = 63;
            if (j == 0) { use_range = true; hv = c.ql; }
            else if (tc == qb - 8) { use_range = true; lo = c.ql + 1; }
            stream_step(c, slot, qr, true, use_range, lo, hv, j == 0, st);
            slot = (slot == 2) ? 0 : slot + 1;
        }
        const float lt = halfsum(st.l);
        float cf[16]; row_bcast((lt > 0.f) ? g2 / lt : 0.f, cf, c.wsf, c.r32, c.hi);
#pragma unroll
        for (int r = 0; r < 16; ++r) { ot[0][r] = accp[r * 64] + st.o[0][r] * cf[r]; ot[1][r] = accp[(16 + r) * 64] + st.o[1][r] * cf[r]; }
        LDS_WAIT();
    }
    {
        LAS bf16_t* stg = (LAS bf16_t*)(shm + L_IA) + c.wid * 4096;
        int lny = c.lane; LAUNDER(lny);
        LAS bf16_t* stw = stg + ((lny >> 5) * 4) * 64 + (lny & 31);
#pragma unroll
        for (int r = 0; r < 16; ++r) { const int orow = (r & 3) + 8 * (r >> 2);
#pragma unroll
            for (int d0 = 0; d0 < 2; ++d0) stw[orow * 64 + d0 * 32] = (bf16_t)(cvtpk(ot[d0][r], 0.f) & 0xffffu); }
        LDS_WAIT();
        bf16_t* Ow = O + ((size_t)qb * 64 + qh * 32) * DM + head * 64;
#pragma unroll
        for (int i = 0; i < 4; ++i) { const int row = i * 8 + (lny >> 3), chn = lny & 7; const u32x4 v = *(const LAS u32x4*)(stg + row * 64 + chn * 8); *(u32x4*)(Ow + (size_t)row * DM + chn * 8) = v; }
    }
    ATT_WAIT_BAR(0);
}
#undef SBAR
}

#define XB_TMO      128
#define XB_XCNT(j)  (256  + 64 * (j))
#define XB_XSUB(j)  (1280 + 64 * (j))
#define XB_XGEN(j)  (2304 + 64 * (j))
#define XB_TOP      3328
#define XB_TOPGEN   3392
#define XB_LSUB(j)  (3456 + 64 * (j))
#define XB_LGEN(j)  (4480 + 64 * (j))
#define XCD_BAR_WORDS 5504
#define XB_SPIN_CAP (1u << 18)
__device__ __forceinline__ unsigned xb_ld(unsigned* p)              { return __hip_atomic_load(p, __ATOMIC_RELAXED, __HIP_MEMORY_SCOPE_AGENT); }
__device__ __forceinline__ unsigned xb_add(unsigned* p, unsigned v) { return __hip_atomic_fetch_add(p, v, __ATOMIC_RELAXED, __HIP_MEMORY_SCOPE_AGENT); }
__device__ __forceinline__ unsigned xb_xcc_id() { return (unsigned)__builtin_amdgcn_s_getreg((3 << 11) | 20) & 0xFu; }
#define XB_SPIN(cond, bar) do { unsigned _sp = 0; while (cond) { __builtin_amdgcn_s_sleep(1); \
    if ((++_sp & 255u) == 0u) { if (xb_ld(&(bar)[XB_TMO])) break; if (_sp > XB_SPIN_CAP) { atomicAdd(&(bar)[XB_TMO], 1u); break; } } } } while (0)
struct XcdBarrier { unsigned* bar; unsigned x; volatile LAS unsigned* st; };
__device__ __forceinline__ XcdBarrier xcd_barrier_post(unsigned* bar, volatile LAS unsigned* st) {
    XcdBarrier b; b.bar = bar; b.x = xb_xcc_id(); b.st = st;
    if (threadIdx.x == 0) { st[2] = xb_add(&bar[XB_XCNT(b.x)], 1u); st[4] = b.x; }
    return b;
}
__device__ __forceinline__ void xcd_barrier_complete(unsigned* bar, unsigned x, unsigned& nloc, unsigned& nx, unsigned& uniform) {
    const unsigned G = gridDim.x * gridDim.y * gridDim.z;
    unsigned sum, cnt, mine, sp = 0u, uni;
    for (;;) {
        sum = 0u; cnt = 0u; mine = 0u; uni = 1u;
#pragma unroll
        for (unsigned j = 0; j < 16; ++j) { const unsigned c = xb_ld(&bar[XB_XCNT(j)]); sum += c; cnt += (c > 0u) ? 1u : 0u; mine = (j == x) ? c : mine;
            if (j < 8u ? (c != 32u) : (c != 0u)) uni = 0u; }
        if (sum == G) break;
        __builtin_amdgcn_s_sleep(1);
        if ((++sp & 255u) == 0u) { if (xb_ld(&bar[XB_TMO])) break; if (sp > XB_SPIN_CAP) { atomicAdd(&bar[XB_TMO], 1u); break; } }
    }
    nloc = mine > 0u ? mine : 1u; nx = cnt > 0u ? cnt : 1u;
    uniform = (uni != 0u && sum == G && G == 256u) ? 1u : 0u;
}
__device__ __forceinline__ void xcd_barrier(const XcdBarrier& b) {
    asm volatile("s_waitcnt vmcnt(0)" ::: "memory");
    __syncthreads();
    if (threadIdx.x == 0) {
        unsigned* bar = b.bar;
        __builtin_amdgcn_s_waitcnt(0);
        unsigned nloc = b.st[0], nx = b.st[1];
        if (nloc == 0u) { unsigned uf; xcd_barrier_complete(bar, b.x, nloc, nx, uf); b.st[0] = nloc; b.st[1] = nx; b.st[3] = uf; }
        const unsigned old = xb_add(&bar[XB_XSUB(b.x)], 1u);
        const unsigned gen = old / nloc;
        if (old + 1u == (gen + 1u) * nloc) {
            __builtin_amdgcn_fence(__ATOMIC_RELEASE, "agent");
            asm volatile("s_waitcnt vmcnt(0)" ::: "memory");
            const unsigned og = xb_add(&bar[XB_TOP], 1u);
            const unsigned tg = og / nx;
            if (og + 1u == (tg + 1u) * nx) xb_add(&bar[XB_TOPGEN], 1u);
            else XB_SPIN(xb_ld(&bar[XB_TOPGEN]) == tg, bar);
            __builtin_amdgcn_fence(__ATOMIC_ACQUIRE, "agent");
            xb_add(&bar[XB_XGEN(b.x)], 1u);
            asm volatile("s_waitcnt vmcnt(0)" ::: "memory");
        } else {
            XB_SPIN(xb_ld(&bar[XB_XGEN(b.x)]) == gen, bar);
            __builtin_amdgcn_fence(__ATOMIC_ACQUIRE, "agent");
            asm volatile("s_waitcnt vmcnt(0)" ::: "memory");
        }
    }
    __syncthreads();
}

__device__ __forceinline__ void xcd_local_barrier(const XcdBarrier& b) {
    asm volatile("s_waitcnt vmcnt(0)" ::: "memory");
    __syncthreads();
    if (threadIdx.x == 0) {
        unsigned* bar = b.bar;
        __builtin_amdgcn_s_waitcnt(0);
        const unsigned nloc = b.st[0];
        const unsigned old = xb_add(&bar[XB_LSUB(b.x)], 1u);
        const unsigned gen = old / nloc;
        if (old + 1u == (gen + 1u) * nloc) xb_add(&bar[XB_LGEN(b.x)], 1u);
        else XB_SPIN(xb_ld(&bar[XB_LGEN(b.x)]) == gen, bar);
        __builtin_amdgcn_fence(__ATOMIC_ACQUIRE, "agent");
        asm volatile("s_waitcnt vmcnt(0)" ::: "memory");
    }
    __syncthreads();
}

struct Args {
    const float *x, *c, *norm_gain, *w_ada, *b_ada, *w_a_in, *conv_w, *w_a_out, *w_qg, *q_gain, *w_o, *kv_norm_gain, *w_ada_kv, *b_ada_kv, *w_kv, *k_gain, *cmp_pe, *cmp_w1, *cmp_w2, *w_mlp1, *w_mlp2;
    float* out; unsigned char* ws; int ph_lo, ph_hi;
};

__device__ __forceinline__ void transpose_item(const float* W, int ldn, int srccol, int nvalid, int k0, bf16_t* WT, int Kd, int drow0, LAS float* scr, int lane) {
    if (nvalid == 32) {
        f32x4 t[8];
#pragma unroll
        for (int i = 0; i < 8; ++i) t[i] = __builtin_nontemporal_load((const f32x4*)(W + (size_t)(k0 + 8 * i + (lane >> 3)) * ldn + srccol + (lane & 7) * 4));
#pragma unroll
        for (int i = 0; i < 8; ++i) { LAS float* d = scr + (8 * i + (lane >> 3)) * 33 + (lane & 7) * 4; d[0] = t[i][0]; d[1] = t[i][1]; d[2] = t[i][2]; d[3] = t[i][3]; }
    } else {
#pragma unroll 8
        for (int i = 0; i < 32; ++i) { const int kk = 2 * i + (lane >> 5), n = lane & 31; scr[kk * 33 + n] = (n < nvalid) ? W[(size_t)(k0 + kk) * ldn + srccol + n] : 0.f; }
    }
    LDS_WAIT(); asm volatile("" ::: "memory");
    const int ch = lane & 7;
#pragma unroll
    for (int j = 0; j < 4; ++j) { const int n = (lane >> 3) + 8 * j; const LAS float* s = scr + (8 * ch) * 33 + n;
        u32x4 o; o.x = cvtpk(s[0 * 33], s[1 * 33]); o.y = cvtpk(s[2 * 33], s[3 * 33]); o.z = cvtpk(s[4 * 33], s[5 * 33]); o.w = cvtpk(s[6 * 33], s[7 * 33]);
        *(u32x4*)(WT + (size_t)(drow0 + n) * Kd + k0 + 8 * ch) = o; }
    LDS_WAIT(); asm volatile("" ::: "memory");
}
__device__ __forceinline__ int perm_head_cols(int d) { const int t = d >> 8, p = d & 255; return 256 * t + 64 * ((p >> 5) & 3) + 32 * (p >> 7) + (p & 31); }

constexpr int TI_AIN = 1536, TI_AOUT = 512, TI_M1 = 2048, TI_M2 = 2048, TI_KV = 768, TI_QG = 640, TI_O = 512, TI_C1 = 256, TI_C2 = 8;
constexpr int TI_TOTAL = TI_AIN + TI_AOUT + 2 * TI_M1 + 2 * TI_M2 + TI_KV + TI_QG + TI_O + 2 * TI_C1 + 2 * TI_C2;

__device__ __forceinline__ void p0_item(const Args& a, int it, LAS float* scr, int lane) {
    unsigned char* ws = a.ws;
    int r = it;
    if (r < TI_AIN) { const int kb = r / 96, nb = r % 96, d = 32 * nb; int src;
        if (d < 1024) src = d; else { const int t = (d - 1024) >> 8, p = (d - 1024) & 255; src = (p < 128) ? (1024 + 128 * t + p) : (2048 + 128 * t + (p - 128)); }
        transpose_item(a.w_a_in, 3072, src, 32, 64 * kb, (bf16_t*)(ws + WS_WAIN), 1024, d, scr, lane); return; }
    r -= TI_AIN;
    if (r < TI_AOUT) { const int kb = r / 32, nb = r % 32; transpose_item(a.w_a_out, 1024, 32 * nb, 32, 64 * kb, (bf16_t*)(ws + WS_WAOUT), 1024, 32 * nb, scr, lane); return; }
    r -= TI_AOUT;
    if (r < 2 * TI_M1) { const int L = r / TI_M1, q = r % TI_M1, kb = q / 128, nb = q % 128;
        transpose_item(a.w_mlp1 + (size_t)L * DM * FF, FF, 32 * nb, 32, 64 * kb, (bf16_t*)(ws + WS_WM1) + (size_t)L * FF * DM, DM, 32 * nb, scr, lane); return; }
    r -= 2 * TI_M1;
    if (r < 2 * TI_M2) { const int L = r / TI_M2, q = r % TI_M2, kb = q / 32, nb = q % 32;
        transpose_item(a.w_mlp2 + (size_t)L * FF * DM, DM, 32 * nb, 32, 64 * kb, (bf16_t*)(ws + WS_WM2) + (size_t)L * DM * FF, FF, 32 * nb, scr, lane); return; }
    r -= 2 * TI_M2;
    if (r < TI_KV) { const int kb = r / 48, nb = r % 48, d = 32 * nb;
        transpose_item(a.w_kv, 1536, perm_head_cols(d), 32, 64 * kb, (bf16_t*)(ws + WS_WKVQ), DM, d, scr, lane); return; }
    r -= TI_KV;
    if (r < TI_QG) { const int kb = r / 40, nb = r % 40, d = 32 * nb; int src, nv = 32;
        if (d < 1024) src = perm_head_cols(d); else { const int p = d - 1024; src = 1024 + p; nv = 48 - p; nv = nv < 0 ? 0 : (nv > 32 ? 32 : nv); if (nv == 0) src = 0; }
        transpose_item(a.w_qg, 1072, src, nv, 64 * kb, (bf16_t*)(ws + WS_WKVQ), DM, 1536 + d, scr, lane); return; }
    r -= TI_QG;
    if (r < TI_O) { const int kb = r / 32, nb = r % 32; transpose_item(a.w_o, 1024, 32 * nb, 32, 64 * kb, (bf16_t*)(ws + WS_WO), 1024, 32 * nb, scr, lane); return; }
    r -= TI_O;
    if (r < 2 * TI_C1) { const int kv = r / TI_C1, q = r % TI_C1, kb = q / 8, nb = q % 8;
        transpose_item(a.cmp_w1 + (size_t)kv * 2048 * 256, 256, 32 * nb, 32, 64 * kb, (bf16_t*)(ws + WS_WC1) + (size_t)kv * 256 * 2048, 2048, 32 * nb, scr, lane); return; }
    r -= 2 * TI_C1;
    { const int kv = r / TI_C2, q = r % TI_C2, kb = q / 2, nb = q % 2;
        transpose_item(a.cmp_w2 + (size_t)kv * 256 * 64, 64, 32 * nb, 32, 64 * kb, (bf16_t*)(ws + WS_WC2) + (size_t)kv * 64 * 256, 256, 32 * nb, scr, lane); }
}

__device__ __forceinline__ void p0_mods(const Args& a, LAS unsigned char* lds, int vblk, int G) {
    LAS float* cact = (LAS float*)lds;
    LAS float* red = (LAS float*)(lds + 32768);
    const int tid = threadIdx.x, lane = tid & 63, wave = tid >> 6;
    bool have = false;
    for (int u = vblk; u < 224; u += G) {
        if (!have) { for (int i = tid; i < 8 * DM; i += 512) { const float cv = a.c[i]; cact[i] = cv / (1.0f + __expf(-cv)); } have = true; }
        __syncthreads();
        const int col = u * 64 + lane;
        const float* W; const float* bias; float* dst; int N, c0;
        if (col < 6144) { W = a.w_ada; bias = a.b_ada; dst = (float*)(a.ws + WS_MOD0); N = 6144; c0 = col; }
        else if (col < 12288) { W = a.w_ada + (size_t)DM * 6144; bias = a.b_ada + 6144; dst = (float*)(a.ws + WS_MOD1); N = 6144; c0 = col - 6144; }
        else { W = a.w_ada_kv; bias = a.b_ada_kv; dst = (float*)(a.ws + WS_MODKV); N = 2048; c0 = col - 12288; }
        float acc[8];
#pragma unroll
        for (int b = 0; b < 8; ++b) acc[b] = 0.f;
        const float* wp = W + (size_t)(wave * 128) * N + c0;
        const LAS float* cp = cact + wave * 128;
#pragma unroll 8
        for (int k = 0; k < 128; ++k) { const float w = __builtin_nontemporal_load(wp + (size_t)k * N);
#pragma unroll
            for (int b = 0; b < 8; ++b) acc[b] += w * cp[b * DM + k]; }
#pragma unroll
        for (int b = 0; b < 8; ++b) red[(wave * 8 + b) * 64 + lane] = acc[b];
        __syncthreads();
        { const int b = wave; float sacc = bias[c0];
#pragma unroll
          for (int w = 0; w < 8; ++w) sacc += red[(w * 8 + b) * 64 + lane];
          dst[(size_t)b * N + c0] = sacc; }
        __syncthreads();
    }
    __syncthreads();
}

__device__ __forceinline__ void p1_norm_row2(const Args& a, int m0, int lane) {
    const int b = m0 >> 11;
    const float* mod0 = (const float*)(a.ws + WS_MOD0) + (size_t)b * 6144;
    const f32x4* xr = (const f32x4*)(a.x + (size_t)m0 * DM) + lane;
    f32x4 v[2][4]; float s0 = 0.f, s1 = 0.f;
#pragma unroll
    for (int j = 0; j < 4; ++j) { v[0][j] = __builtin_nontemporal_load(xr + 64 * j); v[1][j] = __builtin_nontemporal_load(xr + 256 + 64 * j); }
#pragma unroll
    for (int j = 0; j < 4; ++j) { s0 += (v[0][j][0] * v[0][j][0] + v[0][j][1] * v[0][j][1]) + (v[0][j][2] * v[0][j][2] + v[0][j][3] * v[0][j][3]);
                                  s1 += (v[1][j][0] * v[1][j][0] + v[1][j][1] * v[1][j][1]) + (v[1][j][2] * v[1][j][2] + v[1][j][3] * v[1][j][3]); }
#pragma unroll
    for (int o = 1; o < 64; o <<= 1) { s0 += __shfl_xor(s0, o); s1 += __shfl_xor(s1, o); }
    const float r0 = rsqrtf(s0 * (1.0f / DM) + EPS), r1 = rsqrtf(s1 * (1.0f / DM) + EPS);
    u32x2* o8 = (u32x2*)((bf16_t*)(a.ws + WS_A2) + (size_t)m0 * DM) + lane;
#pragma unroll
    for (int j = 0; j < 4; ++j) { const int col = 4 * lane + 256 * j;
        const f32x4 gn = *(const f32x4*)(a.norm_gain + col), sh = *(const f32x4*)(mod0 + col), sc = *(const f32x4*)(mod0 + 1024 + col) + 1.0f;
        const f32x4 h0 = (v[0][j] * r0 * gn) * sc + sh, h1 = (v[1][j] * r1 * gn) * sc + sh;
        u32x2 w; w.x = cvtpk(h0[0], h0[1]); w.y = cvtpk(h0[2], h0[3]); o8[64 * j] = w;
        w.x = cvtpk(h1[0], h1[1]); w.y = cvtpk(h1[2], h1[3]); o8[256 + 64 * j] = w; }
}
__device__ __forceinline__ void p1_bias_task(const bf16_t* Wt, int n0, const float* shift, int shift_stride, float* bias, int bias_stride, int lane) {
    const int r = lane & 15, kq = lane >> 4;
    const bf16_t* wp = Wt + (size_t)(n0 + r) * DM + 8 * kq;
    const float* sp = shift + (size_t)(r & 7) * shift_stride + 8 * kq;
    f32x4 acc = (f32x4){0.f, 0.f, 0.f, 0.f};
#pragma unroll 8
    for (int k0 = 0; k0 < DM; k0 += 32) {
        const bf16x8 bf = *(const bf16x8*)(wp + k0);
        const f32x4 s0 = *(const f32x4*)(sp + k0), s1 = *(const f32x4*)(sp + k0 + 4);
        u32x4 aw; aw.x = cvtpk(s0[0], s0[1]); aw.y = cvtpk(s0[2], s0[3]); aw.z = cvtpk(s1[0], s1[1]); aw.w = cvtpk(s1[2], s1[3]);
        if (r >= 8) aw = (u32x4){0u, 0u, 0u, 0u};
        acc = __builtin_amdgcn_mfma_f32_16x16x32_bf16(__builtin_bit_cast(bf16x8, aw), bf, acc, 0, 0, 0);
    }
    if (kq < 2) {
#pragma unroll
        for (int e = 0; e < 4; ++e) bias[(size_t)(4 * kq + e) * bias_stride + n0 + r] = acc[e];
    }
}
__device__ __forceinline__ void p1_pebias(const Args& a, int idx, int lane) {
    const int kv = idx >> 8;
    const bf16_t* wrow = (const bf16_t*)(a.ws + WS_WC1) + (size_t)idx * 2048;
    const float* pe = a.cmp_pe + (size_t)kv * 2048;
    float d = 0.f;
#pragma unroll
    for (int j = 0; j < 4; ++j) { const int k = (lane + 64 * j) * 8; const u32x4 w = *(const u32x4*)(wrow + k); const f32x4 p0 = *(const f32x4*)(pe + k), p1 = *(const f32x4*)(pe + k + 4);
        d += p0[0] * bf_lo(w.x) + p0[1] * bf_hi(w.x) + p0[2] * bf_lo(w.y) + p0[3] * bf_hi(w.y) + p1[0] * bf_lo(w.z) + p1[1] * bf_hi(w.z) + p1[2] * bf_lo(w.w) + p1[3] * bf_hi(w.w); }
    d = wave_sum(d);
    if (lane == 0) ((float*)(a.ws + WS_PEB))[idx] = d;
}

__device__ __forceinline__ void unpack8(const u32x4 w, float (&f)[8]) { f[0] = bf_lo(w.x); f[1] = bf_hi(w.x); f[2] = bf_lo(w.y); f[3] = bf_hi(w.y); f[4] = bf_lo(w.z); f[5] = bf_hi(w.z); f[6] = bf_lo(w.w); f[7] = bf_hi(w.w); }
__device__ __forceinline__ void p3_conv(const Args& a, int gtid, int nthreads) {
    for (int it0 = gtid; it0 < 128 * 2048; it0 += nthreads) {
        const int pass = it0 / nthreads, vt = it0 - pass * nthreads;
        const int it = (nthreads == 131072) ? ((vt >> 14) * 32768 + pass * 16384 + (vt & 16383)) : it0;
        const int cch = it & 127, rch = it >> 7, col = cch * 8, r0 = (rch * 8) & (SEQ - 1);
        unsigned char* slab = a.ws + WS_R + (size_t)((rch * 8) >> 11) * SLAB;
        const bf16_t* GB = (const bf16_t*)(slab + SO_GB); const bf16_t* V = (const bf16_t*)(slab + SO_V); bf16_t* Y = (bf16_t*)(slab + SO_Y);
        float w0[8], w1[8], w2[8];
        { const f32x4 t0 = *(const f32x4*)(a.conv_w + col), t1 = *(const f32x4*)(a.conv_w + col + 4); w0[0] = t0[0]; w0[1] = t0[1]; w0[2] = t0[2]; w0[3] = t0[3]; w0[4] = t1[0]; w0[5] = t1[1]; w0[6] = t1[2]; w0[7] = t1[3]; }
        { const f32x4 t0 = *(const f32x4*)(a.conv_w + 1024 + col), t1 = *(const f32x4*)(a.conv_w + 1024 + col + 4); w1[0] = t0[0]; w1[1] = t0[1]; w1[2] = t0[2]; w1[3] = t0[3]; w1[4] = t1[0]; w1[5] = t1[1]; w1[6] = t1[2]; w1[7] = t1[3]; }
        { const f32x4 t0 = *(const f32x4*)(a.conv_w + 2048 + col), t1 = *(const f32x4*)(a.conv_w + 2048 + col + 4); w2[0] = t0[0]; w2[1] = t0[1]; w2[2] = t0[2]; w2[3] = t0[3]; w2[4] = t1[0]; w2[5] = t1[1]; w2[6] = t1[2]; w2[7] = t1[3]; }
        float vm2[8], vm1[8];
        if ((r0 & (SEQ - 1)) != 0) { unpack8(*(const u32x4*)(V + (size_t)(r0 - 2) * DM + col), vm2); unpack8(*(const u32x4*)(V + (size_t)(r0 - 1) * DM + col), vm1); }
        else {
#pragma unroll
            for (int e = 0; e < 8; ++e) { vm2[e] = 0.f; vm1[e] = 0.f; } }
#pragma unroll
        for (int i = 0; i < 8; ++i) { float vc[8], gb[8], y[8];
            unpack8(*(const u32x4*)(V + (size_t)(r0 + i) * DM + col), vc); unpack8(*(const u32x4*)(GB + (size_t)(r0 + i) * DM + col), gb);
#pragma unroll
            for (int e = 0; e < 8; ++e) { y[e] = gb[e] * (w2[e] * vc[e] + w1[e] * vm1[e] + w0[e] * vm2[e]); vm2[e] = vm1[e]; vm1[e] = vc[e]; }
            u32x4 w; w.x = cvtpk(y[0], y[1]); w.y = cvtpk(y[2], y[3]); w.z = cvtpk(y[4], y[5]); w.w = cvtpk(y[6], y[7]);
            *(u32x4*)(Y + (size_t)(r0 + i) * DM + col) = w; }
    }
}

__device__ __forceinline__ float gelu_tanh(float x) {
    const float z = 0.7978845608028654f * (x + 0.044715f * x * x * x);
    const float e = __builtin_amdgcn_exp2f(z * 2.8853900817779268f);
    const float th = 1.0f - 2.0f / (e + 1.0f);
    return 0.5f * x * (1.0f + th);
}
constexpr int C_CH = 2064;
constexpr int C_RB0 = 68608;
constexpr int C_HOFF = C_RB0, C_HROW = 528;
__device__ __forceinline__ void p8_unit(const Args& a, int u, LAS unsigned char* lds) {
    const int tid = threadIdx.x, lane = tid & 63, wid = __builtin_amdgcn_readfirstlane(tid >> 6), r = lane & 31, h = lane >> 5;
    const int kv = u >> 7, bg = (u >> 2) & 31, rq = u & 3;
    unsigned char* slab = a.ws + WS_R + (size_t)(bg >> 2) * SLAB;
    const bf16_t* src = (const bf16_t*)(slab + SO_KV) + ((size_t)(kv * 4 + (bg & 3)) * SEQ + 512 * rq) * 64;
    __syncthreads();
    { u32x4 v[8];
#pragma unroll
      for (int j = 0; j < 8; ++j) v[j] = *(const u32x4*)(src + (size_t)(tid + 512 * j) * 8);
      u32x4 vl = (u32x4){0u, 0u, 0u, 0u};
      if (tid < 128 && rq != 3) vl = *(const u32x4*)(src + (size_t)32 * 1024 + tid * 8);
#pragma unroll
      for (int j = 0; j < 8; ++j) { const int idx = tid + 512 * j; *(LAS u32x4*)(lds + (idx >> 7) * C_CH + (idx & 127) * 16) = v[j]; }
      if (tid < 128) *(LAS u32x4*)(lds + 32 * C_CH + tid * 16) = vl; }
    __syncthreads();
    f32x16 acc = f32x16{};
    const unsigned lds0 = (unsigned)(size_t)lds;
    const bf16_t* Wsrc = (const bf16_t*)(a.ws + WS_WC1) + (size_t)(kv * 256) * 2048;
    const int drow = 16 * wid + (lane >> 2);
    const bf16_t* dsrc0 = Wsrc + (size_t)drow * 2048 + 8 * ((lane & 3) ^ ((drow >> 2) & 3));
    const bf16_t* dsrc1 = dsrc0 + (size_t)128 * 2048;
    const unsigned ddst0 = lds0 + C_RB0 + wid * 1024, ddst1 = ddst0 + 8192;
    const int brow = 32 * wid + r;
    const unsigned boff = C_RB0 + brow * 64, bkey = (brow >> 2) & 3;
#define P8_DMA(stg) do { att::glds16(dsrc0 + 32 * (stg), (unsigned)__builtin_amdgcn_readfirstlane(ddst0 + ((stg) & 3) * 16384)); att::glds16(dsrc1 + 32 * (stg), (unsigned)__builtin_amdgcn_readfirstlane(ddst1 + ((stg) & 3) * 16384)); } while (0)
#define P8_STEP(stg, WAITN) do { asm volatile("s_waitcnt vmcnt(" #WAITN ") lgkmcnt(0)\n\ts_barrier" ::: "memory"); \
        if ((stg) + 3 < 64) P8_DMA((stg) + 3); \
        { const LAS unsigned char* bp = lds + boff + ((stg) & 3) * 16384; \
          const LAS unsigned char* ap = lds + (r + ((stg) >> 5)) * C_CH + ((32 * (stg)) & 1023) * 2 + 16 * h; \
          const bf16x8 a0 = *(const LAS bf16x8*)ap, a1 = *(const LAS bf16x8*)(ap + 32); \
          const bf16x8 b0 = *(const LAS bf16x8*)(bp + 16 * ((unsigned)h ^ bkey)), b1 = *(const LAS bf16x8*)(bp + 16 * ((unsigned)(2 + h) ^ bkey)); \
          acc = __builtin_amdgcn_mfma_f32_32x32x16_bf16(a0, b0, acc, 0, 0, 0); acc = __builtin_amdgcn_mfma_f32_32x32x16_bf16(a1, b1, acc, 0, 0, 0); } } while (0)
    P8_DMA(0); P8_DMA(1); P8_DMA(2);
    for (int s4 = 0; s4 < 60; s4 += 4) { P8_STEP(s4, 4); P8_STEP(s4 + 1, 4); P8_STEP(s4 + 2, 4); P8_STEP(s4 + 3, 4); }
    P8_STEP(60, 4); P8_STEP(61, 4); P8_STEP(62, 2); P8_STEP(63, 0);
    asm volatile("s_waitcnt lgkmcnt(0)\n\ts_barrier" ::: "memory");
#undef P8_DMA
#undef P8_STEP
    { const float pb = ((const float*)(a.ws + WS_PEB))[kv * 256 + 32 * wid + r];
      LAS bf16_t* H = (LAS bf16_t*)(lds + C_HOFF);
#pragma unroll
      for (int rg = 0; rg < 16; ++rg) { const int row = att::crow(rg, h); H[row * (C_HROW / 2) + 32 * wid + r] = (bf16_t)(cvtpk(gelu_tanh(acc[rg] + pb), 0.f) & 0xffffu); } }
    __syncthreads();
    if (wid == 0) {
        f32x16 o0 = f32x16{}, o1 = f32x16{};
        const bf16_t* W2 = (const bf16_t*)(a.ws + WS_WC2) + (size_t)kv * 64 * 256;
#pragma unroll
        for (int s = 0; s < 16; ++s) {
            const bf16x8 af = *(const LAS bf16x8*)(lds + C_HOFF + r * C_HROW + (16 * s + 8 * h) * 2);
            const bf16x8 b0 = *(const bf16x8*)(W2 + (size_t)r * 256 + 16 * s + 8 * h), b1 = *(const bf16x8*)(W2 + (size_t)(32 + r) * 256 + 16 * s + 8 * h);
            o0 = __builtin_amdgcn_mfma_f32_32x32x16_bf16(af, b0, o0, 0, 0, 0); o1 = __builtin_amdgcn_mfma_f32_32x32x16_bf16(af, b1, o1, 0, 0, 0);
        }
        const float gk0 = a.k_gain[r], gk1 = a.k_gain[32 + r];
        bf16_t* dst = (bf16_t*)(slab + (kv == 0 ? SO_KC : SO_VC)) + (size_t)(bg & 3) * 8192;
#pragma unroll
        for (int rg = 0; rg < 16; ++rg) { float v0 = o0[rg], v1 = o1[rg];
            if (kv == 0) { float ss = v0 * v0 + v1 * v1;
#pragma unroll
                for (int sft = 1; sft < 32; sft <<= 1) ss += __shfl_xor(ss, sft);
                const float rs = rsqrtf(ss * (1.0f / 64.0f) + EPS); v0 *= rs * gk0; v1 *= rs * gk1; }
            const int n = 32 * rq + att::crow(rg, h);
            if (n == 127) { v0 = 0.f; v1 = 0.f; }
            dst[n * 64 + r] = (bf16_t)(cvtpk(v0, 0.f) & 0xffffu); dst[n * 64 + 32 + r] = (bf16_t)(cvtpk(v1, 0.f) & 0xffffu); }
    }
}

__device__ __forceinline__ void p4_fixup(const Args& a, int pm) {
    const int tid = threadIdx.x;
    if (tid < 256) {
        const int rr = tid >> 7, cc = (tid & 127) * 8, pml = pm & 7, srow = pml * 256 + rr;
        unsigned char* slab = a.ws + WS_R + (size_t)(pm >> 3) * SLAB;
        const bf16_t* V = (const bf16_t*)(slab + SO_V); const bf16_t* GBH = (const bf16_t*)(slab + SO_GB) + (size_t)pml * 2 * DM; bf16_t* Y = (bf16_t*)(slab + SO_Y);
        float gb[8], v0[8], v1[8], v2[8], y[8];
        unpack8(*(const u32x4*)(GBH + (size_t)rr * DM + cc), gb);
        unpack8(*(const u32x4*)(V + (size_t)srow * DM + cc), v0);
        if (srow >= 1) unpack8(*(const u32x4*)(V + (size_t)(srow - 1) * DM + cc), v1); else {
#pragma unroll
            for (int e = 0; e < 8; ++e) v1[e] = 0.f; }
        if (srow >= 2) unpack8(*(const u32x4*)(V + (size_t)(srow - 2) * DM + cc), v2); else {
#pragma unroll
            for (int e = 0; e < 8; ++e) v2[e] = 0.f; }
#pragma unroll
        for (int e = 0; e < 8; ++e) y[e] = gb[e] * (a.conv_w[2 * DM + cc + e] * v0[e] + a.conv_w[DM + cc + e] * v1[e] + a.conv_w[cc + e] * v2[e]);
        u32x4 w; w.x = cvtpk(y[0], y[1]); w.y = cvtpk(y[2], y[3]); w.z = cvtpk(y[4], y[5]); w.w = cvtpk(y[6], y[7]);
        *(u32x4*)(Y + (size_t)srow * DM + cc) = w;
    }
}

__global__ void __launch_bounds__(NWAVES * 64, 2) yoco_fwd(Args args) {
    extern __shared__ __attribute__((aligned(16))) unsigned char lds_raw[];
    LAS unsigned char* lds = (LAS unsigned char*)lds_raw;
    const int tid = threadIdx.x, lane = tid & 63, wave = __builtin_amdgcn_readfirstlane(tid >> 6);
    const int G = gridDim.x, bx = blockIdx.x;
    int vcu = (G % 8 == 0) ? (bx % 8) * (G / 8) + bx / 8 : bx;
    int cid = bx;
    const int gw = vcu * NWAVES + wave, NGW = G * NWAVES;
    unsigned char* ws = args.ws;
    const int lo = args.ph_lo, hi = args.ph_hi;
    volatile LAS unsigned* MISC = (volatile LAS unsigned*)(lds + LDS_BYTES - 256);
    if (tid < 8) MISC[tid] = 0u;
    __syncthreads();
    XcdBarrier bar; bar.bar = (unsigned*)(ws + WS_BAR); bar.x = 0; bar.st = MISC;
    if (hi - lo > 1) bar = xcd_barrier_post((unsigned*)(ws + WS_BAR), MISC);
#define IN(k) (lo <= (k) && (k) < hi)
#define SEAM(k) do { if (IN(k) && IN((k) + 1)) xcd_barrier(bar); } while (0)
#define LSEAM(k) do { if (IN(k) && IN((k) + 1)) { if (local_ok) xcd_local_barrier(bar); else xcd_barrier(bar); } } while (0)
    bool local_ok = false;
    float* MOD0 = (float*)(ws + WS_MOD0); float* MOD1 = (float*)(ws + WS_MOD1); float* MODKV = (float*)(ws + WS_MODKV);
    float* SS1 = (float*)(ws + WS_SS1); float* SS2 = (float*)(ws + WS_SS2); float* SS3 = (float*)(ws + WS_SS3);
    bf16_t* A1 = (bf16_t*)(ws + WS_A1); bf16_t* A2 = (bf16_t*)(ws + WS_A2);
    bf16_t* HB = (bf16_t*)(ws + WS_H);

    if (IN(0)) {
        p0_mods(args, lds, vcu, G);
        LAS float* scr = (LAS float*)(lds + wave * 16384);
        for (int it = gw; it < TI_TOTAL; it += NGW) p0_item(args, it, scr, lane);
    }
    SEAM(0);
    if (IN(1)) {
        for (int m = gw; m < M_TOK / 2; m += NGW) p1_norm_row2(args, 2 * m, lane);
        for (int it = gw; it < (2 * FF + NKVQ) / 16 + 512; it += NGW) {
            const int n = it * 16;
            if (n < FF) p1_bias_task((const bf16_t*)(ws + WS_WM1), n, MOD0 + 3072, 6144, (float*)(ws + WS_BM1L0), FF, lane);
            else if (n < 2 * FF) p1_bias_task((const bf16_t*)(ws + WS_WM1) + (size_t)FF * DM, n - FF, MOD1 + 3072, 6144, (float*)(ws + WS_BM1L1), FF, lane);
            else if (n < 2 * FF + 1536) p1_bias_task((const bf16_t*)(ws + WS_WKVQ), n - 2 * FF, MODKV, 2048, (float*)(ws + WS_BKVQ), NKVQ, lane);
            else if (n < 2 * FF + NKVQ) p1_bias_task((const bf16_t*)(ws + WS_WKVQ), n - 2 * FF, MOD1, 6144, (float*)(ws + WS_BKVQ), NKVQ, lane);
            else p1_pebias(args, it - (2 * FF + NKVQ) / 16, lane);
        }
    }
    SEAM(1);
    if (hi - lo > 1 && lo <= 1) {
        local_ok = MISC[3] != 0u;
        if (local_ok) { const int x = (int)MISC[4], rk = (int)MISC[2]; vcu = x * 32 + rk; cid = rk * 8 + x; }
    }
    if (IN(2)) {
        pg8::Gemm g{A2, A2, 1 << 30, (const bf16_t*)(ws + WS_WAIN), M_TOK, 3072, DM, (size_t)SEQ * DM * 2}; pg8::StaticOrder S; S.init_ain(G, cid);
        pg8::EpiAin E{ws + WS_R, args.conv_w};
        pg8::gemm_phase(lds, g, S, E);
    }
    LSEAM(2);
    if (IN(4)) {
        pg8::Gemm g{(const bf16_t*)(ws + WS_R + SO_Y), (const bf16_t*)(ws + WS_R + SO_Y), 1 << 30, (const bf16_t*)(ws + WS_WAOUT), M_TOK, DM, DM, SLAB}; pg8::StaticOrder S; S.init(M_TOK, DM, G, cid);
        { pg8::Unit fu; for (int i = 0; S.next(i, fu); ++i) p4_fixup(args, fu.pm); asm volatile("s_waitcnt vmcnt(0)" ::: "memory"); __syncthreads(); }
        pg8::EpiRes<1, 0, 2> E{args.x, nullptr, MOD0 + 2048, 6144, args.norm_gain + 1024, MOD0 + 4096, 6144, A1, nullptr, nullptr, 0, nullptr, SS1, nullptr, nullptr, 0};
        pg8::gemm_phase(lds, g, S, E);
    }
    LSEAM(4);
    if (IN(5)) {
        pg8::Gemm g{A1, A1, 1 << 30, (const bf16_t*)(ws + WS_WM1), M_TOK, FF, DM, (size_t)SEQ * DM * 2}; pg8::StaticOrder S; S.init(M_TOK, FF, G, cid);
        pg8::EpiMlp1 E{HB, (const float*)(ws + WS_BM1L0), SS1};
        pg8::gemm_phase(lds, g, S, E);
    }
    LSEAM(5);
    if (IN(6)) {
        pg8::Gemm g{HB, HB, 1 << 30, (const bf16_t*)(ws + WS_WM2), M_TOK, DM, FF, (size_t)SEQ * FF * 2}; pg8::StaticOrder S; S.init(M_TOK, DM, G, cid);
        pg8::EpiRes<2, 2, 2> E{A1, nullptr, MOD0 + 5120, 6144, args.kv_norm_gain, MODKV + 1024, 2048, A1, args.norm_gain + 2048, MOD1 + 1024, 6144, A2, SS2, args.norm_gain + 1024, MOD0 + 4096, 6144, lds};
        pg8::gemm_phase(lds, g, S, E);
    }
    LSEAM(6);
    if (IN(7)) {
        pg8::Gemm g{A1, A2, 6, (const bf16_t*)(ws + WS_WKVQ), M_TOK, NKVQ, DM, (size_t)SEQ * DM * 2}; pg8::StaticOrder S; S.init(M_TOK, NKVQ, G, cid);
        pg8::EpiKVQ E{ws + WS_R, (const float*)(ws + WS_BKVQ), SS2, args.k_gain, args.q_gain};
        pg8::gemm_phase(lds, g, S, E);
    }
    LSEAM(7);
    if (IN(8)) { for (int v = vcu; v < 256; v += G) { const int rk = v & 31; p8_unit(args, ((rk >> 4) << 7) | ((((v >> 5) << 2) | ((rk >> 2) & 3)) << 2) | (rk & 3), lds); } __syncthreads(); }
    LSEAM(8);
    if (IN(9)) {
        for (int v = vcu; v < 256; v += G) { const int bgp = v >> 3, s = v & 7;
            for (int i = 0; i < 4; ++i) { const int qb = (i == 0) ? s : (i == 1) ? 15 - s : (i == 2) ? 16 + s : 31 - s;
                att::attn_unit(bgp >> 2, bgp & 3, qb, ws + WS_R + (size_t)(bgp >> 2) * SLAB, lds); } }
    }
    LSEAM(9);
    if (IN(10)) {
        pg8::Gemm g{(const bf16_t*)(ws + WS_R + SO_O), (const bf16_t*)(ws + WS_R + SO_O), 1 << 30, (const bf16_t*)(ws + WS_WO), M_TOK, DM, DM, SLAB}; pg8::StaticOrder S; S.init(M_TOK, DM, G, cid);
        pg8::EpiRes<1, 2, 2> E{A2, nullptr, MOD1 + 2048, 6144, args.norm_gain + 3072, MOD1 + 4096, 6144, A1, nullptr, nullptr, 0, nullptr, SS3, args.norm_gain + 2048, MOD1 + 1024, 6144, lds};
        pg8::gemm_phase(lds, g, S, E);
    }
    LSEAM(10);
    if (IN(11)) {
        pg8::Gemm g{A1, A1, 1 << 30, (const bf16_t*)(ws + WS_WM1) + (size_t)FF * DM, M_TOK, FF, DM, (size_t)SEQ * DM * 2}; pg8::StaticOrder S; S.init(M_TOK, FF, G, cid);
        pg8::EpiMlp1 E{HB, (const float*)(ws + WS_BM1L1), SS3};
        pg8::gemm_phase(lds, g, S, E);
    }
    LSEAM(11);
    if (IN(12)) {
        pg8::Gemm g{HB, HB, 1 << 30, (const bf16_t*)(ws + WS_WM2) + (size_t)DM * FF, M_TOK, DM, FF, (size_t)SEQ * FF * 2}; pg8::StaticOrder S; S.init(M_TOK, DM, G, cid);
        pg8::EpiRes<0, 2, 0> E{A1, args.out, MOD1 + 5120, 6144, nullptr, nullptr, 0, nullptr, nullptr, nullptr, 0, nullptr, nullptr, args.norm_gain + 3072, MOD1 + 4096, 6144, lds};
        pg8::gemm_phase(lds, g, S, E);
    }
#undef IN
#undef SEAM
}

extern "C" void kernel_launch(void* const* d_in, const int* in_sizes, int n_in, void* d_out, int out_size, void* d_ws, size_t ws_size, hipStream_t stream) {
    static int grid = 0;
    if (grid == 0) {
        if (n_in != 21 || in_sizes[0] != M_TOK * DM || out_size != M_TOK * DM || ws_size < WS_END) { fprintf(stderr, "kernel_launch: unexpected shapes (n_in %d, in0 %d, out %d, ws %zu); nothing launched\n", n_in, n_in > 0 ? in_sizes[0] : -1, out_size, ws_size); grid = -1; return; }
        int dev = 0, cus = 0, per_cu = 0;
        if (hipGetDevice(&dev) != hipSuccess || hipDeviceGetAttribute(&cus, hipDeviceAttributeMultiprocessorCount, dev) != hipSuccess) { grid = -1; return; }
        if (hipFuncSetAttribute((const void*)yoco_fwd, hipFuncAttributeMaxDynamicSharedMemorySize, LDS_BYTES) != hipSuccess) { fprintf(stderr, "kernel_launch: hipFuncSetAttribute failed\n"); grid = -1; return; }
        if (hipOccupancyMaxActiveBlocksPerMultiprocessor(&per_cu, (const void*)yoco_fwd, NWAVES * 64, LDS_BYTES) != hipSuccess || per_cu < 1) { fprintf(stderr, "kernel_launch: occupancy query says %d blocks per CU\n", per_cu); per_cu = 1; }
        (void)hipGetLastError();
        grid = cus;
        if (grid != 256) { fprintf(stderr, "kernel_launch: this build deals the w_a_in tiles to exactly 256 workgroups (device has %d CUs); nothing launched\n", cus); grid = -1; return; }
    }
    if (grid < 0) return;
    (void)hipMemsetAsync((char*)d_ws + WS_ZERO, 0, ZERO_BYTES, stream);
    Args a{};
    a.x = (const float*)d_in[0]; a.c = (const float*)d_in[1]; a.norm_gain = (const float*)d_in[2]; a.w_ada = (const float*)d_in[3]; a.b_ada = (const float*)d_in[4];
    a.w_a_in = (const float*)d_in[5]; a.conv_w = (const float*)d_in[6]; a.w_a_out = (const float*)d_in[7]; a.w_qg = (const float*)d_in[8]; a.q_gain = (const float*)d_in[9];
    a.w_o = (const float*)d_in[10]; a.kv_norm_gain = (const float*)d_in[11]; a.w_ada_kv = (const float*)d_in[12]; a.b_ada_kv = (const float*)d_in[13]; a.w_kv = (const float*)d_in[14];
    a.k_gain = (const float*)d_in[15]; a.cmp_pe = (const float*)d_in[16]; a.cmp_w1 = (const float*)d_in[17]; a.cmp_w2 = (const float*)d_in[18]; a.w_mlp1 = (const float*)d_in[19]; a.w_mlp2 = (const float*)d_in[20];
    a.out = (float*)d_out; a.ws = (unsigned char*)d_ws;
#if MK_N_LAUNCHES == 1
    a.ph_lo = 0; a.ph_hi = N_PHASES;
    void* kargs[] = {&a};
    hipError_t e = hipLaunchCooperativeKernel((const void*)yoco_fwd, dim3(grid), dim3(NWAVES * 64), kargs, LDS_BYTES, stream);
    if (e != hipSuccess) fprintf(stderr, "kernel_launch: cooperative launch failed: %s (grid %d)\n", hipGetErrorString(e), grid);
#else
    for (int p = 0; p < N_PHASES; ++p) { a.ph_lo = p; a.ph_hi = p + 1; hipLaunchKernelGGL(yoco_fwd, dim3(grid), dim3(NWAVES * 64), LDS_BYTES, stream, a); }
#endif
}
```

```cpp
#include <hip/hip_runtime.h>
#include <cstdio>
#include <cstdint>
#include <cmath>

#ifndef MK_N_LAUNCHES
#define MK_N_LAUNCHES 1
#endif
constexpr int N_PHASES = 13;

#define LAS __attribute__((address_space(3)))
typedef unsigned short bf16_t;
typedef short bf16x8 __attribute__((ext_vector_type(8)));
typedef short s16x4 __attribute__((ext_vector_type(4)));
typedef float f32x2 __attribute__((ext_vector_type(2)));
typedef float f32x4 __attribute__((ext_vector_type(4)));
typedef float f32x16 __attribute__((ext_vector_type(16)));
typedef unsigned u32x4 __attribute__((ext_vector_type(4)));
typedef unsigned u32x2 __attribute__((ext_vector_type(2)));
typedef __bf16 bf16x2_t __attribute__((ext_vector_type(2)));

constexpr int BATCH = 8, SEQ = 2048, DM = 1024, FF = 4096, M_TOK = BATCH * SEQ;
constexpr int NKVQ = 2816;
constexpr float EPS = 1e-6f;
constexpr float QSCALE = 0.125f * 1.4426950408889634f;

constexpr size_t MiB = 1u << 20;
constexpr size_t WS_ZERO = 0, ZERO_BYTES = 1 * MiB;
constexpr size_t WS_MOD0 = 0, WS_MOD1 = 196608, WS_MODKV = 393216;
constexpr size_t WS_SS1 = 524288, WS_SS2 = 589824, WS_SS3 = 655360;
constexpr size_t WS_BAR = 786432;
constexpr size_t WS_BM1L0 = 1 * MiB, WS_BM1L1 = WS_BM1L0 + 131072, WS_BKVQ = WS_BM1L1 + 131072, WS_PEB = WS_BKVQ + 131072, WS_WC2 = WS_PEB + 4096;
constexpr size_t WS_WAIN = 2 * MiB, WS_WAOUT = 8 * MiB, WS_WM1 = 10 * MiB  , WS_WM2 = 26 * MiB  , WS_WKVQ = 42 * MiB, WS_WO = 48 * MiB, WS_WC1 = 50 * MiB;
constexpr size_t WS_R = 56 * MiB;
constexpr size_t SLAB = 16 * MiB;
constexpr size_t SO_GB = 0, SO_V = 4 * MiB, SO_Y = 8 * MiB;
constexpr size_t WS_H = WS_R;
constexpr size_t SO_Q = 0, SO_KV = 4 * MiB  , SO_O = 10 * MiB, SO_GATES = 14 * MiB  , SO_KC = 14 * MiB + 512 * 1024  , SO_VC = SO_KC + 65536;
constexpr size_t WS_A1 = 184 * MiB, WS_A2 = 216 * MiB, WS_END = 248 * MiB;

constexpr int LDS_BYTES = 147456;
constexpr int NWAVES = 8;

__device__ __forceinline__ unsigned cvtpk(float lo, float hi) { f32x2 v = {lo, hi}; bf16x2_t b = __builtin_convertvector(v, bf16x2_t); return __builtin_bit_cast(unsigned, b); }
__device__ __forceinline__ float bf_lo(unsigned u) { return __builtin_bit_cast(float, u << 16); }
__device__ __forceinline__ float bf_hi(unsigned u) { return __builtin_bit_cast(float, u & 0xffff0000u); }
__device__ __forceinline__ float wave_sum(float v) {
#pragma unroll
    for (int o = 1; o < 64; o <<= 1) v += __shfl_xor(v, o);
    return v;
}
#define LDS_WAIT() asm volatile("s_waitcnt lgkmcnt(0)" ::: "memory")
#define LAUNDER(x) asm volatile("" : "+v"(x))

namespace pg8 {
constexpr int BM = 256, BK = 64, HALF = 128, HTB = HALF * BK * 2, STAGE_BYTES = 8 * HTB, NXCD = 8, WGM = 8;
__host__ __device__ __forceinline__ int lds_byte(int r, int c) { const int st = (r >> 4) * 2 + (c >> 5), rr = r & 15, cc = c & 31, ob = rr * 64 + cc * 2; return st * 1024 + (ob ^ (((ob >> 9) & 1) << 5)); }
__host__ __device__ __forceinline__ void stage_rc(int b, int& R, int& C) { const int st = b / 1024, sb = b % 1024, swz = sb ^ (((sb >> 9) & 1) << 5); R = (st >> 1) * 16 + swz / 64; C = (st & 1) * 32 + (swz % 64) / 2; }
__host__ __device__ __forceinline__ int perm32(int rho) { const int n = rho >> 4, i = rho & 15; return 8 * (i >> 2) + 4 * n + (i & 3); }

struct Unit { int pm, pn; };
struct Gemm { const bf16_t* A; const bf16_t* A2; int pn_split; const bf16_t* Bt; int M, N, K; size_t abatch; };

struct StaticOrder {
    int nM, nN, nwg, G, c, ain;
    __device__ void init(int M, int N, int G_, int c_) { nM = M / BM; nN = N / BM; nwg = nM * nN; G = G_; c = c_; ain = 0; }
    __device__ void init_ain(int G_, int c_) { init(M_TOK, 3072, G_, c_); ain = 1; }
    __device__ bool next(int i, Unit& u) const {
        if (ain) { if (i >= 3) return false; const int x = c & 7, rk = c >> 3, p = rk >> 3; u.pm = 8 * x + (rk & 7); u.pn = (i == 2) ? p : 4 + 2 * p + i; return true; }
        const long L = (long)i * G + c; if (L >= nwg) return false;
        int wgid = (int)L; { const int q = nwg / NXCD, r = nwg % NXCD, xcd = wgid % NXCD, off = wgid / NXCD; wgid = (xcd < r ? xcd * (q + 1) : r * (q + 1) + (xcd - r) * q) + off; }
        const int nig = WGM * nN, gid = wgid / nig, fm = gid * WGM, gsz = (nM - fm) < WGM ? (nM - fm) : WGM;
        u.pm = fm + ((wgid % nig) % gsz); u.pn = (wgid % nig) / gsz; return true;
    }
};

template <class Epi>
__device__ __forceinline__ void gemm_phase(LAS unsigned char* lds, const Gemm g, const StaticOrder& S, const Epi& E) {
    const int tid = threadIdx.x, wid = __builtin_amdgcn_readfirstlane(tid >> 6), lane = tid & 63, wr = wid >> 2, wc = wid & 3, fr = lane & 15, fq = lane >> 4;
    const int K = g.K, nt = K / BK;
    unsigned voffA[2], voffB[2];
#pragma unroll
    for (int i = 0; i < 2; ++i) { int R, C; stage_rc(tid * 16 + i * 8192, R, C); const int Rb = Epi::PERM ? ((R & ~31) + perm32(R & 31)) : R;
        voffA[i] = (unsigned)(R * K + C) * 2u; voffB[i] = (unsigned)(Rb * K + C) * 2u; }
    const size_t kstep = (size_t)(BK * 2);
    const size_t hstep = (size_t)HALF * K * 2;
    const size_t tstep = 2 * hstep;
    const unsigned ldsw = (unsigned)wid * 1024u;
    const int aoff = lds_byte(wr * 64 + fr, fq * 8), boff = lds_byte(wc * 32 + fr, fq * 8);
#define PG8_SA(b, h) (((b) * 2 + (h)) * HTB)
#define PG8_SB(b, h) ((4 + (b) * 2 + (h)) * HTB)
#define PG8_STAGE(bufoff, gbase, voff) do { _Pragma("unroll") for (int _i = 0; _i < 2; ++_i) \
        __builtin_amdgcn_global_load_lds((const unsigned*)((const char*)(gbase) + (voff)[_i]), (LAS unsigned*)(lds + (bufoff) + ldsw + _i * 8192), 16, 0, 0); } while (0)
#define PG8_LDA(dst, b, h) do { _Pragma("unroll") for (int m = 0; m < 4; ++m) _Pragma("unroll") for (int k = 0; k < 2; ++k) dst[m][k] = *(const LAS bf16x8*)(lds + PG8_SA(b, h) + aoff + m * 2048 + k * 1024); } while (0)
#define PG8_LDB(dst, b, h) do { _Pragma("unroll") for (int n = 0; n < 2; ++n) _Pragma("unroll") for (int k = 0; k < 2; ++k) dst[n][k] = *(const LAS bf16x8*)(lds + PG8_SB(b, h) + boff + n * 2048 + k * 1024); } while (0)
#define PG8_MMA(ai, bj, At, Bt) do { __builtin_amdgcn_s_setprio(1); _Pragma("unroll") for (int m = 0; m < 4; ++m) _Pragma("unroll") for (int n = 0; n < 2; ++n) _Pragma("unroll") for (int k = 0; k < 2; ++k) \
        acc[ai][bj][m][n] = __builtin_amdgcn_mfma_f32_16x16x32_bf16(Bt[n][k], At[m][k], acc[ai][bj][m][n], 0, 0, 0); __builtin_amdgcn_s_setprio(0); } while (0)
#define PG8_WAIT_V(n) asm volatile("s_waitcnt vmcnt(" #n ")" ::: "memory")
#define PG8_WAIT_L(n) asm volatile("s_waitcnt lgkmcnt(" #n ")" ::: "memory")
#define PG8_BAR __builtin_amdgcn_s_barrier()
#define PG8_SCHED __builtin_amdgcn_sched_barrier(0)
#define PG8_ABASE(u) ((const char*)((u).pn < g.pn_split ? g.A : g.A2) + (size_t)((u).pm >> 3) * g.abatch + (size_t)((u).pm & 7) * tstep)
    Unit cur, nxt; int ui = 0;
    if (!S.next(0, cur)) return;
    f32x4 acc[2][2][4][2];
#pragma unroll
    for (int a = 0; a < 2; ++a)
#pragma unroll
        for (int b = 0; b < 2; ++b)
#pragma unroll
            for (int m = 0; m < 4; ++m)
#pragma unroll
                for (int n = 0; n < 2; ++n) acc[a][b][m][n] = (f32x4){0.f, 0.f, 0.f, 0.f};
    bf16x8 At[4][2], B0[2][2], B1[2][2];
    const char* cA = PG8_ABASE(cur); const char* cB = (const char*)g.Bt + (size_t)cur.pn * tstep;
    PG8_STAGE(PG8_SB(0, 0), cB, voffB); PG8_STAGE(PG8_SB(0, 1), cB + hstep, voffB); PG8_STAGE(PG8_SA(0, 0), cA, voffA); PG8_STAGE(PG8_SA(0, 1), cA + hstep, voffA);
    if (wr == 1) PG8_BAR;
    PG8_WAIT_V(2); PG8_BAR;
    PG8_STAGE(PG8_SB(1, 0), cB + kstep, voffB); PG8_STAGE(PG8_SA(1, 0), cA + kstep, voffA); PG8_STAGE(PG8_SB(1, 1), cB + hstep + kstep, voffB);
    PG8_WAIT_V(6); PG8_BAR;
    for (;;) {
        const bool has_next = S.next(ui + 1, nxt);
        const char* nA = has_next ? PG8_ABASE(nxt) : cA; const char* nB = has_next ? (const char*)g.Bt + (size_t)nxt.pn * tstep : cB;
        for (int t = 0; t < nt; t += 2) {
            const bool last = (t == nt - 2);
            const char* a1 = cA + (size_t)(t + 1) * kstep;
            const char* a2 = last ? nA : cA + (size_t)(t + 2) * kstep; const char* b2 = last ? nB : cB + (size_t)(t + 2) * kstep;
            const char* a3 = a2 + kstep; const char* b3 = b2 + kstep;
            PG8_LDB(B0, 0, 0); PG8_LDB(B1, 0, 1); PG8_SCHED; PG8_LDA(At, 0, 0); PG8_STAGE(PG8_SA(1, 1), a1 + hstep, voffA);
            PG8_WAIT_V(8); PG8_WAIT_L(0); PG8_BAR; PG8_MMA(0, 0, At, B0); PG8_MMA(0, 1, At, B1); PG8_BAR; PG8_SCHED;
            PG8_LDA(At, 0, 1); PG8_STAGE(PG8_SB(0, 0), b2, voffB); PG8_STAGE(PG8_SB(0, 1), b2 + hstep, voffB); PG8_STAGE(PG8_SA(0, 0), a2, voffA);
            PG8_WAIT_V(8); PG8_WAIT_L(0); PG8_BAR; PG8_MMA(1, 0, At, B0); PG8_MMA(1, 1, At, B1); PG8_BAR; PG8_SCHED;
            PG8_LDB(B0, 1, 0); PG8_LDB(B1, 1, 1); PG8_SCHED; PG8_LDA(At, 1, 0); PG8_STAGE(PG8_SA(0, 1), a2 + hstep, voffA);
            PG8_WAIT_V(8); PG8_WAIT_L(0); PG8_BAR; PG8_MMA(0, 0, At, B0); PG8_MMA(0, 1, At, B1); PG8_BAR; PG8_SCHED;
            PG8_LDA(At, 1, 1); PG8_STAGE(PG8_SB(1, 0), b3, voffB); PG8_STAGE(PG8_SB(1, 1), b3 + hstep, voffB); PG8_STAGE(PG8_SA(1, 0), a3, voffA);
            PG8_WAIT_V(8); PG8_WAIT_L(0); PG8_BAR; PG8_MMA(1, 0, At, B0); PG8_MMA(1, 1, At, B1); PG8_BAR; PG8_SCHED;
        }
        if (wr == 0) PG8_BAR;
        E(acc, cur, wr, wc, fr, fq);
        if (!has_next) break;
#pragma unroll
        for (int a = 0; a < 2; ++a)
#pragma unroll
            for (int b = 0; b < 2; ++b)
#pragma unroll
                for (int m = 0; m < 4; ++m)
#pragma unroll
                    for (int n = 0; n < 2; ++n) acc[a][b][m][n] = (f32x4){0.f, 0.f, 0.f, 0.f};
        cur = nxt; cA = nA; cB = nB; ++ui;
        if (wr == 1) PG8_BAR;
    }
    PG8_WAIT_V(0);
    PG8_BAR;
#undef PG8_SA
#undef PG8_SB
#undef PG8_STAGE
#undef PG8_LDA
#undef PG8_LDB
#undef PG8_MMA
#undef PG8_WAIT_V
#undef PG8_WAIT_L
#undef PG8_BAR
#undef PG8_SCHED
#undef PG8_ABASE
}

typedef f32x4 Acc[2][2][4][2];

struct EpiAin {
    static constexpr bool PERM = true;
    static constexpr bool HAS_PRE = false; struct Pre {};
    unsigned char* slab0;
    const float* conv_w;
    __device__ __forceinline__ void operator()(const Acc& acc, const Unit& u, int wr, int wc, int fr, int fq) const {
        const int rip0 = wr * 64 + fr;
        const int row0 = (u.pm & 7) * BM + rip0;
        unsigned char* slab = slab0 + (size_t)(u.pm >> 3) * SLAB;
        bf16_t* V = (bf16_t*)(slab + SO_V);
        if (u.pn < 4) {
            bf16_t* Y = (bf16_t*)(slab + SO_Y); bf16_t* GBH = (bf16_t*)(slab + SO_GB) + (size_t)(u.pm & 7) * 2 * DM;
            const int col0 = u.pn * BM + wc * 32 + 8 * fq;
#pragma unroll
            for (int bj = 0; bj < 2; ++bj) { const int cw = col0 + bj * HALF;
                f32x4 w0[2], w1[2], w2[2];
#pragma unroll
                for (int n = 0; n < 2; ++n) { w0[n] = *(const f32x4*)(conv_w + cw + 4 * n); w1[n] = *(const f32x4*)(conv_w + DM + cw + 4 * n); w2[n] = *(const f32x4*)(conv_w + 2 * DM + cw + 4 * n); }
#pragma unroll
                for (int ai = 0; ai < 2; ++ai)
#pragma unroll
                    for (int mp = 0; mp < 2; ++mp) {
                        u32x4 vr[2][3];
#pragma unroll
                        for (int mm = 0; mm < 2; ++mm) { const int rip = rip0 + ai * HALF + (2 * mp + mm) * 16; const bf16_t* vp = V + (size_t)(row0 + ai * HALF + (2 * mp + mm) * 16) * DM + cw;
#pragma unroll
                            for (int k = 0; k < 3; ++k) vr[mm][k] = (rip >= 2) ? *(const u32x4*)(vp - (size_t)k * DM) : (u32x4){0u, 0u, 0u, 0u}; }
                        asm volatile("" : "+v"(vr[0][0]), "+v"(vr[0][1]), "+v"(vr[0][2]), "+v"(vr[1][0]), "+v"(vr[1][1]), "+v"(vr[1][2]));
#pragma unroll
                        for (int mm = 0; mm < 2; ++mm) { const int m = 2 * mp + mm; const int rip = rip0 + ai * HALF + m * 16;
                            const f32x4 g0 = acc[ai][bj][m][0], g1 = acc[ai][bj][m][1];
                            u32x4 w;
                            if (rip >= 2) {
                                const u32x4 a = vr[mm][0], b1 = vr[mm][1], b2 = vr[mm][2];
                                const f32x4 v0a = (f32x4){bf_lo(a.x), bf_hi(a.x), bf_lo(a.y), bf_hi(a.y)}, v0b = (f32x4){bf_lo(a.z), bf_hi(a.z), bf_lo(a.w), bf_hi(a.w)};
                                const f32x4 v1a = (f32x4){bf_lo(b1.x), bf_hi(b1.x), bf_lo(b1.y), bf_hi(b1.y)}, v1b = (f32x4){bf_lo(b1.z), bf_hi(b1.z), bf_lo(b1.w), bf_hi(b1.w)};
                                const f32x4 v2a = (f32x4){bf_lo(b2.x), bf_hi(b2.x), bf_lo(b2.y), bf_hi(b2.y)}, v2b = (f32x4){bf_lo(b2.z), bf_hi(b2.z), bf_lo(b2.w), bf_hi(b2.w)};
                                const f32x4 ya = g0 * (w2[0] * v0a + w1[0] * v1a + w0[0] * v2a), yb = g1 * (w2[1] * v0b + w1[1] * v1b + w0[1] * v2b);
                                w.x = cvtpk(ya[0], ya[1]); w.y = cvtpk(ya[2], ya[3]); w.z = cvtpk(yb[0], yb[1]); w.w = cvtpk(yb[2], yb[3]);
                                *(u32x4*)(Y + (size_t)(row0 + ai * HALF + m * 16) * DM + cw) = w;
                            } else {
                                w.x = cvtpk(g0[0], g0[1]); w.y = cvtpk(g0[2], g0[3]); w.z = cvtpk(g1[0], g1[1]); w.w = cvtpk(g1[2], g1[3]);
                                *(u32x4*)(GBH + (size_t)rip * DM + cw) = w;
                            } } }
            }
        } else {
            const int col0 = (u.pn - 4) * HALF + wc * 32 + 8 * fq;
#pragma unroll
            for (int ai = 0; ai < 2; ++ai)
#pragma unroll
                for (int m = 0; m < 4; ++m) { bf16_t* rowp = V + (size_t)(row0 + ai * HALF + m * 16) * DM + col0;
                    const f32x4 v0 = acc[ai][0][m][0] * acc[ai][1][m][0], v1 = acc[ai][0][m][1] * acc[ai][1][m][1];
                    u32x4 w; w.x = cvtpk(v0[0], v0[1]); w.y = cvtpk(v0[2], v0[3]); w.z = cvtpk(v1[0], v1[1]); w.w = cvtpk(v1[2], v1[3]);
                    *(u32x4*)rowp = w; }
        }
    }
};

constexpr int RES_AUX = 2;
template <int NA, int INM, int OUTM> struct EpiRes {
    static constexpr bool PERM = true;
    const void* xin; void* xout; const float* gate; int gate_stride;
    const float* gain0; const float* sc0; int sc0_stride; bf16_t* A0;
    const float* gain1; const float* sc1; int sc1_stride; bf16_t* A1;
    float* sumsq;
    const float* gain_in; const float* sc_in; int sc_in_stride;
    LAS unsigned char* lds = nullptr;
    __device__ __forceinline__ void operator()(const Acc& acc, const Unit& u, int wr, int wc, int fr, int fq) const {
        constexpr bool IN16 = INM != 0;
        const int b = u.pm >> 3;
        const int row0 = u.pm * BM + wr * 64 + fr, col0 = u.pn * BM + wc * 32 + 8 * fq;
        const size_t tbase = (size_t)u.pm * BM * DM + (size_t)u.pn * BM;
        const unsigned loff = (unsigned)((wr * 64 + fr) * DM + wc * 32 + 8 * fq);
        f32x4 gv[2][2], a0[2][2], a1[2][2], ia[2][2];
        constexpr int NH = IN16 ? 1 : 2, ROWB = IN16 ? 512 : 1024;
        const int lane_ = threadIdx.x & 63, wid_ = __builtin_amdgcn_readfirstlane(threadIdx.x >> 6);
        asm volatile("s_waitcnt vmcnt(0)\n\ts_barrier" ::: "memory");
#pragma unroll
        for (int hh = 0; hh < NH; ++hh) {
            if (hh > 0) asm volatile("s_waitcnt lgkmcnt(0)\n\ts_barrier" ::: "memory");
            if constexpr (IN16) {
                const bf16_t* gsrc = (const bf16_t*)xin + tbase + (size_t)(32 * wid_) * DM;
                const int rl_ = lane_ >> 5, cp_ = lane_ & 31;
                unsigned vo_[4];
#pragma unroll
                for (int k = 0; k < 4; ++k) vo_[k] = (unsigned)(rl_ * DM + ((cp_ ^ (((2 * k + rl_) & 7) << 2)) << 3));
#pragma unroll
                for (int i = 0; i < 16; ++i)
                    __builtin_amdgcn_global_load_lds((const unsigned*)((gsrc + (size_t)(2 * i) * DM) + vo_[i & 3]), (LAS unsigned*)(lds + (32 * wid_ + 2 * i) * 512), 16, 0, RES_AUX);
            } else {
                const float* gsrc = (const float*)xin + tbase + (size_t)(hh * HALF + 16 * wid_) * DM;
#pragma unroll 2
                for (int i = 0; i < 16; ++i)
                    __builtin_amdgcn_global_load_lds((const unsigned*)((gsrc + (size_t)i * DM) + (unsigned)((lane_ ^ i) << 2)), (LAS unsigned*)(lds + (16 * wid_ + i) * 1024), 16, 0, RES_AUX);
            }
            if (hh == 0) {
#pragma unroll
                for (int bj = 0; bj < 2; ++bj)
#pragma unroll
                    for (int n = 0; n < 2; ++n) { const int c = col0 + bj * HALF + 4 * n;
                        gv[bj][n] = *(const f32x4*)(gate + (size_t)b * gate_stride + c);
                        if (NA >= 1) a0[bj][n] = *(const f32x4*)(gain0 + c) * (*(const f32x4*)(sc0 + (size_t)b * sc0_stride + c) + 1.0f);
                        if (NA >= 2) a1[bj][n] = *(const f32x4*)(gain1 + c) * (*(const f32x4*)(sc1 + (size_t)b * sc1_stride + c) + 1.0f);
                        if (INM == 2) { const f32x4 t = *(const f32x4*)(gain_in + c) * (*(const f32x4*)(sc_in + (size_t)b * sc_in_stride + c) + 1.0f); ia[bj][n] = (f32x4){1.0f / t[0], 1.0f / t[1], 1.0f / t[2], 1.0f / t[3]}; } }
            }
            asm volatile("s_waitcnt vmcnt(0)\n\ts_barrier" ::: "memory");
            const LAS unsigned char* ldr = lds + (wr * 64 + fr) * ROWB;
#pragma unroll
            for (int qq = 0; qq < 8 / NH; ++qq) { const int q = hh * (8 / NH) + qq, ai = q >> 2, m = q & 3; const int row = row0 + ai * HALF + m * 16; const size_t off = tbase + (size_t)((ai * HALF + m * 16) * DM); float ss = 0.f;
#pragma unroll
                for (int bj = 0; bj < 2; ++bj) { const size_t o = off + bj * HALF;
                    f32x4 x0, x1;
                    if constexpr (IN16) { const u32x4 w = *(const LAS u32x4*)(ldr + (ai * HALF + m * 16) * 512 + (((16 * bj + 4 * wc + fq) ^ ((fr & 7) << 2)) << 4));
                        x0 = (f32x4){bf_lo(w.x), bf_hi(w.x), bf_lo(w.y), bf_hi(w.y)}; x1 = (f32x4){bf_lo(w.z), bf_hi(w.z), bf_lo(w.w), bf_hi(w.w)}; }
                    else { const int c0_ = 32 * bj + 8 * wc + 2 * fq; x0 = *(const LAS f32x4*)(ldr + (m * 16) * 1024 + ((c0_ ^ fr) << 4)); x1 = *(const LAS f32x4*)(ldr + (m * 16) * 1024 + (((c0_ + 1) ^ fr) << 4)); }
                    if (INM == 2) { x0 = x0 * ia[bj][0]; x1 = x1 * ia[bj][1]; }
                    x0 = x0 + gv[bj][0] * acc[ai][bj][m][0]; x1 = x1 + gv[bj][1] * acc[ai][bj][m][1];
                    if (OUTM == 0) {
                        f32x4 s0 = x0, s1 = x1;
#pragma unroll
                        for (int e = 0; e < 4; ++e) { auto rr = __builtin_amdgcn_permlane16_swap(__float_as_uint(s0[e]), __float_as_uint(s1[e]), false, false);
                            rr = __builtin_amdgcn_permlane32_swap(rr[0], rr[1], false, false); s0[e] = __uint_as_float(rr[0]); s1[e] = __uint_as_float(rr[1]); }
                        const int adj0 = -4 * fq, adj1 = 16 - 4 * fq;
                        *(f32x4*)(((float*)xout + o) + (loff + adj0)) = s0; *(f32x4*)(((float*)xout + o) + (loff + adj1)) = s1; }
                    if (NA >= 1) { ss += ((x0[0] * x0[0] + x0[1] * x0[1]) + (x0[2] * x0[2] + x0[3] * x0[3])) + ((x1[0] * x1[0] + x1[1] * x1[1]) + (x1[2] * x1[2] + x1[3] * x1[3]));
                        const f32x4 t0 = x0 * a0[bj][0], t1 = x1 * a0[bj][1]; u32x4 w; w.x = cvtpk(t0[0], t0[1]); w.y = cvtpk(t0[2], t0[3]); w.z = cvtpk(t1[0], t1[1]); w.w = cvtpk(t1[2], t1[3]); *(u32x4*)((A0 + o) + loff) = w; }
                    if (NA >= 2) { const f32x4 t0 = x0 * a1[bj][0], t1 = x1 * a1[bj][1]; u32x4 w; w.x = cvtpk(t0[0], t0[1]); w.y = cvtpk(t0[2], t0[3]); w.z = cvtpk(t1[0], t1[1]); w.w = cvtpk(t1[2], t1[3]); *(u32x4*)((A1 + o) + loff) = w; } }
                if (NA >= 1) { ss += __shfl_xor(ss, 16); ss += __shfl_xor(ss, 32); if (fq == 0) unsafeAtomicAdd(sumsq + row, ss); } }
        }
    }
};

struct EpiMlp1 {
    static constexpr bool PERM = true;
    bf16_t* H; const float* bias; const float* sumsq;
    __device__ __forceinline__ void operator()(const Acc& acc, const Unit& u, int wr, int wc, int fr, int fq) const {
        const int b = u.pm >> 3;
        const int row0 = u.pm * BM + wr * 64 + fr, col0 = u.pn * BM + wc * 32 + 8 * fq;
        f32x4 bv[2][2];
#pragma unroll
        for (int bj = 0; bj < 2; ++bj)
#pragma unroll
            for (int n = 0; n < 2; ++n) bv[bj][n] = *(const f32x4*)(bias + (size_t)b * FF + col0 + bj * HALF + 4 * n);
        float ssv[8];
#pragma unroll
        for (int q = 0; q < 8; ++q) ssv[q] = sumsq[row0 + (q >> 2) * HALF + (q & 3) * 16];
        asm volatile("" : "+v"(ssv[0]), "+v"(ssv[1]), "+v"(ssv[2]), "+v"(ssv[3]), "+v"(ssv[4]), "+v"(ssv[5]), "+v"(ssv[6]), "+v"(ssv[7]));
#pragma unroll
        for (int ai = 0; ai < 2; ++ai)
#pragma unroll
            for (int m = 0; m < 4; ++m) { const int row = row0 + ai * HALF + m * 16; const float rs = rsqrtf(ssv[ai * 4 + m] * (1.0f / DM) + EPS);
                bf16_t* rowp = H + (size_t)row * FF + col0;
#pragma unroll
                for (int bj = 0; bj < 2; ++bj) { f32x4 v0 = acc[ai][bj][m][0] * rs + bv[bj][0], v1 = acc[ai][bj][m][1] * rs + bv[bj][1];
#pragma unroll
                    for (int e = 0; e < 4; ++e) { const float r0 = fmaxf(v0[e], 0.f), r1 = fmaxf(v1[e], 0.f); v0[e] = r0 * r0; v1[e] = r1 * r1; }
                    u32x4 w; w.x = cvtpk(v0[0], v0[1]); w.y = cvtpk(v0[2], v0[3]); w.z = cvtpk(v1[0], v1[1]); w.w = cvtpk(v1[2], v1[3]);
                    *(u32x4*)(rowp + bj * HALF) = w; } }
    }
};

struct EpiKVQ {
    static constexpr bool PERM = true;
    unsigned char* slab0; const float* bias; const float* sumsq; const float* k_gain; const float* q_gain;
    __device__ __forceinline__ void operator()(const Acc& acc, const Unit& u, int wr, int wc, int fr, int fq) const {
        const int b = u.pm >> 3, pn = u.pn;
        const int row0 = u.pm * BM + wr * 64 + fr;
        unsigned char* slab = slab0 + (size_t)b * SLAB;
        bf16_t* KV = (bf16_t*)(slab + SO_KV); bf16_t* Q = (bf16_t*)(slab + SO_Q); float* gates = (float*)(slab + SO_GATES);
        f32x4 bv[2][2];
#pragma unroll
        for (int bj = 0; bj < 2; ++bj)
#pragma unroll
            for (int n = 0; n < 2; ++n) bv[bj][n] = *(const f32x4*)(bias + (size_t)b * NKVQ + pn * BM + bj * HALF + wc * 32 + 8 * fq + 4 * n);
        float ssv[8];
#pragma unroll
        for (int q = 0; q < 8; ++q) ssv[q] = sumsq[row0 + (q >> 2) * HALF + (q & 3) * 16];
        asm volatile("" : "+v"(ssv[0]), "+v"(ssv[1]), "+v"(ssv[2]), "+v"(ssv[3]), "+v"(ssv[4]), "+v"(ssv[5]), "+v"(ssv[6]), "+v"(ssv[7]));
        if (pn == 10) {
            if (wc < 2) {
#pragma unroll
                for (int ai = 0; ai < 2; ++ai)
#pragma unroll
                    for (int m = 0; m < 4; ++m) { const int row = row0 + ai * HALF + m * 16; const float rs = rsqrtf(ssv[ai * 4 + m] * (1.0f / DM) + EPS);
#pragma unroll
                        for (int n = 0; n < 2; ++n) { const int c = wc * 32 + 8 * fq + 4 * n;
                            if (c < 48) { const f32x4 v = acc[ai][0][m][n] * rs + bv[0][n]; f32x4 o;
#pragma unroll
                                for (int e = 0; e < 4; ++e) o[e] = 1.0f / (1.0f + __expf(-v[e]));
                                *(f32x4*)(gates + (size_t)(row & (SEQ - 1)) * 48 + c) = o; } } }
            }
            return;
        }
        const bool is_q = pn >= 6;
        const bool do_norm = is_q || pn == 2 || pn == 4;
        f32x4 gn[2][2];
        { const float* gp = is_q ? q_gain : (k_gain + (pn == 2 ? 64 : 128)); const float sc = is_q ? QSCALE : 1.0f;
#pragma unroll
          for (int bj = 0; bj < 2; ++bj)
#pragma unroll
              for (int n = 0; n < 2; ++n) gn[bj][n] = do_norm ? *(const f32x4*)(gp + 32 * bj + 8 * fq + 4 * n) * sc : (f32x4){1.f, 1.f, 1.f, 1.f}; }
#pragma unroll
        for (int ai = 0; ai < 2; ++ai)
#pragma unroll
            for (int m = 0; m < 4; ++m) { const int row = row0 + ai * HALF + m * 16; const float rs = rsqrtf(ssv[ai * 4 + m] * (1.0f / DM) + EPS);
                f32x4 v[2][2]; float ss = 0.f;
#pragma unroll
                for (int bj = 0; bj < 2; ++bj)
#pragma unroll
                    for (int n = 0; n < 2; ++n) { v[bj][n] = acc[ai][bj][m][n] * rs + bv[bj][n]; const f32x4 t = v[bj][n]; ss += (t[0] * t[0] + t[1] * t[1]) + (t[2] * t[2] + t[3] * t[3]); }
                float hs = 1.0f;
                if (do_norm) { ss += __shfl_xor(ss, 16); ss += __shfl_xor(ss, 32); hs = rsqrtf(ss * (1.0f / 64.0f) + EPS); }
                bf16_t* rowp;
                if (is_q) rowp = Q + (size_t)(row & (SEQ - 1)) * DM + ((pn - 6) * 4 + wc) * 64 + 8 * fq;
                else rowp = KV + ((size_t)(pn * 4 + wc) * SEQ + (row & (SEQ - 1))) * 64 + 8 * fq;
#pragma unroll
                for (int bj = 0; bj < 2; ++bj) { const f32x4 v0 = v[bj][0] * hs * gn[bj][0], v1 = v[bj][1] * hs * gn[bj][1];
                    u32x4 w; w.x = cvtpk(v0[0], v0[1]); w.y = cvtpk(v0[2], v0[3]); w.z = cvtpk(v1[0], v1[1]); w.w = cvtpk(v1[2], v1[3]);
                    *(u32x4*)(rowp + 32 * bj) = w; } }
    }
};
}

namespace att {
constexpr int SLOTB = 8192;
constexpr int L_K = 0, L_V = 3 * SLOTB, L_WS = 6 * SLOTB, L_SEL = L_WS + 4096, L_NIB = L_SEL + 256, L_SC = L_NIB + 768, L_IA = L_SC + 8704, L_IB = L_IA + 33792, L_END = L_IB + 33792, L_OST = L_IA;
static_assert(L_END <= 131072 && (L_IA % 16) == 0 && (L_SC % 16) == 0, "attention LDS map");
#define SBAR() __builtin_amdgcn_sched_barrier(0)
#define ATT_WAIT_BAR(N) asm volatile("s_waitcnt vmcnt(" #N ") lgkmcnt(0)\n\ts_barrier" ::: "memory")
__device__ __forceinline__ int crow(int r, int hi) { return (r & 3) + 8 * (r >> 2) + 4 * hi; }
__device__ __forceinline__ void glds16(const void* gsrc, unsigned lds_dst) { unsigned keep;
    asm volatile("s_mov_b32 %0, m0\n\ts_mov_b32 m0, %2\n\ts_nop 0\n\tglobal_load_lds_dwordx4 %1, off\n\ts_mov_b32 m0, %0" : "=&s"(keep) : "v"(gsrc), "s"(lds_dst) : "memory"); }

__device__ __forceinline__ void qkt_c(f32x16& p0, f32x16& p1, const LAS unsigned char* Kslot, const bf16x8* qr, const f32x16& ci, int r32, int hi) {
    const LAS unsigned char* kb = Kslot + hi * 1024 + r32 * 16;
    bf16x8 kf[8];
#pragma unroll
    for (int i = 0; i < 8; ++i) kf[i] = *(const LAS bf16x8*)(kb + (i >> 1) * 2048 + (i & 1) * 512);
    asm volatile("" : "+v"(kf[0]), "+v"(kf[1]), "+v"(kf[2]), "+v"(kf[3]), "+v"(kf[4]), "+v"(kf[5]), "+v"(kf[6]), "+v"(kf[7]));
    p0 = __builtin_amdgcn_mfma_f32_32x32x16_bf16(kf[0], qr[0], ci, 0, 0, 0); p1 = __builtin_amdgcn_mfma_f32_32x32x16_bf16(kf[1], qr[0], ci, 0, 0, 0);
#pragma unroll
    for (int d0 = 1; d0 < 4; ++d0) { p0 = __builtin_amdgcn_mfma_f32_32x32x16_bf16(kf[2 * d0], qr[d0], p0, 0, 0, 0); p1 = __builtin_amdgcn_mfma_f32_32x32x16_bf16(kf[2 * d0 + 1], qr[d0], p1, 0, 0, 0); }
}
__device__ __forceinline__ void qkt(f32x16& p0, f32x16& p1, const LAS unsigned char* Kslot, const bf16x8* qr, int r32, int hi) {
    const LAS unsigned char* kb = Kslot + hi * 1024 + r32 * 16;
    bf16x8 kf[8];
#pragma unroll
    for (int i = 0; i < 8; ++i) kf[i] = *(const LAS bf16x8*)(kb + (i >> 1) * 2048 + (i & 1) * 512);
    asm volatile("" : "+v"(kf[0]), "+v"(kf[1]), "+v"(kf[2]), "+v"(kf[3]), "+v"(kf[4]), "+v"(kf[5]), "+v"(kf[6]), "+v"(kf[7]));
    const f32x16 z = f32x16{};
    p0 = __builtin_amdgcn_mfma_f32_32x32x16_bf16(kf[0], qr[0], z, 0, 0, 0); p1 = __builtin_amdgcn_mfma_f32_32x32x16_bf16(kf[1], qr[0], z, 0, 0, 0);
#pragma unroll
    for (int d0 = 1; d0 < 4; ++d0) { p0 = __builtin_amdgcn_mfma_f32_32x32x16_bf16(kf[2 * d0], qr[d0], p0, 0, 0, 0); p1 = __builtin_amdgcn_mfma_f32_32x32x16_bf16(kf[2 * d0 + 1], qr[d0], p1, 0, 0, 0); }
}
__device__ __forceinline__ void range_mask(f32x16& p0, f32x16& p1, int lo, int hv, int hi) {
    const int lo2 = lo - 4 * hi, hv2 = hv - 4 * hi;
#pragma unroll
    for (int r = 0; r < 16; ++r) { const int kc = (r & 3) + 8 * (r >> 2); if (kc < lo2 || kc > hv2) p0[r] = -INFINITY; if (kc + 32 < lo2 || kc + 32 > hv2) p1[r] = -INFINITY; }
}
__device__ __forceinline__ float max3f(float a, float b, float c) { float r; asm("v_max3_f32 %0, %1, %2, %3" : "=v"(r) : "v"(a), "v"(b), "v"(c)); return r; }
__device__ __forceinline__ float max2f(float a, float b) { float r; asm("v_max_f32_e32 %0, %1, %2" : "=v"(r) : "v"(a), "v"(b)); return r; }
__device__ __forceinline__ float rowmax(const f32x16& p0, const f32x16& p1) {
    float a = max3f(p0[0], p0[1], p1[0]), b = max3f(p0[2], p0[3], p1[1]); a = max3f(a, p1[2], p1[3]);
#pragma unroll
    for (int r = 4; r < 16; r += 4) { a = max3f(a, p0[r], p0[r + 1]); b = max3f(b, p0[r + 2], p0[r + 3]); a = max3f(a, p1[r], p1[r + 1]); b = max3f(b, p1[r + 2], p1[r + 3]); }
    const float m = max2f(a, b);
    auto rr = __builtin_amdgcn_permlane32_swap(__float_as_uint(m), __float_as_uint(m), false, false);
    return max2f(__uint_as_float(rr[0]), __uint_as_float(rr[1]));
}
__device__ __forceinline__ float halfsum(float a) {
    auto rr = __builtin_amdgcn_permlane32_swap(__float_as_uint(a), __float_as_uint(a), false, false);
    return __uint_as_float(rr[0]) + __uint_as_float(rr[1]);
}
__device__ __forceinline__ void pv(f32x16* o, int vb, bf16x8 pa0, bf16x8 pa1, bf16x8 pa2, bf16x8 pa3) {
    s16x4 lo[8], hi4[8];
#pragma unroll
    for (int q = 0; q < 8; ++q) {
        asm volatile("ds_read_b64_tr_b16 %0,%1 offset:%c2" : "=&v"(lo[q]) : "v"(vb), "i"((q >> 2) * 4096 + (q & 3) * 1024) : "memory");
        asm volatile("ds_read_b64_tr_b16 %0,%1 offset:%c2" : "=&v"(hi4[q]) : "v"(vb), "i"((q >> 2) * 4096 + (q & 3) * 1024 + 512) : "memory"); }
    asm volatile("s_waitcnt lgkmcnt(0)" ::: "memory"); SBAR();
#define PK(k) (bf16x8){lo[k][0], lo[k][1], lo[k][2], lo[k][3], hi4[k][0], hi4[k][1], hi4[k][2], hi4[k][3]}
    o[0] = __builtin_amdgcn_mfma_f32_32x32x16_bf16(pa0, PK(0), o[0], 0, 0, 0);
    o[1] = __builtin_amdgcn_mfma_f32_32x32x16_bf16(pa0, PK(4), o[1], 0, 0, 0);
    o[0] = __builtin_amdgcn_mfma_f32_32x32x16_bf16(pa1, PK(1), o[0], 0, 0, 0);
    o[1] = __builtin_amdgcn_mfma_f32_32x32x16_bf16(pa1, PK(5), o[1], 0, 0, 0);
    o[0] = __builtin_amdgcn_mfma_f32_32x32x16_bf16(pa2, PK(2), o[0], 0, 0, 0);
    o[1] = __builtin_amdgcn_mfma_f32_32x32x16_bf16(pa2, PK(6), o[1], 0, 0, 0);
    o[0] = __builtin_amdgcn_mfma_f32_32x32x16_bf16(pa3, PK(3), o[0], 0, 0, 0);
    o[1] = __builtin_amdgcn_mfma_f32_32x32x16_bf16(pa3, PK(7), o[1], 0, 0, 0);
#undef PK
}
__device__ __forceinline__ bf16x8 pack8(const f32x16& p, int base) {
    u32x4 w; w.x = cvtpk(p[base], p[base + 1]); w.y = cvtpk(p[base + 2], p[base + 3]); w.z = cvtpk(p[base + 4], p[base + 5]); w.w = cvtpk(p[base + 6], p[base + 7]);
    return __builtin_bit_cast(bf16x8, w);
}
__device__ __forceinline__ void row_bcast(float v, float (&out)[16], LAS float* wsf, int r32, int hi) {
    if (hi == 0) wsf[r32] = v;
#pragma unroll
    for (int i = 0; i < 4; ++i) { const f32x4 t = *(const LAS f32x4*)(wsf + 8 * i + 4 * hi); out[4 * i] = t[0]; out[4 * i + 1] = t[1]; out[4 * i + 2] = t[2]; out[4 * i + 3] = t[3]; }
}

struct Ctx {
    int lane, r32, hi, wid, ql, qb; unsigned lds0; LAS unsigned char* shm; LAS float* wsf; int koff, voff; unsigned kdst, vdst; int vb0;
};
__device__ __forceinline__ void dma_k(const Ctx& c, const bf16_t* base, int tile, int slot) { glds16(base + (size_t)tile * 4096 + c.koff, (unsigned)__builtin_amdgcn_readfirstlane(c.kdst + slot * SLOTB)); }
__device__ __forceinline__ void dma_v(const Ctx& c, const bf16_t* base, int tile, int slot) { glds16(base + (size_t)tile * 4096 + c.voff, (unsigned)__builtin_amdgcn_readfirstlane(c.vdst + slot * SLOTB)); }

constexpr float THR = 8.0f;
struct BrState { float mhat, l; f32x16 negm; f32x16 o[2]; };
__device__ __forceinline__ void br_reset(BrState& st) { st.mhat = 0.f; st.l = 0.f; st.negm = f32x16{}; st.o[0] = f32x16{}; st.o[1] = f32x16{}; }
__device__ __forceinline__ void stream_step(const Ctx& c, int slot, const bf16x8* qr, bool row_on, bool use_range, int lo, int hv, bool first, BrState& st) {
    f32x16 p0, p1;
    if (__any(!row_on)) { f32x16 ci;
#pragma unroll
        for (int r = 0; r < 16; ++r) ci[r] = row_on ? st.negm[r] : -INFINITY;
        qkt_c(p0, p1, c.shm + L_K + slot * SLOTB, qr, ci, c.r32, c.hi);
    } else qkt_c(p0, p1, c.shm + L_K + slot * SLOTB, qr, st.negm, c.r32, c.hi);
    if (use_range) range_mask(p0, p1, lo, hv, c.hi);
    const float rm = rowmax(p0, p1);
    if (first || __any(rm > THR)) {
        float dl = first ? rm : fmaxf(rm, 0.f);
        if (dl == -INFINITY) dl = 0.f;
        st.mhat += dl;
#pragma unroll
        for (int r = 0; r < 16; ++r) { p0[r] -= dl; p1[r] -= dl; st.negm[r] = -st.mhat; }
        if (!first) { const float f = __builtin_amdgcn_exp2f(-dl); st.l *= f; float al[16]; row_bcast(f, al, c.wsf, c.r32, c.hi);
#pragma unroll
            for (int r = 0; r < 16; ++r) { st.o[0][r] *= al[r]; st.o[1][r] *= al[r]; } }
    }
#pragma unroll
    for (int r = 0; r < 16; ++r) { p0[r] = __builtin_amdgcn_exp2f(p0[r]); p1[r] = __builtin_amdgcn_exp2f(p1[r]); }
    { const f32x16 sv = p0 + p1; st.l += ((sv[0] + sv[1]) + (sv[2] + sv[3])) + ((sv[4] + sv[5]) + (sv[6] + sv[7])) + ((sv[8] + sv[9]) + (sv[10] + sv[11])) + ((sv[12] + sv[13]) + (sv[14] + sv[15])); }
    pv(st.o, c.vb0 + slot * SLOTB, pack8(p0, 0), pack8(p0, 8), pack8(p1, 0), pack8(p1, 8));
}
struct Cursor { unsigned sm, wm; };
__device__ __forceinline__ int cur_pop(Cursor& k, int& br) {
    if (k.sm) { const int t = __builtin_ctz(k.sm); k.sm &= k.sm - 1u; br = 1; return t; }
    const int t = 31 - __builtin_clz(k.wm); k.wm &= ~(1u << t); br = 2; return t;
}

typedef __attribute__((address_space(3))) const char* lds_cptr;
typedef short v4i16_t __attribute__((ext_vector_type(4)));
__device__ __forceinline__ void kload8(bf16x8* kf, lds_cptr kp) {
    kf[0] = *(const LAS bf16x8*)(kp);        kf[1] = *(const LAS bf16x8*)(kp + 512);
    kf[2] = *(const LAS bf16x8*)(kp + 2048); kf[3] = *(const LAS bf16x8*)(kp + 2560);
    kf[4] = *(const LAS bf16x8*)(kp + 4096); kf[5] = *(const LAS bf16x8*)(kp + 4608);
    kf[6] = *(const LAS bf16x8*)(kp + 6144); kf[7] = *(const LAS bf16x8*)(kp + 6656);
}
__device__ __forceinline__ void kload2(bf16x8* kf, lds_cptr kp, int j) { kf[2 * j] = *(const LAS bf16x8*)(kp + j * 2048); kf[2 * j + 1] = *(const LAS bf16x8*)(kp + j * 2048 + 512); }
__device__ __forceinline__ s16x4 vtr(lds_cptr p) { return __builtin_bit_cast(s16x4, __builtin_amdgcn_ds_read_tr16_b64_v4i16((LAS v4i16_t*)p)); }
__device__ __forceinline__ float fadd_s(float a, float b) { float r; asm("v_add_f32_e32 %0, %1, %2" : "=v"(r) : "v"(a), "v"(b)); return r; }
__device__ __forceinline__ float fsub_s(float a, float b) { float r; asm("v_sub_f32_e32 %0, %1, %2" : "=v"(r) : "v"(a), "v"(b)); return r; }
template <int THRL>
__device__ __forceinline__ void sel_stream(const Ctx& c, const bf16_t* Kb, const bf16_t* Vb, const bf16x8* qr, unsigned msel, int qb, f32x16* o, float& l_out) {
  const int lane = c.lane, r32 = c.r32, hi = c.hi;
  LAS float* wsf = c.wsf;
  const lds_cptr shm3 = (lds_cptr)c.shm;
  const lds_cptr kp0 = shm3 + L_K + hi * 1024 + r32 * 16;
  const lds_cptr vp0 = shm3 + L_V + ((lane >> 4) & 1) * 32 + (lane & 3) * 8 + (4 * hi + ((lane & 15) >> 2)) * 64;
  const int NTr = qb + 1, NT = NTr < 4 ? 4 : ((NTr + 1) & ~1);
  #define WAIT_BAR(N) asm volatile("s_waitcnt vmcnt(" #N ") lgkmcnt(0)\n\ts_barrier":::"memory")
  #define TILE_OF(t) (((t) < NTr) ? (t) : qb)
  #define DMA_K(t, slotb) glds16(Kb + (size_t)TILE_OF(t) * 4096 + c.koff, (unsigned)__builtin_amdgcn_readfirstlane(c.kdst + (slotb)))
  #define DMA_V(t, slotb) glds16(Vb + (size_t)TILE_OF(t) * 4096 + c.voff, (unsigned)__builtin_amdgcn_readfirstlane(c.vdst + (slotb)))
  #define CMASK(P0, P1, t) do { const bool on_ = ((t) < NTr) && (((msel >> ((t) & 31)) & 1u) != 0u); \
      if (__any(!on_)) { const float ng_ = on_ ? 0.f : -INFINITY; _Pragma("unroll") for (int r = 0; r < 16; ++r) { P0[r] += ng_; P1[r] += ng_; } } \
      if ((t) == qb) range_mask(P0, P1, 0, c.ql, hi); } while (0)
  float mhat = 0.f, l_reg = 0.f; o[0] = f32x16{}; o[1] = f32x16{}; f32x16 negm = f32x16{}; asm volatile("" : "+v"(negm));
  bf16x8 kf[8];
  bool resc = false;
  #define START(P0,P1) do{ const float rm=rowmax(P0,P1); resc=false; \
    { const float dl=rm; mhat=fadd_s(mhat,dl); \
      _Pragma("unroll") for(int r=0;r<16;++r){P0[r]=fsub_s(P0[r],dl);P1[r]=fsub_s(P1[r],dl);} \
      _Pragma("unroll") for(int r=0;r<16;++r)negm[r]=-mhat; asm volatile("":"+v"(negm)); } \
    _Pragma("unroll") for(int r=0;r<16;++r)P0[r]=__builtin_amdgcn_exp2f(P0[r]); }while(0)
  #define RESC() do{ if(resc){ asm volatile("s_waitcnt lgkmcnt(0)":::"memory"); \
      _Pragma("unroll") for(int d_=0;d_<2;++d_) _Pragma("unroll") for(int r=0;r<16;++r)o[d_][r]*=wsf[crow(r,hi)]; } }while(0)
  f32x16 pA0,pA1,pB0,pB1;
  int sl_prev=SLOTB,sl_cur=2*SLOTB,sl_next=0;
  #define ROT() do{sl_prev=sl_cur;sl_cur=sl_next;sl_next=(sl_next==2*SLOTB)?0:sl_next+SLOTB;}while(0)
  DMA_K(1,0); DMA_K(2,SLOTB);
  { const f32x16 z = f32x16{}; qkt_c(pA0,pA1,c.shm+L_K+2*SLOTB,qr,z,r32,hi); }
  asm volatile("s_nop 15\n\ts_nop 7":"+v"(pA0),"+v"(pA1)); CMASK(pA0,pA1,0);
  START(pA0,pA1);
  _Pragma("unroll") for(int r=0;r<16;++r)pA1[r]=__builtin_amdgcn_exp2f(pA1[r]);
  WAIT_BAR(0);
  DMA_K(3,2*SLOTB);DMA_V(1,0);
  ROT();
  kload8(kf,kp0+sl_cur);
  WAIT_BAR(2);
  s16x4 vlo[8],vhi[8]; u32x4 pw0,pw1,pw2,pw3;
  #define PKW(P,B) cvtpk(P[B],P[B+1])
  #define PAF(k) __builtin_bit_cast(bf16x8,pw##k)
  #define VFR(i) (bf16x8){vlo[i][0],vlo[i][1],vlo[i][2],vlo[i][3],vhi[i][0],vhi[i][1],vhi[i][2],vhi[i][3]}
  #define PIN(x) asm volatile("":"+v"(x))
  #define MX3(a,b,c) __builtin_fmaxf(__builtin_fmaxf((a),(b)),(c))
  #define GAPA(MF,A0,A1,A2,A3,W0,W1,PW) do{ MF; sacc+=A0; sacc+=A1; sacc+=A2; sacc+=A3; PIN(sacc); W0; W1; PIN(PW); SBAR(); }while(0)
  #define EX(v) __builtin_amdgcn_exp2f(v)
  #define GAPB(MF,X,B) do{ MF; X[B]=EX(X[B]); X[B+1]=EX(X[B+1]); X[B+2]=EX(X[B+2]); X[B+3]=EX(X[B+3]); PIN(X); SBAR(); }while(0)
  #define VRD(i) do{ vlo[i]=vtr(vp_+(((i)>>2)*4096+((i)&3)*1024)); vhi[i]=vtr(vp_+(((i)>>2)*4096+((i)&3)*1024+512)); }while(0)
  #define KRD(G,j) do{ if(G){ kload2(kf,kp0+sl_next,j); SBAR(); } }while(0)
  #define STEP(C0,C1,P0,P1,t,GK,GV,GL) do{ SBAR(); \
    const lds_cptr vp_=vp0+sl_prev; \
    VRD(0); SBAR(); float sacc=(P0[0]+P0[1]); \
    GAPA(C0=__builtin_amdgcn_mfma_f32_32x32x16_bf16(kf[0],qr[0],negm,0,0,0), P0[2],P0[3],P0[4],P0[5],     pw0[0]=PKW(P0,0), pw0[1]=PKW(P0,2), pw0); \
    VRD(4); SBAR(); GAPA(C1=__builtin_amdgcn_mfma_f32_32x32x16_bf16(kf[1],qr[0],negm,0,0,0), P0[6],P0[7],P0[8],P0[9],     pw0[2]=PKW(P0,4), pw0[3]=PKW(P0,6), pw0); \
    VRD(1); SBAR(); GAPA(C0=__builtin_amdgcn_mfma_f32_32x32x16_bf16(kf[2],qr[1],C0,0,0,0),   P0[10],P0[11],P0[12],P0[13], pw1[0]=PKW(P0,8), pw1[1]=PKW(P0,10), pw1); \
    VRD(5); SBAR(); GAPA(C1=__builtin_amdgcn_mfma_f32_32x32x16_bf16(kf[3],qr[1],C1,0,0,0),   P0[14],P0[15],P1[0],P1[1],   pw1[2]=PKW(P0,12),pw1[3]=PKW(P0,14), pw1); \
    VRD(2); SBAR(); GAPA(C0=__builtin_amdgcn_mfma_f32_32x32x16_bf16(kf[4],qr[2],C0,0,0,0),   P1[2],P1[3],P1[4],P1[5],     pw2[0]=PKW(P1,0), pw2[1]=PKW(P1,2), pw2); \
    VRD(6); SBAR(); GAPA(C1=__builtin_amdgcn_mfma_f32_32x32x16_bf16(kf[5],qr[2],C1,0,0,0),   P1[6],P1[7],P1[8],P1[9],     pw2[2]=PKW(P1,4), pw2[3]=PKW(P1,6), pw2); \
    VRD(3); SBAR(); GAPA(C0=__builtin_amdgcn_mfma_f32_32x32x16_bf16(kf[6],qr[3],C0,0,0,0),   P1[10],P1[11],P1[12],P1[13], pw3[0]=PKW(P1,8), pw3[1]=PKW(P1,10), pw3); \
    VRD(7); SBAR(); GAPA(C1=__builtin_amdgcn_mfma_f32_32x32x16_bf16(kf[7],qr[3],C1,0,0,0),   P1[14],P1[15],0.f,0.f,       pw3[2]=PKW(P1,12),pw3[3]=PKW(P1,14), pw3); \
    l_reg+=sacc; \
    if(GK){DMA_K((t)+3,sl_cur);} if(GV){DMA_V((t)+1,sl_next);} \
    CMASK(C0,C1,t); \
    { float a=MX3(C0[0],C0[1],C1[0]),b=MX3(C0[2],C0[3],C1[1]); a=MX3(a,C1[2],C1[3]); \
      _Pragma("unroll") for(int r=4;r<16;r+=4){a=MX3(a,C0[r],C0[r+1]);b=MX3(b,C0[r+2],C0[r+3]);a=MX3(a,C1[r],C1[r+1]);b=MX3(b,C1[r+2],C1[r+3]);} \
      float rm=__builtin_fmaxf(a,b); { auto rr=__builtin_amdgcn_permlane32_swap(__float_as_uint(rm),__float_as_uint(rm),false,false); rm=__builtin_fmaxf(__uint_as_float(rr[0]),__uint_as_float(rr[1])); } \
      resc=false; \
      if(__builtin_expect(__any(rm>(float)THRL),0)){ const float dl=__builtin_fmaxf(rm,0.f); mhat+=dl; \
        _Pragma("unroll") for(int r=0;r<16;++r){C0[r]-=dl;C1[r]-=dl;} \
        _Pragma("unroll") for(int r=0;r<16;++r)negm[r]=-mhat; asm volatile("":"+v"(negm)); \
        const float f=__builtin_amdgcn_exp2f(-dl); l_reg*=f; if(hi==0)wsf[r32]=f; resc=true; } } \
    SBAR(); \
    GAPB(o[0]=__builtin_amdgcn_mfma_f32_32x32x16_bf16(PAF(0),VFR(0),o[0],0,0,0), C0,0); \
    GAPB(o[1]=__builtin_amdgcn_mfma_f32_32x32x16_bf16(PAF(0),VFR(4),o[1],0,0,0), C0,4); \
    KRD(GL,0); GAPB(o[0]=__builtin_amdgcn_mfma_f32_32x32x16_bf16(PAF(1),VFR(1),o[0],0,0,0), C0,8); \
    KRD(GL,1); GAPB(o[1]=__builtin_amdgcn_mfma_f32_32x32x16_bf16(PAF(1),VFR(5),o[1],0,0,0), C0,12); \
    KRD(GL,2); GAPB(o[0]=__builtin_amdgcn_mfma_f32_32x32x16_bf16(PAF(2),VFR(2),o[0],0,0,0), C1,0); \
    KRD(GL,3); GAPB(o[1]=__builtin_amdgcn_mfma_f32_32x32x16_bf16(PAF(2),VFR(6),o[1],0,0,0), C1,4); \
    GAPB(o[0]=__builtin_amdgcn_mfma_f32_32x32x16_bf16(PAF(3),VFR(3),o[0],0,0,0), C1,8); \
    GAPB(o[1]=__builtin_amdgcn_mfma_f32_32x32x16_bf16(PAF(3),VFR(7),o[1],0,0,0), C1,12); \
    }while(0)
  #define ENDW(tt) do{ if((tt)+3<NT){WAIT_BAR(2);} else if((tt)+2<NT){WAIT_BAR(1);} else {WAIT_BAR(0);} }while(0)
  int t=1;
  for(;t+1<NT;t+=2){
    STEP(pB0,pB1,pA0,pA1,t,(t+3<NT),(t+1<NT),(t+1<NT));       ENDW(t);   RESC(); ROT();
    STEP(pA0,pA1,pB0,pB1,t+1,(t+4<NT),(t+2<NT),(t+2<NT));     ENDW(t+1); RESC(); ROT();
  }
  STEP(pB0,pB1,pA0,pA1,NT-1,false,false,false); RESC();
  { float sacc=pB0[0]+pB0[1]; _Pragma("unroll") for(int r=2;r<16;++r)sacc+=pB0[r]; _Pragma("unroll") for(int r=0;r<16;++r)sacc+=pB1[r]; l_reg+=sacc;
    SBAR(); pv(o, c.vb0 + sl_cur, pack8(pB0,0), pack8(pB0,8), pack8(pB1,0), pack8(pB1,8)); }
  l_out = l_reg;
  asm volatile("s_waitcnt lgkmcnt(0)\n\ts_barrier":::"memory");
  #undef WAIT_BAR
  #undef TILE_OF
  #undef DMA_K
  #undef DMA_V
  #undef CMASK
  #undef START
  #undef RESC
  #undef ROT
  #undef PKW
  #undef PAF
  #undef VFR
  #undef PIN
  #undef MX3
  #undef GAPA
  #undef EX
  #undef GAPB
  #undef VRD
  #undef KRD
  #undef STEP
  #undef ENDW
}

__device__ __forceinline__ void attn_unit(int b, int g, int qb, unsigned char* slab, LAS unsigned char* shm) {
    const bf16_t* Q = (const bf16_t*)(slab + SO_Q); const bf16_t* KV = (const bf16_t*)(slab + SO_KV); const bf16_t* KC = (const bf16_t*)(slab + SO_KC); const bf16_t* VC = (const bf16_t*)(slab + SO_VC);
    const float* gates = (const float*)(slab + SO_GATES); bf16_t* O = (bf16_t*)(slab + SO_O);
    Ctx c;
    const int tid = threadIdx.x;
    c.lane = tid & 63; c.r32 = c.lane & 31; c.hi = c.lane >> 5; c.wid = __builtin_amdgcn_readfirstlane(tid >> 6);
    const int kh = c.wid >> 1, qh = c.wid & 1, head = g * 4 + kh;
    c.ql = qh * 32 + c.r32; c.qb = qb; c.shm = shm; c.lds0 = (unsigned)(size_t)shm;
    c.wsf = (LAS float*)(shm + L_WS) + c.wid * 128;
    c.koff = c.lane * 64 + c.wid * 8;
    c.voff = (16 * (c.wid & 3) + (c.lane >> 2)) * 64 + (c.wid >> 2) * 32 + (c.lane & 3) * 8;
    c.kdst = c.lds0 + L_K + c.wid * 1024; c.vdst = c.lds0 + L_V + c.wid * 1024;
    c.vb0 = (int)(c.lds0 + L_V) + ((c.lane >> 4) & 1) * 32 + (c.lane & 3) * 8 + (4 * c.hi + ((c.lane & 15) >> 2)) * 64;
    const int t = qb * 64 + c.ql;
    const size_t mrow = (size_t)t;
    const size_t bg = (size_t)g;
    const bf16_t* KSb = KV + ((size_t)2 * 4 + g) * (SEQ * 64);
    const bf16_t* VSb = KV + ((size_t)3 * 4 + g) * (SEQ * 64);
    const bf16_t* KWb = KV + ((size_t)4 * 4 + g) * (SEQ * 64);
    const bf16_t* VWb = KV + ((size_t)5 * 4 + g) * (SEQ * 64);
    const bf16_t* KCb = KC + bg * 8192; const bf16_t* VCb = VC + bg * 8192;
    dma_k(c, KCb, 0, 0); dma_k(c, KCb, 1, 1); dma_v(c, VCb, 0, 0); dma_v(c, VCb, 1, 1);
    dma_k(c, KSb, 0, 2); dma_v(c, VSb, 0, 2);
    bf16x8 qr[4];
    { const bf16_t* Qw = Q + mrow * DM + head * 64 + c.hi * 8;
#pragma unroll
      for (int d0 = 0; d0 < 4; ++d0) qr[d0] = *(const bf16x8*)(Qw + d0 * 16); }
    const float* gp = gates + mrow * 48 + head * 3;
    const float g0 = gp[0], g1 = gp[1], g2 = gp[2];
    f32x16 ot[2];
    f32x16 o[2];
    const bool two = qb >= 16;
    ATT_WAIT_BAR(2);
    {
        f32x16 a0, a1, b0, b1;
        qkt(a0, a1, shm + L_K, qr, c.r32, c.hi);
        const int nmax = (t >= 31) ? ((t - 31) >> 4) : -1;
        range_mask(a0, a1, 0, nmax, c.hi);
        float rm = rowmax(a0, a1);
        if (two) { qkt(b0, b1, shm + L_K + SLOTB, qr, c.r32, c.hi); range_mask(b0, b1, 0, nmax - 64, c.hi); rm = fmaxf(rm, rowmax(b0, b1)); }
        const float mu = (rm == -INFINITY) ? 0.f : rm;
        float s = 0.f;
#pragma unroll
        for (int r = 0; r < 16; ++r) { a0[r] = __builtin_amdgcn_exp2f(a0[r] - mu); a1[r] = __builtin_amdgcn_exp2f(a1[r] - mu); s += a0[r] + a1[r]; }
        if (two) {
#pragma unroll
            for (int r = 0; r < 16; ++r) { b0[r] = __builtin_amdgcn_exp2f(b0[r] - mu); b1[r] = __builtin_amdgcn_exp2f(b1[r] - mu); s += b0[r] + b1[r]; }
        }
        s = halfsum(s);
        const float inv = (s > 0.f) ? 1.0f / s : 0.f;
#pragma unroll
        for (int r = 0; r < 16; ++r) { a0[r] *= inv; a1[r] *= inv; }
        if (two) {
#pragma unroll
            for (int r = 0; r < 16; ++r) { b0[r] *= inv; b1[r] *= inv; }
            int qlx = c.ql; LAUNDER(qlx);
            LAS float* IA = (LAS float*)(shm + L_IA) + (kh * 64 + qlx) * 33;
            LAS float* IB = (LAS float*)(shm + L_IB) + (kh * 64 + qlx) * 33;
#pragma unroll
            for (int i = 0; i < 4; ++i) {
                const int j = 2 * i + c.hi;
                IA[j]      = a0[4 * i] + a0[4 * i + 1] + a0[4 * i + 2] + 0.5f * a0[4 * i + 3]; IB[j + 1]  = 0.5f * a0[4 * i + 3];
                IA[j + 8]  = a1[4 * i] + a1[4 * i + 1] + a1[4 * i + 2] + 0.5f * a1[4 * i + 3]; IB[j + 9]  = 0.5f * a1[4 * i + 3];
                IA[j + 16] = b0[4 * i] + b0[4 * i + 1] + b0[4 * i + 2] + 0.5f * b0[4 * i + 3]; IB[j + 17] = 0.5f * b0[4 * i + 3];
                IA[j + 24] = b1[4 * i] + b1[4 * i + 1] + b1[4 * i + 2] + 0.5f * b1[4 * i + 3]; IB[j + 25] = 0.5f * b1[4 * i + 3];
            }
        }
        o[0] = f32x16{}; o[1] = f32x16{};
        pv(o, c.vb0, pack8(a0, 0), pack8(a0, 8), pack8(a1, 0), pack8(a1, 8));
        if (two) pv(o, c.vb0 + SLOTB, pack8(b0, 0), pack8(b0, 8), pack8(b1, 0), pack8(b1, 8));
        float cf[16]; row_bcast(g0, cf, c.wsf, c.r32, c.hi);
#pragma unroll
        for (int r = 0; r < 16; ++r) { ot[0][r] = o[0][r] * cf[r]; ot[1][r] = o[1][r] * cf[r]; }
    }
    ATT_WAIT_BAR(0);
    LAS unsigned* SEL = (LAS unsigned*)(shm + L_SEL);
    if (two) {
        int q = tid & 63, jg = tid >> 6; LAUNDER(q); LAUNDER(jg);
        LAS float* SC = (LAS float*)(shm + L_SC);
        const LAS float* IA = (const LAS float*)(shm + L_IA); const LAS float* IB = (const LAS float*)(shm + L_IB);
#pragma unroll
        for (int jj = 0; jj < 4; ++jj) { const int j = 4 * jg + jj; float sc = 0.f;
#pragma unroll
            for (int k = 0; k < 4; ++k) { sc += IA[(k * 64 + q) * 33 + j]; if (j > 0) sc += IB[(k * 64 + q) * 33 + j]; }
            const bool forced = (j == 0) || (j == qb) || (j == qb - 1);
            SC[q * 33 + j] = forced ? 1e30f : ((j <= qb) ? sc : -1e30f); }
        ATT_WAIT_BAR(0);
        unsigned nib = 0u;
        float sj[4];
#pragma unroll
        for (int jj = 0; jj < 4; ++jj) sj[jj] = SC[q * 33 + 4 * jg + jj];
        int rank[4] = {0, 0, 0, 0};
        for (int i = 0; i < 32; ++i) { const float si = SC[q * 33 + i];
#pragma unroll
            for (int jj = 0; jj < 4; ++jj) { const int j = 4 * jg + jj; rank[jj] += (si > sj[jj] || (si == sj[jj] && i < j)) ? 1 : 0; } }
#pragma unroll
        for (int jj = 0; jj < 4; ++jj) nib |= (rank[jj] < 16 ? 1u : 0u) << jj;
        ((LAS unsigned char*)(shm + L_NIB))[q * 8 + jg] = (unsigned char)nib;
        ATT_WAIT_BAR(0);
        if (tid < 64) { unsigned mk = 0u; int tq = tid; LAUNDER(tq);
#pragma unroll
            for (int k = 0; k < 8; ++k) mk |= (unsigned)((LAS unsigned char*)(shm + L_NIB))[tq * 8 + k] << (4 * k);
            SEL[tq] = mk; }
        ATT_WAIT_BAR(0);
    } else {
        if (tid < 64) SEL[tid] = (1u << (qb + 1)) - 1u;
        ATT_WAIT_BAR(0);
    }
    int lnx = c.lane, qlx2 = c.ql; LAUNDER(lnx); LAUNDER(qlx2);
    LAS float* accp = (LAS float*)(shm + L_IA) + c.wid * 2048 + lnx;
#pragma unroll
    for (int r = 0; r < 16; ++r) { accp[r * 64] = ot[0][r]; accp[(16 + r) * 64] = ot[1][r]; }
    unsigned um = SEL[lnx];
#pragma unroll
    for (int sft = 1; sft < 64; sft <<= 1) um |= (unsigned)__shfl_xor((int)um, sft);
    um = (unsigned)__builtin_amdgcn_readfirstlane((int)um);
    um &= (qb == 31) ? 0xffffffffu : ((1u << (qb + 1)) - 1u);
    const unsigned msel = SEL[qlx2];
    (void)um;
    {
        float l_sel; f32x16 osel[2];
        sel_stream<8>(c, KSb, VSb, qr, msel, qb, osel, l_sel);
        const float lt = halfsum(l_sel);
        float cf[16]; row_bcast((lt > 0.f) ? g1 / lt : 0.f, cf, c.wsf, c.r32, c.hi);
#pragma unroll
        for (int r = 0; r < 16; ++r) { accp[r * 64] += osel[0][r] * cf[r]; accp[(16 + r) * 64] += osel[1][r] * cf[r]; }
    }
    {
        const int lo_t = qb >= 8 ? qb - 8 : 0, nw = qb - lo_t + 1;
        dma_k(c, KWb, qb, 0); dma_v(c, VWb, qb, 0);
        if (nw > 1) { dma_k(c, KWb, qb - 1, 1); dma_v(c, VWb, qb - 1, 1); }
        BrState st; br_reset(st);
        int slot = 0;
        for (int j = 0; j < nw; ++j) {
            if (j + 1 < nw) ATT_WAIT_BAR(2); else ATT_WAIT_BAR(0);
            if (j + 2 < nw) { const int ps = (slot == 0) ? 2 : slot - 1; dma_k(c, KWb, qb - j - 2, ps); dma_v(c, VWb, qb - j - 2, ps); }
            const int tc = qb - j;
            bool use_range = false; int lo = 0, hv = 63;
            if (j == 0) { use_range = true; hv = c.ql; }
            else if (tc == qb - 8) { use_range = true; lo = c.ql + 1; }
            stream_step(c, slot, qr, true, use_range, lo, hv, j == 0, st);
            slot = (slot == 2) ? 0 : slot + 1;
        }
        const float lt = halfsum(st.l);
        float cf[16]; row_bcast((lt > 0.f) ? g2 / lt : 0.f, cf, c.wsf, c.r32, c.hi);
#pragma unroll
        for (int r = 0; r < 16; ++r) { ot[0][r] = accp[r * 64] + st.o[0][r] * cf[r]; ot[1][r] = accp[(16 + r) * 64] + st.o[1][r] * cf[r]; }
        LDS_WAIT();
    }
    {
        LAS bf16_t* stg = (LAS bf16_t*)(shm + L_IA) + c.wid * 4096;
        int lny = c.lane; LAUNDER(lny);
        LAS bf16_t* stw = stg + ((lny >> 5) * 4) * 64 + (lny & 31);
#pragma unroll
        for (int r = 0; r < 16; ++r) { const int orow = (r & 3) + 8 * (r >> 2);
#pragma unroll
            for (int d0 = 0; d0 < 2; ++d0) stw[orow * 64 + d0 * 32] = (bf16_t)(cvtpk(ot[d0][r], 0.f) & 0xffffu); }
        LDS_WAIT();
        bf16_t* Ow = O + ((size_t)qb * 64 + qh * 32) * DM + head * 64;
#pragma unroll
        for (int i = 0; i < 4; ++i) { const int row = i * 8 + (lny >> 3), chn = lny & 7; const u32x4 v = *(const LAS u32x4*)(stg + row * 64 + chn * 8); *(u32x4*)(Ow + (size_t)row * DM + chn * 8) = v; }
    }
    ATT_WAIT_BAR(0);
}
#undef SBAR
}

#define XB_TMO      128
#define XB_XCNT(j)  (256  + 64 * (j))
#define XB_XSUB(j)  (1280 + 64 * (j))
#define XB_XGEN(j)  (2304 + 64 * (j))
#define XB_TOP      3328
#define XB_TOPGEN   3392
#define XB_LSUB(j)  (3456 + 64 * (j))
#define XB_LGEN(j)  (4480 + 64 * (j))
#define XCD_BAR_WORDS 5504
#define XB_SPIN_CAP (1u << 18)
__device__ __forceinline__ unsigned xb_ld(unsigned* p)              { return __hip_atomic_load(p, __ATOMIC_RELAXED, __HIP_MEMORY_SCOPE_AGENT); }
__device__ __forceinline__ unsigned xb_add(unsigned* p, unsigned v) { return __hip_atomic_fetch_add(p, v, __ATOMIC_RELAXED, __HIP_MEMORY_SCOPE_AGENT); }
__device__ __forceinline__ unsigned xb_xcc_id() { return (unsigned)__builtin_amdgcn_s_getreg((3 << 11) | 20) & 0xFu; }
#define XB_SPIN(cond, bar) do { unsigned _sp = 0; while (cond) { __builtin_amdgcn_s_sleep(1); \
    if ((++_sp & 255u) == 0u) { if (xb_ld(&(bar)[XB_TMO])) break; if (_sp > XB_SPIN_CAP) { atomicAdd(&(bar)[XB_TMO], 1u); break; } } } } while (0)
struct XcdBarrier { unsigned* bar; unsigned x; volatile LAS unsigned* st; };
__device__ __forceinline__ XcdBarrier xcd_barrier_post(unsigned* bar, volatile LAS unsigned* st) {
    XcdBarrier b; b.bar = bar; b.x = xb_xcc_id(); b.st = st;
    if (threadIdx.x == 0) { st[2] = xb_add(&bar[XB_XCNT(b.x)], 1u); st[4] = b.x; }
    return b;
}
__device__ __forceinline__ void xcd_barrier_complete(unsigned* bar, unsigned x, unsigned& nloc, unsigned& nx, unsigned& uniform) {
    const unsigned G = gridDim.x * gridDim.y * gridDim.z;
    unsigned sum, cnt, mine, sp = 0u, uni;
    for (;;) {
        sum = 0u; cnt = 0u; mine = 0u; uni = 1u;
#pragma unroll
        for (unsigned j = 0; j < 16; ++j) { const unsigned c = xb_ld(&bar[XB_XCNT(j)]); sum += c; cnt += (c > 0u) ? 1u : 0u; mine = (j == x) ? c : mine;
            if (j < 8u ? (c != 32u) : (c != 0u)) uni = 0u; }
        if (sum == G) break;
        __builtin_amdgcn_s_sleep(1);
        if ((++sp & 255u) == 0u) { if (xb_ld(&bar[XB_TMO])) break; if (sp > XB_SPIN_CAP) { atomicAdd(&bar[XB_TMO], 1u); break; } }
    }
    nloc = mine > 0u ? mine : 1u; nx = cnt > 0u ? cnt : 1u;
    uniform = (uni != 0u && sum == G && G == 256u) ? 1u : 0u;
}
__device__ __forceinline__ void xcd_barrier(const XcdBarrier& b) {
    asm volatile("s_waitcnt vmcnt(0)" ::: "memory");
    __syncthreads();
    if (threadIdx.x == 0) {
        unsigned* bar = b.bar;
        __builtin_amdgcn_s_waitcnt(0);
        unsigned nloc = b.st[0], nx = b.st[1];
        if (nloc == 0u) { unsigned uf; xcd_barrier_complete(bar, b.x, nloc, nx, uf); b.st[0] = nloc; b.st[1] = nx; b.st[3] = uf; }
        const unsigned old = xb_add(&bar[XB_XSUB(b.x)], 1u);
        const unsigned gen = old / nloc;
        if (old + 1u == (gen + 1u) * nloc) {
            __builtin_amdgcn_fence(__ATOMIC_RELEASE, "agent");
            asm volatile("s_waitcnt vmcnt(0)" ::: "memory");
            const unsigned og = xb_add(&bar[XB_TOP], 1u);
            const unsigned tg = og / nx;
            if (og + 1u == (tg + 1u) * nx) xb_add(&bar[XB_TOPGEN], 1u);
            else XB_SPIN(xb_ld(&bar[XB_TOPGEN]) == tg, bar);
            __builtin_amdgcn_fence(__ATOMIC_ACQUIRE, "agent");
            xb_add(&bar[XB_XGEN(b.x)], 1u);
            asm volatile("s_waitcnt vmcnt(0)" ::: "memory");
        } else {
            XB_SPIN(xb_ld(&bar[XB_XGEN(b.x)]) == gen, bar);
            __builtin_amdgcn_fence(__ATOMIC_ACQUIRE, "agent");
            asm volatile("s_waitcnt vmcnt(0)" ::: "memory");
        }
    }
    __syncthreads();
}

__device__ __forceinline__ void xcd_local_barrier(const XcdBarrier& b) {
    asm volatile("s_waitcnt vmcnt(0)" ::: "memory");
    __syncthreads();
    if (threadIdx.x == 0) {
        unsigned* bar = b.bar;
        __builtin_amdgcn_s_waitcnt(0);
        const unsigned nloc = b.st[0];
        const unsigned old = xb_add(&bar[XB_LSUB(b.x)], 1u);
        const unsigned gen = old / nloc;
        if (old + 1u == (gen + 1u) * nloc) xb_add(&bar[XB_LGEN(b.x)], 1u);
        else XB_SPIN(xb_ld(&bar[XB_LGEN(b.x)]) == gen, bar);
        __builtin_amdgcn_fence(__ATOMIC_ACQUIRE, "agent");
        asm volatile("s_waitcnt vmcnt(0)" ::: "memory");
    }
    __syncthreads();
}

struct Args {
    const float *x, *c, *norm_gain, *w_ada, *b_ada, *w_a_in, *conv_w, *w_a_out, *w_qg, *q_gain, *w_o, *kv_norm_gain, *w_ada_kv, *b_ada_kv, *w_kv, *k_gain, *cmp_pe, *cmp_w1, *cmp_w2, *w_mlp1, *w_mlp2;
    float* out; unsigned char* ws; int ph_lo, ph_hi;
};

__device__ __forceinline__ void transpose_item(const float* W, int ldn, int srccol, int nvalid, int k0, bf16_t* WT, int Kd, int drow0, LAS float* scr, int lane) {
    if (nvalid == 32) {
        f32x4 t[8];
#pragma unroll
        for (int i = 0; i < 8; ++i) t[i] = __builtin_nontemporal_load((const f32x4*)(W + (size_t)(k0 + 8 * i + (lane >> 3)) * ldn + srccol + (lane & 7) * 4));
#pragma unroll
        for (int i = 0; i < 8; ++i) { LAS float* d = scr + (8 * i + (lane >> 3)) * 33 + (lane & 7) * 4; d[0] = t[i][0]; d[1] = t[i][1]; d[2] = t[i][2]; d[3] = t[i][3]; }
    } else {
#pragma unroll 8
        for (int i = 0; i < 32; ++i) { const int kk = 2 * i + (lane >> 5), n = lane & 31; scr[kk * 33 + n] = (n < nvalid) ? W[(size_t)(k0 + kk) * ldn + srccol + n] : 0.f; }
    }
    LDS_WAIT(); asm volatile("" ::: "memory");
    const int ch = lane & 7;
#pragma unroll
    for (int j = 0; j < 4; ++j) { const int n = (lane >> 3) + 8 * j; const LAS float* s = scr + (8 * ch) * 33 + n;
        u32x4 o; o.x = cvtpk(s[0 * 33], s[1 * 33]); o.y = cvtpk(s[2 * 33], s[3 * 33]); o.z = cvtpk(s[4 * 33], s[5 * 33]); o.w = cvtpk(s[6 * 33], s[7 * 33]);
        *(u32x4*)(WT + (size_t)(drow0 + n) * Kd + k0 + 8 * ch) = o; }
    LDS_WAIT(); asm volatile("" ::: "memory");
}
__device__ __forceinline__ int perm_head_cols(int d) { const int t = d >> 8, p = d & 255; return 256 * t + 64 * ((p >> 5) & 3) + 32 * (p >> 7) + (p & 31); }

constexpr int TI_AIN = 1536, TI_AOUT = 512, TI_M1 = 2048, TI_M2 = 2048, TI_KV = 768, TI_QG = 640, TI_O = 512, TI_C1 = 256, TI_C2 = 8;
constexpr int TI_TOTAL = TI_AIN + TI_AOUT + 2 * TI_M1 + 2 * TI_M2 + TI_KV + TI_QG + TI_O + 2 * TI_C1 + 2 * TI_C2;

__device__ __forceinline__ void p0_item(const Args& a, int it, LAS float* scr, int lane) {
    unsigned char* ws = a.ws;
    int r = it;
    if (r < TI_AIN) { const int kb = r / 96, nb = r % 96, d = 32 * nb; int src;
        if (d < 1024) src = d; else { const int t = (d - 1024) >> 8, p = (d - 1024) & 255; src = (p < 128) ? (1024 + 128 * t + p) : (2048 + 128 * t + (p - 128)); }
        transpose_item(a.w_a_in, 3072, src, 32, 64 * kb, (bf16_t*)(ws + WS_WAIN), 1024, d, scr, lane); return; }
    r -= TI_AIN;
    if (r < TI_AOUT) { const int kb = r / 32, nb = r % 32; transpose_item(a.w_a_out, 1024, 32 * nb, 32, 64 * kb, (bf16_t*)(ws + WS_WAOUT), 1024, 32 * nb, scr, lane); return; }
    r -= TI_AOUT;
    if (r < 2 * TI_M1) { const int L = r / TI_M1, q = r % TI_M1, kb = q / 128, nb = q % 128;
        transpose_item(a.w_mlp1 + (size_t)L * DM * FF, FF, 32 * nb, 32, 64 * kb, (bf16_t*)(ws + WS_WM1) + (size_t)L * FF * DM, DM, 32 * nb, scr, lane); return; }
    r -= 2 * TI_M1;
    if (r < 2 * TI_M2) { const int L = r / TI_M2, q = r % TI_M2, kb = q / 32, nb = q % 32;
        transpose_item(a.w_mlp2 + (size_t)L * FF * DM, DM, 32 * nb, 32, 64 * kb, (bf16_t*)(ws + WS_WM2) + (size_t)L * DM * FF, FF, 32 * nb, scr, lane); return; }
    r -= 2 * TI_M2;
    if (r < TI_KV) { const int kb = r / 48, nb = r % 48, d = 32 * nb;
        transpose_item(a.w_kv, 1536, perm_head_cols(d), 32, 64 * kb, (bf16_t*)(ws + WS_WKVQ), DM, d, scr, lane); return; }
    r -= TI_KV;
    if (r < TI_QG) { const int kb = r / 40, nb = r % 40, d = 32 * nb; int src, nv = 32;
        if (d < 1024) src = perm_head_cols(d); else { const int p = d - 1024; src = 1024 + p; nv = 48 - p; nv = nv < 0 ? 0 : (nv > 32 ? 32 : nv); if (nv == 0) src = 0; }
        transpose_item(a.w_qg, 1072, src, nv, 64 * kb, (bf16_t*)(ws + WS_WKVQ), DM, 1536 + d, scr, lane); return; }
    r -= TI_QG;
    if (r < TI_O) { const int kb = r / 32, nb = r % 32; transpose_item(a.w_o, 1024, 32 * nb, 32, 64 * kb, (bf16_t*)(ws + WS_WO), 1024, 32 * nb, scr, lane); return; }
    r -= TI_O;
    if (r < 2 * TI_C1) { const int kv = r / TI_C1, q = r % TI_C1, kb = q / 8, nb = q % 8;
        transpose_item(a.cmp_w1 + (size_t)kv * 2048 * 256, 256, 32 * nb, 32, 64 * kb, (bf16_t*)(ws + WS_WC1) + (size_t)kv * 256 * 2048, 2048, 32 * nb, scr, lane); return; }
    r -= 2 * TI_C1;
    { const int kv = r / TI_C2, q = r % TI_C2, kb = q / 2, nb = q % 2;
        transpose_item(a.cmp_w2 + (size_t)kv * 256 * 64, 64, 32 * nb, 32, 64 * kb, (bf16_t*)(ws + WS_WC2) + (size_t)kv * 64 * 256, 256, 32 * nb, scr, lane); }
}

__device__ __forceinline__ void p0_mods(const Args& a, LAS unsigned char* lds, int vblk, int G) {
    LAS float* cact = (LAS float*)lds;
    LAS float* red = (LAS float*)(lds + 32768);
    const int tid = threadIdx.x, lane = tid & 63, wave = tid >> 6;
    bool have = false;
    for (int u = vblk; u < 224; u += G) {
        if (!have) { for (int i = tid; i < 8 * DM; i += 512) { const float cv = a.c[i]; cact[i] = cv / (1.0f + __expf(-cv)); } have = true; }
        __syncthreads();
        const int col = u * 64 + lane;
        const float* W; const float* bias; float* dst; int N, c0;
        if (col < 6144) { W = a.w_ada; bias = a.b_ada; dst = (float*)(a.ws + WS_MOD0); N = 6144; c0 = col; }
        else if (col < 12288) { W = a.w_ada + (size_t)DM * 6144; bias = a.b_ada + 6144; dst = (float*)(a.ws + WS_MOD1); N = 6144; c0 = col - 6144; }
        else { W = a.w_ada_kv; bias = a.b_ada_kv; dst = (float*)(a.ws + WS_MODKV); N = 2048; c0 = col - 12288; }
        float acc[8];
#pragma unroll
        for (int b = 0; b < 8; ++b) acc[b] = 0.f;
        const float* wp = W + (size_t)(wave * 128) * N + c0;
        const LAS float* cp = cact + wave * 128;
#pragma unroll 8
        for (int k = 0; k < 128; ++k) { const float w = __builtin_nontemporal_load(wp + (size_t)k * N);
#pragma unroll
            for (int b = 0; b < 8; ++b) acc[b] += w * cp[b * DM + k]; }
#pragma unroll
        for (int b = 0; b < 8; ++b) red[(wave * 8 + b) * 64 + lane] = acc[b];
        __syncthreads();
        { const int b = wave; float sacc = bias[c0];
#pragma unroll
          for (int w = 0; w < 8; ++w) sacc += red[(w * 8 + b) * 64 + lane];
          dst[(size_t)b * N + c0] = sacc; }
        __syncthreads();
    }
    __syncthreads();
}

__device__ __forceinline__ void p1_norm_row2(const Args& a, int m0, int lane) {
    const int b = m0 >> 11;
    const float* mod0 = (const float*)(a.ws + WS_MOD0) + (size_t)b * 6144;
    const f32x4* xr = (const f32x4*)(a.x + (size_t)m0 * DM) + lane;
    f32x4 v[2][4]; float s0 = 0.f, s1 = 0.f;
#pragma unroll
    for (int j = 0; j < 4; ++j) { v[0][j] = __builtin_nontemporal_load(xr + 64 * j); v[1][j] = __builtin_nontemporal_load(xr + 256 + 64 * j); }
#pragma unroll
    for (int j = 0; j < 4; ++j) { s0 += (v[0][j][0] * v[0][j][0] + v[0][j][1] * v[0][j][1]) + (v[0][j][2] * v[0][j][2] + v[0][j][3] * v[0][j][3]);
                                  s1 += (v[1][j][0] * v[1][j][0] + v[1][j][1] * v[1][j][1]) + (v[1][j][2] * v[1][j][2] + v[1][j][3] * v[1][j][3]); }
#pragma unroll
    for (int o = 1; o < 64; o <<= 1) { s0 += __shfl_xor(s0, o); s1 += __shfl_xor(s1, o); }
    const float r0 = rsqrtf(s0 * (1.0f / DM) + EPS), r1 = rsqrtf(s1 * (1.0f / DM) + EPS);
    u32x2* o8 = (u32x2*)((bf16_t*)(a.ws + WS_A2) + (size_t)m0 * DM) + lane;
#pragma unroll
    for (int j = 0; j < 4; ++j) { const int col = 4 * lane + 256 * j;
        const f32x4 gn = *(const f32x4*)(a.norm_gain + col), sh = *(const f32x4*)(mod0 + col), sc = *(const f32x4*)(mod0 + 1024 + col) + 1.0f;
        const f32x4 h0 = (v[0][j] * r0 * gn) * sc + sh, h1 = (v[1][j] * r1 * gn) * sc + sh;
        u32x2 w; w.x = cvtpk(h0[0], h0[1]); w.y = cvtpk(h0[2], h0[3]); o8[64 * j] = w;
        w.x = cvtpk(h1[0], h1[1]); w.y = cvtpk(h1[2], h1[3]); o8[256 + 64 * j] = w; }
}
__device__ __forceinline__ void p1_bias_task(const bf16_t* Wt, int n0, const float* shift, int shift_stride, float* bias, int bias_stride, int lane) {
    const int r = lane & 15, kq = lane >> 4;
    const bf16_t* wp = Wt + (size_t)(n0 + r) * DM + 8 * kq;
    const float* sp = shift + (size_t)(r & 7) * shift_stride + 8 * kq;
    f32x4 acc = (f32x4){0.f, 0.f, 0.f, 0.f};
#pragma unroll 8
    for (int k0 = 0; k0 < DM; k0 += 32) {
        const bf16x8 bf = *(const bf16x8*)(wp + k0);
        const f32x4 s0 = *(const f32x4*)(sp + k0), s1 = *(const f32x4*)(sp + k0 + 4);
        u32x4 aw; aw.x = cvtpk(s0[0], s0[1]); aw.y = cvtpk(s0[2], s0[3]); aw.z = cvtpk(s1[0], s1[1]); aw.w = cvtpk(s1[2], s1[3]);
        if (r >= 8) aw = (u32x4){0u, 0u, 0u, 0u};
        acc = __builtin_amdgcn_mfma_f32_16x16x32_bf16(__builtin_bit_cast(bf16x8, aw), bf, acc, 0, 0, 0);
    }
    if (kq < 2) {
#pragma unroll
        for (int e = 0; e < 4; ++e) bias[(size_t)(4 * kq + e) * bias_stride + n0 + r] = acc[e];
    }
}
__device__ __forceinline__ void p1_pebias(const Args& a, int idx, int lane) {
    const int kv = idx >> 8;
    const bf16_t* wrow = (const bf16_t*)(a.ws + WS_WC1) + (size_t)idx * 2048;
    const float* pe = a.cmp_pe + (size_t)kv * 2048;
    float d = 0.f;
#pragma unroll
    for (int j = 0; j < 4; ++j) { const int k = (lane + 64 * j) * 8; const u32x4 w = *(const u32x4*)(wrow + k); const f32x4 p0 = *(const f32x4*)(pe + k), p1 = *(const f32x4*)(pe + k + 4);
        d += p0[0] * bf_lo(w.x) + p0[1] * bf_hi(w.x) + p0[2] * bf_lo(w.y) + p0[3] * bf_hi(w.y) + p1[0] * bf_lo(w.z) + p1[1] * bf_hi(w.z) + p1[2] * bf_lo(w.w) + p1[3] * bf_hi(w.w); }
    d = wave_sum(d);
    if (lane == 0) ((float*)(a.ws + WS_PEB))[idx] = d;
}

__device__ __forceinline__ void unpack8(const u32x4 w, float (&f)[8]) { f[0] = bf_lo(w.x); f[1] = bf_hi(w.x); f[2] = bf_lo(w.y); f[3] = bf_hi(w.y); f[4] = bf_lo(w.z); f[5] = bf_hi(w.z); f[6] = bf_lo(w.w); f[7] = bf_hi(w.w); }
__device__ __forceinline__ void p3_conv(const Args& a, int gtid, int nthreads) {
    for (int it0 = gtid; it0 < 128 * 2048; it0 += nthreads) {
        const int pass = it0 / nthreads, vt = it0 - pass * nthreads;
        const int it = (nthreads == 131072) ? ((vt >> 14) * 32768 + pass * 16384 + (vt & 16383)) : it0;
        const int cch = it & 127, rch = it >> 7, col = cch * 8, r0 = (rch * 8) & (SEQ - 1);
        unsigned char* slab = a.ws + WS_R + (size_t)((rch * 8) >> 11) * SLAB;
        const bf16_t* GB = (const bf16_t*)(slab + SO_GB); const bf16_t* V = (const bf16_t*)(slab + SO_V); bf16_t* Y = (bf16_t*)(slab + SO_Y);
        float w0[8], w1[8], w2[8];
        { const f32x4 t0 = *(const f32x4*)(a.conv_w + col), t1 = *(const f32x4*)(a.conv_w + col + 4); w0[0] = t0[0]; w0[1] = t0[1]; w0[2] = t0[2]; w0[3] = t0[3]; w0[4] = t1[0]; w0[5] = t1[1]; w0[6] = t1[2]; w0[7] = t1[3]; }
        { const f32x4 t0 = *(const f32x4*)(a.conv_w + 1024 + col), t1 = *(const f32x4*)(a.conv_w + 1024 + col + 4); w1[0] = t0[0]; w1[1] = t0[1]; w1[2] = t0[2]; w1[3] = t0[3]; w1[4] = t1[0]; w1[5] = t1[1]; w1[6] = t1[2]; w1[7] = t1[3]; }
        { const f32x4 t0 = *(const f32x4*)(a.conv_w + 2048 + col), t1 = *(const f32x4*)(a.conv_w + 2048 + col + 4); w2[0] = t0[0]; w2[1] = t0[1]; w2[2] = t0[2]; w2[3] = t0[3]; w2[4] = t1[0]; w2[5] = t1[1]; w2[6] = t1[2]; w2[7] = t1[3]; }
        float vm2[8], vm1[8];
        if ((r0 & (SEQ - 1)) != 0) { unpack8(*(const u32x4*)(V + (size_t)(r0 - 2) * DM + col), vm2); unpack8(*(const u32x4*)(V + (size_t)(r0 - 1) * DM + col), vm1); }
        else {
#pragma unroll
            for (int e = 0; e < 8; ++e) { vm2[e] = 0.f; vm1[e] = 0.f; } }
#pragma unroll
        for (int i = 0; i < 8; ++i) { float vc[8], gb[8], y[8];
            unpack8(*(const u32x4*)(V + (size_t)(r0 + i) * DM + col), vc); unpack8(*(const u32x4*)(GB + (size_t)(r0 + i) * DM + col), gb);
#pragma unroll
            for (int e = 0; e < 8; ++e) { y[e] = gb[e] * (w2[e] * vc[e] + w1[e] * vm1[e] + w0[e] * vm2[e]); vm2[e] = vm1[e]; vm1[e] = vc[e]; }
            u32x4 w; w.x = cvtpk(y[0], y[1]); w.y = cvtpk(y[2], y[3]); w.z = cvtpk(y[4], y[5]); w.w = cvtpk(y[6], y[7]);
            *(u32x4*)(Y + (size_t)(r0 + i) * DM + col) = w; }
    }
}

__device__ __forceinline__ float gelu_tanh(float x) {
    const float z = 0.7978845608028654f * (x + 0.044715f * x * x * x);
    const float e = __builtin_amdgcn_exp2f(z * 2.8853900817779268f);
    const float th = 1.0f - 2.0f / (e + 1.0f);
    return 0.5f * x * (1.0f + th);
}
constexpr int C_CH = 2064;
constexpr int C_RB0 = 68608;
constexpr int C_HOFF = C_RB0, C_HROW = 528;
__device__ __forceinline__ void p8_unit(const Args& a, int u, LAS unsigned char* lds) {
    const int tid = threadIdx.x, lane = tid & 63, wid = __builtin_amdgcn_readfirstlane(tid >> 6), r = lane & 31, h = lane >> 5;
    const int kv = u >> 7, bg = (u >> 2) & 31, rq = u & 3;
    unsigned char* slab = a.ws + WS_R + (size_t)(bg >> 2) * SLAB;
    const bf16_t* src = (const bf16_t*)(slab + SO_KV) + ((size_t)(kv * 4 + (bg & 3)) * SEQ + 512 * rq) * 64;
    __syncthreads();
    { u32x4 v[8];
#pragma unroll
      for (int j = 0; j < 8; ++j) v[j] = *(const u32x4*)(src + (size_t)(tid + 512 * j) * 8);
      u32x4 vl = (u32x4){0u, 0u, 0u, 0u};
      if (tid < 128 && rq != 3) vl = *(const u32x4*)(src + (size_t)32 * 1024 + tid * 8);
#pragma unroll
      for (int j = 0; j < 8; ++j) { const int idx = tid + 512 * j; *(LAS u32x4*)(lds + (idx >> 7) * C_CH + (idx & 127) * 16) = v[j]; }
      if (tid < 128) *(LAS u32x4*)(lds + 32 * C_CH + tid * 16) = vl; }
    __syncthreads();
    f32x16 acc = f32x16{};
    const unsigned lds0 = (unsigned)(size_t)lds;
    const bf16_t* Wsrc = (const bf16_t*)(a.ws + WS_WC1) + (size_t)(kv * 256) * 2048;
    const int drow = 16 * wid + (lane >> 2);
    const bf16_t* dsrc0 = Wsrc + (size_t)drow * 2048 + 8 * ((lane & 3) ^ ((drow >> 2) & 3));
    const bf16_t* dsrc1 = dsrc0 + (size_t)128 * 2048;
    const unsigned ddst0 = lds0 + C_RB0 + wid * 1024, ddst1 = ddst0 + 8192;
    const int brow = 32 * wid + r;
    const unsigned boff = C_RB0 + brow * 64, bkey = (brow >> 2) & 3;
#define P8_DMA(stg) do { att::glds16(dsrc0 + 32 * (stg), (unsigned)__builtin_amdgcn_readfirstlane(ddst0 + ((stg) & 3) * 16384)); att::glds16(dsrc1 + 32 * (stg), (unsigned)__builtin_amdgcn_readfirstlane(ddst1 + ((stg) & 3) * 16384)); } while (0)
#define P8_STEP(stg, WAITN) do { asm volatile("s_waitcnt vmcnt(" #WAITN ") lgkmcnt(0)\n\ts_barrier" ::: "memory"); \
        if ((stg) + 3 < 64) P8_DMA((stg) + 3); \
        { const LAS unsigned char* bp = lds + boff + ((stg) & 3) * 16384; \
          const LAS unsigned char* ap = lds + (r + ((stg) >> 5)) * C_CH + ((32 * (stg)) & 1023) * 2 + 16 * h; \
          const bf16x8 a0 = *(const LAS bf16x8*)ap, a1 = *(const LAS bf16x8*)(ap + 32); \
          const bf16x8 b0 = *(const LAS bf16x8*)(bp + 16 * ((unsigned)h ^ bkey)), b1 = *(const LAS bf16x8*)(bp + 16 * ((unsigned)(2 + h) ^ bkey)); \
          acc = __builtin_amdgcn_mfma_f32_32x32x16_bf16(a0, b0, acc, 0, 0, 0); acc = __builtin_amdgcn_mfma_f32_32x32x16_bf16(a1, b1, acc, 0, 0, 0); } } while (0)
    P8_DMA(0); P8_DMA(1); P8_DMA(2);
    for (int s4 = 0; s4 < 60; s4 += 4) { P8_STEP(s4, 4); P8_STEP(s4 + 1, 4); P8_STEP(s4 + 2, 4); P8_STEP(s4 + 3, 4); }
    P8_STEP(60, 4); P8_STEP(61, 4); P8_STEP(62, 2); P8_STEP(63, 0);
    asm volatile("s_waitcnt lgkmcnt(0)\n\ts_barrier" ::: "memory");
#undef P8_DMA
#undef P8_STEP
    { const float pb = ((const float*)(a.ws + WS_PEB))[kv * 256 + 32 * wid + r];
      LAS bf16_t* H = (LAS bf16_t*)(lds + C_HOFF);
#pragma unroll
      for (int rg = 0; rg < 16; ++rg) { const int row = att::crow(rg, h); H[row * (C_HROW / 2) + 32 * wid + r] = (bf16_t)(cvtpk(gelu_tanh(acc[rg] + pb), 0.f) & 0xffffu); } }
    __syncthreads();
    if (wid == 0) {
        f32x16 o0 = f32x16{}, o1 = f32x16{};
        const bf16_t* W2 = (const bf16_t*)(a.ws + WS_WC2) + (size_t)kv * 64 * 256;
#pragma unroll
        for (int s = 0; s < 16; ++s) {
            const bf16x8 af = *(const LAS bf16x8*)(lds + C_HOFF + r * C_HROW + (16 * s + 8 * h) * 2);
            const bf16x8 b0 = *(const bf16x8*)(W2 + (size_t)r * 256 + 16 * s + 8 * h), b1 = *(const bf16x8*)(W2 + (size_t)(32 + r) * 256 + 16 * s + 8 * h);
            o0 = __builtin_amdgcn_mfma_f32_32x32x16_bf16(af, b0, o0, 0, 0, 0); o1 = __builtin_amdgcn_mfma_f32_32x32x16_bf16(af, b1, o1, 0, 0, 0);
        }
        const float gk0 = a.k_gain[r], gk1 = a.k_gain[32 + r];
        bf16_t* dst = (bf16_t*)(slab + (kv == 0 ? SO_KC : SO_VC)) + (size_t)(bg & 3) * 8192;
#pragma unroll
        for (int rg = 0; rg < 16; ++rg) { float v0 = o0[rg], v1 = o1[rg];
            if (kv == 0) { float ss = v0 * v0 + v1 * v1;
#pragma unroll
                for (int sft = 1; sft < 32; sft <<= 1) ss += __shfl_xor(ss, sft);
                const float rs = rsqrtf(ss * (1.0f / 64.0f) + EPS); v0 *= rs * gk0; v1 *= rs * gk1; }
            const int n = 32 * rq + att::crow(rg, h);
            if (n == 127) { v0 = 0.f; v1 = 0.f; }
            dst[n * 64 + r] = (bf16_t)(cvtpk(v0, 0.f) & 0xffffu); dst[n * 64 + 32 + r] = (bf16_t)(cvtpk(v1, 0.f) & 0xffffu); }
    }
}

__device__ __forceinline__ void p4_fixup(const Args& a, int pm) {
    const int tid = threadIdx.x;
    if (tid < 256) {
        const int rr = tid >> 7, cc = (tid & 127) * 8, pml = pm & 7, srow = pml * 256 + rr;
        unsigned char* slab = a.ws + WS_R + (size_t)(pm >> 3) * SLAB;
        const bf16_t* V = (const bf16_t*)(slab + SO_V); const bf16_t* GBH = (const bf16_t*)(slab + SO_GB) + (size_t)pml * 2 * DM; bf16_t* Y = (bf16_t*)(slab + SO_Y);
        float gb[8], v0[8], v1[8], v2[8], y[8];
        unpack8(*(const u32x4*)(GBH + (size_t)rr * DM + cc), gb);
        unpack8(*(const u32x4*)(V + (size_t)srow * DM + cc), v0);
        if (srow >= 1) unpack8(*(const u32x4*)(V + (size_t)(srow - 1) * DM + cc), v1); else {
#pragma unroll
            for (int e = 0; e < 8; ++e) v1[e] = 0.f; }
        if (srow >= 2) unpack8(*(const u32x4*)(V + (size_t)(srow - 2) * DM + cc), v2); else {
#pragma unroll
            for (int e = 0; e < 8; ++e) v2[e] = 0.f; }
#pragma unroll
        for (int e = 0; e < 8; ++e) y[e] = gb[e] * (a.conv_w[2 * DM + cc + e] * v0[e] + a.conv_w[DM + cc + e] * v1[e] + a.conv_w[cc + e] * v2[e]);
        u32x4 w; w.x = cvtpk(y[0], y[1]); w.y = cvtpk(y[2], y[3]); w.z = cvtpk(y[4], y[5]); w.w = cvtpk(y[6], y[7]);
        *(u32x4*)(Y + (size_t)srow * DM + cc) = w;
    }
}

__global__ void __launch_bounds__(NWAVES * 64, 2) yoco_fwd(Args args) {
    extern __shared__ __attribute__((aligned(16))) unsigned char lds_raw[];
    LAS unsigned char* lds = (LAS unsigned char*)lds_raw;
    const int tid = threadIdx.x, lane = tid & 63, wave = __builtin_amdgcn_readfirstlane(tid >> 6);
    const int G = gridDim.x, bx = blockIdx.x;
    int vcu = (G % 8 == 0) ? (bx % 8) * (G / 8) + bx / 8 : bx;
    int cid = bx;
    const int gw = vcu * NWAVES + wave, NGW = G * NWAVES;
    unsigned char* ws = args.ws;
    const int lo = args.ph_lo, hi = args.ph_hi;
    volatile LAS unsigned* MISC = (volatile LAS unsigned*)(lds + LDS_BYTES - 256);
    if (tid < 8) MISC[tid] = 0u;
    __syncthreads();
    XcdBarrier bar; bar.bar = (unsigned*)(ws + WS_BAR); bar.x = 0; bar.st = MISC;
    if (hi - lo > 1) bar = xcd_barrier_post((unsigned*)(ws + WS_BAR), MISC);
#define IN(k) (lo <= (k) && (k) < hi)
#define SEAM(k) do { if (IN(k) && IN((k) + 1)) xcd_barrier(bar); } while (0)
#define LSEAM(k) do { if (IN(k) && IN((k) + 1)) { if (local_ok) xcd_local_barrier(bar); else xcd_barrier(bar); } } while (0)
    bool local_ok = false;
    float* MOD0 = (float*)(ws + WS_MOD0); float* MOD1 = (float*)(ws + WS_MOD1); float* MODKV = (float*)(ws + WS_MODKV);
    float* SS1 = (float*)(ws + WS_SS1); float* SS2 = (float*)(ws + WS_SS2); float* SS3 = (float*)(ws + WS_SS3);
    bf16_t* A1 = (bf16_t*)(ws + WS_A1); bf16_t* A2 = (bf16_t*)(ws + WS_A2);
    bf16_t* HB = (bf16_t*)(ws + WS_H);

    if (IN(0)) {
        p0_mods(args, lds, vcu, G);
        LAS float* scr = (LAS float*)(lds + wave * 16384);
        for (int it = gw; it < TI_TOTAL; it += NGW) p0_item(args, it, scr, lane);
    }
    SEAM(0);
    if (IN(1)) {
        for (int m = gw; m < M_TOK / 2; m += NGW) p1_norm_row2(args, 2 * m, lane);
        for (int it = gw; it < (2 * FF + NKVQ) / 16 + 512; it += NGW) {
            const int n = it * 16;
            if (n < FF) p1_bias_task((const bf16_t*)(ws + WS_WM1), n, MOD0 + 3072, 6144, (float*)(ws + WS_BM1L0), FF, lane);
            else if (n < 2 * FF) p1_bias_task((const bf16_t*)(ws + WS_WM1) + (size_t)FF * DM, n - FF, MOD1 + 3072, 6144, (float*)(ws + WS_BM1L1), FF, lane);
            else if (n < 2 * FF + 1536) p1_bias_task((const bf16_t*)(ws + WS_WKVQ), n - 2 * FF, MODKV, 2048, (float*)(ws + WS_BKVQ), NKVQ, lane);
            else if (n < 2 * FF + NKVQ) p1_bias_task((const bf16_t*)(ws + WS_WKVQ), n - 2 * FF, MOD1, 6144, (float*)(ws + WS_BKVQ), NKVQ, lane);
            else p1_pebias(args, it - (2 * FF + NKVQ) / 16, lane);
        }
    }
    SEAM(1);
    if (hi - lo > 1 && lo <= 1) {
        local_ok = MISC[3] != 0u;
        if (local_ok) { const int x = (int)MISC[4], rk = (int)MISC[2]; vcu = x * 32 + rk; cid = rk * 8 + x; }
    }
    if (IN(2)) {
        pg8::Gemm g{A2, A2, 1 << 30, (const bf16_t*)(ws + WS_WAIN), M_TOK, 3072, DM, (size_t)SEQ * DM * 2}; pg8::StaticOrder S; S.init_ain(G, cid);
        pg8::EpiAin E{ws + WS_R, args.conv_w};
        pg8::gemm_phase(lds, g, S, E);
    }
    LSEAM(2);
    if (IN(4)) {
        pg8::Gemm g{(const bf16_t*)(ws + WS_R + SO_Y), (const bf16_t*)(ws + WS_R + SO_Y), 1 << 30, (const bf16_t*)(ws + WS_WAOUT), M_TOK, DM, DM, SLAB}; pg8::StaticOrder S; S.init(M_TOK, DM, G, cid);
        { pg8::Unit fu; for (int i = 0; S.next(i, fu); ++i) p4_fixup(args, fu.pm); asm volatile("s_waitcnt vmcnt(0)" ::: "memory"); __syncthreads(); }
        pg8::EpiRes<1, 0, 2> E{args.x, nullptr, MOD0 + 2048, 6144, args.norm_gain + 1024, MOD0 + 4096, 6144, A1, nullptr, nullptr, 0, nullptr, SS1, nullptr, nullptr, 0, lds};
        pg8::gemm_phase(lds, g, S, E);
    }
    LSEAM(4);
    if (IN(5)) {
        pg8::Gemm g{A1, A1, 1 << 30, (const bf16_t*)(ws + WS_WM1), M_TOK, FF, DM, (size_t)SEQ * DM * 2}; pg8::StaticOrder S; S.init(M_TOK, FF, G, cid);
        pg8::EpiMlp1 E{HB, (const float*)(ws + WS_BM1L0), SS1};
        pg8::gemm_phase(lds, g, S, E);
    }
    LSEAM(5);
    if (IN(6)) {
        pg8::Gemm g{HB, HB, 1 << 30, (const bf16_t*)(ws + WS_WM2), M_TOK, DM, FF, (size_t)SEQ * FF * 2}; pg8::StaticOrder S; S.init(M_TOK, DM, G, cid);
        pg8::EpiRes<2, 2, 2> E{A1, nullptr, MOD0 + 5120, 6144, args.kv_norm_gain, MODKV + 1024, 2048, A1, args.norm_gain + 2048, MOD1 + 1024, 6144, A2, SS2, args.norm_gain + 1024, MOD0 + 4096, 6144, lds};
        pg8::gemm_phase(lds, g, S, E);
    }
    LSEAM(6);
    if (IN(7)) {
        pg8::Gemm g{A1, A2, 6, (const bf16_t*)(ws + WS_WKVQ), M_TOK, NKVQ, DM, (size_t)SEQ * DM * 2}; pg8::StaticOrder S; S.init(M_TOK, NKVQ, G, cid);
        pg8::EpiKVQ E{ws + WS_R, (const float*)(ws + WS_BKVQ), SS2, args.k_gain, args.q_gain};
        pg8::gemm_phase(lds, g, S, E);
    }
    LSEAM(7);
    if (IN(8)) { for (int v = vcu; v < 256; v += G) { const int rk = v & 31; p8_unit(args, ((rk >> 4) << 7) | ((((v >> 5) << 2) | ((rk >> 2) & 3)) << 2) | (rk & 3), lds); } __syncthreads(); }
    LSEAM(8);
    if (IN(9)) {
        for (int v = vcu; v < 256; v += G) { const int bgp = v >> 3, s = v & 7;
            for (int i = 0; i < 4; ++i) { const int qb = (i == 0) ? s : (i == 1) ? 15 - s : (i == 2) ? 16 + s : 31 - s;
                att::attn_unit(bgp >> 2, bgp & 3, qb, ws + WS_R + (size_t)(bgp >> 2) * SLAB, lds); } }
    }
    LSEAM(9);
    if (IN(10)) {
        pg8::Gemm g{(const bf16_t*)(ws + WS_R + SO_O), (const bf16_t*)(ws + WS_R + SO_O), 1 << 30, (const bf16_t*)(ws + WS_WO), M_TOK, DM, DM, SLAB}; pg8::StaticOrder S; S.init(M_TOK, DM, G, cid);
        pg8::EpiRes<1, 2, 2> E{A2, nullptr, MOD1 + 2048, 6144, args.norm_gain + 3072, MOD1 + 4096, 6144, A1, nullptr, nullptr, 0, nullptr, SS3, args.norm_gain + 2048, MOD1 + 1024, 6144, lds};
        pg8::gemm_phase(lds, g, S, E);
    }
    LSEAM(10);
    if (IN(11)) {
        pg8::Gemm g{A1, A1, 1 << 30, (const bf16_t*)(ws + WS_WM1) + (size_t)FF * DM, M_TOK, FF, DM, (size_t)SEQ * DM * 2}; pg8::StaticOrder S; S.init(M_TOK, FF, G, cid);
        pg8::EpiMlp1 E{HB, (const float*)(ws + WS_BM1L1), SS3};
        pg8::gemm_phase(lds, g, S, E);
    }
    LSEAM(11);
    if (IN(12)) {
        pg8::Gemm g{HB, HB, 1 << 30, (const bf16_t*)(ws + WS_WM2) + (size_t)DM * FF, M_TOK, DM, FF, (size_t)SEQ * FF * 2}; pg8::StaticOrder S; S.init(M_TOK, DM, G, cid);
        pg8::EpiRes<0, 2, 0> E{A1, args.out, MOD1 + 5120, 6144, nullptr, nullptr, 0, nullptr, nullptr, nullptr, 0, nullptr, nullptr, args.norm_gain + 3072, MOD1 + 4096, 6144, lds};
        pg8::gemm_phase(lds, g, S, E);
    }
#undef IN
#undef SEAM
}

extern "C" void kernel_launch(void* const* d_in, const int* in_sizes, int n_in, void* d_out, int out_size, void* d_ws, size_t ws_size, hipStream_t stream) {
    static int grid = 0;
    if (grid == 0) {
        if (n_in != 21 || in_sizes[0] != M_TOK * DM || out_size != M_TOK * DM || ws_size < WS_END) { fprintf(stderr, "kernel_launch: unexpected shapes (n_in %d, in0 %d, out %d, ws %zu); nothing launched\n", n_in, n_in > 0 ? in_sizes[0] : -1, out_size, ws_size); grid = -1; return; }
        int dev = 0, cus = 0, per_cu = 0;
        if (hipGetDevice(&dev) != hipSuccess || hipDeviceGetAttribute(&cus, hipDeviceAttributeMultiprocessorCount, dev) != hipSuccess) { grid = -1; return; }
        if (hipFuncSetAttribute((const void*)yoco_fwd, hipFuncAttributeMaxDynamicSharedMemorySize, LDS_BYTES) != hipSuccess) { fprintf(stderr, "kernel_launch: hipFuncSetAttribute failed\n"); grid = -1; return; }
        if (hipOccupancyMaxActiveBlocksPerMultiprocessor(&per_cu, (const void*)yoco_fwd, NWAVES * 64, LDS_BYTES) != hipSuccess || per_cu < 1) { fprintf(stderr, "kernel_launch: occupancy query says %d blocks per CU\n", per_cu); per_cu = 1; }
        (void)hipGetLastError();
        grid = cus;
        if (grid != 256) { fprintf(stderr, "kernel_launch: this build deals the w_a_in tiles to exactly 256 workgroups (device has %d CUs); nothing launched\n", cus); grid = -1; return; }
    }
    if (grid < 0) return;
    (void)hipMemsetAsync((char*)d_ws + WS_ZERO, 0, ZERO_BYTES, stream);
    Args a{};
    a.x = (const float*)d_in[0]; a.c = (const float*)d_in[1]; a.norm_gain = (const float*)d_in[2]; a.w_ada = (const float*)d_in[3]; a.b_ada = (const float*)d_in[4];
    a.w_a_in = (const float*)d_in[5]; a.conv_w = (const float*)d_in[6]; a.w_a_out = (const float*)d_in[7]; a.w_qg = (const float*)d_in[8]; a.q_gain = (const float*)d_in[9];
    a.w_o = (const float*)d_in[10]; a.kv_norm_gain = (const float*)d_in[11]; a.w_ada_kv = (const float*)d_in[12]; a.b_ada_kv = (const float*)d_in[13]; a.w_kv = (const float*)d_in[14];
    a.k_gain = (const float*)d_in[15]; a.cmp_pe = (const float*)d_in[16]; a.cmp_w1 = (const float*)d_in[17]; a.cmp_w2 = (const float*)d_in[18]; a.w_mlp1 = (const float*)d_in[19]; a.w_mlp2 = (const float*)d_in[20];
    a.out = (float*)d_out; a.ws = (unsigned char*)d_ws;
#if MK_N_LAUNCHES == 1
    a.ph_lo = 0; a.ph_hi = N_PHASES;
    void* kargs[] = {&a};
    hipError_t e = hipLaunchCooperativeKernel((const void*)yoco_fwd, dim3(grid), dim3(NWAVES * 64), kargs, LDS_BYTES, stream);
    if (e != hipSuccess) fprintf(stderr, "kernel_launch: cooperative launch failed: %s (grid %d)\n", hipGetErrorString(e), grid);
#else
    for (int p = 0; p < N_PHASES; ++p) { a.ph_lo = p; a.ph_hi = p + 1; hipLaunchKernelGGL(yoco_fwd, dim3(grid), dim3(NWAVES * 64), LDS_BYTES, stream, a); }
#endif
}
```

```cpp
#include <hip/hip_runtime.h>
#include <cstdio>
#include <cstdint>
#include <cmath>

#ifndef MK_N_LAUNCHES
#define MK_N_LAUNCHES 1
#endif
constexpr int N_PHASES = 13;

#define LAS __attribute__((address_space(3)))
typedef unsigned short bf16_t;
typedef short bf16x8 __attribute__((ext_vector_type(8)));
typedef short s16x4 __attribute__((ext_vector_type(4)));
typedef float f32x2 __attribute__((ext_vector_type(2)));
typedef float f32x4 __attribute__((ext_vector_type(4)));
typedef float f32x16 __attribute__((ext_vector_type(16)));
typedef unsigned u32x4 __attribute__((ext_vector_type(4)));
typedef unsigned u32x2 __attribute__((ext_vector_type(2)));
typedef __bf16 bf16x2_t __attribute__((ext_vector_type(2)));

constexpr int BATCH = 8, SEQ = 2048, DM = 1024, FF = 4096, M_TOK = BATCH * SEQ;
constexpr int NKVQ = 2816;
constexpr float EPS = 1e-6f;
constexpr float QSCALE = 0.125f * 1.4426950408889634f;

constexpr size_t MiB = 1u << 20;
constexpr size_t WS_ZERO = 0, ZERO_BYTES = 1 * MiB;
constexpr size_t WS_MOD0 = 0, WS_MOD1 = 196608, WS_MODKV = 393216;
constexpr size_t WS_SS1 = 524288, WS_SS2 = 589824, WS_SS3 = 655360;
constexpr size_t WS_BAR = 786432;
constexpr size_t WS_BM1L0 = 1 * MiB, WS_BM1L1 = WS_BM1L0 + 131072, WS_BKVQ = WS_BM1L1 + 131072, WS_PEB = WS_BKVQ + 131072, WS_WC2 = WS_PEB + 4096;
constexpr size_t WS_WAIN = 2 * MiB, WS_WAOUT = 8 * MiB, WS_WM1 = 10 * MiB  , WS_WM2 = 26 * MiB  , WS_WKVQ = 42 * MiB, WS_WO = 48 * MiB, WS_WC1 = 50 * MiB;
constexpr size_t WS_R = 56 * MiB;
constexpr size_t SLAB = 16 * MiB;
constexpr size_t SO_GB = 0, SO_V = 4 * MiB, SO_Y = 8 * MiB;
constexpr size_t WS_H = WS_R;
constexpr size_t SO_Q = 0, SO_KV = 4 * MiB  , SO_O = 10 * MiB, SO_GATES = 14 * MiB  , SO_KC = 14 * MiB + 512 * 1024  , SO_VC = SO_KC + 65536;
constexpr size_t WS_A1 = 184 * MiB, WS_A2 = 216 * MiB, WS_END = 248 * MiB;

constexpr int LDS_BYTES = 147456;
constexpr int NWAVES = 8;

__device__ __forceinline__ unsigned cvtpk(float lo, float hi) { f32x2 v = {lo, hi}; bf16x2_t b = __builtin_convertvector(v, bf16x2_t); return __builtin_bit_cast(unsigned, b); }
__device__ __forceinline__ float bf_lo(unsigned u) { return __builtin_bit_cast(float, u << 16); }
__device__ __forceinline__ float bf_hi(unsigned u) { return __builtin_bit_cast(float, u & 0xffff0000u); }
__device__ __forceinline__ float wave_sum(float v) {
#pragma unroll
    for (int o = 1; o < 64; o <<= 1) v += __shfl_xor(v, o);
    return v;
}
#define LDS_WAIT() asm volatile("s_waitcnt lgkmcnt(0)" ::: "memory")
#define LAUNDER(x) asm volatile("" : "+v"(x))

namespace pg8 {
constexpr int BM = 256, BK = 64, HALF = 128, HTB = HALF * BK * 2, STAGE_BYTES = 8 * HTB, NXCD = 8, WGM = 8, VEC_LDS = 131072;
__host__ __device__ __forceinline__ int lds_byte(int r, int c) { const int st = (r >> 4) * 2 + (c >> 5), rr = r & 15, cc = c & 31, ob = rr * 64 + cc * 2; return st * 1024 + (ob ^ (((ob >> 9) & 1) << 5)); }
__host__ __device__ __forceinline__ void stage_rc(int b, int& R, int& C) { const int st = b / 1024, sb = b % 1024, swz = sb ^ (((sb >> 9) & 1) << 5); R = (st >> 1) * 16 + swz / 64; C = (st & 1) * 32 + (swz % 64) / 2; }
__host__ __device__ __forceinline__ int perm32(int rho) { const int n = rho >> 4, i = rho & 15; return 8 * (i >> 2) + 4 * n + (i & 3); }

struct Unit { int pm, pn; };
struct Gemm { const bf16_t* A; const bf16_t* A2; int pn_split; const bf16_t* Bt; int M, N, K; size_t abatch; };

struct StaticOrder {
    int nM, nN, nwg, G, c, ain;
    __device__ __forceinline__ void init(int M, int N, int G_, int c_) { nM = M / BM; nN = N / BM; nwg = nM * nN; G = G_; c = c_; ain = 0; }
    __device__ __forceinline__ void init_ain(int G_, int c_) { init(M_TOK, 3072, G_, c_); ain = 1; }
    __device__ __forceinline__ bool next(int i, Unit& u) const {
        if (ain) { if (i >= 3) return false; const int x = c & 7, rk = c >> 3, p = rk >> 3; u.pm = 8 * x + (rk & 7); u.pn = (i == 2) ? p : 4 + 2 * p + i; return true; }
        const long L = (long)i * G + c; if (L >= nwg) return false;
        int wgid = (int)L; { const int q = nwg / NXCD, r = nwg % NXCD, xcd = wgid % NXCD, off = wgid / NXCD; wgid = (xcd < r ? xcd * (q + 1) : r * (q + 1) + (xcd - r) * q) + off; }
        const int nig = WGM * nN, gid = wgid / nig, fm = gid * WGM, gsz = (nM - fm) < WGM ? (nM - fm) : WGM;
        u.pm = fm + ((wgid % nig) % gsz); u.pn = (wgid % nig) / gsz; return true;
    }
};

template <class Epi>
__device__ __forceinline__ void gemm_phase(LAS unsigned char* lds, const Gemm g, const StaticOrder& S, const Epi& E) {
    const int tid = threadIdx.x, wid = __builtin_amdgcn_readfirstlane(tid >> 6), lane = tid & 63, wr = wid >> 2, wc = wid & 3, fr = lane & 15, fq = lane >> 4;
    const int K = g.K, nt = K / BK;
    unsigned voffA[2], voffB[2];
#pragma unroll
    for (int i = 0; i < 2; ++i) { int R, C; stage_rc(tid * 16 + i * 8192, R, C); const int Rb = Epi::PERM ? ((R & ~31) + perm32(R & 31)) : R;
        voffA[i] = (unsigned)(R * K + C) * 2u; voffB[i] = (unsigned)(Rb * K + C) * 2u; }
    const size_t kstep = (size_t)(BK * 2);
    const size_t hstep = (size_t)HALF * K * 2;
    const size_t tstep = 2 * hstep;
    const unsigned ldsw = (unsigned)wid * 1024u;
    const int aoff = lds_byte(wr * 64 + fr, fq * 8), boff = lds_byte(wc * 32 + fr, fq * 8);
#define PG8_SA(b, h) (((b) * 2 + (h)) * HTB)
#define PG8_SB(b, h) ((4 + (b) * 2 + (h)) * HTB)
#define PG8_STAGE(bufoff, gbase, voff) do { _Pragma("unroll") for (int _i = 0; _i < 2; ++_i) \
        __builtin_amdgcn_global_load_lds((const unsigned*)((const char*)(gbase) + (voff)[_i]), (LAS unsigned*)(lds + (bufoff) + ldsw + _i * 8192), 16, 0, 0); } while (0)
#define PG8_LDA(dst, b, h) do { _Pragma("unroll") for (int m = 0; m < 4; ++m) _Pragma("unroll") for (int k = 0; k < 2; ++k) dst[m][k] = *(const LAS bf16x8*)(lds + PG8_SA(b, h) + aoff + m * 2048 + k * 1024); } while (0)
#define PG8_LDB(dst, b, h) do { _Pragma("unroll") for (int n = 0; n < 2; ++n) _Pragma("unroll") for (int k = 0; k < 2; ++k) dst[n][k] = *(const LAS bf16x8*)(lds + PG8_SB(b, h) + boff + n * 2048 + k * 1024); } while (0)
#define PG8_MMA(ai, bj, At, Bt) do { __builtin_amdgcn_s_setprio(1); _Pragma("unroll") for (int m = 0; m < 4; ++m) _Pragma("unroll") for (int n = 0; n < 2; ++n) _Pragma("unroll") for (int k = 0; k < 2; ++k) \
        acc[ai][bj][m][n] = __builtin_amdgcn_mfma_f32_16x16x32_bf16(Bt[n][k], At[m][k], acc[ai][bj][m][n], 0, 0, 0); __builtin_amdgcn_s_setprio(0); } while (0)
#define PG8_WAIT_V(n) asm volatile("s_waitcnt vmcnt(" #n ")" ::: "memory")
#define PG8_WAIT_L(n) asm volatile("s_waitcnt lgkmcnt(" #n ")" ::: "memory")
#define PG8_BAR __builtin_amdgcn_s_barrier()
#define PG8_SCHED __builtin_amdgcn_sched_barrier(0)
#define PG8_ABASE(u) ((const char*)((u).pn < g.pn_split ? g.A : g.A2) + (size_t)((u).pm >> 3) * g.abatch + (size_t)((u).pm & 7) * tstep)
    Unit cur, nxt; int ui = 0;
    if (!S.next(0, cur)) return;
    f32x4 acc[2][2][4][2];
#pragma unroll
    for (int a = 0; a < 2; ++a)
#pragma unroll
        for (int b = 0; b < 2; ++b)
#pragma unroll
            for (int m = 0; m < 4; ++m)
#pragma unroll
                for (int n = 0; n < 2; ++n) acc[a][b][m][n] = (f32x4){0.f, 0.f, 0.f, 0.f};
    bf16x8 At[4][2], B0[2][2], B1[2][2];
    const char* cA = PG8_ABASE(cur); const char* cB = (const char*)g.Bt + (size_t)cur.pn * tstep;
#define PG8_VEC(u, slot) do { if (Epi::HAS_VEC && wid == 0) { \
        __builtin_amdgcn_global_load_lds((const unsigned*)(E.vec_rows(u) + 4 * lane), (LAS unsigned*)(lds + VEC_LDS + (slot) * 2048), 16, 0, 0); \
        __builtin_amdgcn_global_load_lds((const unsigned*)(E.vec_cols(u) + 4 * lane), (LAS unsigned*)(lds + VEC_LDS + (slot) * 2048 + 1024), 16, 0, 0); } } while (0)
    PG8_VEC(cur, 0);
    PG8_STAGE(PG8_SB(0, 0), cB, voffB); PG8_STAGE(PG8_SB(0, 1), cB + hstep, voffB); PG8_STAGE(PG8_SA(0, 0), cA, voffA); PG8_STAGE(PG8_SA(0, 1), cA + hstep, voffA);
    if (wr == 1) PG8_BAR;
    PG8_WAIT_V(2); PG8_BAR;
    PG8_STAGE(PG8_SB(1, 0), cB + kstep, voffB); PG8_STAGE(PG8_SA(1, 0), cA + kstep, voffA); PG8_STAGE(PG8_SB(1, 1), cB + hstep + kstep, voffB);
    PG8_WAIT_V(6); PG8_BAR;
    for (;;) {
        const bool has_next = S.next(ui + 1, nxt);
        const char* nA = has_next ? PG8_ABASE(nxt) : cA; const char* nB = has_next ? (const char*)g.Bt + (size_t)nxt.pn * tstep : cB;
        for (int t = 0; t < nt; t += 2) {
            const bool last = (t == nt - 2);
            const char* a1 = cA + (size_t)(t + 1) * kstep;
            const char* a2 = last ? nA : cA + (size_t)(t + 2) * kstep; const char* b2 = last ? nB : cB + (size_t)(t + 2) * kstep;
            const char* a3 = a2 + kstep; const char* b3 = b2 + kstep;
            PG8_LDB(B0, 0, 0); PG8_LDB(B1, 0, 1); PG8_SCHED; PG8_LDA(At, 0, 0); PG8_STAGE(PG8_SA(1, 1), a1 + hstep, voffA);
            PG8_WAIT_V(8); PG8_WAIT_L(0); PG8_BAR; PG8_MMA(0, 0, At, B0); PG8_MMA(0, 1, At, B1); PG8_BAR; PG8_SCHED;
            PG8_LDA(At, 0, 1); PG8_STAGE(PG8_SB(0, 0), b2, voffB); PG8_STAGE(PG8_SB(0, 1), b2 + hstep, voffB); PG8_STAGE(PG8_SA(0, 0), a2, voffA);
            PG8_WAIT_V(8); PG8_WAIT_L(0); PG8_BAR; PG8_MMA(1, 0, At, B0); PG8_MMA(1, 1, At, B1); PG8_BAR; PG8_SCHED;
            PG8_LDB(B0, 1, 0); PG8_LDB(B1, 1, 1); PG8_SCHED; PG8_LDA(At, 1, 0); PG8_STAGE(PG8_SA(0, 1), a2 + hstep, voffA);
            PG8_WAIT_V(8); PG8_WAIT_L(0); PG8_BAR; PG8_MMA(0, 0, At, B0); PG8_MMA(0, 1, At, B1); PG8_BAR; PG8_SCHED;
            PG8_LDA(At, 1, 1); PG8_STAGE(PG8_SB(1, 0), b3, voffB); PG8_STAGE(PG8_SB(1, 1), b3 + hstep, voffB); PG8_STAGE(PG8_SA(1, 0), a3, voffA);
            PG8_WAIT_V(8); PG8_WAIT_L(0); PG8_BAR; PG8_MMA(1, 0, At, B0); PG8_MMA(1, 1, At, B1); PG8_BAR; PG8_SCHED;
        }
        if (wr == 0) PG8_BAR;
        E(acc, cur, wr, wc, fr, fq, ui & 1);
        if (!has_next) break;
        PG8_VEC(nxt, (ui + 1) & 1);
#pragma unroll
        for (int a = 0; a < 2; ++a)
#pragma unroll
            for (int b = 0; b < 2; ++b)
#pragma unroll
                for (int m = 0; m < 4; ++m)
#pragma unroll
                    for (int n = 0; n < 2; ++n) acc[a][b][m][n] = (f32x4){0.f, 0.f, 0.f, 0.f};
        cur = nxt; cA = nA; cB = nB; ++ui;
        if (wr == 1) PG8_BAR;
    }
    PG8_WAIT_V(0);
    PG8_BAR;
#undef PG8_SA
#undef PG8_SB
#undef PG8_STAGE
#undef PG8_LDA
#undef PG8_LDB
#undef PG8_MMA
#undef PG8_WAIT_V
#undef PG8_WAIT_L
#undef PG8_BAR
#undef PG8_SCHED
#undef PG8_ABASE
#undef PG8_VEC
}

typedef f32x4 Acc[2][2][4][2];

struct EpiAin {
    static constexpr bool PERM = true, HAS_VEC = false;
    __device__ __forceinline__ const float* vec_rows(const Unit&) const { return nullptr; } __device__ __forceinline__ const float* vec_cols(const Unit&) const { return nullptr; }
    static constexpr bool HAS_PRE = false; struct Pre {};
    unsigned char* slab0;
    const float* conv_w;
    __device__ __forceinline__ void operator()(const Acc& acc, const Unit& u, int wr, int wc, int fr, int fq, int vslot) const {
        const int rip0 = wr * 64 + fr;
        const int row0 = (u.pm & 7) * BM + rip0;
        unsigned char* slab = slab0 + (size_t)(u.pm >> 3) * SLAB;
        bf16_t* V = (bf16_t*)(slab + SO_V);
        if (u.pn < 4) {
            bf16_t* Y = (bf16_t*)(slab + SO_Y); bf16_t* GBH = (bf16_t*)(slab + SO_GB) + (size_t)(u.pm & 7) * 2 * DM;
            const int col0 = u.pn * BM + wc * 32 + 8 * fq;
#pragma unroll
            for (int bj = 0; bj < 2; ++bj) { const int cw = col0 + bj * HALF;
                f32x4 w0[2], w1[2], w2[2];
#pragma unroll
                for (int n = 0; n < 2; ++n) { w0[n] = *(const f32x4*)(conv_w + cw + 4 * n); w1[n] = *(const f32x4*)(conv_w + DM + cw + 4 * n); w2[n] = *(const f32x4*)(conv_w + 2 * DM + cw + 4 * n); }
#pragma unroll
                for (int ai = 0; ai < 2; ++ai)
#pragma unroll
                    for (int mp = 0; mp < 2; ++mp) {
                        u32x4 vr[2][3];
#pragma unroll
                        for (int mm = 0; mm < 2; ++mm) { const int rip = rip0 + ai * HALF + (2 * mp + mm) * 16; const bf16_t* vp = V + (size_t)(row0 + ai * HALF + (2 * mp + mm) * 16) * DM + cw;
#pragma unroll
                            for (int k = 0; k < 3; ++k) vr[mm][k] = (rip >= 2) ? *(const u32x4*)(vp - (size_t)k * DM) : (u32x4){0u, 0u, 0u, 0u}; }
                        asm volatile("" : "+v"(vr[0][0]), "+v"(vr[0][1]), "+v"(vr[0][2]), "+v"(vr[1][0]), "+v"(vr[1][1]), "+v"(vr[1][2]));
#pragma unroll
                        for (int mm = 0; mm < 2; ++mm) { const int m = 2 * mp + mm; const int rip = rip0 + ai * HALF + m * 16;
                            const f32x4 g0 = acc[ai][bj][m][0], g1 = acc[ai][bj][m][1];
                            u32x4 w;
                            if (rip >= 2) {
                                const u32x4 a = vr[mm][0], b1 = vr[mm][1], b2 = vr[mm][2];
                                const f32x4 v0a = (f32x4){bf_lo(a.x), bf_hi(a.x), bf_lo(a.y), bf_hi(a.y)}, v0b = (f32x4){bf_lo(a.z), bf_hi(a.z), bf_lo(a.w), bf_hi(a.w)};
                                const f32x4 v1a = (f32x4){bf_lo(b1.x), bf_hi(b1.x), bf_lo(b1.y), bf_hi(b1.y)}, v1b = (f32x4){bf_lo(b1.z), bf_hi(b1.z), bf_lo(b1.w), bf_hi(b1.w)};
                                const f32x4 v2a = (f32x4){bf_lo(b2.x), bf_hi(b2.x), bf_lo(b2.y), bf_hi(b2.y)}, v2b = (f32x4){bf_lo(b2.z), bf_hi(b2.z), bf_lo(b2.w), bf_hi(b2.w)};
                                const f32x4 ya = g0 * (w2[0] * v0a + w1[0] * v1a + w0[0] * v2a), yb = g1 * (w2[1] * v0b + w1[1] * v1b + w0[1] * v2b);
                                w.x = cvtpk(ya[0], ya[1]); w.y = cvtpk(ya[2], ya[3]); w.z = cvtpk(yb[0], yb[1]); w.w = cvtpk(yb[2], yb[3]);
                                *(u32x4*)(Y + (size_t)(row0 + ai * HALF + m * 16) * DM + cw) = w;
                            } else {
                                w.x = cvtpk(g0[0], g0[1]); w.y = cvtpk(g0[2], g0[3]); w.z = cvtpk(g1[0], g1[1]); w.w = cvtpk(g1[2], g1[3]);
                                *(u32x4*)(GBH + (size_t)rip * DM + cw) = w;
                            } } }
            }
        } else {
            const int col0 = (u.pn - 4) * HALF + wc * 32 + 8 * fq;
#pragma unroll
            for (int ai = 0; ai < 2; ++ai)
#pragma unroll
                for (int m = 0; m < 4; ++m) { bf16_t* rowp = V + (size_t)(row0 + ai * HALF + m * 16) * DM + col0;
                    const f32x4 v0 = acc[ai][0][m][0] * acc[ai][1][m][0], v1 = acc[ai][0][m][1] * acc[ai][1][m][1];
                    u32x4 w; w.x = cvtpk(v0[0], v0[1]); w.y = cvtpk(v0[2], v0[3]); w.z = cvtpk(v1[0], v1[1]); w.w = cvtpk(v1[2], v1[3]);
                    *(u32x4*)rowp = w; }
        }
    }
};

constexpr int RES_AUX = 2;
template <int NA, int INM, int OUTM> struct EpiRes {
    static constexpr bool PERM = true, HAS_VEC = false;
    __device__ __forceinline__ const float* vec_rows(const Unit&) const { return nullptr; } __device__ __forceinline__ const float* vec_cols(const Unit&) const { return nullptr; }
    const void* xin; void* xout; const float* gate; int gate_stride;
    const float* gain0; const float* sc0; int sc0_stride; bf16_t* A0;
    const float* gain1; const float* sc1; int sc1_stride; bf16_t* A1;
    float* sumsq;
    const float* gain_in; const float* sc_in; int sc_in_stride;
    LAS unsigned char* lds = nullptr;
    __device__ __forceinline__ void operator()(const Acc& acc, const Unit& u, int wr, int wc, int fr, int fq, int vslot) const {
        constexpr bool IN16 = INM != 0;
        const int b = u.pm >> 3;
        const int row0 = u.pm * BM + wr * 64 + fr, col0 = u.pn * BM + wc * 32 + 8 * fq;
        const size_t tbase = (size_t)u.pm * BM * DM + (size_t)u.pn * BM;
        const unsigned loff = (unsigned)((wr * 64 + fr) * DM + wc * 32 + 8 * fq);
        f32x4 gv[2][2], a0[2][2], a1[2][2], ia[2][2];
        constexpr int NH = IN16 ? 1 : 2, ROWB = IN16 ? 512 : 1024;
        const int lane_ = threadIdx.x & 63, wid_ = __builtin_amdgcn_readfirstlane(threadIdx.x >> 6);
        asm volatile("s_waitcnt vmcnt(0)\n\ts_barrier" ::: "memory");
#pragma unroll
        for (int hh = 0; hh < NH; ++hh) {
            if (hh > 0) asm volatile("s_waitcnt lgkmcnt(0)\n\ts_barrier" ::: "memory");
            if constexpr (IN16) {
                const bf16_t* gsrc = (const bf16_t*)xin + tbase + (size_t)(32 * wid_) * DM;
                const int rl_ = lane_ >> 5, cp_ = lane_ & 31;
                unsigned vo_[4];
#pragma unroll
                for (int k = 0; k < 4; ++k) vo_[k] = (unsigned)(rl_ * DM + ((cp_ ^ (((2 * k + rl_) & 7) << 2)) << 3));
#pragma unroll
                for (int i = 0; i < 16; ++i)
                    __builtin_amdgcn_global_load_lds((const unsigned*)((gsrc + (size_t)(2 * i) * DM) + vo_[i & 3]), (LAS unsigned*)(lds + (32 * wid_ + 2 * i) * 512), 16, 0, RES_AUX);
            } else {
                const float* gsrc = (const float*)xin + tbase + (size_t)(hh * HALF + 16 * wid_) * DM;
#pragma unroll 2
                for (int i = 0; i < 16; ++i)
                    __builtin_amdgcn_global_load_lds((const unsigned*)((gsrc + (size_t)i * DM) + (unsigned)((lane_ ^ i) << 2)), (LAS unsigned*)(lds + (16 * wid_ + i) * 1024), 16, 0, RES_AUX);
            }
            if (hh == 0) {
#pragma unroll
                for (int bj = 0; bj < 2; ++bj)
#pragma unroll
                    for (int n = 0; n < 2; ++n) { const int c = col0 + bj * HALF + 4 * n;
                        gv[bj][n] = *(const f32x4*)(gate + (size_t)b * gate_stride + c);
                        if (NA >= 1) a0[bj][n] = *(const f32x4*)(gain0 + c) * (*(const f32x4*)(sc0 + (size_t)b * sc0_stride + c) + 1.0f);
                        if (NA >= 2) a1[bj][n] = *(const f32x4*)(gain1 + c) * (*(const f32x4*)(sc1 + (size_t)b * sc1_stride + c) + 1.0f);
                        if (INM == 2) { const f32x4 t = *(const f32x4*)(gain_in + c) * (*(const f32x4*)(sc_in + (size_t)b * sc_in_stride + c) + 1.0f); ia[bj][n] = (f32x4){1.0f / t[0], 1.0f / t[1], 1.0f / t[2], 1.0f / t[3]}; } }
            }
            asm volatile("s_waitcnt vmcnt(0)\n\ts_barrier" ::: "memory");
            const LAS unsigned char* ldr = lds + (wr * 64 + fr) * ROWB;
#pragma unroll
            for (int qq = 0; qq < 8 / NH; ++qq) { const int q = hh * (8 / NH) + qq, ai = q >> 2, m = q & 3; const int row = row0 + ai * HALF + m * 16; const size_t off = tbase + (size_t)((ai * HALF + m * 16) * DM); float ss = 0.f;
#pragma unroll
                for (int bj = 0; bj < 2; ++bj) { const size_t o = off + bj * HALF;
                    f32x4 x0, x1;
                    if constexpr (IN16) { const u32x4 w = *(const LAS u32x4*)(ldr + (ai * HALF + m * 16) * 512 + (((16 * bj + 4 * wc + fq) ^ ((fr & 7) << 2)) << 4));
                        x0 = (f32x4){bf_lo(w.x), bf_hi(w.x), bf_lo(w.y), bf_hi(w.y)}; x1 = (f32x4){bf_lo(w.z), bf_hi(w.z), bf_lo(w.w), bf_hi(w.w)}; }
                    else { const int c0_ = 32 * bj + 8 * wc + 2 * fq; x0 = *(const LAS f32x4*)(ldr + (m * 16) * 1024 + ((c0_ ^ fr) << 4)); x1 = *(const LAS f32x4*)(ldr + (m * 16) * 1024 + (((c0_ + 1) ^ fr) << 4)); }
                    if (INM == 2) { x0 = x0 * ia[bj][0]; x1 = x1 * ia[bj][1]; }
                    x0 = x0 + gv[bj][0] * acc[ai][bj][m][0]; x1 = x1 + gv[bj][1] * acc[ai][bj][m][1];
                    if (OUTM == 0) {
                        f32x4 s0 = x0, s1 = x1;
#pragma unroll
                        for (int e = 0; e < 4; ++e) { auto rr = __builtin_amdgcn_permlane16_swap(__float_as_uint(s0[e]), __float_as_uint(s1[e]), false, false);
                            rr = __builtin_amdgcn_permlane32_swap(rr[0], rr[1], false, false); s0[e] = __uint_as_float(rr[0]); s1[e] = __uint_as_float(rr[1]); }
                        const int adj0 = -4 * fq, adj1 = 16 - 4 * fq;
                        *(f32x4*)(((float*)xout + o) + (loff + adj0)) = s0; *(f32x4*)(((float*)xout + o) + (loff + adj1)) = s1; }
                    if (NA >= 1) { ss += ((x0[0] * x0[0] + x0[1] * x0[1]) + (x0[2] * x0[2] + x0[3] * x0[3])) + ((x1[0] * x1[0] + x1[1] * x1[1]) + (x1[2] * x1[2] + x1[3] * x1[3]));
                        const f32x4 t0 = x0 * a0[bj][0], t1 = x1 * a0[bj][1]; u32x4 w; w.x = cvtpk(t0[0], t0[1]); w.y = cvtpk(t0[2], t0[3]); w.z = cvtpk(t1[0], t1[1]); w.w = cvtpk(t1[2], t1[3]); *(u32x4*)((A0 + o) + loff) = w; }
                    if (NA >= 2) { const f32x4 t0 = x0 * a1[bj][0], t1 = x1 * a1[bj][1]; u32x4 w; w.x = cvtpk(t0[0], t0[1]); w.y = cvtpk(t0[2], t0[3]); w.z = cvtpk(t1[0], t1[1]); w.w = cvtpk(t1[2], t1[3]); *(u32x4*)((A1 + o) + loff) = w; } }
                if (NA >= 1) { ss += __shfl_xor(ss, 16); ss += __shfl_xor(ss, 32); if (fq == 0) unsafeAtomicAdd(sumsq + row, ss); } }
        }
    }
};

struct EpiMlp1 {
    static constexpr bool PERM = true, HAS_VEC = true;
    bf16_t* H; const float* bias; const float* sumsq; LAS unsigned char* lds;
    __device__ __forceinline__ const float* vec_rows(const Unit& u) const { return sumsq + (size_t)u.pm * BM; }
    __device__ __forceinline__ const float* vec_cols(const Unit& u) const { return bias + (size_t)(u.pm >> 3) * FF + (size_t)u.pn * BM; }
    __device__ __forceinline__ void operator()(const Acc& acc, const Unit& u, int wr, int wc, int fr, int fq, int vslot) const {
        const int row0 = u.pm * BM + wr * 64 + fr, col0 = u.pn * BM + wc * 32 + 8 * fq;
        const LAS float* lv = (const LAS float*)(lds + VEC_LDS + vslot * 2048);
        f32x4 bv[2][2];
#pragma unroll
        for (int bj = 0; bj < 2; ++bj)
#pragma unroll
            for (int n = 0; n < 2; ++n) bv[bj][n] = *(const LAS f32x4*)(lv + 256 + bj * HALF + wc * 32 + 8 * fq + 4 * n);
        float ssv[8];
#pragma unroll
        for (int q = 0; q < 8; ++q) ssv[q] = lv[wr * 64 + fr + (q >> 2) * HALF + (q & 3) * 16];
        asm volatile("" : "+v"(ssv[0]), "+v"(ssv[1]), "+v"(ssv[2]), "+v"(ssv[3]), "+v"(ssv[4]), "+v"(ssv[5]), "+v"(ssv[6]), "+v"(ssv[7]));
#pragma unroll
        for (int ai = 0; ai < 2; ++ai)
#pragma unroll
            for (int m = 0; m < 4; ++m) { const int row = row0 + ai * HALF + m * 16; const float rs = rsqrtf(ssv[ai * 4 + m] * (1.0f / DM) + EPS);
                bf16_t* rowp = H + (size_t)row * FF + col0;
#pragma unroll
                for (int bj = 0; bj < 2; ++bj) { f32x4 v0 = acc[ai][bj][m][0] * rs + bv[bj][0], v1 = acc[ai][bj][m][1] * rs + bv[bj][1];
#pragma unroll
                    for (int e = 0; e < 4; ++e) { const float r0 = fmaxf(v0[e], 0.f), r1 = fmaxf(v1[e], 0.f); v0[e] = r0 * r0; v1[e] = r1 * r1; }
                    u32x4 w; w.x = cvtpk(v0[0], v0[1]); w.y = cvtpk(v0[2], v0[3]); w.z = cvtpk(v1[0], v1[1]); w.w = cvtpk(v1[2], v1[3]);
                    *(u32x4*)(rowp + bj * HALF) = w; } }
    }
};

struct EpiKVQ {
    static constexpr bool PERM = true, HAS_VEC = true;
    unsigned char* slab0; const float* bias; const float* sumsq; const float* k_gain; const float* q_gain; LAS unsigned char* lds;
    __device__ __forceinline__ const float* vec_rows(const Unit& u) const { return sumsq + (size_t)u.pm * BM; }
    __device__ __forceinline__ const float* vec_cols(const Unit& u) const { return bias + (size_t)(u.pm >> 3) * NKVQ + (size_t)u.pn * BM; }
    __device__ __forceinline__ void operator()(const Acc& acc, const Unit& u, int wr, int wc, int fr, int fq, int vslot) const {
        const int b = u.pm >> 3, pn = u.pn;
        const int row0 = u.pm * BM + wr * 64 + fr;
        unsigned char* slab = slab0 + (size_t)b * SLAB;
        bf16_t* KV = (bf16_t*)(slab + SO_KV); bf16_t* Q = (bf16_t*)(slab + SO_Q); float* gates = (float*)(slab + SO_GATES);
        const LAS float* lv = (const LAS float*)(lds + VEC_LDS + vslot * 2048);
        f32x4 bv[2][2];
#pragma unroll
        for (int bj = 0; bj < 2; ++bj)
#pragma unroll
            for (int n = 0; n < 2; ++n) bv[bj][n] = *(const LAS f32x4*)(lv + 256 + bj * HALF + wc * 32 + 8 * fq + 4 * n);
        float ssv[8];
#pragma unroll
        for (int q = 0; q < 8; ++q) ssv[q] = lv[wr * 64 + fr + (q >> 2) * HALF + (q & 3) * 16];
        asm volatile("" : "+v"(ssv[0]), "+v"(ssv[1]), "+v"(ssv[2]), "+v"(ssv[3]), "+v"(ssv[4]), "+v"(ssv[5]), "+v"(ssv[6]), "+v"(ssv[7]));
        if (pn == 10) {
            if (wc < 2) {
#pragma unroll
                for (int ai = 0; ai < 2; ++ai)
#pragma unroll
                    for (int m = 0; m < 4; ++m) { const int row = row0 + ai * HALF + m * 16; const float rs = rsqrtf(ssv[ai * 4 + m] * (1.0f / DM) + EPS);
#pragma unroll
                        for (int n = 0; n < 2; ++n) { const int c = wc * 32 + 8 * fq + 4 * n;
                            if (c < 48) { const f32x4 v = acc[ai][0][m][n] * rs + bv[0][n]; f32x4 o;
#pragma unroll
                                for (int e = 0; e < 4; ++e) o[e] = 1.0f / (1.0f + __expf(-v[e]));
                                *(f32x4*)(gates + (size_t)(row & (SEQ - 1)) * 48 + c) = o; } } }
            }
            return;
        }
        const bool is_q = pn >= 6;
        const bool do_norm = is_q || pn == 2 || pn == 4;
        f32x4 gn[2][2];
        { const float* gp = is_q ? q_gain : (k_gain + (pn == 2 ? 64 : 128)); const float sc = is_q ? QSCALE : 1.0f;
#pragma unroll
          for (int bj = 0; bj < 2; ++bj)
#pragma unroll
              for (int n = 0; n < 2; ++n) gn[bj][n] = do_norm ? *(const f32x4*)(gp + 32 * bj + 8 * fq + 4 * n) * sc : (f32x4){1.f, 1.f, 1.f, 1.f}; }
#pragma unroll
        for (int ai = 0; ai < 2; ++ai)
#pragma unroll
            for (int m = 0; m < 4; ++m) { const int row = row0 + ai * HALF + m * 16; const float rs = rsqrtf(ssv[ai * 4 + m] * (1.0f / DM) + EPS);
                f32x4 v[2][2]; float ss = 0.f;
#pragma unroll
                for (int bj = 0; bj < 2; ++bj)
#pragma unroll
                    for (int n = 0; n < 2; ++n) { v[bj][n] = acc[ai][bj][m][n] * rs + bv[bj][n]; const f32x4 t = v[bj][n]; ss += (t[0] * t[0] + t[1] * t[1]) + (t[2] * t[2] + t[3] * t[3]); }
                float hs = 1.0f;
                if (do_norm) { ss += __shfl_xor(ss, 16); ss += __shfl_xor(ss, 32); hs = rsqrtf(ss * (1.0f / 64.0f) + EPS); }
                bf16_t* rowp;
                if (is_q) rowp = Q + (size_t)(row & (SEQ - 1)) * DM + ((pn - 6) * 4 + wc) * 64 + 8 * fq;
                else rowp = KV + ((size_t)(pn * 4 + wc) * SEQ + (row & (SEQ - 1))) * 64 + 8 * fq;
#pragma unroll
                for (int bj = 0; bj < 2; ++bj) { const f32x4 v0 = v[bj][0] * hs * gn[bj][0], v1 = v[bj][1] * hs * gn[bj][1];
                    u32x4 w; w.x = cvtpk(v0[0], v0[1]); w.y = cvtpk(v0[2], v0[3]); w.z = cvtpk(v1[0], v1[1]); w.w = cvtpk(v1[2], v1[3]);
                    *(u32x4*)(rowp + 32 * bj) = w; } }
    }
};
}

namespace att {
constexpr int SLOTB = 8192;
constexpr int L_K = 0, L_V = 3 * SLOTB, L_WS = 6 * SLOTB, L_SEL = L_WS + 4096, L_NIB = L_SEL + 256, L_SC = L_NIB + 768, L_IA = L_SC + 8704, L_IB = L_IA + 33792, L_END = L_IB + 33792, L_OST = L_IA;
static_assert(L_END <= 131072 && (L_IA % 16) == 0 && (L_SC % 16) == 0, "attention LDS map");
#define SBAR() __builtin_amdgcn_sched_barrier(0)
#define ATT_WAIT_BAR(N) asm volatile("s_waitcnt vmcnt(" #N ") lgkmcnt(0)\n\ts_barrier" ::: "memory")
__device__ __forceinline__ int crow(int r, int hi) { return (r & 3) + 8 * (r >> 2) + 4 * hi; }
__device__ __forceinline__ void glds16(const void* gsrc, unsigned lds_dst) { unsigned keep;
    asm volatile("s_mov_b32 %0, m0\n\ts_mov_b32 m0, %2\n\ts_nop 0\n\tglobal_load_lds_dwordx4 %1, off\n\ts_mov_b32 m0, %0" : "=&s"(keep) : "v"(gsrc), "s"(lds_dst) : "memory"); }

__device__ __forceinline__ void qkt_c(f32x16& p0, f32x16& p1, const LAS unsigned char* Kslot, const bf16x8* qr, const f32x16& ci, int r32, int hi) {
    const LAS unsigned char* kb = Kslot + hi * 1024 + r32 * 16;
    bf16x8 kf[8];
#pragma unroll
    for (int i = 0; i < 8; ++i) kf[i] = *(const LAS bf16x8*)(kb + (i >> 1) * 2048 + (i & 1) * 512);
    asm volatile("" : "+v"(kf[0]), "+v"(kf[1]), "+v"(kf[2]), "+v"(kf[3]), "+v"(kf[4]), "+v"(kf[5]), "+v"(kf[6]), "+v"(kf[7]));
    p0 = __builtin_amdgcn_mfma_f32_32x32x16_bf16(kf[0], qr[0], ci, 0, 0, 0); p1 = __builtin_amdgcn_mfma_f32_32x32x16_bf16(kf[1], qr[0], ci, 0, 0, 0);
#pragma unroll
    for (int d0 = 1; d0 < 4; ++d0) { p0 = __builtin_amdgcn_mfma_f32_32x32x16_bf16(kf[2 * d0], qr[d0], p0, 0, 0, 0); p1 = __builtin_amdgcn_mfma_f32_32x32x16_bf16(kf[2 * d0 + 1], qr[d0], p1, 0, 0, 0); }
}
__device__ __forceinline__ void qkt(f32x16& p0, f32x16& p1, const LAS unsigned char* Kslot, const bf16x8* qr, int r32, int hi) {
    const LAS unsigned char* kb = Kslot + hi * 1024 + r32 * 16;
    bf16x8 kf[8];
#pragma unroll
    for (int i = 0; i < 8; ++i) kf[i] = *(const LAS bf16x8*)(kb + (i >> 1) * 2048 + (i & 1) * 512);
    asm volatile("" : "+v"(kf[0]), "+v"(kf[1]), "+v"(kf[2]), "+v"(kf[3]), "+v"(kf[4]), "+v"(kf[5]), "+v"(kf[6]), "+v"(kf[7]));
    const f32x16 z = f32x16{};
    p0 = __builtin_amdgcn_mfma_f32_32x32x16_bf16(kf[0], qr[0], z, 0, 0, 0); p1 = __builtin_amdgcn_mfma_f32_32x32x16_bf16(kf[1], qr[0], z, 0, 0, 0);
#pragma unroll
    for (int d0 = 1; d0 < 4; ++d0) { p0 = __builtin_amdgcn_mfma_f32_32x32x16_bf16(kf[2 * d0], qr[d0], p0, 0, 0, 0); p1 = __builtin_amdgcn_mfma_f32_32x32x16_bf16(kf[2 * d0 + 1], qr[d0], p1, 0, 0, 0); }
}
__device__ __forceinline__ void range_mask(f32x16& p0, f32x16& p1, int lo, int hv, int hi) {
    const int lo2 = lo - 4 * hi, hv2 = hv - 4 * hi;
#pragma unroll
    for (int r = 0; r < 16; ++r) { const int kc = (r & 3) + 8 * (r >> 2); if (kc < lo2 || kc > hv2) p0[r] = -INFINITY; if (kc + 32 < lo2 || kc + 32 > hv2) p1[r] = -INFINITY; }
}
__device__ __forceinline__ float max3f(float a, float b, float c) { float r; asm("v_max3_f32 %0, %1, %2, %3" : "=v"(r) : "v"(a), "v"(b), "v"(c)); return r; }
__device__ __forceinline__ float max2f(float a, float b) { float r; asm("v_max_f32_e32 %0, %1, %2" : "=v"(r) : "v"(a), "v"(b)); return r; }
__device__ __forceinline__ float rowmax(const f32x16& p0, const f32x16& p1) {
    float a = max3f(p0[0], p0[1], p1[0]), b = max3f(p0[2], p0[3], p1[1]); a = max3f(a, p1[2], p1[3]);
#pragma unroll
    for (int r = 4; r < 16; r += 4) { a = max3f(a, p0[r], p0[r + 1]); b = max3f(b, p0[r + 2], p0[r + 3]); a = max3f(a, p1[r], p1[r + 1]); b = max3f(b, p1[r + 2], p1[r + 3]); }
    const float m = max2f(a, b);
    auto rr = __builtin_amdgcn_permlane32_swap(__float_as_uint(m), __float_as_uint(m), false, false);
    return max2f(__uint_as_float(rr[0]), __uint_as_float(rr[1]));
}
__device__ __forceinline__ float halfsum(float a) {
    auto rr = __builtin_amdgcn_permlane32_swap(__float_as_uint(a), __float_as_uint(a), false, false);
    return __uint_as_float(rr[0]) + __uint_as_float(rr[1]);
}
__device__ __forceinline__ void pv(f32x16* o, int vb, bf16x8 pa0, bf16x8 pa1, bf16x8 pa2, bf16x8 pa3) {
    s16x4 lo[8], hi4[8];
#pragma unroll
    for (int q = 0; q < 8; ++q) {
        asm volatile("ds_read_b64_tr_b16 %0,%1 offset:%c2" : "=&v"(lo[q]) : "v"(vb), "i"((q >> 2) * 4096 + (q & 3) * 1024) : "memory");
        asm volatile("ds_read_b64_tr_b16 %0,%1 offset:%c2" : "=&v"(hi4[q]) : "v"(vb), "i"((q >> 2) * 4096 + (q & 3) * 1024 + 512) : "memory"); }
    asm volatile("s_waitcnt lgkmcnt(0)" ::: "memory"); SBAR();
#define PK(k) (bf16x8){lo[k][0], lo[k][1], lo[k][2], lo[k][3], hi4[k][0], hi4[k][1], hi4[k][2], hi4[k][3]}
    o[0] = __builtin_amdgcn_mfma_f32_32x32x16_bf16(pa0, PK(0), o[0], 0, 0, 0);
    o[1] = __builtin_amdgcn_mfma_f32_32x32x16_bf16(pa0, PK(4), o[1], 0, 0, 0);
    o[0] = __builtin_amdgcn_mfma_f32_32x32x16_bf16(pa1, PK(1), o[0], 0, 0, 0);
    o[1] = __builtin_amdgcn_mfma_f32_32x32x16_bf16(pa1, PK(5), o[1], 0, 0, 0);
    o[0] = __builtin_amdgcn_mfma_f32_32x32x16_bf16(pa2, PK(2), o[0], 0, 0, 0);
    o[1] = __builtin_amdgcn_mfma_f32_32x32x16_bf16(pa2, PK(6), o[1], 0, 0, 0);
    o[0] = __builtin_amdgcn_mfma_f32_32x32x16_bf16(pa3, PK(3), o[0], 0, 0, 0);
    o[1] = __builtin_amdgcn_mfma_f32_32x32x16_bf16(pa3, PK(7), o[1], 0, 0, 0);
#undef PK
}
__device__ __forceinline__ bf16x8 pack8(const f32x16& p, int base) {
    u32x4 w; w.x = cvtpk(p[base], p[base + 1]); w.y = cvtpk(p[base + 2], p[base + 3]); w.z = cvtpk(p[base + 4], p[base + 5]); w.w = cvtpk(p[base + 6], p[base + 7]);
    return __builtin_bit_cast(bf16x8, w);
}
__device__ __forceinline__ void row_bcast(float v, float (&out)[16], LAS float* wsf, int r32, int hi) {
    if (hi == 0) wsf[r32] = v;
#pragma unroll
    for (int i = 0; i < 4; ++i) { const f32x4 t = *(const LAS f32x4*)(wsf + 8 * i + 4 * hi); out[4 * i] = t[0]; out[4 * i + 1] = t[1]; out[4 * i + 2] = t[2]; out[4 * i + 3] = t[3]; }
}

struct Ctx {
    int lane, r32, hi, wid, ql, qb; unsigned lds0; LAS unsigned char* shm; LAS float* wsf; int koff, voff; unsigned kdst, vdst; int vb0;
};
__device__ __forceinline__ void dma_k(const Ctx& c, const bf16_t* base, int tile, int slot) { glds16(base + (size_t)tile * 4096 + c.koff, (unsigned)__builtin_amdgcn_readfirstlane(c.kdst + slot * SLOTB)); }
__device__ __forceinline__ void dma_v(const Ctx& c, const bf16_t* base, int tile, int slot) { glds16(base + (size_t)tile * 4096 + c.voff, (unsigned)__builtin_amdgcn_readfirstlane(c.vdst + slot * SLOTB)); }

constexpr float THR = 8.0f;
struct BrState { float mhat, l; f32x16 negm; f32x16 o[2]; };
__device__ __forceinline__ void br_reset(BrState& st) { st.mhat = 0.f; st.l = 0.f; st.negm = f32x16{}; st.o[0] = f32x16{}; st.o[1] = f32x16{}; }
__device__ __forceinline__ void stream_step(const Ctx& c, int slot, const bf16x8* qr, bool row_on, bool use_range, int lo, int hv, bool first, BrState& st) {
    f32x16 p0, p1;
    if (__any(!row_on)) { f32x16 ci;
#pragma unroll
        for (int r = 0; r < 16; ++r) ci[r] = row_on ? st.negm[r] : -INFINITY;
        qkt_c(p0, p1, c.shm + L_K + slot * SLOTB, qr, ci, c.r32, c.hi);
    } else qkt_c(p0, p1, c.shm + L_K + slot * SLOTB, qr, st.negm, c.r32, c.hi);
    if (use_range) range_mask(p0, p1, lo, hv, c.hi);
    const float rm = rowmax(p0, p1);
    if (first || __any(rm > THR)) {
        float dl = first ? rm : fmaxf(rm, 0.f);
        if (dl == -INFINITY) dl = 0.f;
        st.mhat += dl;
#pragma unroll
        for (int r = 0; r < 16; ++r) { p0[r] -= dl; p1[r] -= dl; st.negm[r] = -st.mhat; }
        if (!first) { const float f = __builtin_amdgcn_exp2f(-dl); st.l *= f; float al[16]; row_bcast(f, al, c.wsf, c.r32, c.hi);
#pragma unroll
            for (int r = 0; r < 16; ++r) { st.o[0][r] *= al[r]; st.o[1][r] *= al[r]; } }
    }
#pragma unroll
    for (int r = 0; r < 16; ++r) { p0[r] = __builtin_amdgcn_exp2f(p0[r]); p1[r] = __builtin_amdgcn_exp2f(p1[r]); }
    { const f32x16 sv = p0 + p1; st.l += ((sv[0] + sv[1]) + (sv[2] + sv[3])) + ((sv[4] + sv[5]) + (sv[6] + sv[7])) + ((sv[8] + sv[9]) + (sv[10] + sv[11])) + ((sv[12] + sv[13]) + (sv[14] + sv[15])); }
    pv(st.o, c.vb0 + slot * SLOTB, pack8(p0, 0), pack8(p0, 8), pack8(p1, 0), pack8(p1, 8));
}
struct Cursor { unsigned sm, wm; };
__device__ __forceinline__ int cur_pop(Cursor& k, int& br) {
    if (k.sm) { const int t = __builtin_ctz(k.sm); k.sm &= k.sm - 1u; br = 1; return t; }
    const int t = 31 - __builtin_clz(k.wm); k.wm &= ~(1u << t); br = 2; return t;
}

typedef __attribute__((address_space(3))) const char* lds_cptr;
typedef short v4i16_t __attribute__((ext_vector_type(4)));
__device__ __forceinline__ void kload8(bf16x8* kf, lds_cptr kp) {
    kf[0] = *(const LAS bf16x8*)(kp);        kf[1] = *(const LAS bf16x8*)(kp + 512);
    kf[2] = *(const LAS bf16x8*)(kp + 2048); kf[3] = *(const LAS bf16x8*)(kp + 2560);
    kf[4] = *(const LAS bf16x8*)(kp + 4096); kf[5] = *(const LAS bf16x8*)(kp + 4608);
    kf[6] = *(const LAS bf16x8*)(kp + 6144); kf[7] = *(const LAS bf16x8*)(kp + 6656);
}
__device__ __forceinline__ void kload2(bf16x8* kf, lds_cptr kp, int j) { kf[2 * j] = *(const LAS bf16x8*)(kp + j * 2048); kf[2 * j + 1] = *(const LAS bf16x8*)(kp + j * 2048 + 512); }
__device__ __forceinline__ s16x4 vtr(lds_cptr p) { return __builtin_bit_cast(s16x4, __builtin_amdgcn_ds_read_tr16_b64_v4i16((LAS v4i16_t*)p)); }
__device__ __forceinline__ float fadd_s(float a, float b) { float r; asm("v_add_f32_e32 %0, %1, %2" : "=v"(r) : "v"(a), "v"(b)); return r; }
__device__ __forceinline__ float fsub_s(float a, float b) { float r; asm("v_sub_f32_e32 %0, %1, %2" : "=v"(r) : "v"(a), "v"(b)); return r; }
template <int THRL>
__device__ __forceinline__ void sel_stream(const Ctx& c, const bf16_t* Kb, const bf16_t* Vb, const bf16x8* qr, unsigned msel, int qb, f32x16* o, float& l_out) {
  const int lane = c.lane, r32 = c.r32, hi = c.hi;
  LAS float* wsf = c.wsf;
  const lds_cptr shm3 = (lds_cptr)c.shm;
  const lds_cptr kp0 = shm3 + L_K + hi * 1024 + r32 * 16;
  const lds_cptr vp0 = shm3 + L_V + ((lane >> 4) & 1) * 32 + (lane & 3) * 8 + (4 * hi + ((lane & 15) >> 2)) * 64;
  const int NTr = qb + 1, NT = NTr < 4 ? 4 : ((NTr + 1) & ~1);
  #define WAIT_BAR(N) asm volatile("s_waitcnt vmcnt(" #N ") lgkmcnt(0)\n\ts_barrier":::"memory")
  #define TILE_OF(t) (((t) < NTr) ? (t) : qb)
  #define DMA_K(t, slotb) glds16(Kb + (size_t)TILE_OF(t) * 4096 + c.koff, (unsigned)__builtin_amdgcn_readfirstlane(c.kdst + (slotb)))
  #define DMA_V(t, slotb) glds16(Vb + (size_t)TILE_OF(t) * 4096 + c.voff, (unsigned)__builtin_amdgcn_readfirstlane(c.vdst + (slotb)))
  #define CMASK(P0, P1, t) do { const bool on_ = ((t) < NTr) && (((msel >> ((t) & 31)) & 1u) != 0u); \
      if (__any(!on_)) { const float ng_ = on_ ? 0.f : -INFINITY; _Pragma("unroll") for (int r = 0; r < 16; ++r) { P0[r] += ng_; P1[r] += ng_; } } \
      if ((t) == qb) range_mask(P0, P1, 0, c.ql, hi); } while (0)
  float mhat = 0.f, l_reg = 0.f; o[0] = f32x16{}; o[1] = f32x16{}; f32x16 negm = f32x16{}; asm volatile("" : "+v"(negm));
  bf16x8 kf[8];
  bool resc = false;
  #define START(P0,P1) do{ const float rm=rowmax(P0,P1); resc=false; \
    { const float dl=rm; mhat=fadd_s(mhat,dl); \
      _Pragma("unroll") for(int r=0;r<16;++r){P0[r]=fsub_s(P0[r],dl);P1[r]=fsub_s(P1[r],dl);} \
      _Pragma("unroll") for(int r=0;r<16;++r)negm[r]=-mhat; asm volatile("":"+v"(negm)); } \
    _Pragma("unroll") for(int r=0;r<16;++r)P0[r]=__builtin_amdgcn_exp2f(P0[r]); }while(0)
  #define RESC() do{ if(resc){ asm volatile("s_waitcnt lgkmcnt(0)":::"memory"); \
      _Pragma("unroll") for(int d_=0;d_<2;++d_) _Pragma("unroll") for(int r=0;r<16;++r)o[d_][r]*=wsf[crow(r,hi)]; } }while(0)
  f32x16 pA0,pA1,pB0,pB1;
  int sl_prev=SLOTB,sl_cur=2*SLOTB,sl_next=0;
  #define ROT() do{sl_prev=sl_cur;sl_cur=sl_next;sl_next=(sl_next==2*SLOTB)?0:sl_next+SLOTB;}while(0)
  DMA_K(1,0); DMA_K(2,SLOTB);
  { const f32x16 z = f32x16{}; qkt_c(pA0,pA1,c.shm+L_K+2*SLOTB,qr,z,r32,hi); }
  asm volatile("s_nop 15\n\ts_nop 7":"+v"(pA0),"+v"(pA1)); CMASK(pA0,pA1,0);
  START(pA0,pA1);
  _Pragma("unroll") for(int r=0;r<16;++r)pA1[r]=__builtin_amdgcn_exp2f(pA1[r]);
  WAIT_BAR(0);
  DMA_K(3,2*SLOTB);DMA_V(1,0);
  ROT();
  kload8(kf,kp0+sl_cur);
  WAIT_BAR(2);
  s16x4 vlo[8],vhi[8]; u32x4 pw0,pw1,pw2,pw3;
  #define PKW(P,B) cvtpk(P[B],P[B+1])
  #define PAF(k) __builtin_bit_cast(bf16x8,pw##k)
  #define VFR(i) (bf16x8){vlo[i][0],vlo[i][1],vlo[i][2],vlo[i][3],vhi[i][0],vhi[i][1],vhi[i][2],vhi[i][3]}
  #define PIN(x) asm volatile("":"+v"(x))
  #define MX3(a,b,c) __builtin_fmaxf(__builtin_fmaxf((a),(b)),(c))
  #define GAPA(MF,A0,A1,A2,A3,W0,W1,PW) do{ MF; sacc+=A0; sacc+=A1; sacc+=A2; sacc+=A3; PIN(sacc); W0; W1; PIN(PW); SBAR(); }while(0)
  #define EX(v) __builtin_amdgcn_exp2f(v)
  #define GAPB(MF,X,B) do{ MF; X[B]=EX(X[B]); X[B+1]=EX(X[B+1]); X[B+2]=EX(X[B+2]); X[B+3]=EX(X[B+3]); PIN(X); SBAR(); }while(0)
  #define VRD(i) do{ vlo[i]=vtr(vp_+(((i)>>2)*4096+((i)&3)*1024)); vhi[i]=vtr(vp_+(((i)>>2)*4096+((i)&3)*1024+512)); }while(0)
  #define KRD(G,j) do{ if(G){ kload2(kf,kp0+sl_next,j); SBAR(); } }while(0)
  #define STEP(C0,C1,P0,P1,t,GK,GV,GL) do{ SBAR(); \
    const lds_cptr vp_=vp0+sl_prev; \
    VRD(0); SBAR(); float sacc=(P0[0]+P0[1]); \
    GAPA(C0=__builtin_amdgcn_mfma_f32_32x32x16_bf16(kf[0],qr[0],negm,0,0,0), P0[2],P0[3],P0[4],P0[5],     pw0[0]=PKW(P0,0), pw0[1]=PKW(P0,2), pw0); \
    VRD(4); SBAR(); GAPA(C1=__builtin_amdgcn_mfma_f32_32x32x16_bf16(kf[1],qr[0],negm,0,0,0), P0[6],P0[7],P0[8],P0[9],     pw0[2]=PKW(P0,4), pw0[3]=PKW(P0,6), pw0); \
    VRD(1); SBAR(); GAPA(C0=__builtin_amdgcn_mfma_f32_32x32x16_bf16(kf[2],qr[1],C0,0,0,0),   P0[10],P0[11],P0[12],P0[13], pw1[0]=PKW(P0,8), pw1[1]=PKW(P0,10), pw1); \
    VRD(5); SBAR(); GAPA(C1=__builtin_amdgcn_mfma_f32_32x32x16_bf16(kf[3],qr[1],C1,0,0,0),   P0[14],P0[15],P1[0],P1[1],   pw1[2]=PKW(P0,12),pw1[3]=PKW(P0,14), pw1); \
    VRD(2); SBAR(); GAPA(C0=__builtin_amdgcn_mfma_f32_32x32x16_bf16(kf[4],qr[2],C0,0,0,0),   P1[2],P1[3],P1[4],P1[5],     pw2[0]=PKW(P1,0), pw2[1]=PKW(P1,2), pw2); \
    VRD(6); SBAR(); GAPA(C1=__builtin_amdgcn_mfma_f32_32x32x16_bf16(kf[5],qr[2],C1,0,0,0),   P1[6],P1[7],P1[8],P1[9],     pw2[2]=PKW(P1,4), pw2[3]=PKW(P1,6), pw2); \
    VRD(3); SBAR(); GAPA(C0=__builtin_amdgcn_mfma_f32_32x32x16_bf16(kf[6],qr[3],C0,0,0,0),   P1[10],P1[11],P1[12],P1[13], pw3[0]=PKW(P1,8), pw3[1]=PKW(P1,10), pw3); \
    VRD(7); SBAR(); GAPA(C1=__builtin_amdgcn_mfma_f32_32x32x16_bf16(kf[7],qr[3],C1,0,0,0),   P1[14],P1[15],0.f,0.f,       pw3[2]=PKW(P1,12),pw3[3]=PKW(P1,14), pw3); \
    l_reg+=sacc; \
    if(GK){DMA_K((t)+3,sl_cur);} if(GV){DMA_V((t)+1,sl_next);} \
    CMASK(C0,C1,t); \
    { float a=MX3(C0[0],C0[1],C1[0]),b=MX3(C0[2],C0[3],C1[1]); a=MX3(a,C1[2],C1[3]); \
      _Pragma("unroll") for(int r=4;r<16;r+=4){a=MX3(a,C0[r],C0[r+1]);b=MX3(b,C0[r+2],C0[r+3]);a=MX3(a,C1[r],C1[r+1]);b=MX3(b,C1[r+2],C1[r+3]);} \
      float rm=__builtin_fmaxf(a,b); { auto rr=__builtin_amdgcn_permlane32_swap(__float_as_uint(rm),__float_as_uint(rm),false,false); rm=__builtin_fmaxf(__uint_as_float(rr[0]),__uint_as_float(rr[1])); } \
      resc=false; \
      if(__builtin_expect(__any(rm>(float)THRL),0)){ const float dl=__builtin_fmaxf(rm,0.f); mhat+=dl; \
        _Pragma("unroll") for(int r=0;r<16;++r){C0[r]-=dl;C1[r]-=dl;} \
        _Pragma("unroll") for(int r=0;r<16;++r)negm[r]=-mhat; asm volatile("":"+v"(negm)); \
        const float f=__builtin_amdgcn_exp2f(-dl); l_reg*=f; if(hi==0)wsf[r32]=f; resc=true; } } \
    SBAR(); \
    GAPB(o[0]=__builtin_amdgcn_mfma_f32_32x32x16_bf16(PAF(0),VFR(0),o[0],0,0,0), C0,0); \
    GAPB(o[1]=__builtin_amdgcn_mfma_f32_32x32x16_bf16(PAF(0),VFR(4),o[1],0,0,0), C0,4); \
    KRD(GL,0); GAPB(o[0]=__builtin_amdgcn_mfma_f32_32x32x16_bf16(PAF(1),VFR(1),o[0],0,0,0), C0,8); \
    KRD(GL,1); GAPB(o[1]=__builtin_amdgcn_mfma_f32_32x32x16_bf16(PAF(1),VFR(5),o[1],0,0,0), C0,12); \
    KRD(GL,2); GAPB(o[0]=__builtin_amdgcn_mfma_f32_32x32x16_bf16(PAF(2),VFR(2),o[0],0,0,0), C1,0); \
    KRD(GL,3); GAPB(o[1]=__builtin_amdgcn_mfma_f32_32x32x16_bf16(PAF(2),VFR(6),o[1],0,0,0), C1,4); \
    GAPB(o[0]=__builtin_amdgcn_mfma_f32_32x32x16_bf16(PAF(3),VFR(3),o[0],0,0,0), C1,8); \
    GAPB(o[1]=__builtin_amdgcn_mfma_f32_32x32x16_bf16(PAF(3),VFR(7),o[1],0,0,0), C1,12); \
    }while(0)
  #define ENDW(tt) do{ if((tt)+3<NT){WAIT_BAR(2);} else if((tt)+2<NT){WAIT_BAR(1);} else {WAIT_BAR(0);} }while(0)
  int t=1;
  for(;t+1<NT;t+=2){
    STEP(pB0,pB1,pA0,pA1,t,(t+3<NT),(t+1<NT),(t+1<NT));       ENDW(t);   RESC(); ROT();
    STEP(pA0,pA1,pB0,pB1,t+1,(t+4<NT),(t+2<NT),(t+2<NT));     ENDW(t+1); RESC(); ROT();
  }
  STEP(pB0,pB1,pA0,pA1,NT-1,false,false,false); RESC();
  { float sacc=pB0[0]+pB0[1]; _Pragma("unroll") for(int r=2;r<16;++r)sacc+=pB0[r]; _Pragma("unroll") for(int r=0;r<16;++r)sacc+=pB1[r]; l_reg+=sacc;
    SBAR(); pv(o, c.vb0 + sl_cur, pack8(pB0,0), pack8(pB0,8), pack8(pB1,0), pack8(pB1,8)); }
  l_out = l_reg;
  asm volatile("s_waitcnt lgkmcnt(0)\n\ts_barrier":::"memory");
  #undef WAIT_BAR
  #undef TILE_OF
  #undef DMA_K
  #undef DMA_V
  #undef CMASK
  #undef START
  #undef RESC
  #undef ROT
  #undef PKW
  #undef PAF
  #undef VFR
  #undef PIN
  #undef MX3
  #undef GAPA
  #undef EX
  #undef GAPB
  #undef VRD
  #undef KRD
  #undef STEP
  #undef ENDW
}

__device__ __forceinline__ void attn_unit(int b, int g, int qb, unsigned char* slab, LAS unsigned char* shm) {
    const bf16_t* Q = (const bf16_t*)(slab + SO_Q); const bf16_t* KV = (const bf16_t*)(slab + SO_KV); const bf16_t* KC = (const bf16_t*)(slab + SO_KC); const bf16_t* VC = (const bf16_t*)(slab + SO_VC);
    const float* gates = (const float*)(slab + SO_GATES); bf16_t* O = (bf16_t*)(slab + SO_O);
    Ctx c;
    const int tid = threadIdx.x;
    c.lane = tid & 63; c.r32 = c.lane & 31; c.hi = c.lane >> 5; c.wid = __builtin_amdgcn_readfirstlane(tid >> 6);
    const int kh = c.wid >> 1, qh = c.wid & 1, head = g * 4 + kh;
    c.ql = qh * 32 + c.r32; c.qb = qb; c.shm = shm; c.lds0 = (unsigned)(size_t)shm;
    c.wsf = (LAS float*)(shm + L_WS) + c.wid * 128;
    c.koff = c.lane * 64 + c.wid * 8;
    c.voff = (16 * (c.wid & 3) + (c.lane >> 2)) * 64 + (c.wid >> 2) * 32 + (c.lane & 3) * 8;
    c.kdst = c.lds0 + L_K + c.wid * 1024; c.vdst = c.lds0 + L_V + c.wid * 1024;
    c.vb0 = (int)(c.lds0 + L_V) + ((c.lane >> 4) & 1) * 32 + (c.lane & 3) * 8 + (4 * c.hi + ((c.lane & 15) >> 2)) * 64;
    const int t = qb * 64 + c.ql;
    const size_t mrow = (size_t)t;
    const size_t bg = (size_t)g;
    const bf16_t* KSb = KV + ((size_t)2 * 4 + g) * (SEQ * 64);
    const bf16_t* VSb = KV + ((size_t)3 * 4 + g) * (SEQ * 64);
    const bf16_t* KWb = KV + ((size_t)4 * 4 + g) * (SEQ * 64);
    const bf16_t* VWb = KV + ((size_t)5 * 4 + g) * (SEQ * 64);
    const bf16_t* KCb = KC + bg * 8192; const bf16_t* VCb = VC + bg * 8192;
    dma_k(c, KCb, 0, 0); dma_k(c, KCb, 1, 1); dma_v(c, VCb, 0, 0); dma_v(c, VCb, 1, 1);
    dma_k(c, KSb, 0, 2); dma_v(c, VSb, 0, 2);
    bf16x8 qr[4];
    { const bf16_t* Qw = Q + mrow * DM + head * 64 + c.hi * 8;
#pragma unroll
      for (int d0 = 0; d0 < 4; ++d0) qr[d0] = *(const bf16x8*)(Qw + d0 * 16); }
    const float* gp = gates + mrow * 48 + head * 3;
    const float g0 = gp[0], g1 = gp[1], g2 = gp[2];
    f32x16 ot[2];
    f32x16 o[2];
    const bool two = qb >= 16;
    ATT_WAIT_BAR(2);
    {
        f32x16 a0, a1, b0, b1;
        qkt(a0, a1, shm + L_K, qr, c.r32, c.hi);
        const int nmax = (t >= 31) ? ((t - 31) >> 4) : -1;
        range_mask(a0, a1, 0, nmax, c.hi);
        float rm = rowmax(a0, a1);
        if (two) { qkt(b0, b1, shm + L_K + SLOTB, qr, c.r32, c.hi); range_mask(b0, b1, 0, nmax - 64, c.hi); rm = fmaxf(rm, rowmax(b0, b1)); }
        const float mu = (rm == -INFINITY) ? 0.f : rm;
        float s = 0.f;
#pragma unroll
        for (int r = 0; r < 16; ++r) { a0[r] = __builtin_amdgcn_exp2f(a0[r] - mu); a1[r] = __builtin_amdgcn_exp2f(a1[r] - mu); s += a0[r] + a1[r]; }
        if (two) {
#pragma unroll
            for (int r = 0; r < 16; ++r) { b0[r] = __builtin_amdgcn_exp2f(b0[r] - mu); b1[r] = __builtin_amdgcn_exp2f(b1[r] - mu); s += b0[r] + b1[r]; }
        }
        s = halfsum(s);
        const float inv = (s > 0.f) ? 1.0f / s : 0.f;
#pragma unroll
        for (int r = 0; r < 16; ++r) { a0[r] *= inv; a1[r] *= inv; }
        if (two) {
#pragma unroll
            for (int r = 0; r < 16; ++r) { b0[r] *= inv; b1[r] *= inv; }
            int qlx = c.ql; LAUNDER(qlx);
            LAS float* IA = (LAS float*)(shm + L_IA) + (kh * 64 + qlx) * 33;
            LAS float* IB = (LAS float*)(shm + L_IB) + (kh * 64 + qlx) * 33;
#pragma unroll
            for (int i = 0; i < 4; ++i) {
                const int j = 2 * i + c.hi;
                IA[j]      = a0[4 * i] + a0[4 * i + 1] + a0[4 * i + 2] + 0.5f * a0[4 * i + 3]; IB[j + 1]  = 0.5f * a0[4 * i + 3];
                IA[j + 8]  = a1[4 * i] + a1[4 * i + 1] + a1[4 * i + 2] + 0.5f * a1[4 * i + 3]; IB[j + 9]  = 0.5f * a1[4 * i + 3];
                IA[j + 16] = b0[4 * i] + b0[4 * i + 1] + b0[4 * i + 2] + 0.5f * b0[4 * i + 3]; IB[j + 17] = 0.5f * b0[4 * i + 3];
                IA[j + 24] = b1[4 * i] + b1[4 * i + 1] + b1[4 * i + 2] + 0.5f * b1[4 * i + 3]; IB[j + 25] = 0.5f * b1[4 * i + 3];
            }
        }
        o[0] = f32x16{}; o[1] = f32x16{};
        pv(o, c.vb0, pack8(a0, 0), pack8(a0, 8), pack8(a1, 0), pack8(a1, 8));
        if (two) pv(o, c.vb0 + SLOTB, pack8(b0, 0), pack8(b0, 8), pack8(b1, 0), pack8(b1, 8));
        float cf[16]; row_bcast(g0, cf, c.wsf, c.r32, c.hi);
#pragma unroll
        for (int r = 0; r < 16; ++r) { ot[0][r] = o[0][r] * cf[r]; ot[1][r] = o[1][r] * cf[r]; }
    }
    ATT_WAIT_BAR(0);
    LAS unsigned* SEL = (LAS unsigned*)(shm + L_SEL);
    if (two) {
        int q = tid & 63, jg = tid >> 6; LAUNDER(q); LAUNDER(jg);
        LAS float* SC = (LAS float*)(shm + L_SC);
        const LAS float* IA = (const LAS float*)(shm + L_IA); const LAS float* IB = (const LAS float*)(shm + L_IB);
#pragma unroll
        for (int jj = 0; jj < 4; ++jj) { const int j = 4 * jg + jj; float sc = 0.f;
#pragma unroll
            for (int k = 0; k < 4; ++k) { sc += IA[(k * 64 + q) * 33 + j]; if (j > 0) sc += IB[(k * 64 + q) * 33 + j]; }
            const bool forced = (j == 0) || (j == qb) || (j == qb - 1);
            SC[q * 33 + j] = forced ? 1e30f : ((j <= qb) ? sc : -1e30f); }
        ATT_WAIT_BAR(0);
        unsigned nib = 0u;
        float sj[4];
#pragma unroll
        for (int jj = 0; jj < 4; ++jj) sj[jj] = SC[q * 33 + 4 * jg + jj];
        int rank[4] = {0, 0, 0, 0};
        for (int i = 0; i < 32; ++i) { const float si = SC[q * 33 + i];
#pragma unroll
            for (int jj = 0; jj < 4; ++jj) { const int j = 4 * jg + jj; rank[jj] += (si > sj[jj] || (si == sj[jj] && i < j)) ? 1 : 0; } }
#pragma unroll
        for (int jj = 0; jj < 4; ++jj) nib |= (rank[jj] < 16 ? 1u : 0u) << jj;
        ((LAS unsigned char*)(shm + L_NIB))[q * 8 + jg] = (unsigned char)nib;
        ATT_WAIT_BAR(0);
        if (tid < 64) { unsigned mk = 0u; int tq = tid; LAUNDER(tq);
#pragma unroll
            for (int k = 0; k < 8; ++k) mk |= (unsigned)((LAS unsigned char*)(shm + L_NIB))[tq * 8 + k] << (4 * k);
            SEL[tq] = mk; }
        ATT_WAIT_BAR(0);
    } else {
        if (tid < 64) SEL[tid] = (1u << (qb + 1)) - 1u;
        ATT_WAIT_BAR(0);
    }
    int lnx = c.lane, qlx2 = c.ql; LAUNDER(lnx); LAUNDER(qlx2);
    LAS float* accp = (LAS float*)(shm + L_IA) + c.wid * 2048 + lnx;
#pragma unroll
    for (int r = 0; r < 16; ++r) { accp[r * 64] = ot[0][r]; accp[(16 + r) * 64] = ot[1][r]; }
    unsigned um = SEL[lnx];
#pragma unroll
    for (int sft = 1; sft < 64; sft <<= 1) um |= (unsigned)__shfl_xor((int)um, sft);
    um = (unsigned)__builtin_amdgcn_readfirstlane((int)um);
    um &= (qb == 31) ? 0xffffffffu : ((1u << (qb + 1)) - 1u);
    const unsigned msel = SEL[qlx2];
    (void)um;
    {
        float l_sel; f32x16 osel[2];
        sel_stream<8>(c, KSb, VSb, qr, msel, qb, osel, l_sel);
        const float lt = halfsum(l_sel);
        float cf[16]; row_bcast((lt > 0.f) ? g1 / lt : 0.f, cf, c.wsf, c.r32, c.hi);
#pragma unroll
        for (int r = 0; r < 16; ++r) { accp[r * 64] += osel[0][r] * cf[r]; accp[(16 + r) * 64] += osel[1][r] * cf[r]; }
    }
    {
        const int lo_t = qb >= 8 ? qb - 8 : 0, nw = qb - lo_t + 1;
        dma_k(c, KWb, qb, 0); dma_v(c, VWb, qb, 0);
        if (nw > 1) { dma_k(c, KWb, qb - 1, 1); dma_v(c, VWb, qb - 1, 1); }
        BrState st; br_reset(st);
        int slot = 0;
        for (int j = 0; j < nw; ++j) {
            if (j + 1 < nw) ATT_WAIT_BAR(2); else ATT_WAIT_BAR(0);
            if (j + 2 < nw) { const int ps = (slot == 0) ? 2 : slot - 1; dma_k(c, KWb, qb - j - 2, ps); dma_v(c, VWb, qb - j - 2, ps); }
            const int tc = qb - j;
            bool use_range = false; int lo = 0, hv = 63;
            if (j == 0) { use_range = true; hv = c.ql; }
            else if (tc == qb - 8) { use_range = true; lo = c.ql + 1; }
            stream_step(c, slot, qr, true, use_range, lo, hv, j == 0, st);
            slot = (slot == 2) ? 0 : slot + 1;
        }
        const float lt = halfsum(st.l);
        float cf[16]; row_bcast((lt > 0.f) ? g2 / lt : 0.f, cf, c.wsf, c.r32, c.hi);
#pragma unroll
        for (int r = 0; r < 16; ++r) { ot[0][r] = accp[r * 64] + st.o[0][r] * cf[r]; ot[1][r] = accp[(16 + r) * 64] + st.o[1][r] * cf[r]; }
        LDS_WAIT();
    }
    {
        LAS bf16_t* stg = (LAS bf16_t*)(shm + L_IA) + c.wid * 4096;
        int lny = c.lane; LAUNDER(lny);
        LAS bf16_t* stw = stg + ((lny >> 5) * 4) * 64 + (lny & 31);
#pragma unroll
        for (int r = 0; r < 16; ++r) { const int orow = (r & 3) + 8 * (r >> 2);
#pragma unroll
            for (int d0 = 0; d0 < 2; ++d0) stw[orow * 64 + d0 * 32] = (bf16_t)(cvtpk(ot[d0][r], 0.f) & 0xffffu); }
        LDS_WAIT();
        bf16_t* Ow = O + ((size_t)qb * 64 + qh * 32) * DM + head * 64;
#pragma unroll
        for (int i = 0; i < 4; ++i) { const int row = i * 8 + (lny >> 3), chn = lny & 7; const u32x4 v = *(const LAS u32x4*)(stg + row * 64 + chn * 8); *(u32x4*)(Ow + (size_t)row * DM + chn * 8) = v; }
    }
    ATT_WAIT_BAR(0);
}
#undef SBAR
}

#define XB_TMO      128
#define XB_XCNT(j)  (256  + 64 * (j))
#define XB_XSUB(j)  (1280 + 64 * (j))
#define XB_XGEN(j)  (2304 + 64 * (j))
#define XB_TOP      3328
#define XB_TOPGEN   3392
#define XB_LSUB(j)  (3456 + 64 * (j))
#define XB_LGEN(j)  (4480 + 64 * (j))
#define XCD_BAR_WORDS 5504
#define XB_SPIN_CAP (1u << 18)
__device__ __forceinline__ unsigned xb_ld(unsigned* p)              { return __hip_atomic_load(p, __ATOMIC_RELAXED, __HIP_MEMORY_SCOPE_AGENT); }
__device__ __forceinline__ unsigned xb_add(unsigned* p, unsigned v) { return __hip_atomic_fetch_add(p, v, __ATOMIC_RELAXED, __HIP_MEMORY_SCOPE_AGENT); }
__device__ __forceinline__ unsigned xb_xcc_id() { return (unsigned)__builtin_amdgcn_s_getreg((3 << 11) | 20) & 0xFu; }
#define XB_SPIN(cond, bar) do { unsigned _sp = 0; while (cond) { __builtin_amdgcn_s_sleep(1); \
    if ((++_sp & 255u) == 0u) { if (xb_ld(&(bar)[XB_TMO])) break; if (_sp > XB_SPIN_CAP) { atomicAdd(&(bar)[XB_TMO], 1u); break; } } } } while (0)
struct XcdBarrier { unsigned* bar; unsigned x; volatile LAS unsigned* st; };
__device__ __forceinline__ XcdBarrier xcd_barrier_post(unsigned* bar, volatile LAS unsigned* st) {
    XcdBarrier b; b.bar = bar; b.x = xb_xcc_id(); b.st = st;
    if (threadIdx.x == 0) { st[2] = xb_add(&bar[XB_XCNT(b.x)], 1u); st[4] = b.x; }
    return b;
}
__device__ __forceinline__ void xcd_barrier_complete(unsigned* bar, unsigned x, unsigned& nloc, unsigned& nx, unsigned& uniform) {
    const unsigned G = gridDim.x * gridDim.y * gridDim.z;
    unsigned sum, cnt, mine, sp = 0u, uni;
    for (;;) {
        sum = 0u; cnt = 0u; mine = 0u; uni = 1u;
#pragma unroll
        for (unsigned j = 0; j < 16; ++j) { const unsigned c = xb_ld(&bar[XB_XCNT(j)]); sum += c; cnt += (c > 0u) ? 1u : 0u; mine = (j == x) ? c : mine;
            if (j < 8u ? (c != 32u) : (c != 0u)) uni = 0u; }
        if (sum == G) break;
        __builtin_amdgcn_s_sleep(1);
        if ((++sp & 255u) == 0u) { if (xb_ld(&bar[XB_TMO])) break; if (sp > XB_SPIN_CAP) { atomicAdd(&bar[XB_TMO], 1u); break; } }
    }
    nloc = mine > 0u ? mine : 1u; nx = cnt > 0u ? cnt : 1u;
    uniform = (uni != 0u && sum == G && G == 256u) ? 1u : 0u;
}
__device__ __forceinline__ void xcd_barrier(const XcdBarrier& b) {
    asm volatile("s_waitcnt vmcnt(0)" ::: "memory");
    __syncthreads();
    if (threadIdx.x == 0) {
        unsigned* bar = b.bar;
        __builtin_amdgcn_s_waitcnt(0);
        unsigned nloc = b.st[0], nx = b.st[1];
        if (nloc == 0u) { unsigned uf; xcd_barrier_complete(bar, b.x, nloc, nx, uf); b.st[0] = nloc; b.st[1] = nx; b.st[3] = uf; }
        const unsigned old = xb_add(&bar[XB_XSUB(b.x)], 1u);
        const unsigned gen = old / nloc;
        if (old + 1u == (gen + 1u) * nloc) {
            __builtin_amdgcn_fence(__ATOMIC_RELEASE, "agent");
            asm volatile("s_waitcnt vmcnt(0)" ::: "memory");
            const unsigned og = xb_add(&bar[XB_TOP], 1u);
            const unsigned tg = og / nx;
            if (og + 1u == (tg + 1u) * nx) xb_add(&bar[XB_TOPGEN], 1u);
            else XB_SPIN(xb_ld(&bar[XB_TOPGEN]) == tg, bar);
            __builtin_amdgcn_fence(__ATOMIC_ACQUIRE, "agent");
            xb_add(&bar[XB_XGEN(b.x)], 1u);
            asm volatile("s_waitcnt vmcnt(0)" ::: "memory");
        } else {
            XB_SPIN(xb_ld(&bar[XB_XGEN(b.x)]) == gen, bar);
            __builtin_amdgcn_fence(__ATOMIC_ACQUIRE, "agent");
            asm volatile("s_waitcnt vmcnt(0)" ::: "memory");
        }
    }
    __syncthreads();
}

__device__ __forceinline__ void xcd_local_barrier(const XcdBarrier& b) {
    asm volatile("s_waitcnt vmcnt(0)" ::: "memory");
    __syncthreads();
    if (threadIdx.x == 0) {
        unsigned* bar = b.bar;
        __builtin_amdgcn_s_waitcnt(0);
        const unsigned nloc = b.st[0];
        const unsigned old = xb_add(&bar[XB_LSUB(b.x)], 1u);
        const unsigned gen = old / nloc;
        if (old + 1u == (gen + 1u) * nloc) xb_add(&bar[XB_LGEN(b.x)], 1u);
        else XB_SPIN(xb_ld(&bar[XB_LGEN(b.x)]) == gen, bar);
        __builtin_amdgcn_fence(__ATOMIC_ACQUIRE, "agent");
        asm volatile("s_waitcnt vmcnt(0)" ::: "memory");
    }
    __syncthreads();
}

struct Args {
    const float *x, *c, *norm_gain, *w_ada, *b_ada, *w_a_in, *conv_w, *w_a_out, *w_qg, *q_gain, *w_o, *kv_norm_gain, *w_ada_kv, *b_ada_kv, *w_kv, *k_gain, *cmp_pe, *cmp_w1, *cmp_w2, *w_mlp1, *w_mlp2;
    float* out; unsigned char* ws; int ph_lo, ph_hi;
};

__device__ __forceinline__ void transpose_item(const float* W, int ldn, int srccol, int nvalid, int k0, bf16_t* WT, int Kd, int drow0, LAS float* scr, int lane) {
    if (nvalid == 32) {
        f32x4 t[8];
#pragma unroll
        for (int i = 0; i < 8; ++i) t[i] = __builtin_nontemporal_load((const f32x4*)(W + (size_t)(k0 + 8 * i + (lane >> 3)) * ldn + srccol + (lane & 7) * 4));
#pragma unroll
        for (int i = 0; i < 8; ++i) { LAS float* d = scr + (8 * i + (lane >> 3)) * 33 + (lane & 7) * 4; d[0] = t[i][0]; d[1] = t[i][1]; d[2] = t[i][2]; d[3] = t[i][3]; }
    } else {
#pragma unroll 8
        for (int i = 0; i < 32; ++i) { const int kk = 2 * i + (lane >> 5), n = lane & 31; scr[kk * 33 + n] = (n < nvalid) ? W[(size_t)(k0 + kk) * ldn + srccol + n] : 0.f; }
    }
    LDS_WAIT(); asm volatile("" ::: "memory");
    const int ch = lane & 7;
#pragma unroll
    for (int j = 0; j < 4; ++j) { const int n = (lane >> 3) + 8 * j; const LAS float* s = scr + (8 * ch) * 33 + n;
        u32x4 o; o.x = cvtpk(s[0 * 33], s[1 * 33]); o.y = cvtpk(s[2 * 33], s[3 * 33]); o.z = cvtpk(s[4 * 33], s[5 * 33]); o.w = cvtpk(s[6 * 33], s[7 * 33]);
        *(u32x4*)(WT + (size_t)(drow0 + n) * Kd + k0 + 8 * ch) = o; }
    LDS_WAIT(); asm volatile("" ::: "memory");
}
__device__ __forceinline__ int perm_head_cols(int d) { const int t = d >> 8, p = d & 255; return 256 * t + 64 * ((p >> 5) & 3) + 32 * (p >> 7) + (p & 31); }

constexpr int TI_AIN = 1536, TI_AOUT = 512, TI_M1 = 2048, TI_M2 = 2048, TI_KV = 768, TI_QG = 640, TI_O = 512, TI_C1 = 256, TI_C2 = 8;
constexpr int TI_TOTAL = TI_AIN + TI_AOUT + 2 * TI_M1 + 2 * TI_M2 + TI_KV + TI_QG + TI_O + 2 * TI_C1 + 2 * TI_C2;

__device__ __forceinline__ void p0_item(const Args& a, int it, LAS float* scr, int lane) {
    unsigned char* ws = a.ws;
    int r = it;
    if (r < TI_AIN) { const int kb = r / 96, nb = r % 96, d = 32 * nb; int src;
        if (d < 1024) src = d; else { const int t = (d - 1024) >> 8, p = (d - 1024) & 255; src = (p < 128) ? (1024 + 128 * t + p) : (2048 + 128 * t + (p - 128)); }
        transpose_item(a.w_a_in, 3072, src, 32, 64 * kb, (bf16_t*)(ws + WS_WAIN), 1024, d, scr, lane); return; }
    r -= TI_AIN;
    if (r < TI_AOUT) { const int kb = r / 32, nb = r % 32; transpose_item(a.w_a_out, 1024, 32 * nb, 32, 64 * kb, (bf16_t*)(ws + WS_WAOUT), 1024, 32 * nb, scr, lane); return; }
    r -= TI_AOUT;
    if (r < 2 * TI_M1) { const int L = r / TI_M1, q = r % TI_M1, kb = q / 128, nb = q % 128;
        transpose_item(a.w_mlp1 + (size_t)L * DM * FF, FF, 32 * nb, 32, 64 * kb, (bf16_t*)(ws + WS_WM1) + (size_t)L * FF * DM, DM, 32 * nb, scr, lane); return; }
    r -= 2 * TI_M1;
    if (r < 2 * TI_M2) { const int L = r / TI_M2, q = r % TI_M2, kb = q / 32, nb = q % 32;
        transpose_item(a.w_mlp2 + (size_t)L * FF * DM, DM, 32 * nb, 32, 64 * kb, (bf16_t*)(ws + WS_WM2) + (size_t)L * DM * FF, FF, 32 * nb, scr, lane); return; }
    r -= 2 * TI_M2;
    if (r < TI_KV) { const int kb = r / 48, nb = r % 48, d = 32 * nb;
        transpose_item(a.w_kv, 1536, perm_head_cols(d), 32, 64 * kb, (bf16_t*)(ws + WS_WKVQ), DM, d, scr, lane); return; }
    r -= TI_KV;
    if (r < TI_QG) { const int kb = r / 40, nb = r % 40, d = 32 * nb; int src, nv = 32;
        if (d < 1024) src = perm_head_cols(d); else { const int p = d - 1024; src = 1024 + p; nv = 48 - p; nv = nv < 0 ? 0 : (nv > 32 ? 32 : nv); if (nv == 0) src = 0; }
        transpose_item(a.w_qg, 1072, src, nv, 64 * kb, (bf16_t*)(ws + WS_WKVQ), DM, 1536 + d, scr, lane); return; }
    r -= TI_QG;
    if (r < TI_O) { const int kb = r / 32, nb = r % 32; transpose_item(a.w_o, 1024, 32 * nb, 32, 64 * kb, (bf16_t*)(ws + WS_WO), 1024, 32 * nb, scr, lane); return; }
    r -= TI_O;
    if (r < 2 * TI_C1) { const int kv = r / TI_C1, q = r % TI_C1, kb = q / 8, nb = q % 8;
        transpose_item(a.cmp_w1 + (size_t)kv * 2048 * 256, 256, 32 * nb, 32, 64 * kb, (bf16_t*)(ws + WS_WC1) + (size_t)kv * 256 * 2048, 2048, 32 * nb, scr, lane); return; }
    r -= 2 * TI_C1;
    { const int kv = r / TI_C2, q = r % TI_C2, kb = q / 2, nb = q % 2;
        transpose_item(a.cmp_w2 + (size_t)kv * 256 * 64, 64, 32 * nb, 32, 64 * kb, (bf16_t*)(ws + WS_WC2) + (size_t)kv * 64 * 256, 256, 32 * nb, scr, lane); }
}

__device__ __forceinline__ void p0_mods(const Args& a, LAS unsigned char* lds, int vblk, int G) {
    LAS float* cact = (LAS float*)lds;
    LAS float* red = (LAS float*)(lds + 32768);
    const int tid = threadIdx.x, lane = tid & 63, wave = tid >> 6;
    bool have = false;
    for (int u = vblk; u < 224; u += G) {
        if (!have) { for (int i = tid; i < 8 * DM; i += 512) { const float cv = a.c[i]; cact[i] = cv / (1.0f + __expf(-cv)); } have = true; }
        __syncthreads();
        const int col = u * 64 + lane;
        const float* W; const float* bias; float* dst; int N, c0;
        if (col < 6144) { W = a.w_ada; bias = a.b_ada; dst = (float*)(a.ws + WS_MOD0); N = 6144; c0 = col; }
        else if (col < 12288) { W = a.w_ada + (size_t)DM * 6144; bias = a.b_ada + 6144; dst = (float*)(a.ws + WS_MOD1); N = 6144; c0 = col - 6144; }
        else { W = a.w_ada_kv; bias = a.b_ada_kv; dst = (float*)(a.ws + WS_MODKV); N = 2048; c0 = col - 12288; }
        float acc[8];
#pragma unroll
        for (int b = 0; b < 8; ++b) acc[b] = 0.f;
        const float* wp = W + (size_t)(wave * 128) * N + c0;
        const LAS float* cp = cact + wave * 128;
#pragma unroll 8
        for (int k = 0; k < 128; ++k) { const float w = __builtin_nontemporal_load(wp + (size_t)k * N);
#pragma unroll
            for (int b = 0; b < 8; ++b) acc[b] += w * cp[b * DM + k]; }
#pragma unroll
        for (int b = 0; b < 8; ++b) red[(wave * 8 + b) * 64 + lane] = acc[b];
        __syncthreads();
        { const int b = wave; float sacc = bias[c0];
#pragma unroll
          for (int w = 0; w < 8; ++w) sacc += red[(w * 8 + b) * 64 + lane];
          dst[(size_t)b * N + c0] = sacc; }
        __syncthreads();
    }
    __syncthreads();
}

__device__ __forceinline__ void p1_norm_row2(const Args& a, int m0, int lane) {
    const int b = m0 >> 11;
    const float* mod0 = (const float*)(a.ws + WS_MOD0) + (size_t)b * 6144;
    const f32x4* xr = (const f32x4*)(a.x + (size_t)m0 * DM) + lane;
    f32x4 v[2][4]; float s0 = 0.f, s1 = 0.f;
#pragma unroll
    for (int j = 0; j < 4; ++j) { v[0][j] = __builtin_nontemporal_load(xr + 64 * j); v[1][j] = __builtin_nontemporal_load(xr + 256 + 64 * j); }
#pragma unroll
    for (int j = 0; j < 4; ++j) { s0 += (v[0][j][0] * v[0][j][0] + v[0][j][1] * v[0][j][1]) + (v[0][j][2] * v[0][j][2] + v[0][j][3] * v[0][j][3]);
                                  s1 += (v[1][j][0] * v[1][j][0] + v[1][j][1] * v[1][j][1]) + (v[1][j][2] * v[1][j][2] + v[1][j][3] * v[1][j][3]); }
#pragma unroll
    for (int o = 1; o < 64; o <<= 1) { s0 += __shfl_xor(s0, o); s1 += __shfl_xor(s1, o); }
    const float r0 = rsqrtf(s0 * (1.0f / DM) + EPS), r1 = rsqrtf(s1 * (1.0f / DM) + EPS);
    u32x2* o8 = (u32x2*)((bf16_t*)(a.ws + WS_A2) + (size_t)m0 * DM) + lane;
#pragma unroll
    for (int j = 0; j < 4; ++j) { const int col = 4 * lane + 256 * j;
        const f32x4 gn = *(const f32x4*)(a.norm_gain + col), sh = *(const f32x4*)(mod0 + col), sc = *(const f32x4*)(mod0 + 1024 + col) + 1.0f;
        const f32x4 h0 = (v[0][j] * r0 * gn) * sc + sh, h1 = (v[1][j] * r1 * gn) * sc + sh;
        u32x2 w; w.x = cvtpk(h0[0], h0[1]); w.y = cvtpk(h0[2], h0[3]); o8[64 * j] = w;
        w.x = cvtpk(h1[0], h1[1]); w.y = cvtpk(h1[2], h1[3]); o8[256 + 64 * j] = w; }
}
__device__ __forceinline__ void p1_norm_stream(const Args& a, int wv, LAS unsigned char* wbuf, int lane) {
    const int mbase = 8 * wv, b = mbase >> 11;
    const float* mod0 = (const float*)(a.ws + WS_MOD0) + (size_t)b * 6144;
    const float* xb = a.x + (size_t)mbase * DM + 4 * lane;
#define P1_ISSUE(it_) do { _Pragma("unroll") for (int j = 0; j < 8; ++j) \
        __builtin_amdgcn_global_load_lds((const unsigned*)(xb + (size_t)(2 * (it_)) * DM + j * 256), (LAS unsigned*)(wbuf + ((it_) & 1) * 8192 + j * 1024), 16, 0, 2); } while (0)
    asm volatile("s_waitcnt lgkmcnt(0)" ::: "memory");
    P1_ISSUE(0);
    f32x4 ga[4], sh[4];
#pragma unroll
    for (int j = 0; j < 4; ++j) { const int col = 4 * lane + 256 * j;
        ga[j] = *(const f32x4*)(a.norm_gain + col) * (*(const f32x4*)(mod0 + 1024 + col) + 1.0f); sh[j] = *(const f32x4*)(mod0 + col); }
    asm volatile("" : "+v"(ga[0]), "+v"(ga[1]), "+v"(ga[2]), "+v"(ga[3]), "+v"(sh[0]), "+v"(sh[1]), "+v"(sh[2]), "+v"(sh[3]));
#pragma unroll
    for (int it = 0; it < 4; ++it) {
        if (it + 1 < 4) { asm volatile("s_waitcnt lgkmcnt(0)" ::: "memory"); P1_ISSUE(it + 1); asm volatile("s_waitcnt vmcnt(8)" ::: "memory"); }
        else asm volatile("s_waitcnt vmcnt(0)" ::: "memory");
        const LAS unsigned char* bp = wbuf + (it & 1) * 8192 + lane * 16;
        f32x4 v[2][4]; float s0 = 0.f, s1 = 0.f;
#pragma unroll
        for (int j = 0; j < 4; ++j) { v[0][j] = *(const LAS f32x4*)(bp + j * 1024); v[1][j] = *(const LAS f32x4*)(bp + (4 + j) * 1024); }
#pragma unroll
        for (int j = 0; j < 4; ++j) { s0 += (v[0][j][0] * v[0][j][0] + v[0][j][1] * v[0][j][1]) + (v[0][j][2] * v[0][j][2] + v[0][j][3] * v[0][j][3]);
                                      s1 += (v[1][j][0] * v[1][j][0] + v[1][j][1] * v[1][j][1]) + (v[1][j][2] * v[1][j][2] + v[1][j][3] * v[1][j][3]); }
#pragma unroll
        for (int o = 1; o < 64; o <<= 1) { s0 += __shfl_xor(s0, o); s1 += __shfl_xor(s1, o); }
        const float r0 = rsqrtf(s0 * (1.0f / DM) + EPS), r1 = rsqrtf(s1 * (1.0f / DM) + EPS);
        u32x2* o8 = (u32x2*)((bf16_t*)(a.ws + WS_A2) + (size_t)(mbase + 2 * it) * DM) + lane;
#pragma unroll
        for (int j = 0; j < 4; ++j) {
            const f32x4 h0 = (v[0][j] * r0) * ga[j] + sh[j], h1 = (v[1][j] * r1) * ga[j] + sh[j];
            u32x2 w; w.x = cvtpk(h0[0], h0[1]); w.y = cvtpk(h0[2], h0[3]); o8[64 * j] = w;
            w.x = cvtpk(h1[0], h1[1]); w.y = cvtpk(h1[2], h1[3]); o8[256 + 64 * j] = w; }
    }
#undef P1_ISSUE
}
__device__ __forceinline__ void p1_bias_task(const bf16_t* Wt, int n0, const float* shift, int shift_stride, float* bias, int bias_stride, int lane) {
    const int r = lane & 15, kq = lane >> 4;
    const bf16_t* wp = Wt + (size_t)(n0 + r) * DM + 8 * kq;
    const float* sp = shift + (size_t)(r & 7) * shift_stride + 8 * kq;
    f32x4 acc = (f32x4){0.f, 0.f, 0.f, 0.f};
#pragma unroll 8
    for (int k0 = 0; k0 < DM; k0 += 32) {
        const bf16x8 bf = *(const bf16x8*)(wp + k0);
        const f32x4 s0 = *(const f32x4*)(sp + k0), s1 = *(const f32x4*)(sp + k0 + 4);
        u32x4 aw; aw.x = cvtpk(s0[0], s0[1]); aw.y = cvtpk(s0[2], s0[3]); aw.z = cvtpk(s1[0], s1[1]); aw.w = cvtpk(s1[2], s1[3]);
        if (r >= 8) aw = (u32x4){0u, 0u, 0u, 0u};
        acc = __builtin_amdgcn_mfma_f32_16x16x32_bf16(__builtin_bit_cast(bf16x8, aw), bf, acc, 0, 0, 0);
    }
    if (kq < 2) {
#pragma unroll
        for (int e = 0; e < 4; ++e) bias[(size_t)(4 * kq + e) * bias_stride + n0 + r] = acc[e];
    }
}
__device__ __forceinline__ void p1_pebias(const Args& a, int idx, int lane) {
    const int kv = idx >> 8;
    const bf16_t* wrow = (const bf16_t*)(a.ws + WS_WC1) + (size_t)idx * 2048;
    const float* pe = a.cmp_pe + (size_t)kv * 2048;
    float d = 0.f;
#pragma unroll
    for (int j = 0; j < 4; ++j) { const int k = (lane + 64 * j) * 8; const u32x4 w = *(const u32x4*)(wrow + k); const f32x4 p0 = *(const f32x4*)(pe + k), p1 = *(const f32x4*)(pe + k + 4);
        d += p0[0] * bf_lo(w.x) + p0[1] * bf_hi(w.x) + p0[2] * bf_lo(w.y) + p0[3] * bf_hi(w.y) + p1[0] * bf_lo(w.z) + p1[1] * bf_hi(w.z) + p1[2] * bf_lo(w.w) + p1[3] * bf_hi(w.w); }
    d = wave_sum(d);
    if (lane == 0) ((float*)(a.ws + WS_PEB))[idx] = d;
}

__device__ __forceinline__ void unpack8(const u32x4 w, float (&f)[8]) { f[0] = bf_lo(w.x); f[1] = bf_hi(w.x); f[2] = bf_lo(w.y); f[3] = bf_hi(w.y); f[4] = bf_lo(w.z); f[5] = bf_hi(w.z); f[6] = bf_lo(w.w); f[7] = bf_hi(w.w); }
__device__ __forceinline__ void p3_conv(const Args& a, int gtid, int nthreads) {
    for (int it0 = gtid; it0 < 128 * 2048; it0 += nthreads) {
        const int pass = it0 / nthreads, vt = it0 - pass * nthreads;
        const int it = (nthreads == 131072) ? ((vt >> 14) * 32768 + pass * 16384 + (vt & 16383)) : it0;
        const int cch = it & 127, rch = it >> 7, col = cch * 8, r0 = (rch * 8) & (SEQ - 1);
        unsigned char* slab = a.ws + WS_R + (size_t)((rch * 8) >> 11) * SLAB;
        const bf16_t* GB = (const bf16_t*)(slab + SO_GB); const bf16_t* V = (const bf16_t*)(slab + SO_V); bf16_t* Y = (bf16_t*)(slab + SO_Y);
        float w0[8], w1[8], w2[8];
        { const f32x4 t0 = *(const f32x4*)(a.conv_w + col), t1 = *(const f32x4*)(a.conv_w + col + 4); w0[0] = t0[0]; w0[1] = t0[1]; w0[2] = t0[2]; w0[3] = t0[3]; w0[4] = t1[0]; w0[5] = t1[1]; w0[6] = t1[2]; w0[7] = t1[3]; }
        { const f32x4 t0 = *(const f32x4*)(a.conv_w + 1024 + col), t1 = *(const f32x4*)(a.conv_w + 1024 + col + 4); w1[0] = t0[0]; w1[1] = t0[1]; w1[2] = t0[2]; w1[3] = t0[3]; w1[4] = t1[0]; w1[5] = t1[1]; w1[6] = t1[2]; w1[7] = t1[3]; }
        { const f32x4 t0 = *(const f32x4*)(a.conv_w + 2048 + col), t1 = *(const f32x4*)(a.conv_w + 2048 + col + 4); w2[0] = t0[0]; w2[1] = t0[1]; w2[2] = t0[2]; w2[3] = t0[3]; w2[4] = t1[0]; w2[5] = t1[1]; w2[6] = t1[2]; w2[7] = t1[3]; }
        float vm2[8], vm1[8];
        if ((r0 & (SEQ - 1)) != 0) { unpack8(*(const u32x4*)(V + (size_t)(r0 - 2) * DM + col), vm2); unpack8(*(const u32x4*)(V + (size_t)(r0 - 1) * DM + col), vm1); }
        else {
#pragma unroll
            for (int e = 0; e < 8; ++e) { vm2[e] = 0.f; vm1[e] = 0.f; } }
#pragma unroll
        for (int i = 0; i < 8; ++i) { float vc[8], gb[8], y[8];
            unpack8(*(const u32x4*)(V + (size_t)(r0 + i) * DM + col), vc); unpack8(*(const u32x4*)(GB + (size_t)(r0 + i) * DM + col), gb);
#pragma unroll
            for (int e = 0; e < 8; ++e) { y[e] = gb[e] * (w2[e] * vc[e] + w1[e] * vm1[e] + w0[e] * vm2[e]); vm2[e] = vm1[e]; vm1[e] = vc[e]; }
            u32x4 w; w.x = cvtpk(y[0], y[1]); w.y = cvtpk(y[2], y[3]); w.z = cvtpk(y[4], y[5]); w.w = cvtpk(y[6], y[7]);
            *(u32x4*)(Y + (size_t)(r0 + i) * DM + col) = w; }
    }
}

__device__ __forceinline__ float gelu_tanh(float x) {
    const float z = 0.7978845608028654f * (x + 0.044715f * x * x * x);
    const float e = __builtin_amdgcn_exp2f(z * 2.8853900817779268f);
    const float th = 1.0f - 2.0f / (e + 1.0f);
    return 0.5f * x * (1.0f + th);
}
constexpr int C_CH = 2064;
constexpr int C_RB0 = 68608;
constexpr int C_HOFF = C_RB0, C_HROW = 528;
__device__ __forceinline__ void p8_unit(const Args& a, int u, LAS unsigned char* lds) {
    const int tid = threadIdx.x, lane = tid & 63, wid = __builtin_amdgcn_readfirstlane(tid >> 6), r = lane & 31, h = lane >> 5;
    const int kv = u >> 7, bg = (u >> 2) & 31, rq = u & 3;
    unsigned char* slab = a.ws + WS_R + (size_t)(bg >> 2) * SLAB;
    const bf16_t* src = (const bf16_t*)(slab + SO_KV) + ((size_t)(kv * 4 + (bg & 3)) * SEQ + 512 * rq) * 64;
    __syncthreads();
    { u32x4 v[8];
#pragma unroll
      for (int j = 0; j < 8; ++j) v[j] = *(const u32x4*)(src + (size_t)(tid + 512 * j) * 8);
      u32x4 vl = (u32x4){0u, 0u, 0u, 0u};
      if (tid < 128 && rq != 3) vl = *(const u32x4*)(src + (size_t)32 * 1024 + tid * 8);
#pragma unroll
      for (int j = 0; j < 8; ++j) { const int idx = tid + 512 * j; *(LAS u32x4*)(lds + (idx >> 7) * C_CH + (idx & 127) * 16) = v[j]; }
      if (tid < 128) *(LAS u32x4*)(lds + 32 * C_CH + tid * 16) = vl; }
    __syncthreads();
    f32x16 acc = f32x16{};
    const unsigned lds0 = (unsigned)(size_t)lds;
    const bf16_t* Wsrc = (const bf16_t*)(a.ws + WS_WC1) + (size_t)(kv * 256) * 2048;
    const int drow = 16 * wid + (lane >> 2);
    const bf16_t* dsrc0 = Wsrc + (size_t)drow * 2048 + 8 * ((lane & 3) ^ ((drow >> 2) & 3));
    const bf16_t* dsrc1 = dsrc0 + (size_t)128 * 2048;
    const unsigned ddst0 = lds0 + C_RB0 + wid * 1024, ddst1 = ddst0 + 8192;
    const int brow = 32 * wid + r;
    const unsigned boff = C_RB0 + brow * 64, bkey = (brow >> 2) & 3;
#define P8_DMA(stg) do { att::glds16(dsrc0 + 32 * (stg), (unsigned)__builtin_amdgcn_readfirstlane(ddst0 + ((stg) & 3) * 16384)); att::glds16(dsrc1 + 32 * (stg), (unsigned)__builtin_amdgcn_readfirstlane(ddst1 + ((stg) & 3) * 16384)); } while (0)
#define P8_STEP(stg, WAITN) do { asm volatile("s_waitcnt vmcnt(" #WAITN ") lgkmcnt(0)\n\ts_barrier" ::: "memory"); \
        if ((stg) + 3 < 64) P8_DMA((stg) + 3); \
        { const LAS unsigned char* bp = lds + boff + ((stg) & 3) * 16384; \
          const LAS unsigned char* ap = lds + (r + ((stg) >> 5)) * C_CH + ((32 * (stg)) & 1023) * 2 + 16 * h; \
          const bf16x8 a0 = *(const LAS bf16x8*)ap, a1 = *(const LAS bf16x8*)(ap + 32); \
          const bf16x8 b0 = *(const LAS bf16x8*)(bp + 16 * ((unsigned)h ^ bkey)), b1 = *(const LAS bf16x8*)(bp + 16 * ((unsigned)(2 + h) ^ bkey)); \
          acc = __builtin_amdgcn_mfma_f32_32x32x16_bf16(a0, b0, acc, 0, 0, 0); acc = __builtin_amdgcn_mfma_f32_32x32x16_bf16(a1, b1, acc, 0, 0, 0); } } while (0)
    P8_DMA(0); P8_DMA(1); P8_DMA(2);
    for (int s4 = 0; s4 < 60; s4 += 4) { P8_STEP(s4, 4); P8_STEP(s4 + 1, 4); P8_STEP(s4 + 2, 4); P8_STEP(s4 + 3, 4); }
    P8_STEP(60, 4); P8_STEP(61, 4); P8_STEP(62, 2); P8_STEP(63, 0);
    asm volatile("s_waitcnt lgkmcnt(0)\n\ts_barrier" ::: "memory");
#undef P8_DMA
#undef P8_STEP
    { const float pb = ((const float*)(a.ws + WS_PEB))[kv * 256 + 32 * wid + r];
      LAS bf16_t* H = (LAS bf16_t*)(lds + C_HOFF);
#pragma unroll
      for (int rg = 0; rg < 16; ++rg) { const int row = att::crow(rg, h); H[row * (C_HROW / 2) + 32 * wid + r] = (bf16_t)(cvtpk(gelu_tanh(acc[rg] + pb), 0.f) & 0xffffu); } }
    __syncthreads();
    if (wid == 0) {
        f32x16 o0 = f32x16{}, o1 = f32x16{};
        const bf16_t* W2 = (const bf16_t*)(a.ws + WS_WC2) + (size_t)kv * 64 * 256;
#pragma unroll
        for (int s = 0; s < 16; ++s) {
            const bf16x8 af = *(const LAS bf16x8*)(lds + C_HOFF + r * C_HROW + (16 * s + 8 * h) * 2);
            const bf16x8 b0 = *(const bf16x8*)(W2 + (size_t)r * 256 + 16 * s + 8 * h), b1 = *(const bf16x8*)(W2 + (size_t)(32 + r) * 256 + 16 * s + 8 * h);
            o0 = __builtin_amdgcn_mfma_f32_32x32x16_bf16(af, b0, o0, 0, 0, 0); o1 = __builtin_amdgcn_mfma_f32_32x32x16_bf16(af, b1, o1, 0, 0, 0);
        }
        const float gk0 = a.k_gain[r], gk1 = a.k_gain[32 + r];
        bf16_t* dst = (bf16_t*)(slab + (kv == 0 ? SO_KC : SO_VC)) + (size_t)(bg & 3) * 8192;
#pragma unroll
        for (int rg = 0; rg < 16; ++rg) { float v0 = o0[rg], v1 = o1[rg];
            if (kv == 0) { float ss = v0 * v0 + v1 * v1;
#pragma unroll
                for (int sft = 1; sft < 32; sft <<= 1) ss += __shfl_xor(ss, sft);
                const float rs = rsqrtf(ss * (1.0f / 64.0f) + EPS); v0 *= rs * gk0; v1 *= rs * gk1; }
            const int n = 32 * rq + att::crow(rg, h);
            if (n == 127) { v0 = 0.f; v1 = 0.f; }
            dst[n * 64 + r] = (bf16_t)(cvtpk(v0, 0.f) & 0xffffu); dst[n * 64 + 32 + r] = (bf16_t)(cvtpk(v1, 0.f) & 0xffffu); }
    }
}

__device__ __forceinline__ void p4_fixup(const Args& a, int pm) {
    const int tid = threadIdx.x;
    if (tid < 256) {
        const int rr = tid >> 7, cc = (tid & 127) * 8, pml = pm & 7, srow = pml * 256 + rr;
        unsigned char* slab = a.ws + WS_R + (size_t)(pm >> 3) * SLAB;
        const bf16_t* V = (const bf16_t*)(slab + SO_V); const bf16_t* GBH = (const bf16_t*)(slab + SO_GB) + (size_t)pml * 2 * DM; bf16_t* Y = (bf16_t*)(slab + SO_Y);
        float gb[8], v0[8], v1[8], v2[8], y[8];
        unpack8(*(const u32x4*)(GBH + (size_t)rr * DM + cc), gb);
        unpack8(*(const u32x4*)(V + (size_t)srow * DM + cc), v0);
        if (srow >= 1) unpack8(*(const u32x4*)(V + (size_t)(srow - 1) * DM + cc), v1); else {
#pragma unroll
            for (int e = 0; e < 8; ++e) v1[e] = 0.f; }
        if (srow >= 2) unpack8(*(const u32x4*)(V + (size_t)(srow - 2) * DM + cc), v2); else {
#pragma unroll
            for (int e = 0; e < 8; ++e) v2[e] = 0.f; }
#pragma unroll
        for (int e = 0; e < 8; ++e) y[e] = gb[e] * (a.conv_w[2 * DM + cc + e] * v0[e] + a.conv_w[DM + cc + e] * v1[e] + a.conv_w[cc + e] * v2[e]);
        u32x4 w; w.x = cvtpk(y[0], y[1]); w.y = cvtpk(y[2], y[3]); w.z = cvtpk(y[4], y[5]); w.w = cvtpk(y[6], y[7]);
        *(u32x4*)(Y + (size_t)srow * DM + cc) = w;
    }
}

__global__ void __launch_bounds__(NWAVES * 64, 2) yoco_fwd(Args args) {
    extern __shared__ __attribute__((aligned(16))) unsigned char lds_raw[];
    LAS unsigned char* lds = (LAS unsigned char*)lds_raw;
    const int tid = threadIdx.x, lane = tid & 63, wave = __builtin_amdgcn_readfirstlane(tid >> 6);
    const int G = gridDim.x, bx = blockIdx.x;
    int vcu = (G % 8 == 0) ? (bx % 8) * (G / 8) + bx / 8 : bx;
    int cid = bx;
    const int gw = vcu * NWAVES + wave, NGW = G * NWAVES;
    unsigned char* ws = args.ws;
    const int lo = args.ph_lo, hi = args.ph_hi;
    volatile LAS unsigned* MISC = (volatile LAS unsigned*)(lds + LDS_BYTES - 256);
    if (tid < 8) MISC[tid] = 0u;
    __syncthreads();
    XcdBarrier bar; bar.bar = (unsigned*)(ws + WS_BAR); bar.x = 0; bar.st = MISC;
    if (hi - lo > 1) bar = xcd_barrier_post((unsigned*)(ws + WS_BAR), MISC);
#define IN(k) (lo <= (k) && (k) < hi)
#define SEAM(k) do { if (IN(k) && IN((k) + 1)) xcd_barrier(bar); } while (0)
#define LSEAM(k) do { if (IN(k) && IN((k) + 1)) { if (local_ok) xcd_local_barrier(bar); else xcd_barrier(bar); } } while (0)
    bool local_ok = false;
    float* MOD0 = (float*)(ws + WS_MOD0); float* MOD1 = (float*)(ws + WS_MOD1); float* MODKV = (float*)(ws + WS_MODKV);
    float* SS1 = (float*)(ws + WS_SS1); float* SS2 = (float*)(ws + WS_SS2); float* SS3 = (float*)(ws + WS_SS3);
    bf16_t* A1 = (bf16_t*)(ws + WS_A1); bf16_t* A2 = (bf16_t*)(ws + WS_A2);
    bf16_t* HB = (bf16_t*)(ws + WS_H);

    if (IN(0)) {
        p0_mods(args, lds, vcu, G);
        LAS float* scr = (LAS float*)(lds + wave * 16384);
        for (int it = gw; it < TI_TOTAL; it += NGW) p0_item(args, it, scr, lane);
    }
    SEAM(0);
    if (IN(1)) {
        for (int wv = gw; wv < M_TOK / 8; wv += NGW) p1_norm_stream(args, wv, lds + wave * 16384, lane);
        asm volatile("s_waitcnt vmcnt(0) lgkmcnt(0)" ::: "memory");
        for (int it = gw; it < (2 * FF + NKVQ) / 16 + 512; it += NGW) {
            const int n = it * 16;
            if (n < FF) p1_bias_task((const bf16_t*)(ws + WS_WM1), n, MOD0 + 3072, 6144, (float*)(ws + WS_BM1L0), FF, lane);
            else if (n < 2 * FF) p1_bias_task((const bf16_t*)(ws + WS_WM1) + (size_t)FF * DM, n - FF, MOD1 + 3072, 6144, (float*)(ws + WS_BM1L1), FF, lane);
            else if (n < 2 * FF + 1536) p1_bias_task((const bf16_t*)(ws + WS_WKVQ), n - 2 * FF, MODKV, 2048, (float*)(ws + WS_BKVQ), NKVQ, lane);
            else if (n < 2 * FF + NKVQ) p1_bias_task((const bf16_t*)(ws + WS_WKVQ), n - 2 * FF, MOD1, 6144, (float*)(ws + WS_BKVQ), NKVQ, lane);
            else p1_pebias(args, it - (2 * FF + NKVQ) / 16, lane);
        }
    }
    SEAM(1);
    if (hi - lo > 1 && lo <= 1) {
        local_ok = MISC[3] != 0u;
        if (local_ok) { const int x = (int)MISC[4], rk = (int)MISC[2]; vcu = x * 32 + rk; cid = rk * 8 + x; }
    }
    if (IN(2)) {
        pg8::Gemm g{A2, A2, 1 << 30, (const bf16_t*)(ws + WS_WAIN), M_TOK, 3072, DM, (size_t)SEQ * DM * 2}; pg8::StaticOrder S; S.init_ain(G, cid);
        pg8::EpiAin E{ws + WS_R, args.conv_w};
        pg8::gemm_phase(lds, g, S, E);
    }
    LSEAM(2);
    if (IN(4)) {
        pg8::Gemm g{(const bf16_t*)(ws + WS_R + SO_Y), (const bf16_t*)(ws + WS_R + SO_Y), 1 << 30, (const bf16_t*)(ws + WS_WAOUT), M_TOK, DM, DM, SLAB}; pg8::StaticOrder S; S.init(M_TOK, DM, G, cid);
        { pg8::Unit fu; for (int i = 0; S.next(i, fu); ++i) p4_fixup(args, fu.pm); asm volatile("s_waitcnt vmcnt(0)" ::: "memory"); __syncthreads(); }
        pg8::EpiRes<1, 0, 2> E{args.x, nullptr, MOD0 + 2048, 6144, args.norm_gain + 1024, MOD0 + 4096, 6144, A1, nullptr, nullptr, 0, nullptr, SS1, nullptr, nullptr, 0, lds};
        pg8::gemm_phase(lds, g, S, E);
    }
    LSEAM(4);
    if (IN(5)) {
        pg8::Gemm g{A1, A1, 1 << 30, (const bf16_t*)(ws + WS_WM1), M_TOK, FF, DM, (size_t)SEQ * DM * 2}; pg8::StaticOrder S; S.init(M_TOK, FF, G, cid);
        pg8::EpiMlp1 E{HB, (const float*)(ws + WS_BM1L0), SS1, lds};
        pg8::gemm_phase(lds, g, S, E);
    }
    LSEAM(5);
    if (IN(6)) {
        pg8::Gemm g{HB, HB, 1 << 30, (const bf16_t*)(ws + WS_WM2), M_TOK, DM, FF, (size_t)SEQ * FF * 2}; pg8::StaticOrder S; S.init(M_TOK, DM, G, cid);
        pg8::EpiRes<2, 2, 2> E{A1, nullptr, MOD0 + 5120, 6144, args.kv_norm_gain, MODKV + 1024, 2048, A1, args.norm_gain + 2048, MOD1 + 1024, 6144, A2, SS2, args.norm_gain + 1024, MOD0 + 4096, 6144, lds};
        pg8::gemm_phase(lds, g, S, E);
    }
    LSEAM(6);
    if (IN(7)) {
        pg8::Gemm g{A1, A2, 6, (const bf16_t*)(ws + WS_WKVQ), M_TOK, NKVQ, DM, (size_t)SEQ * DM * 2}; pg8::StaticOrder S; S.init(M_TOK, NKVQ, G, cid);
        pg8::EpiKVQ E{ws + WS_R, (const float*)(ws + WS_BKVQ), SS2, args.k_gain, args.q_gain, lds};
        pg8::gemm_phase(lds, g, S, E);
    }
    LSEAM(7);
    if (IN(8)) { for (int v = vcu; v < 256; v += G) { const int rk = v & 31; p8_unit(args, ((rk >> 4) << 7) | ((((v >> 5) << 2) | ((rk >> 2) & 3)) << 2) | (rk & 3), lds); } __syncthreads(); }
    LSEAM(8);
    if (IN(9)) {
        for (int v = vcu; v < 256; v += G) { const int bgp = v >> 3, s = v & 7;
            for (int i = 0; i < 4; ++i) { const int qb = (i == 0) ? s : (i == 1) ? 15 - s : (i == 2) ? 16 + s : 31 - s;
                att::attn_unit(bgp >> 2, bgp & 3, qb, ws + WS_R + (size_t)(bgp >> 2) * SLAB, lds); } }
    }
    LSEAM(9);
    if (IN(10)) {
        pg8::Gemm g{(const bf16_t*)(ws + WS_R + SO_O), (const bf16_t*)(ws + WS_R + SO_O), 1 << 30, (const bf16_t*)(ws + WS_WO), M_TOK, DM, DM, SLAB}; pg8::StaticOrder S; S.init(M_TOK, DM, G, cid);
        pg8::EpiRes<1, 2, 2> E{A2, nullptr, MOD1 + 2048, 6144, args.norm_gain + 3072, MOD1 + 4096, 6144, A1, nullptr, nullptr, 0, nullptr, SS3, args.norm_gain + 2048, MOD1 + 1024, 6144, lds};
        pg8::gemm_phase(lds, g, S, E);
    }
    LSEAM(10);
    if (IN(11)) {
        pg8::Gemm g{A1, A1, 1 << 30, (const bf16_t*)(ws + WS_WM1) + (size_t)FF * DM, M_TOK, FF, DM, (size_t)SEQ * DM * 2}; pg8::StaticOrder S; S.init(M_TOK, FF, G, cid);
        pg8::EpiMlp1 E{HB, (const float*)(ws + WS_BM1L1), SS3, lds};
        pg8::gemm_phase(lds, g, S, E);
    }
    LSEAM(11);
    if (IN(12)) {
        pg8::Gemm g{HB, HB, 1 << 30, (const bf16_t*)(ws + WS_WM2) + (size_t)DM * FF, M_TOK, DM, FF, (size_t)SEQ * FF * 2}; pg8::StaticOrder S; S.init(M_TOK, DM, G, cid);
        pg8::EpiRes<0, 2, 0> E{A1, args.out, MOD1 + 5120, 6144, nullptr, nullptr, 0, nullptr, nullptr, nullptr, 0, nullptr, nullptr, args.norm_gain + 3072, MOD1 + 4096, 6144, lds};
        pg8::gemm_phase(lds, g, S, E);
    }
#undef IN
#undef SEAM
}

extern "C" void kernel_launch(void* const* d_in, const int* in_sizes, int n_in, void* d_out, int out_size, void* d_ws, size_t ws_size, hipStream_t stream) {
    static int grid = 0;
    if (grid == 0) {
        if (n_in != 21 || in_sizes[0] != M_TOK * DM || out_size != M_TOK * DM || ws_size < WS_END) { fprintf(stderr, "kernel_launch: unexpected shapes (n_in %d, in0 %d, out %d, ws %zu); nothing launched\n", n_in, n_in > 0 ? in_sizes[0] : -1, out_size, ws_size); grid = -1; return; }
        int dev = 0, cus = 0, per_cu = 0;
        if (hipGetDevice(&dev) != hipSuccess || hipDeviceGetAttribute(&cus, hipDeviceAttributeMultiprocessorCount, dev) != hipSuccess) { grid = -1; return; }
        if (hipFuncSetAttribute((const void*)yoco_fwd, hipFuncAttributeMaxDynamicSharedMemorySize, LDS_BYTES) != hipSuccess) { fprintf(stderr, "kernel_launch: hipFuncSetAttribute failed\n"); grid = -1; return; }
        if (hipOccupancyMaxActiveBlocksPerMultiprocessor(&per_cu, (const void*)yoco_fwd, NWAVES * 64, LDS_BYTES) != hipSuccess || per_cu < 1) { fprintf(stderr, "kernel_launch: occupancy query says %d blocks per CU\n", per_cu); per_cu = 1; }
        (void)hipGetLastError();
        grid = cus;
        if (grid != 256) { fprintf(stderr, "kernel_launch: this build deals the w_a_in tiles to exactly 256 workgroups (device has %d CUs); nothing launched\n", cus); grid = -1; return; }
    }
    if (grid < 0) return;
    (void)hipMemsetAsync((char*)d_ws + WS_ZERO, 0, ZERO_BYTES, stream);
    Args a{};
    a.x = (const float*)d_in[0]; a.c = (const float*)d_in[1]; a.norm_gain = (const float*)d_in[2]; a.w_ada = (const float*)d_in[3]; a.b_ada = (const float*)d_in[4];
    a.w_a_in = (const float*)d_in[5]; a.conv_w = (const float*)d_in[6]; a.w_a_out = (const float*)d_in[7]; a.w_qg = (const float*)d_in[8]; a.q_gain = (const float*)d_in[9];
    a.w_o = (const float*)d_in[10]; a.kv_norm_gain = (const float*)d_in[11]; a.w_ada_kv = (const float*)d_in[12]; a.b_ada_kv = (const float*)d_in[13]; a.w_kv = (const float*)d_in[14];
    a.k_gain = (const float*)d_in[15]; a.cmp_pe = (const float*)d_in[16]; a.cmp_w1 = (const float*)d_in[17]; a.cmp_w2 = (const float*)d_in[18]; a.w_mlp1 = (const float*)d_in[19]; a.w_mlp2 = (const float*)d_in[20];
    a.out = (float*)d_out; a.ws = (unsigned char*)d_ws;
#if MK_N_LAUNCHES == 1
    a.ph_lo = 0; a.ph_hi = N_PHASES;
    void* kargs[] = {&a};
    hipError_t e = hipLaunchCooperativeKernel((const void*)yoco_fwd, dim3(grid), dim3(NWAVES * 64), kargs, LDS_BYTES, stream);
    if (e != hipSuccess) fprintf(stderr, "kernel_launch: cooperative launch failed: %s (grid %d)\n", hipGetErrorString(e), grid);
#else
    for (int p = 0; p < N_PHASES; ++p) { a.ph_lo = p; a.ph_hi = p + 1; hipLaunchKernelGGL(yoco_fwd, dim3(grid), dim3(NWAVES * 64), LDS_BYTES, stream, a); }
#endif
}
```

```cpp
#include <hip/hip_runtime.h>
#include <cstdio>
#include <cstdint>
#include <cmath>

#ifndef MK_N_LAUNCHES
#define MK_N_LAUNCHES 1
#endif
constexpr int N_PHASES = 13;

#define LAS __attribute__((address_space(3)))
typedef unsigned short bf16_t;
typedef short bf16x8 __attribute__((ext_vector_type(8)));
typedef short s16x4 __attribute__((ext_vector_type(4)));
typedef float f32x2 __attribute__((ext_vector_type(2)));
typedef float f32x4 __attribute__((ext_vector_type(4)));
typedef float f32x16 __attribute__((ext_vector_type(16)));
typedef unsigned u32x4 __attribute__((ext_vector_type(4)));
typedef unsigned u32x2 __attribute__((ext_vector_type(2)));
typedef __bf16 bf16x2_t __attribute__((ext_vector_type(2)));

constexpr int BATCH = 8, SEQ = 2048, DM = 1024, FF = 4096, M_TOK = BATCH * SEQ;
constexpr int NKVQ = 2816;
constexpr float EPS = 1e-6f;
constexpr float QSCALE = 0.125f * 1.4426950408889634f;

constexpr size_t MiB = 1u << 20;
constexpr size_t WS_ZERO = 0, ZERO_BYTES = 1 * MiB;
constexpr size_t WS_MOD0 = 0, WS_MOD1 = 196608, WS_MODKV = 393216;
constexpr size_t WS_SS1 = 524288, WS_SS2 = 589824, WS_SS3 = 655360;
constexpr size_t WS_BAR = 786432;
constexpr size_t WS_BM1L0 = 1 * MiB, WS_BM1L1 = WS_BM1L0 + 131072, WS_BKVQ = WS_BM1L1 + 131072, WS_PEB = WS_BKVQ + 131072, WS_WC2 = WS_PEB + 4096;
constexpr size_t WS_WAIN = 2 * MiB, WS_WAOUT = 8 * MiB, WS_WM1 = 10 * MiB  , WS_WM2 = 26 * MiB  , WS_WKVQ = 42 * MiB, WS_WO = 48 * MiB, WS_WC1 = 50 * MiB;
constexpr size_t WS_R = 56 * MiB;
constexpr size_t SLAB = 16 * MiB;
constexpr size_t SO_GB = 0, SO_V = 4 * MiB, SO_Y = 8 * MiB;
constexpr size_t WS_H = WS_R;
constexpr size_t SO_Q = 0, SO_KV = 4 * MiB  , SO_O = 10 * MiB, SO_GATES = 14 * MiB  , SO_KC = 14 * MiB + 512 * 1024  , SO_VC = SO_KC + 65536;
constexpr size_t WS_A1 = 184 * MiB, WS_A2 = 216 * MiB, WS_END = 248 * MiB;

constexpr int LDS_BYTES = 147456;
constexpr int NWAVES = 8;

__device__ __forceinline__ unsigned cvtpk(float lo, float hi) { f32x2 v = {lo, hi}; bf16x2_t b = __builtin_convertvector(v, bf16x2_t); return __builtin_bit_cast(unsigned, b); }
__device__ __forceinline__ float bf_lo(unsigned u) { return __builtin_bit_cast(float, u << 16); }
__device__ __forceinline__ float bf_hi(unsigned u) { return __builtin_bit_cast(float, u & 0xffff0000u); }
__device__ __forceinline__ float wave_sum(float v) {
#pragma unroll
    for (int o = 1; o < 64; o <<= 1) v += __shfl_xor(v, o);
    return v;
}
#define LDS_WAIT() asm volatile("s_waitcnt lgkmcnt(0)" ::: "memory")
#define LAUNDER(x) asm volatile("" : "+v"(x))

namespace pg8 {
constexpr int BM = 256, BK = 64, HALF = 128, HTB = HALF * BK * 2, STAGE_BYTES = 8 * HTB, NXCD = 8, WGM = 8, VEC_LDS = 131072;
__host__ __device__ __forceinline__ int lds_byte(int r, int c) { const int st = (r >> 4) * 2 + (c >> 5), rr = r & 15, cc = c & 31, ob = rr * 64 + cc * 2; return st * 1024 + (ob ^ (((ob >> 9) & 1) << 5)); }
__host__ __device__ __forceinline__ void stage_rc(int b, int& R, int& C) { const int st = b / 1024, sb = b % 1024, swz = sb ^ (((sb >> 9) & 1) << 5); R = (st >> 1) * 16 + swz / 64; C = (st & 1) * 32 + (swz % 64) / 2; }
__host__ __device__ __forceinline__ int perm32(int rho) { const int n = rho >> 4, i = rho & 15; return 8 * (i >> 2) + 4 * n + (i & 3); }

struct Unit { int pm, pn; };
struct Gemm { const bf16_t* A; const bf16_t* A2; int pn_split; const bf16_t* Bt; int M, N, K; size_t abatch; };

struct StaticOrder {
    int nM, nN, nwg, G, c, ain;
    __device__ __forceinline__ void init(int M, int N, int G_, int c_) { nM = M / BM; nN = N / BM; nwg = nM * nN; G = G_; c = c_; ain = 0; }
    __device__ __forceinline__ void init_ain(int G_, int c_) { init(M_TOK, 3072, G_, c_); ain = 1; }
    __device__ __forceinline__ bool next(int i, Unit& u) const {
        if (ain) { if (i >= 3) return false; const int x = c & 7, rk = c >> 3, p = rk >> 3; u.pm = 8 * x + (rk & 7); u.pn = (i == 2) ? p : 4 + 2 * p + i; return true; }
        const long L = (long)i * G + c; if (L >= nwg) return false;
        int wgid = (int)L; { const int q = nwg / NXCD, r = nwg % NXCD, xcd = wgid % NXCD, off = wgid / NXCD; wgid = (xcd < r ? xcd * (q + 1) : r * (q + 1) + (xcd - r) * q) + off; }
        const int nig = WGM * nN, gid = wgid / nig, fm = gid * WGM, gsz = (nM - fm) < WGM ? (nM - fm) : WGM;
        u.pm = fm + ((wgid % nig) % gsz); u.pn = (wgid % nig) / gsz; return true;
    }
};

template <class Epi>
__device__ __forceinline__ void gemm_phase(LAS unsigned char* lds, const Gemm g, const StaticOrder& S, const Epi& E) {
    const int tid = threadIdx.x, wid = __builtin_amdgcn_readfirstlane(tid >> 6), lane = tid & 63, wr = wid >> 2, wc = wid & 3, fr = lane & 15, fq = lane >> 4;
    const int K = g.K, nt = K / BK;
    unsigned voffA[2], voffB[2];
#pragma unroll
    for (int i = 0; i < 2; ++i) { int R, C; stage_rc(tid * 16 + i * 8192, R, C); const int Rb = Epi::PERM ? ((R & ~31) + perm32(R & 31)) : R;
        voffA[i] = (unsigned)(R * K + C) * 2u; voffB[i] = (unsigned)(Rb * K + C) * 2u; }
    const size_t kstep = (size_t)(BK * 2);
    const size_t hstep = (size_t)HALF * K * 2;
    const size_t tstep = 2 * hstep;
    const unsigned ldsw = (unsigned)wid * 1024u;
    const int aoff = lds_byte(wr * 64 + fr, fq * 8), boff = lds_byte(wc * 32 + fr, fq * 8);
#define PG8_SA(b, h) (((b) * 2 + (h)) * HTB)
#define PG8_SB(b, h) ((4 + (b) * 2 + (h)) * HTB)
#define PG8_STAGE(bufoff, gbase, voff) do { _Pragma("unroll") for (int _i = 0; _i < 2; ++_i) \
        __builtin_amdgcn_global_load_lds((const unsigned*)((const char*)(gbase) + (voff)[_i]), (LAS unsigned*)(lds + (bufoff) + ldsw + _i * 8192), 16, 0, 0); } while (0)
#define PG8_LDA(dst, b, h) do { _Pragma("unroll") for (int m = 0; m < 4; ++m) _Pragma("unroll") for (int k = 0; k < 2; ++k) dst[m][k] = *(const LAS bf16x8*)(lds + PG8_SA(b, h) + aoff + m * 2048 + k * 1024); } while (0)
#define PG8_LDB(dst, b, h) do { _Pragma("unroll") for (int n = 0; n < 2; ++n) _Pragma("unroll") for (int k = 0; k < 2; ++k) dst[n][k] = *(const LAS bf16x8*)(lds + PG8_SB(b, h) + boff + n * 2048 + k * 1024); } while (0)
#define PG8_MMA(ai, bj, At, Bt) do { __builtin_amdgcn_s_setprio(1); _Pragma("unroll") for (int m = 0; m < 4; ++m) _Pragma("unroll") for (int n = 0; n < 2; ++n) _Pragma("unroll") for (int k = 0; k < 2; ++k) \
        acc[ai][bj][m][n] = __builtin_amdgcn_mfma_f32_16x16x32_bf16(Bt[n][k], At[m][k], acc[ai][bj][m][n], 0, 0, 0); __builtin_amdgcn_s_setprio(0); } while (0)
#define PG8_WAIT_V(n) asm volatile("s_waitcnt vmcnt(" #n ")" ::: "memory")
#define PG8_WAIT_L(n) asm volatile("s_waitcnt lgkmcnt(" #n ")" ::: "memory")
#define PG8_BAR __builtin_amdgcn_s_barrier()
#define PG8_SCHED __builtin_amdgcn_sched_barrier(0)
#define PG8_ABASE(u) ((const char*)((u).pn < g.pn_split ? g.A : g.A2) + (size_t)((u).pm >> 3) * g.abatch + (size_t)((u).pm & 7) * tstep)
    Unit cur, nxt; int ui = 0;
    if (!S.next(0, cur)) return;
    f32x4 acc[2][2][4][2];
#pragma unroll
    for (int a = 0; a < 2; ++a)
#pragma unroll
        for (int b = 0; b < 2; ++b)
#pragma unroll
            for (int m = 0; m < 4; ++m)
#pragma unroll
                for (int n = 0; n < 2; ++n) acc[a][b][m][n] = (f32x4){0.f, 0.f, 0.f, 0.f};
    bf16x8 At[4][2], B0[2][2], B1[2][2];
    const char* cA = PG8_ABASE(cur); const char* cB = (const char*)g.Bt + (size_t)cur.pn * tstep;
#define PG8_VEC(u, slot) do { if (Epi::HAS_VEC && wid == 0) { \
        __builtin_amdgcn_global_load_lds((const unsigned*)(E.vec_rows(u) + 4 * lane), (LAS unsigned*)(lds + VEC_LDS + (slot) * 2048), 16, 0, 0); \
        __builtin_amdgcn_global_load_lds((const unsigned*)(E.vec_cols(u) + 4 * lane), (LAS unsigned*)(lds + VEC_LDS + (slot) * 2048 + 1024), 16, 0, 0); } } while (0)
    PG8_VEC(cur, 0);
    PG8_STAGE(PG8_SB(0, 0), cB, voffB); PG8_STAGE(PG8_SB(0, 1), cB + hstep, voffB); PG8_STAGE(PG8_SA(0, 0), cA, voffA); PG8_STAGE(PG8_SA(0, 1), cA + hstep, voffA);
    if (wr == 1) PG8_BAR;
    PG8_WAIT_V(2); PG8_BAR;
    PG8_STAGE(PG8_SB(1, 0), cB + kstep, voffB); PG8_STAGE(PG8_SA(1, 0), cA + kstep, voffA); PG8_STAGE(PG8_SB(1, 1), cB + hstep + kstep, voffB);
    PG8_WAIT_V(6); PG8_BAR;
    for (;;) {
        const bool has_next = S.next(ui + 1, nxt);
        const char* nA = has_next ? PG8_ABASE(nxt) : cA; const char* nB = has_next ? (const char*)g.Bt + (size_t)nxt.pn * tstep : cB;
        for (int t = 0; t < nt; t += 2) {
            const bool last = (t == nt - 2);
            const char* a1 = cA + (size_t)(t + 1) * kstep;
            const char* a2 = last ? nA : cA + (size_t)(t + 2) * kstep; const char* b2 = last ? nB : cB + (size_t)(t + 2) * kstep;
            const char* a3 = a2 + kstep; const char* b3 = b2 + kstep;
            PG8_LDB(B0, 0, 0); PG8_LDB(B1, 0, 1); PG8_SCHED; PG8_LDA(At, 0, 0); PG8_STAGE(PG8_SA(1, 1), a1 + hstep, voffA);
            PG8_WAIT_V(8); PG8_WAIT_L(0); PG8_BAR; PG8_MMA(0, 0, At, B0); PG8_MMA(0, 1, At, B1); PG8_BAR; PG8_SCHED;
            PG8_LDA(At, 0, 1); PG8_STAGE(PG8_SB(0, 0), b2, voffB); PG8_STAGE(PG8_SB(0, 1), b2 + hstep, voffB); PG8_STAGE(PG8_SA(0, 0), a2, voffA);
            PG8_WAIT_V(8); PG8_WAIT_L(0); PG8_BAR; PG8_MMA(1, 0, At, B0); PG8_MMA(1, 1, At, B1); PG8_BAR; PG8_SCHED;
            PG8_LDB(B0, 1, 0); PG8_LDB(B1, 1, 1); PG8_SCHED; PG8_LDA(At, 1, 0); PG8_STAGE(PG8_SA(0, 1), a2 + hstep, voffA);
            PG8_WAIT_V(8); PG8_WAIT_L(0); PG8_BAR; PG8_MMA(0, 0, At, B0); PG8_MMA(0, 1, At, B1); PG8_BAR; PG8_SCHED;
            PG8_LDA(At, 1, 1); PG8_STAGE(PG8_SB(1, 0), b3, voffB); PG8_STAGE(PG8_SB(1, 1), b3 + hstep, voffB); PG8_STAGE(PG8_SA(1, 0), a3, voffA);
            PG8_WAIT_V(8); PG8_WAIT_L(0); PG8_BAR; PG8_MMA(1, 0, At, B0); PG8_MMA(1, 1, At, B1); PG8_BAR; PG8_SCHED;
        }
        if (wr == 0) PG8_BAR;
        E(acc, cur, wr, wc, fr, fq, ui & 1);
        if (!has_next) break;
        PG8_VEC(nxt, (ui + 1) & 1);
#pragma unroll
        for (int a = 0; a < 2; ++a)
#pragma unroll
            for (int b = 0; b < 2; ++b)
#pragma unroll
                for (int m = 0; m < 4; ++m)
#pragma unroll
                    for (int n = 0; n < 2; ++n) acc[a][b][m][n] = (f32x4){0.f, 0.f, 0.f, 0.f};
        cur = nxt; cA = nA; cB = nB; ++ui;
        if (wr == 1) PG8_BAR;
    }
    PG8_WAIT_V(0);
    PG8_BAR;
#undef PG8_SA
#undef PG8_SB
#undef PG8_STAGE
#undef PG8_LDA
#undef PG8_LDB
#undef PG8_MMA
#undef PG8_WAIT_V
#undef PG8_WAIT_L
#undef PG8_BAR
#undef PG8_SCHED
#undef PG8_ABASE
#undef PG8_VEC
}

typedef f32x4 Acc[2][2][4][2];

struct EpiAin {
    static constexpr bool PERM = true, HAS_VEC = false;
    __device__ __forceinline__ const float* vec_rows(const Unit&) const { return nullptr; } __device__ __forceinline__ const float* vec_cols(const Unit&) const { return nullptr; }
    static constexpr bool HAS_PRE = false; struct Pre {};
    unsigned char* slab0;
    const float* conv_w;
    LAS unsigned char* lds;
    __device__ __forceinline__ void operator()(const Acc& acc, const Unit& u, int wr, int wc, int fr, int fq, int vslot) const {
        const int rip0 = wr * 64 + fr;
        const int row0 = (u.pm & 7) * BM + rip0;
        unsigned char* slab = slab0 + (size_t)(u.pm >> 3) * SLAB;
        bf16_t* V = (bf16_t*)(slab + SO_V);
        if (u.pn < 4) {
            bf16_t* Y = (bf16_t*)(slab + SO_Y); bf16_t* GBH = (bf16_t*)(slab + SO_GB) + (size_t)(u.pm & 7) * 2 * DM;
            const int col0 = u.pn * BM + wc * 32 + 8 * fq;
            {
                const int lane_ = threadIdx.x & 63, wid_ = __builtin_amdgcn_readfirstlane(threadIdx.x >> 6);
                asm volatile("s_waitcnt vmcnt(0)\n\ts_barrier" ::: "memory");
                const bf16_t* gsrc = V + ((size_t)((u.pm & 7) * BM) + 32 * wid_) * DM + u.pn * BM;
                const int rl_ = lane_ >> 5, cp_ = lane_ & 31;
                unsigned vo_[4];
#pragma unroll
                for (int k = 0; k < 4; ++k) vo_[k] = (unsigned)(rl_ * DM + ((cp_ ^ (((2 * k + rl_) & 7) << 2)) << 3));
#pragma unroll
                for (int i = 0; i < 16; ++i)
                    __builtin_amdgcn_global_load_lds((const unsigned*)((gsrc + (size_t)(2 * i) * DM) + vo_[i & 3]), (LAS unsigned*)(lds + (32 * wid_ + 2 * i) * 512), 16, 0, 0);
                asm volatile("s_waitcnt vmcnt(0)\n\ts_barrier" ::: "memory");
            }
            const LAS unsigned char* ldr = lds + rip0 * 512;
            int sw_[3];
#pragma unroll
            for (int k = 0; k < 3; ++k) sw_[k] = ((fr - k) & 7) << 2;
#pragma unroll
            for (int bj = 0; bj < 2; ++bj) { const int cw = col0 + bj * HALF; const int ch = 16 * bj + 4 * wc + fq;
                f32x4 w0[2], w1[2], w2[2];
#pragma unroll
                for (int n = 0; n < 2; ++n) { w0[n] = *(const f32x4*)(conv_w + cw + 4 * n); w1[n] = *(const f32x4*)(conv_w + DM + cw + 4 * n); w2[n] = *(const f32x4*)(conv_w + 2 * DM + cw + 4 * n); }
#pragma unroll
                for (int ai = 0; ai < 2; ++ai)
#pragma unroll
                    for (int m = 0; m < 4; ++m) { const int rip = rip0 + ai * HALF + m * 16;
                        const f32x4 g0 = acc[ai][bj][m][0], g1 = acc[ai][bj][m][1];
                        u32x4 w;
                        if (rip >= 2) {
                            const LAS unsigned char* rp = ldr + (ai * HALF + m * 16) * 512;
                            const u32x4 a = *(const LAS u32x4*)(rp + ((ch ^ sw_[0]) << 4)), b1 = *(const LAS u32x4*)(rp - 512 + ((ch ^ sw_[1]) << 4)), b2 = *(const LAS u32x4*)(rp - 1024 + ((ch ^ sw_[2]) << 4));
                            const f32x4 v0a = (f32x4){bf_lo(a.x), bf_hi(a.x), bf_lo(a.y), bf_hi(a.y)}, v0b = (f32x4){bf_lo(a.z), bf_hi(a.z), bf_lo(a.w), bf_hi(a.w)};
                            const f32x4 v1a = (f32x4){bf_lo(b1.x), bf_hi(b1.x), bf_lo(b1.y), bf_hi(b1.y)}, v1b = (f32x4){bf_lo(b1.z), bf_hi(b1.z), bf_lo(b1.w), bf_hi(b1.w)};
                            const f32x4 v2a = (f32x4){bf_lo(b2.x), bf_hi(b2.x), bf_lo(b2.y), bf_hi(b2.y)}, v2b = (f32x4){bf_lo(b2.z), bf_hi(b2.z), bf_lo(b2.w), bf_hi(b2.w)};
                            const f32x4 ya = g0 * (w2[0] * v0a + w1[0] * v1a + w0[0] * v2a), yb = g1 * (w2[1] * v0b + w1[1] * v1b + w0[1] * v2b);
                            w.x = cvtpk(ya[0], ya[1]); w.y = cvtpk(ya[2], ya[3]); w.z = cvtpk(yb[0], yb[1]); w.w = cvtpk(yb[2], yb[3]);
                            *(u32x4*)(Y + (size_t)(row0 + ai * HALF + m * 16) * DM + cw) = w;
                        } else {
                            w.x = cvtpk(g0[0], g0[1]); w.y = cvtpk(g0[2], g0[3]); w.z = cvtpk(g1[0], g1[1]); w.w = cvtpk(g1[2], g1[3]);
                            *(u32x4*)(GBH + (size_t)rip * DM + cw) = w;
                        } }
            }
        } else {
            const int col0 = (u.pn - 4) * HALF + wc * 32 + 8 * fq;
#pragma unroll
            for (int ai = 0; ai < 2; ++ai)
#pragma unroll
                for (int m = 0; m < 4; ++m) { bf16_t* rowp = V + (size_t)(row0 + ai * HALF + m * 16) * DM + col0;
                    const f32x4 v0 = acc[ai][0][m][0] * acc[ai][1][m][0], v1 = acc[ai][0][m][1] * acc[ai][1][m][1];
                    u32x4 w; w.x = cvtpk(v0[0], v0[1]); w.y = cvtpk(v0[2], v0[3]); w.z = cvtpk(v1[0], v1[1]); w.w = cvtpk(v1[2], v1[3]);
                    *(u32x4*)rowp = w; }
        }
    }
};

constexpr int RES_AUX = 2;
template <int NA, int INM, int OUTM> struct EpiRes {
    static constexpr bool PERM = true, HAS_VEC = false;
    __device__ __forceinline__ const float* vec_rows(const Unit&) const { return nullptr; } __device__ __forceinline__ const float* vec_cols(const Unit&) const { return nullptr; }
    const void* xin; void* xout; const float* gate; int gate_stride;
    const float* gain0; const float* sc0; int sc0_stride; bf16_t* A0;
    const float* gain1; const float* sc1; int sc1_stride; bf16_t* A1;
    float* sumsq;
    const float* gain_in; const float* sc_in; int sc_in_stride;
    LAS unsigned char* lds = nullptr;
    __device__ __forceinline__ void operator()(const Acc& acc, const Unit& u, int wr, int wc, int fr, int fq, int vslot) const {
        constexpr bool IN16 = INM != 0;
        const int b = u.pm >> 3;
        const int row0 = u.pm * BM + wr * 64 + fr, col0 = u.pn * BM + wc * 32 + 8 * fq;
        const size_t tbase = (size_t)u.pm * BM * DM + (size_t)u.pn * BM;
        const unsigned loff = (unsigned)((wr * 64 + fr) * DM + wc * 32 + 8 * fq);
        f32x4 gv[2][2], a0[2][2], a1[2][2], ia[2][2];
        constexpr int NH = IN16 ? 1 : 2, ROWB = IN16 ? 512 : 1024;
        const int lane_ = threadIdx.x & 63, wid_ = __builtin_amdgcn_readfirstlane(threadIdx.x >> 6);
        asm volatile("s_waitcnt vmcnt(0)\n\ts_barrier" ::: "memory");
#pragma unroll
        for (int hh = 0; hh < NH; ++hh) {
            if (hh > 0) asm volatile("s_waitcnt lgkmcnt(0)\n\ts_barrier" ::: "memory");
            if constexpr (IN16) {
                const bf16_t* gsrc = (const bf16_t*)xin + tbase + (size_t)(32 * wid_) * DM;
                const int rl_ = lane_ >> 5, cp_ = lane_ & 31;
                unsigned vo_[4];
#pragma unroll
                for (int k = 0; k < 4; ++k) vo_[k] = (unsigned)(rl_ * DM + ((cp_ ^ (((2 * k + rl_) & 7) << 2)) << 3));
#pragma unroll
                for (int i = 0; i < 16; ++i)
                    __builtin_amdgcn_global_load_lds((const unsigned*)((gsrc + (size_t)(2 * i) * DM) + vo_[i & 3]), (LAS unsigned*)(lds + (32 * wid_ + 2 * i) * 512), 16, 0, RES_AUX);
            } else {
                const float* gsrc = (const float*)xin + tbase + (size_t)(hh * HALF + 16 * wid_) * DM;
#pragma unroll 2
                for (int i = 0; i < 16; ++i)
                    __builtin_amdgcn_global_load_lds((const unsigned*)((gsrc + (size_t)i * DM) + (unsigned)((lane_ ^ i) << 2)), (LAS unsigned*)(lds + (16 * wid_ + i) * 1024), 16, 0, RES_AUX);
            }
            if (hh == 0) {
#pragma unroll
                for (int bj = 0; bj < 2; ++bj)
#pragma unroll
                    for (int n = 0; n < 2; ++n) { const int c = col0 + bj * HALF + 4 * n;
                        gv[bj][n] = *(const f32x4*)(gate + (size_t)b * gate_stride + c);
                        if (NA >= 1) a0[bj][n] = *(const f32x4*)(gain0 + c) * (*(const f32x4*)(sc0 + (size_t)b * sc0_stride + c) + 1.0f);
                        if (NA >= 2) a1[bj][n] = *(const f32x4*)(gain1 + c) * (*(const f32x4*)(sc1 + (size_t)b * sc1_stride + c) + 1.0f);
                        if (INM == 2) { const f32x4 t = *(const f32x4*)(gain_in + c) * (*(const f32x4*)(sc_in + (size_t)b * sc_in_stride + c) + 1.0f); ia[bj][n] = (f32x4){1.0f / t[0], 1.0f / t[1], 1.0f / t[2], 1.0f / t[3]}; } }
            }
            asm volatile("s_waitcnt vmcnt(0)\n\ts_barrier" ::: "memory");
            const LAS unsigned char* ldr = lds + (wr * 64 + fr) * ROWB;
#pragma unroll
            for (int qq = 0; qq < 8 / NH; ++qq) { const int q = hh * (8 / NH) + qq, ai = q >> 2, m = q & 3; const int row = row0 + ai * HALF + m * 16; const size_t off = tbase + (size_t)((ai * HALF + m * 16) * DM); float ss = 0.f;
#pragma unroll
                for (int bj = 0; bj < 2; ++bj) { const size_t o = off + bj * HALF;
                    f32x4 x0, x1;
                    if constexpr (IN16) { const u32x4 w = *(const LAS u32x4*)(ldr + (ai * HALF + m * 16) * 512 + (((16 * bj + 4 * wc + fq) ^ ((fr & 7) << 2)) << 4));
                        x0 = (f32x4){bf_lo(w.x), bf_hi(w.x), bf_lo(w.y), bf_hi(w.y)}; x1 = (f32x4){bf_lo(w.z), bf_hi(w.z), bf_lo(w.w), bf_hi(w.w)}; }
                    else { const int c0_ = 32 * bj + 8 * wc + 2 * fq; x0 = *(const LAS f32x4*)(ldr + (m * 16) * 1024 + ((c0_ ^ fr) << 4)); x1 = *(const LAS f32x4*)(ldr + (m * 16) * 1024 + (((c0_ + 1) ^ fr) << 4)); }
                    if (INM == 2) { x0 = x0 * ia[bj][0]; x1 = x1 * ia[bj][1]; }
                    x0 = x0 + gv[bj][0] * acc[ai][bj][m][0]; x1 = x1 + gv[bj][1] * acc[ai][bj][m][1];
                    if (OUTM == 0) {
                        f32x4 s0 = x0, s1 = x1;
#pragma unroll
                        for (int e = 0; e < 4; ++e) { auto rr = __builtin_amdgcn_permlane16_swap(__float_as_uint(s0[e]), __float_as_uint(s1[e]), false, false);
                            rr = __builtin_amdgcn_permlane32_swap(rr[0], rr[1], false, false); s0[e] = __uint_as_float(rr[0]); s1[e] = __uint_as_float(rr[1]); }
                        const int adj0 = -4 * fq, adj1 = 16 - 4 * fq;
                        *(f32x4*)(((float*)xout + o) + (loff + adj0)) = s0; *(f32x4*)(((float*)xout + o) + (loff + adj1)) = s1; }
                    if (NA >= 1) { ss += ((x0[0] * x0[0] + x0[1] * x0[1]) + (x0[2] * x0[2] + x0[3] * x0[3])) + ((x1[0] * x1[0] + x1[1] * x1[1]) + (x1[2] * x1[2] + x1[3] * x1[3]));
                        const f32x4 t0 = x0 * a0[bj][0], t1 = x1 * a0[bj][1]; u32x4 w; w.x = cvtpk(t0[0], t0[1]); w.y = cvtpk(t0[2], t0[3]); w.z = cvtpk(t1[0], t1[1]); w.w = cvtpk(t1[2], t1[3]); *(u32x4*)((A0 + o) + loff) = w; }
                    if (NA >= 2) { const f32x4 t0 = x0 * a1[bj][0], t1 = x1 * a1[bj][1]; u32x4 w; w.x = cvtpk(t0[0], t0[1]); w.y = cvtpk(t0[2], t0[3]); w.z = cvtpk(t1[0], t1[1]); w.w = cvtpk(t1[2], t1[3]); *(u32x4*)((A1 + o) + loff) = w; } }
                if (NA >= 1) { ss += __shfl_xor(ss, 16); ss += __shfl_xor(ss, 32); if (fq == 0) unsafeAtomicAdd(sumsq + row, ss); } }
        }
    }
};

struct EpiMlp1 {
    static constexpr bool PERM = true, HAS_VEC = true;
    bf16_t* H; const float* bias; const float* sumsq; LAS unsigned char* lds;
    __device__ __forceinline__ const float* vec_rows(const Unit& u) const { return sumsq + (size_t)u.pm * BM; }
    __device__ __forceinline__ const float* vec_cols(const Unit& u) const { return bias + (size_t)(u.pm >> 3) * FF + (size_t)u.pn * BM; }
    __device__ __forceinline__ void operator()(const Acc& acc, const Unit& u, int wr, int wc, int fr, int fq, int vslot) const {
        const int row0 = u.pm * BM + wr * 64 + fr, col0 = u.pn * BM + wc * 32 + 8 * fq;
        const LAS float* lv = (const LAS float*)(lds + VEC_LDS + vslot * 2048);
        f32x4 bv[2][2];
#pragma unroll
        for (int bj = 0; bj < 2; ++bj)
#pragma unroll
            for (int n = 0; n < 2; ++n) bv[bj][n] = *(const LAS f32x4*)(lv + 256 + bj * HALF + wc * 32 + 8 * fq + 4 * n);
        float ssv[8];
#pragma unroll
        for (int q = 0; q < 8; ++q) ssv[q] = lv[wr * 64 + fr + (q >> 2) * HALF + (q & 3) * 16];
        asm volatile("" : "+v"(ssv[0]), "+v"(ssv[1]), "+v"(ssv[2]), "+v"(ssv[3]), "+v"(ssv[4]), "+v"(ssv[5]), "+v"(ssv[6]), "+v"(ssv[7]));
#pragma unroll
        for (int ai = 0; ai < 2; ++ai)
#pragma unroll
            for (int m = 0; m < 4; ++m) { const int row = row0 + ai * HALF + m * 16; const float rs = rsqrtf(ssv[ai * 4 + m] * (1.0f / DM) + EPS);
                bf16_t* rowp = H + (size_t)row * FF + col0;
#pragma unroll
                for (int bj = 0; bj < 2; ++bj) { f32x4 v0 = acc[ai][bj][m][0] * rs + bv[bj][0], v1 = acc[ai][bj][m][1] * rs + bv[bj][1];
#pragma unroll
                    for (int e = 0; e < 4; ++e) { const float r0 = fmaxf(v0[e], 0.f), r1 = fmaxf(v1[e], 0.f); v0[e] = r0 * r0; v1[e] = r1 * r1; }
                    u32x4 w; w.x = cvtpk(v0[0], v0[1]); w.y = cvtpk(v0[2], v0[3]); w.z = cvtpk(v1[0], v1[1]); w.w = cvtpk(v1[2], v1[3]);
                    *(u32x4*)(rowp + bj * HALF) = w; } }
    }
};

struct EpiKVQ {
    static constexpr bool PERM = true, HAS_VEC = true;
    unsigned char* slab0; const float* bias; const float* sumsq; const float* k_gain; const float* q_gain; LAS unsigned char* lds;
    __device__ __forceinline__ const float* vec_rows(const Unit& u) const { return sumsq + (size_t)u.pm * BM; }
    __device__ __forceinline__ const float* vec_cols(const Unit& u) const { return bias + (size_t)(u.pm >> 3) * NKVQ + (size_t)u.pn * BM; }
    __device__ __forceinline__ void operator()(const Acc& acc, const Unit& u, int wr, int wc, int fr, int fq, int vslot) const {
        const int b = u.pm >> 3, pn = u.pn;
        const int row0 = u.pm * BM + wr * 64 + fr;
        unsigned char* slab = slab0 + (size_t)b * SLAB;
        bf16_t* KV = (bf16_t*)(slab + SO_KV); bf16_t* Q = (bf16_t*)(slab + SO_Q); float* gates = (float*)(slab + SO_GATES);
        const LAS float* lv = (const LAS float*)(lds + VEC_LDS + vslot * 2048);
        f32x4 bv[2][2];
#pragma unroll
        for (int bj = 0; bj < 2; ++bj)
#pragma unroll
            for (int n = 0; n < 2; ++n) bv[bj][n] = *(const LAS f32x4*)(lv + 256 + bj * HALF + wc * 32 + 8 * fq + 4 * n);
        float ssv[8];
#pragma unroll
        for (int q = 0; q < 8; ++q) ssv[q] = lv[wr * 64 + fr + (q >> 2) * HALF + (q & 3) * 16];
        asm volatile("" : "+v"(ssv[0]), "+v"(ssv[1]), "+v"(ssv[2]), "+v"(ssv[3]), "+v"(ssv[4]), "+v"(ssv[5]), "+v"(ssv[6]), "+v"(ssv[7]));
        if (pn == 10) {
            if (wc < 2) {
#pragma unroll
                for (int ai = 0; ai < 2; ++ai)
#pragma unroll
                    for (int m = 0; m < 4; ++m) { const int row = row0 + ai * HALF + m * 16; const float rs = rsqrtf(ssv[ai * 4 + m] * (1.0f / DM) + EPS);
#pragma unroll
                        for (int n = 0; n < 2; ++n) { const int c = wc * 32 + 8 * fq + 4 * n;
                            if (c < 48) { const f32x4 v = acc[ai][0][m][n] * rs + bv[0][n]; f32x4 o;
#pragma unroll
                                for (int e = 0; e < 4; ++e) o[e] = 1.0f / (1.0f + __expf(-v[e]));
                                *(f32x4*)(gates + (size_t)(row & (SEQ - 1)) * 48 + c) = o; } } }
            }
            return;
        }
        const bool is_q = pn >= 6;
        const bool do_norm = is_q || pn == 2 || pn == 4;
        f32x4 gn[2][2];
        { const float* gp = is_q ? q_gain : (k_gain + (pn == 2 ? 64 : 128)); const float sc = is_q ? QSCALE : 1.0f;
#pragma unroll
          for (int bj = 0; bj < 2; ++bj)
#pragma unroll
              for (int n = 0; n < 2; ++n) gn[bj][n] = do_norm ? *(const f32x4*)(gp + 32 * bj + 8 * fq + 4 * n) * sc : (f32x4){1.f, 1.f, 1.f, 1.f}; }
#pragma unroll
        for (int ai = 0; ai < 2; ++ai)
#pragma unroll
            for (int m = 0; m < 4; ++m) { const int row = row0 + ai * HALF + m * 16; const float rs = rsqrtf(ssv[ai * 4 + m] * (1.0f / DM) + EPS);
                f32x4 v[2][2]; float ss = 0.f;
#pragma unroll
                for (int bj = 0; bj < 2; ++bj)
#pragma unroll
                    for (int n = 0; n < 2; ++n) { v[bj][n] = acc[ai][bj][m][n] * rs + bv[bj][n]; const f32x4 t = v[bj][n]; ss += (t[0] * t[0] + t[1] * t[1]) + (t[2] * t[2] + t[3] * t[3]); }
                float hs = 1.0f;
                if (do_norm) { ss += __shfl_xor(ss, 16); ss += __shfl_xor(ss, 32); hs = rsqrtf(ss * (1.0f / 64.0f) + EPS); }
                bf16_t* rowp;
                if (is_q) rowp = Q + (size_t)(row & (SEQ - 1)) * DM + ((pn - 6) * 4 + wc) * 64 + 8 * fq;
                else rowp = KV + ((size_t)(pn * 4 + wc) * SEQ + (row & (SEQ - 1))) * 64 + 8 * fq;
#pragma unroll
                for (int bj = 0; bj < 2; ++bj) { const f32x4 v0 = v[bj][0] * hs * gn[bj][0], v1 = v[bj][1] * hs * gn[bj][1];
                    u32x4 w; w.x = cvtpk(v0[0], v0[1]); w.y = cvtpk(v0[2], v0[3]); w.z = cvtpk(v1[0], v1[1]); w.w = cvtpk(v1[2], v1[3]);
                    *(u32x4*)(rowp + 32 * bj) = w; } }
    }
};
}

namespace att {
constexpr int SLOTB = 8192;
constexpr int L_K = 0, L_V = 3 * SLOTB, L_WS = 6 * SLOTB, L_SEL = L_WS + 4096, L_NIB = L_SEL + 256, L_SC = L_NIB + 768, L_IA = L_SC + 8704, L_IB = L_IA + 33792, L_END = L_IB + 33792, L_OST = L_IA;
static_assert(L_END <= 131072 && (L_IA % 16) == 0 && (L_SC % 16) == 0, "attention LDS map");
#define SBAR() __builtin_amdgcn_sched_barrier(0)
#define ATT_WAIT_BAR(N) asm volatile("s_waitcnt vmcnt(" #N ") lgkmcnt(0)\n\ts_barrier" ::: "memory")
__device__ __forceinline__ int crow(int r, int hi) { return (r & 3) + 8 * (r >> 2) + 4 * hi; }
__device__ __forceinline__ void glds16(const void* gsrc, unsigned lds_dst) { unsigned keep;
    asm volatile("s_mov_b32 %0, m0\n\ts_mov_b32 m0, %2\n\ts_nop 0\n\tglobal_load_lds_dwordx4 %1, off\n\ts_mov_b32 m0, %0" : "=&s"(keep) : "v"(gsrc), "s"(lds_dst) : "memory"); }

__device__ __forceinline__ void qkt_c(f32x16& p0, f32x16& p1, const LAS unsigned char* Kslot, const bf16x8* qr, const f32x16& ci, int r32, int hi) {
    const LAS unsigned char* kb = Kslot + hi * 1024 + r32 * 16;
    bf16x8 kf[8];
#pragma unroll
    for (int i = 0; i < 8; ++i) kf[i] = *(const LAS bf16x8*)(kb + (i >> 1) * 2048 + (i & 1) * 512);
    asm volatile("" : "+v"(kf[0]), "+v"(kf[1]), "+v"(kf[2]), "+v"(kf[3]), "+v"(kf[4]), "+v"(kf[5]), "+v"(kf[6]), "+v"(kf[7]));
    p0 = __builtin_amdgcn_mfma_f32_32x32x16_bf16(kf[0], qr[0], ci, 0, 0, 0); p1 = __builtin_amdgcn_mfma_f32_32x32x16_bf16(kf[1], qr[0], ci, 0, 0, 0);
#pragma unroll
    for (int d0 = 1; d0 < 4; ++d0) { p0 = __builtin_amdgcn_mfma_f32_32x32x16_bf16(kf[2 * d0], qr[d0], p0, 0, 0, 0); p1 = __builtin_amdgcn_mfma_f32_32x32x16_bf16(kf[2 * d0 + 1], qr[d0], p1, 0, 0, 0); }
}
__device__ __forceinline__ void qkt(f32x16& p0, f32x16& p1, const LAS unsigned char* Kslot, const bf16x8* qr, int r32, int hi) {
    const LAS unsigned char* kb = Kslot + hi * 1024 + r32 * 16;
    bf16x8 kf[8];
#pragma unroll
    for (int i = 0; i < 8; ++i) kf[i] = *(const LAS bf16x8*)(kb + (i >> 1) * 2048 + (i & 1) * 512);
    asm volatile("" : "+v"(kf[0]), "+v"(kf[1]), "+v"(kf[2]), "+v"(kf[3]), "+v"(kf[4]), "+v"(kf[5]), "+v"(kf[6]), "+v"(kf[7]));
    const f32x16 z = f32x16{};
    p0 = __builtin_amdgcn_mfma_f32_32x32x16_bf16(kf[0], qr[0], z, 0, 0, 0); p1 = __builtin_amdgcn_mfma_f32_32x32x16_bf16(kf[1], qr[0], z, 0, 0, 0);
#pragma unroll
    for (int d0 = 1; d0 < 4; ++d0) { p0 = __builtin_amdgcn_mfma_f32_32x32x16_bf16(kf[2 * d0], qr[d0], p0, 0, 0, 0); p1 = __builtin_amdgcn_mfma_f32_32x32x16_bf16(kf[2 * d0 + 1], qr[d0], p1, 0, 0, 0); }
}
__device__ __forceinline__ void range_mask(f32x16& p0, f32x16& p1, int lo, int hv, int hi) {
    const int lo2 = lo - 4 * hi, hv2 = hv - 4 * hi;
#pragma unroll
    for (int r = 0; r < 16; ++r) { const int kc = (r & 3) + 8 * (r >> 2); if (kc < lo2 || kc > hv2) p0[r] = -INFINITY; if (kc + 32 < lo2 || kc + 32 > hv2) p1[r] = -INFINITY; }
}
__device__ __forceinline__ float max3f(float a, float b, float c) { float r; asm("v_max3_f32 %0, %1, %2, %3" : "=v"(r) : "v"(a), "v"(b), "v"(c)); return r; }
__device__ __forceinline__ float max2f(float a, float b) { float r; asm("v_max_f32_e32 %0, %1, %2" : "=v"(r) : "v"(a), "v"(b)); return r; }
__device__ __forceinline__ float rowmax(const f32x16& p0, const f32x16& p1) {
    float a = max3f(p0[0], p0[1], p1[0]), b = max3f(p0[2], p0[3], p1[1]); a = max3f(a, p1[2], p1[3]);
#pragma unroll
    for (int r = 4; r < 16; r += 4) { a = max3f(a, p0[r], p0[r + 1]); b = max3f(b, p0[r + 2], p0[r + 3]); a = max3f(a, p1[r], p1[r + 1]); b = max3f(b, p1[r + 2], p1[r + 3]); }
    const float m = max2f(a, b);
    auto rr = __builtin_amdgcn_permlane32_swap(__float_as_uint(m), __float_as_uint(m), false, false);
    return max2f(__uint_as_float(rr[0]), __uint_as_float(rr[1]));
}
__device__ __forceinline__ float halfsum(float a) {
    auto rr = __builtin_amdgcn_permlane32_swap(__float_as_uint(a), __float_as_uint(a), false, false);
    return __uint_as_float(rr[0]) + __uint_as_float(rr[1]);
}
__device__ __forceinline__ void pv(f32x16* o, int vb, bf16x8 pa0, bf16x8 pa1, bf16x8 pa2, bf16x8 pa3) {
    s16x4 lo[8], hi4[8];
#pragma unroll
    for (int q = 0; q < 8; ++q) {
        asm volatile("ds_read_b64_tr_b16 %0,%1 offset:%c2" : "=&v"(lo[q]) : "v"(vb), "i"((q >> 2) * 4096 + (q & 3) * 1024) : "memory");
        asm volatile("ds_read_b64_tr_b16 %0,%1 offset:%c2" : "=&v"(hi4[q]) : "v"(vb), "i"((q >> 2) * 4096 + (q & 3) * 1024 + 512) : "memory"); }
    asm volatile("s_waitcnt lgkmcnt(0)" ::: "memory"); SBAR();
#define PK(k) (bf16x8){lo[k][0], lo[k][1], lo[k][2], lo[k][3], hi4[k][0], hi4[k][1], hi4[k][2], hi4[k][3]}
    o[0] = __builtin_amdgcn_mfma_f32_32x32x16_bf16(pa0, PK(0), o[0], 0, 0, 0);
    o[1] = __builtin_amdgcn_mfma_f32_32x32x16_bf16(pa0, PK(4), o[1], 0, 0, 0);
    o[0] = __builtin_amdgcn_mfma_f32_32x32x16_bf16(pa1, PK(1), o[0], 0, 0, 0);
    o[1] = __builtin_amdgcn_mfma_f32_32x32x16_bf16(pa1, PK(5), o[1], 0, 0, 0);
    o[0] = __builtin_amdgcn_mfma_f32_32x32x16_bf16(pa2, PK(2), o[0], 0, 0, 0);
    o[1] = __builtin_amdgcn_mfma_f32_32x32x16_bf16(pa2, PK(6), o[1], 0, 0, 0);
    o[0] = __builtin_amdgcn_mfma_f32_32x32x16_bf16(pa3, PK(3), o[0], 0, 0, 0);
    o[1] = __builtin_amdgcn_mfma_f32_32x32x16_bf16(pa3, PK(7), o[1], 0, 0, 0);
#undef PK
}
__device__ __forceinline__ bf16x8 pack8(const f32x16& p, int base) {
    u32x4 w; w.x = cvtpk(p[base], p[base + 1]); w.y = cvtpk(p[base + 2], p[base + 3]); w.z = cvtpk(p[base + 4], p[base + 5]); w.w = cvtpk(p[base + 6], p[base + 7]);
    return __builtin_bit_cast(bf16x8, w);
}
__device__ __forceinline__ void row_bcast(float v, float (&out)[16], LAS float* wsf, int r32, int hi) {
    if (hi == 0) wsf[r32] = v;
#pragma unroll
    for (int i = 0; i < 4; ++i) { const f32x4 t = *(const LAS f32x4*)(wsf + 8 * i + 4 * hi); out[4 * i] = t[0]; out[4 * i + 1] = t[1]; out[4 * i + 2] = t[2]; out[4 * i + 3] = t[3]; }
}

struct Ctx {
    int lane, r32, hi, wid, ql, qb; unsigned lds0; LAS unsigned char* shm; LAS float* wsf; int koff, voff; unsigned kdst, vdst; int vb0;
};
__device__ __forceinline__ void dma_k(const Ctx& c, const bf16_t* base, int tile, int slot) { glds16(base + (size_t)tile * 4096 + c.koff, (unsigned)__builtin_amdgcn_readfirstlane(c.kdst + slot * SLOTB)); }
__device__ __forceinline__ void dma_v(const Ctx& c, const bf16_t* base, int tile, int slot) { glds16(base + (size_t)tile * 4096 + c.voff, (unsigned)__builtin_amdgcn_readfirstlane(c.vdst + slot * SLOTB)); }

constexpr float THR = 8.0f;
struct BrState { float mhat, l; f32x16 negm; f32x16 o[2]; };
__device__ __forceinline__ void br_reset(BrState& st) { st.mhat = 0.f; st.l = 0.f; st.negm = f32x16{}; st.o[0] = f32x16{}; st.o[1] = f32x16{}; }
__device__ __forceinline__ void stream_step(const Ctx& c, int slot, const bf16x8* qr, bool row_on, bool use_range, int lo, int hv, bool first, BrState& st) {
    f32x16 p0, p1;
    if (__any(!row_on)) { f32x16 ci;
#pragma unroll
        for (int r = 0; r < 16; ++r) ci[r] = row_on ? st.negm[r] : -INFINITY;
        qkt_c(p0, p1, c.shm + L_K + slot * SLOTB, qr, ci, c.r32, c.hi);
    } else qkt_c(p0, p1, c.shm + L_K + slot * SLOTB, qr, st.negm, c.r32, c.hi);
    if (use_range) range_mask(p0, p1, lo, hv, c.hi);
    const float rm = rowmax(p0, p1);
    if (first || __any(rm > THR)) {
        float dl = first ? rm : fmaxf(rm, 0.f);
        if (dl == -INFINITY) dl = 0.f;
        st.mhat += dl;
#pragma unroll
        for (int r = 0; r < 16; ++r) { p0[r] -= dl; p1[r] -= dl; st.negm[r] = -st.mhat; }
        if (!first) { const float f = __builtin_amdgcn_exp2f(-dl); st.l *= f; float al[16]; row_bcast(f, al, c.wsf, c.r32, c.hi);
#pragma unroll
            for (int r = 0; r < 16; ++r) { st.o[0][r] *= al[r]; st.o[1][r] *= al[r]; } }
    }
#pragma unroll
    for (int r = 0; r < 16; ++r) { p0[r] = __builtin_amdgcn_exp2f(p0[r]); p1[r] = __builtin_amdgcn_exp2f(p1[r]); }
    { const f32x16 sv = p0 + p1; st.l += ((sv[0] + sv[1]) + (sv[2] + sv[3])) + ((sv[4] + sv[5]) + (sv[6] + sv[7])) + ((sv[8] + sv[9]) + (sv[10] + sv[11])) + ((sv[12] + sv[13]) + (sv[14] + sv[15])); }
    pv(st.o, c.vb0 + slot * SLOTB, pack8(p0, 0), pack8(p0, 8), pack8(p1, 0), pack8(p1, 8));
}
struct Cursor { unsigned sm, wm; };
__device__ __forceinline__ int cur_pop(Cursor& k, int& br) {
    if (k.sm) { const int t = __builtin_ctz(k.sm); k.sm &= k.sm - 1u; br = 1; return t; }
    const int t = 31 - __builtin_clz(k.wm); k.wm &= ~(1u << t); br = 2; return t;
}

typedef __attribute__((address_space(3))) const char* lds_cptr;
typedef short v4i16_t __attribute__((ext_vector_type(4)));
__device__ __forceinline__ void kload8(bf16x8* kf, lds_cptr kp) {
    kf[0] = *(const LAS bf16x8*)(kp);        kf[1] = *(const LAS bf16x8*)(kp + 512);
    kf[2] = *(const LAS bf16x8*)(kp + 2048); kf[3] = *(const LAS bf16x8*)(kp + 2560);
    kf[4] = *(const LAS bf16x8*)(kp + 4096); kf[5] = *(const LAS bf16x8*)(kp + 4608);
    kf[6] = *(const LAS bf16x8*)(kp + 6144); kf[7] = *(const LAS bf16x8*)(kp + 6656);
}
__device__ __forceinline__ void kload2(bf16x8* kf, lds_cptr kp, int j) { kf[2 * j] = *(const LAS bf16x8*)(kp + j * 2048); kf[2 * j + 1] = *(const LAS bf16x8*)(kp + j * 2048 + 512); }
__device__ __forceinline__ s16x4 vtr(lds_cptr p) { return __builtin_bit_cast(s16x4, __builtin_amdgcn_ds_read_tr16_b64_v4i16((LAS v4i16_t*)p)); }
__device__ __forceinline__ float fadd_s(float a, float b) { float r; asm("v_add_f32_e32 %0, %1, %2" : "=v"(r) : "v"(a), "v"(b)); return r; }
__device__ __forceinline__ float fsub_s(float a, float b) { float r; asm("v_sub_f32_e32 %0, %1, %2" : "=v"(r) : "v"(a), "v"(b)); return r; }
template <int THRL>
__device__ __forceinline__ void sel_stream(const Ctx& c, const bf16_t* Kb, const bf16_t* Vb, const bf16x8* qr, unsigned msel, int qb, f32x16* o, float& l_out) {
  const int lane = c.lane, r32 = c.r32, hi = c.hi;
  LAS float* wsf = c.wsf;
  const lds_cptr shm3 = (lds_cptr)c.shm;
  const lds_cptr kp0 = shm3 + L_K + hi * 1024 + r32 * 16;
  const lds_cptr vp0 = shm3 + L_V + ((lane >> 4) & 1) * 32 + (lane & 3) * 8 + (4 * hi + ((lane & 15) >> 2)) * 64;
  const int NTr = qb + 1, NT = NTr < 4 ? 4 : ((NTr + 1) & ~1);
  #define WAIT_BAR(N) asm volatile("s_waitcnt vmcnt(" #N ") lgkmcnt(0)\n\ts_barrier":::"memory")
  #define TILE_OF(t) (((t) < NTr) ? (t) : qb)
  #define DMA_K(t, slotb) glds16(Kb + (size_t)TILE_OF(t) * 4096 + c.koff, (unsigned)__builtin_amdgcn_readfirstlane(c.kdst + (slotb)))
  #define DMA_V(t, slotb) glds16(Vb + (size_t)TILE_OF(t) * 4096 + c.voff, (unsigned)__builtin_amdgcn_readfirstlane(c.vdst + (slotb)))
  #define CMASK(P0, P1, t) do { const bool on_ = ((t) < NTr) && (((msel >> ((t) & 31)) & 1u) != 0u); \
      if (__any(!on_)) { const float ng_ = on_ ? 0.f : -INFINITY; _Pragma("unroll") for (int r = 0; r < 16; ++r) { P0[r] += ng_; P1[r] += ng_; } } \
      if ((t) == qb) range_mask(P0, P1, 0, c.ql, hi); } while (0)
  float mhat = 0.f, l_reg = 0.f; o[0] = f32x16{}; o[1] = f32x16{}; f32x16 negm = f32x16{}; asm volatile("" : "+v"(negm));
  bf16x8 kf[8];
  bool resc = false;
  #define START(P0,P1) do{ const float rm=rowmax(P0,P1); resc=false; \
    { const float dl=rm; mhat=fadd_s(mhat,dl); \
      _Pragma("unroll") for(int r=0;r<16;++r){P0[r]=fsub_s(P0[r],dl);P1[r]=fsub_s(P1[r],dl);} \
      _Pragma("unroll") for(int r=0;r<16;++r)negm[r]=-mhat; asm volatile("":"+v"(negm)); } \
    _Pragma("unroll") for(int r=0;r<16;++r)P0[r]=__builtin_amdgcn_exp2f(P0[r]); }while(0)
  #define RESC() do{ if(resc){ asm volatile("s_waitcnt lgkmcnt(0)":::"memory"); \
      _Pragma("unroll") for(int d_=0;d_<2;++d_) _Pragma("unroll") for(int r=0;r<16;++r)o[d_][r]*=wsf[crow(r,hi)]; } }while(0)
  f32x16 pA0,pA1,pB0,pB1;
  int sl_prev=SLOTB,sl_cur=2*SLOTB,sl_next=0;
  #define ROT() do{sl_prev=sl_cur;sl_cur=sl_next;sl_next=(sl_next==2*SLOTB)?0:sl_next+SLOTB;}while(0)
  DMA_K(1,0); DMA_K(2,SLOTB);
  { const f32x16 z = f32x16{}; qkt_c(pA0,pA1,c.shm+L_K+2*SLOTB,qr,z,r32,hi); }
  asm volatile("s_nop 15\n\ts_nop 7":"+v"(pA0),"+v"(pA1)); CMASK(pA0,pA1,0);
  START(pA0,pA1);
  _Pragma("unroll") for(int r=0;r<16;++r)pA1[r]=__builtin_amdgcn_exp2f(pA1[r]);
  WAIT_BAR(0);
  DMA_K(3,2*SLOTB);DMA_V(1,0);
  ROT();
  kload8(kf,kp0+sl_cur);
  WAIT_BAR(2);
  s16x4 vlo[8],vhi[8]; u32x4 pw0,pw1,pw2,pw3;
  #define PKW(P,B) cvtpk(P[B],P[B+1])
  #define PAF(k) __builtin_bit_cast(bf16x8,pw##k)
  #define VFR(i) (bf16x8){vlo[i][0],vlo[i][1],vlo[i][2],vlo[i][3],vhi[i][0],vhi[i][1],vhi[i][2],vhi[i][3]}
  #define PIN(x) asm volatile("":"+v"(x))
  #define MX3(a,b,c) __builtin_fmaxf(__builtin_fmaxf((a),(b)),(c))
  #define GAPA(MF,A0,A1,A2,A3,W0,W1,PW) do{ MF; sacc+=A0; sacc+=A1; sacc+=A2; sacc+=A3; PIN(sacc); W0; W1; PIN(PW); SBAR(); }while(0)
  #define EX(v) __builtin_amdgcn_exp2f(v)
  #define GAPB(MF,X,B) do{ MF; X[B]=EX(X[B]); X[B+1]=EX(X[B+1]); X[B+2]=EX(X[B+2]); X[B+3]=EX(X[B+3]); PIN(X); SBAR(); }while(0)
  #define VRD(i) do{ vlo[i]=vtr(vp_+(((i)>>2)*4096+((i)&3)*1024)); vhi[i]=vtr(vp_+(((i)>>2)*4096+((i)&3)*1024+512)); }while(0)
  #define KRD(G,j) do{ if(G){ kload2(kf,kp0+sl_next,j); SBAR(); } }while(0)
  #define STEP(C0,C1,P0,P1,t,GK,GV,GL) do{ SBAR(); \
    const lds_cptr vp_=vp0+sl_prev; \
    VRD(0); SBAR(); float sacc=(P0[0]+P0[1]); \
    GAPA(C0=__builtin_amdgcn_mfma_f32_32x32x16_bf16(kf[0],qr[0],negm,0,0,0), P0[2],P0[3],P0[4],P0[5],     pw0[0]=PKW(P0,0), pw0[1]=PKW(P0,2), pw0); \
    VRD(4); SBAR(); GAPA(C1=__builtin_amdgcn_mfma_f32_32x32x16_bf16(kf[1],qr[0],negm,0,0,0), P0[6],P0[7],P0[8],P0[9],     pw0[2]=PKW(P0,4), pw0[3]=PKW(P0,6), pw0); \
    VRD(1); SBAR(); GAPA(C0=__builtin_amdgcn_mfma_f32_32x32x16_bf16(kf[2],qr[1],C0,0,0,0),   P0[10],P0[11],P0[12],P0[13], pw1[0]=PKW(P0,8), pw1[1]=PKW(P0,10), pw1); \
    VRD(5); SBAR(); GAPA(C1=__builtin_amdgcn_mfma_f32_32x32x16_bf16(kf[3],qr[1],C1,0,0,0),   P0[14],P0[15],P1[0],P1[1],   pw1[2]=PKW(P0,12),pw1[3]=PKW(P0,14), pw1); \
    VRD(2); SBAR(); GAPA(C0=__builtin_amdgcn_mfma_f32_32x32x16_bf16(kf[4],qr[2],C0,0,0,0),   P1[2],P1[3],P1[4],P1[5],     pw2[0]=PKW(P1,0), pw2[1]=PKW(P1,2), pw2); \
    VRD(6); SBAR(); GAPA(C1=__builtin_amdgcn_mfma_f32_32x32x16_bf16(kf[5],qr[2],C1,0,0,0),   P1[6],P1[7],P1[8],P1[9],     pw2[2]=PKW(P1,4), pw2[3]=PKW(P1,6), pw2); \
    VRD(3); SBAR(); GAPA(C0=__builtin_amdgcn_mfma_f32_32x32x16_bf16(kf[6],qr[3],C0,0,0,0),   P1[10],P1[11],P1[12],P1[13], pw3[0]=PKW(P1,8), pw3[1]=PKW(P1,10), pw3); \
    VRD(7); SBAR(); GAPA(C1=__builtin_amdgcn_mfma_f32_32x32x16_bf16(kf[7],qr[3],C1,0,0,0),   P1[14],P1[15],0.f,0.f,       pw3[2]=PKW(P1,12),pw3[3]=PKW(P1,14), pw3); \
    l_reg+=sacc; \
    if(GK){DMA_K((t)+3,sl_cur);} if(GV){DMA_V((t)+1,sl_next);} \
    CMASK(C0,C1,t); \
    { float a=MX3(C0[0],C0[1],C1[0]),b=MX3(C0[2],C0[3],C1[1]); a=MX3(a,C1[2],C1[3]); \
      _Pragma("unroll") for(int r=4;r<16;r+=4){a=MX3(a,C0[r],C0[r+1]);b=MX3(b,C0[r+2],C0[r+3]);a=MX3(a,C1[r],C1[r+1]);b=MX3(b,C1[r+2],C1[r+3]);} \
      float rm=__builtin_fmaxf(a,b); { auto rr=__builtin_amdgcn_permlane32_swap(__float_as_uint(rm),__float_as_uint(rm),false,false); rm=__builtin_fmaxf(__uint_as_float(rr[0]),__uint_as_float(rr[1])); } \
      resc=false; \
      if(__builtin_expect(__any(rm>(float)THRL),0)){ const float dl=__builtin_fmaxf(rm,0.f); mhat+=dl; \
        _Pragma("unroll") for(int r=0;r<16;++r){C0[r]-=dl;C1[r]-=dl;} \
        _Pragma("unroll") for(int r=0;r<16;++r)negm[r]=-mhat; asm volatile("":"+v"(negm)); \
        const float f=__builtin_amdgcn_exp2f(-dl); l_reg*=f; if(hi==0)wsf[r32]=f; resc=true; } } \
    SBAR(); \
    GAPB(o[0]=__builtin_amdgcn_mfma_f32_32x32x16_bf16(PAF(0),VFR(0),o[0],0,0,0), C0,0); \
    GAPB(o[1]=__builtin_amdgcn_mfma_f32_32x32x16_bf16(PAF(0),VFR(4),o[1],0,0,0), C0,4); \
    KRD(GL,0); GAPB(o[0]=__builtin_amdgcn_mfma_f32_32x32x16_bf16(PAF(1),VFR(1),o[0],0,0,0), C0,8); \
    KRD(GL,1); GAPB(o[1]=__builtin_amdgcn_mfma_f32_32x32x16_bf16(PAF(1),VFR(5),o[1],0,0,0), C0,12); \
    KRD(GL,2); GAPB(o[0]=__builtin_amdgcn_mfma_f32_32x32x16_bf16(PAF(2),VFR(2),o[0],0,0,0), C1,0); \
    KRD(GL,3); GAPB(o[1]=__builtin_amdgcn_mfma_f32_32x32x16_bf16(PAF(2),VFR(6),o[1],0,0,0), C1,4); \
    GAPB(o[0]=__builtin_amdgcn_mfma_f32_32x32x16_bf16(PAF(3),VFR(3),o[0],0,0,0), C1,8); \
    GAPB(o[1]=__builtin_amdgcn_mfma_f32_32x32x16_bf16(PAF(3),VFR(7),o[1],0,0,0), C1,12); \
    }while(0)
  #define ENDW(tt) do{ if((tt)+3<NT){WAIT_BAR(2);} else if((tt)+2<NT){WAIT_BAR(1);} else {WAIT_BAR(0);} }while(0)
  int t=1;
  for(;t+1<NT;t+=2){
    STEP(pB0,pB1,pA0,pA1,t,(t+3<NT),(t+1<NT),(t+1<NT));       ENDW(t);   RESC(); ROT();
    STEP(pA0,pA1,pB0,pB1,t+1,(t+4<NT),(t+2<NT),(t+2<NT));     ENDW(t+1); RESC(); ROT();
  }
  STEP(pB0,pB1,pA0,pA1,NT-1,false,false,false); RESC();
  { float sacc=pB0[0]+pB0[1]; _Pragma("unroll") for(int r=2;r<16;++r)sacc+=pB0[r]; _Pragma("unroll") for(int r=0;r<16;++r)sacc+=pB1[r]; l_reg+=sacc;
    SBAR(); pv(o, c.vb0 + sl_cur, pack8(pB0,0), pack8(pB0,8), pack8(pB1,0), pack8(pB1,8)); }
  l_out = l_reg;
  asm volatile("s_waitcnt lgkmcnt(0)\n\ts_barrier":::"memory");
  #undef WAIT_BAR
  #undef TILE_OF
  #undef DMA_K
  #undef DMA_V
  #undef CMASK
  #undef START
  #undef RESC
  #undef ROT
  #undef PKW
  #undef PAF
  #undef VFR
  #undef PIN
  #undef MX3
  #undef GAPA
  #undef EX
  #undef GAPB
  #undef VRD
  #undef KRD
  #undef STEP
  #undef ENDW
}

__device__ __forceinline__ void attn_unit(int b, int g, int qb, unsigned char* slab, LAS unsigned char* shm) {
    const bf16_t* Q = (const bf16_t*)(slab + SO_Q); const bf16_t* KV = (const bf16_t*)(slab + SO_KV); const bf16_t* KC = (const bf16_t*)(slab + SO_KC); const bf16_t* VC = (const bf16_t*)(slab + SO_VC);
    const float* gates = (const float*)(slab + SO_GATES); bf16_t* O = (bf16_t*)(slab + SO_O);
    Ctx c;
    const int tid = threadIdx.x;
    c.lane = tid & 63; c.r32 = c.lane & 31; c.hi = c.lane >> 5; c.wid = __builtin_amdgcn_readfirstlane(tid >> 6);
    const int kh = c.wid >> 1, qh = c.wid & 1, head = g * 4 + kh;
    c.ql = qh * 32 + c.r32; c.qb = qb; c.shm = shm; c.lds0 = (unsigned)(size_t)shm;
    c.wsf = (LAS float*)(shm + L_WS) + c.wid * 128;
    c.koff = c.lane * 64 + c.wid * 8;
    c.voff = (16 * (c.wid & 3) + (c.lane >> 2)) * 64 + (c.wid >> 2) * 32 + (c.lane & 3) * 8;
    c.kdst = c.lds0 + L_K + c.wid * 1024; c.vdst = c.lds0 + L_V + c.wid * 1024;
    c.vb0 = (int)(c.lds0 + L_V) + ((c.lane >> 4) & 1) * 32 + (c.lane & 3) * 8 + (4 * c.hi + ((c.lane & 15) >> 2)) * 64;
    const int t = qb * 64 + c.ql;
    const size_t mrow = (size_t)t;
    const size_t bg = (size_t)g;
    const bf16_t* KSb = KV + ((size_t)2 * 4 + g) * (SEQ * 64);
    const bf16_t* VSb = KV + ((size_t)3 * 4 + g) * (SEQ * 64);
    const bf16_t* KWb = KV + ((size_t)4 * 4 + g) * (SEQ * 64);
    const bf16_t* VWb = KV + ((size_t)5 * 4 + g) * (SEQ * 64);
    const bf16_t* KCb = KC + bg * 8192; const bf16_t* VCb = VC + bg * 8192;
    dma_k(c, KCb, 0, 0); dma_k(c, KCb, 1, 1); dma_v(c, VCb, 0, 0); dma_v(c, VCb, 1, 1);
    dma_k(c, KSb, 0, 2); dma_v(c, VSb, 0, 2);
    bf16x8 qr[4];
    { const bf16_t* Qw = Q + mrow * DM + head * 64 + c.hi * 8;
#pragma unroll
      for (int d0 = 0; d0 < 4; ++d0) qr[d0] = *(const bf16x8*)(Qw + d0 * 16); }
    const float* gp = gates + mrow * 48 + head * 3;
    const float g0 = gp[0], g1 = gp[1], g2 = gp[2];
    f32x16 ot[2];
    f32x16 o[2];
    const bool two = qb >= 16;
    ATT_WAIT_BAR(2);
    {
        f32x16 a0, a1, b0, b1;
        qkt(a0, a1, shm + L_K, qr, c.r32, c.hi);
        const int nmax = (t >= 31) ? ((t - 31) >> 4) : -1;
        range_mask(a0, a1, 0, nmax, c.hi);
        float rm = rowmax(a0, a1);
        if (two) { qkt(b0, b1, shm + L_K + SLOTB, qr, c.r32, c.hi); range_mask(b0, b1, 0, nmax - 64, c.hi); rm = fmaxf(rm, rowmax(b0, b1)); }
        const float mu = (rm == -INFINITY) ? 0.f : rm;
        float s = 0.f;
#pragma unroll
        for (int r = 0; r < 16; ++r) { a0[r] = __builtin_amdgcn_exp2f(a0[r] - mu); a1[r] = __builtin_amdgcn_exp2f(a1[r] - mu); s += a0[r] + a1[r]; }
        if (two) {
#pragma unroll
            for (int r = 0; r < 16; ++r) { b0[r] = __builtin_amdgcn_exp2f(b0[r] - mu); b1[r] = __builtin_amdgcn_exp2f(b1[r] - mu); s += b0[r] + b1[r]; }
        }
        s = halfsum(s);
        const float inv = (s > 0.f) ? 1.0f / s : 0.f;
#pragma unroll
        for (int r = 0; r < 16; ++r) { a0[r] *= inv; a1[r] *= inv; }
        if (two) {
#pragma unroll
            for (int r = 0; r < 16; ++r) { b0[r] *= inv; b1[r] *= inv; }
            int qlx = c.ql; LAUNDER(qlx);
            LAS float* IA = (LAS float*)(shm + L_IA) + (kh * 64 + qlx) * 33;
            LAS float* IB = (LAS float*)(shm + L_IB) + (kh * 64 + qlx) * 33;
#pragma unroll
            for (int i = 0; i < 4; ++i) {
                const int j = 2 * i + c.hi;
                IA[j]      = a0[4 * i] + a0[4 * i + 1] + a0[4 * i + 2] + 0.5f * a0[4 * i + 3]; IB[j + 1]  = 0.5f * a0[4 * i + 3];
                IA[j + 8]  = a1[4 * i] + a1[4 * i + 1] + a1[4 * i + 2] + 0.5f * a1[4 * i + 3]; IB[j + 9]  = 0.5f * a1[4 * i + 3];
                IA[j + 16] = b0[4 * i] + b0[4 * i + 1] + b0[4 * i + 2] + 0.5f * b0[4 * i + 3]; IB[j + 17] = 0.5f * b0[4 * i + 3];
                IA[j + 24] = b1[4 * i] + b1[4 * i + 1] + b1[4 * i + 2] + 0.5f * b1[4 * i + 3]; IB[j + 25] = 0.5f * b1[4 * i + 3];
            }
        }
        o[0] = f32x16{}; o[1] = f32x16{};
        pv(o, c.vb0, pack8(a0, 0), pack8(a0, 8), pack8(a1, 0), pack8(a1, 8));
        if (two) pv(o, c.vb0 + SLOTB, pack8(b0, 0), pack8(b0, 8), pack8(b1, 0), pack8(b1, 8));
        float cf[16]; row_bcast(g0, cf, c.wsf, c.r32, c.hi);
#pragma unroll
        for (int r = 0; r < 16; ++r) { ot[0][r] = o[0][r] * cf[r]; ot[1][r] = o[1][r] * cf[r]; }
    }
    ATT_WAIT_BAR(0);
    LAS unsigned* SEL = (LAS unsigned*)(shm + L_SEL);
    if (two) {
        int q = tid & 63, jg = tid >> 6; LAUNDER(q); LAUNDER(jg);
        LAS float* SC = (LAS float*)(shm + L_SC);
        const LAS float* IA = (const LAS float*)(shm + L_IA); const LAS float* IB = (const LAS float*)(shm + L_IB);
#pragma unroll
        for (int jj = 0; jj < 4; ++jj) { const int j = 4 * jg + jj; float sc = 0.f;
#pragma unroll
            for (int k = 0; k < 4; ++k) { sc += IA[(k * 64 + q) * 33 + j]; if (j > 0) sc += IB[(k * 64 + q) * 33 + j]; }
            const bool forced = (j == 0) || (j == qb) || (j == qb - 1);
            SC[q * 33 + j] = forced ? 1e30f : ((j <= qb) ? sc : -1e30f); }
        ATT_WAIT_BAR(0);
        unsigned nib = 0u;
        float sj[4];
#pragma unroll
        for (int jj = 0; jj < 4; ++jj) sj[jj] = SC[q * 33 + 4 * jg + jj];
        int rank[4] = {0, 0, 0, 0};
        for (int i = 0; i < 32; ++i) { const float si = SC[q * 33 + i];
#pragma unroll
            for (int jj = 0; jj < 4; ++jj) { const int j = 4 * jg + jj; rank[jj] += (si > sj[jj] || (si == sj[jj] && i < j)) ? 1 : 0; } }
#pragma unroll
        for (int jj = 0; jj < 4; ++jj) nib |= (rank[jj] < 16 ? 1u : 0u) << jj;
        ((LAS unsigned char*)(shm + L_NIB))[q * 8 + jg] = (unsigned char)nib;
        ATT_WAIT_BAR(0);
        if (tid < 64) { unsigned mk = 0u; int tq = tid; LAUNDER(tq);
#pragma unroll
            for (int k = 0; k < 8; ++k) mk |= (unsigned)((LAS unsigned char*)(shm + L_NIB))[tq * 8 + k] << (4 * k);
            SEL[tq] = mk; }
        ATT_WAIT_BAR(0);
    } else {
        if (tid < 64) SEL[tid] = (1u << (qb + 1)) - 1u;
        ATT_WAIT_BAR(0);
    }
    int lnx = c.lane, qlx2 = c.ql; LAUNDER(lnx); LAUNDER(qlx2);
    LAS float* accp = (LAS float*)(shm + L_IA) + c.wid * 2048 + lnx;
#pragma unroll
    for (int r = 0; r < 16; ++r) { accp[r * 64] = ot[0][r]; accp[(16 + r) * 64] = ot[1][r]; }
    unsigned um = SEL[lnx];
#pragma unroll
    for (int sft = 1; sft < 64; sft <<= 1) um |= (unsigned)__shfl_xor((int)um, sft);
    um = (unsigned)__builtin_amdgcn_readfirstlane((int)um);
    um &= (qb == 31) ? 0xffffffffu : ((1u << (qb + 1)) - 1u);
    const unsigned msel = SEL[qlx2];
    (void)um;
    {
        float l_sel; f32x16 osel[2];
        sel_stream<8>(c, KSb, VSb, qr, msel, qb, osel, l_sel);
        const float lt = halfsum(l_sel);
        float cf[16]; row_bcast((lt > 0.f) ? g1 / lt : 0.f, cf, c.wsf, c.r32, c.hi);
#pragma unroll
        for (int r = 0; r < 16; ++r) { accp[r * 64] += osel[0][r] * cf[r]; accp[(16 + r) * 64] += osel[1][r] * cf[r]; }
    }
    {
        const int lo_t = qb >= 8 ? qb - 8 : 0, nw = qb - lo_t + 1;
        dma_k(c, KWb, qb, 0); dma_v(c, VWb, qb, 0);
        if (nw > 1) { dma_k(c, KWb, qb - 1, 1); dma_v(c, VWb, qb - 1, 1); }
        BrState st; br_reset(st);
        int slot = 0;
        for (int j = 0; j < nw; ++j) {
            if (j + 1 < nw) ATT_WAIT_BAR(2); else ATT_WAIT_BAR(0);
            if (j + 2 < nw) { const int ps = (slot == 0) ? 2 : slot - 1; dma_k(c, KWb, qb - j - 2, ps); dma_v(c, VWb, qb - j - 2, ps); }
            const int tc = qb - j;
            bool use_range = false; int lo = 0, hv = 63;
            if (j == 0) { use_range = true; hv = c.ql; }
            else if (tc == qb - 8) { use_range = true; lo = c.ql + 1; }
            stream_step(c, slot, qr, true, use_range, lo, hv, j == 0, st);
            slot = (slot == 2) ? 0 : slot + 1;
        }
        const float lt = halfsum(st.l);
        float cf[16]; row_bcast((lt > 0.f) ? g2 / lt : 0.f, cf, c.wsf, c.r32, c.hi);
#pragma unroll
        for (int r = 0; r < 16; ++r) { ot[0][r] = accp[r * 64] + st.o[0][r] * cf[r]; ot[1][r] = accp[(16 + r) * 64] + st.o[1][r] * cf[r]; }
        LDS_WAIT();
    }
    {
        LAS bf16_t* stg = (LAS bf16_t*)(shm + L_IA) + c.wid * 4096;
        int lny = c.lane; LAUNDER(lny);
        LAS bf16_t* stw = stg + ((lny >> 5) * 4) * 64 + (lny & 31);
#pragma unroll
        for (int r = 0; r < 16; ++r) { const int orow = (r & 3) + 8 * (r >> 2);
#pragma unroll
            for (int d0 = 0; d0 < 2; ++d0) stw[orow * 64 + d0 * 32] = (bf16_t)(cvtpk(ot[d0][r], 0.f) & 0xffffu); }
        LDS_WAIT();
        bf16_t* Ow = O + ((size_t)qb * 64 + qh * 32) * DM + head * 64;
#pragma unroll
        for (int i = 0; i < 4; ++i) { const int row = i * 8 + (lny >> 3), chn = lny & 7; const u32x4 v = *(const LAS u32x4*)(stg + row * 64 + chn * 8); *(u32x4*)(Ow + (size_t)row * DM + chn * 8) = v; }
    }
    ATT_WAIT_BAR(0);
}
#undef SBAR
}

#define XB_TMO      128
#define XB_XCNT(j)  (256  + 64 * (j))
#define XB_XSUB(j)  (1280 + 64 * (j))
#define XB_XGEN(j)  (2304 + 64 * (j))
#define XB_TOP      3328
#define XB_TOPGEN   3392
#define XB_LSUB(j)  (3456 + 64 * (j))
#define XB_LGEN(j)  (4480 + 64 * (j))
#define XCD_BAR_WORDS 5504
#define XB_SPIN_CAP (1u << 18)
__device__ __forceinline__ unsigned xb_ld(unsigned* p)              { return __hip_atomic_load(p, __ATOMIC_RELAXED, __HIP_MEMORY_SCOPE_AGENT); }
__device__ __forceinline__ unsigned xb_add(unsigned* p, unsigned v) { return __hip_atomic_fetch_add(p, v, __ATOMIC_RELAXED, __HIP_MEMORY_SCOPE_AGENT); }
__device__ __forceinline__ unsigned xb_xcc_id() { return (unsigned)__builtin_amdgcn_s_getreg((3 << 11) | 20) & 0xFu; }
#define XB_SPIN(cond, bar) do { unsigned _sp = 0; while (cond) { __builtin_amdgcn_s_sleep(1); \
    if ((++_sp & 255u) == 0u) { if (xb_ld(&(bar)[XB_TMO])) break; if (_sp > XB_SPIN_CAP) { atomicAdd(&(bar)[XB_TMO], 1u); break; } } } } while (0)
struct XcdBarrier { unsigned* bar; unsigned x; volatile LAS unsigned* st; };
__device__ __forceinline__ XcdBarrier xcd_barrier_post(unsigned* bar, volatile LAS unsigned* st) {
    XcdBarrier b; b.bar = bar; b.x = xb_xcc_id(); b.st = st;
    if (threadIdx.x == 0) { st[2] = xb_add(&bar[XB_XCNT(b.x)], 1u); st[4] = b.x; }
    return b;
}
__device__ __forceinline__ void xcd_barrier_complete(unsigned* bar, unsigned x, unsigned& nloc, unsigned& nx, unsigned& uniform) {
    const unsigned G = gridDim.x * gridDim.y * gridDim.z;
    unsigned sum, cnt, mine, sp = 0u, uni;
    for (;;) {
        sum = 0u; cnt = 0u; mine = 0u; uni = 1u;
#pragma unroll
        for (unsigned j = 0; j < 16; ++j) { const unsigned c = xb_ld(&bar[XB_XCNT(j)]); sum += c; cnt += (c > 0u) ? 1u : 0u; mine = (j == x) ? c : mine;
            if (j < 8u ? (c != 32u) : (c != 0u)) uni = 0u; }
        if (sum == G) break;
        __builtin_amdgcn_s_sleep(1);
        if ((++sp & 255u) == 0u) { if (xb_ld(&bar[XB_TMO])) break; if (sp > XB_SPIN_CAP) { atomicAdd(&bar[XB_TMO], 1u); break; } }
    }
    nloc = mine > 0u ? mine : 1u; nx = cnt > 0u ? cnt : 1u;
    uniform = (uni != 0u && sum == G && G == 256u) ? 1u : 0u;
}
__device__ __forceinline__ void xcd_barrier(const XcdBarrier& b) {
    asm volatile("s_waitcnt vmcnt(0)" ::: "memory");
    __syncthreads();
    if (threadIdx.x == 0) {
        unsigned* bar = b.bar;
        __builtin_amdgcn_s_waitcnt(0);
        unsigned nloc = b.st[0], nx = b.st[1];
        if (nloc == 0u) { unsigned uf; xcd_barrier_complete(bar, b.x, nloc, nx, uf); b.st[0] = nloc; b.st[1] = nx; b.st[3] = uf; }
        const unsigned old = xb_add(&bar[XB_XSUB(b.x)], 1u);
        const unsigned gen = old / nloc;
        if (old + 1u == (gen + 1u) * nloc) {
            __builtin_amdgcn_fence(__ATOMIC_RELEASE, "agent");
            asm volatile("s_waitcnt vmcnt(0)" ::: "memory");
            const unsigned og = xb_add(&bar[XB_TOP], 1u);
            const unsigned tg = og / nx;
            if (og + 1u == (tg + 1u) * nx) xb_add(&bar[XB_TOPGEN], 1u);
            else XB_SPIN(xb_ld(&bar[XB_TOPGEN]) == tg, bar);
            __builtin_amdgcn_fence(__ATOMIC_ACQUIRE, "agent");
            xb_add(&bar[XB_XGEN(b.x)], 1u);
            asm volatile("s_waitcnt vmcnt(0)" ::: "memory");
        } else {
            XB_SPIN(xb_ld(&bar[XB_XGEN(b.x)]) == gen, bar);
            __builtin_amdgcn_fence(__ATOMIC_ACQUIRE, "agent");
            asm volatile("s_waitcnt vmcnt(0)" ::: "memory");
        }
    }
    __syncthreads();
}

__device__ __forceinline__ void xcd_local_barrier(const XcdBarrier& b) {
    asm volatile("s_waitcnt vmcnt(0)" ::: "memory");
    __syncthreads();
    if (threadIdx.x == 0) {
        unsigned* bar = b.bar;
        __builtin_amdgcn_s_waitcnt(0);
        const unsigned nloc = b.st[0];
        const unsigned old = xb_add(&bar[XB_LSUB(b.x)], 1u);
        const unsigned gen = old / nloc;
        if (old + 1u == (gen + 1u) * nloc) xb_add(&bar[XB_LGEN(b.x)], 1u);
        else XB_SPIN(xb_ld(&bar[XB_LGEN(b.x)]) == gen, bar);
        __builtin_amdgcn_fence(__ATOMIC_ACQUIRE, "agent");
        asm volatile("s_waitcnt vmcnt(0)" ::: "memory");
    }
    __syncthreads();
}

struct Args {
    const float *x, *c, *norm_gain, *w_ada, *b_ada, *w_a_in, *conv_w, *w_a_out, *w_qg, *q_gain, *w_o, *kv_norm_gain, *w_ada_kv, *b_ada_kv, *w_kv, *k_gain, *cmp_pe, *cmp_w1, *cmp_w2, *w_mlp1, *w_mlp2;
    float* out; unsigned char* ws; int ph_lo, ph_hi;
};

__device__ __forceinline__ void transpose_item(const float* W, int ldn, int srccol, int nvalid, int k0, bf16_t* WT, int Kd, int drow0, LAS float* scr, int lane) {
    if (nvalid == 32) {
        f32x4 t[8];
#pragma unroll
        for (int i = 0; i < 8; ++i) t[i] = __builtin_nontemporal_load((const f32x4*)(W + (size_t)(k0 + 8 * i + (lane >> 3)) * ldn + srccol + (lane & 7) * 4));
#pragma unroll
        for (int i = 0; i < 8; ++i) { LAS float* d = scr + (8 * i + (lane >> 3)) * 33 + (lane & 7) * 4; d[0] = t[i][0]; d[1] = t[i][1]; d[2] = t[i][2]; d[3] = t[i][3]; }
    } else {
#pragma unroll 8
        for (int i = 0; i < 32; ++i) { const int kk = 2 * i + (lane >> 5), n = lane & 31; scr[kk * 33 + n] = (n < nvalid) ? W[(size_t)(k0 + kk) * ldn + srccol + n] : 0.f; }
    }
    LDS_WAIT(); asm volatile("" ::: "memory");
    const int ch = lane & 7;
#pragma unroll
    for (int j = 0; j < 4; ++j) { const int n = (lane >> 3) + 8 * j; const LAS float* s = scr + (8 * ch) * 33 + n;
        u32x4 o; o.x = cvtpk(s[0 * 33], s[1 * 33]); o.y = cvtpk(s[2 * 33], s[3 * 33]); o.z = cvtpk(s[4 * 33], s[5 * 33]); o.w = cvtpk(s[6 * 33], s[7 * 33]);
        *(u32x4*)(WT + (size_t)(drow0 + n) * Kd + k0 + 8 * ch) = o; }
    LDS_WAIT(); asm volatile("" ::: "memory");
}
__device__ __forceinline__ int perm_head_cols(int d) { const int t = d >> 8, p = d & 255; return 256 * t + 64 * ((p >> 5) & 3) + 32 * (p >> 7) + (p & 31); }

constexpr int TI_AIN = 1536, TI_AOUT = 512, TI_M1 = 2048, TI_M2 = 2048, TI_KV = 768, TI_QG = 640, TI_O = 512, TI_C1 = 256, TI_C2 = 8;
constexpr int TI_TOTAL = TI_AIN + TI_AOUT + 2 * TI_M1 + 2 * TI_M2 + TI_KV + TI_QG + TI_O + 2 * TI_C1 + 2 * TI_C2;

__device__ __forceinline__ void p0_item(const Args& a, int it, LAS float* scr, int lane) {
    unsigned char* ws = a.ws;
    int r = it;
    if (r < TI_AIN) { const int kb = r / 96, nb = r % 96, d = 32 * nb; int src;
        if (d < 1024) src = d; else { const int t = (d - 1024) >> 8, p = (d - 1024) & 255; src = (p < 128) ? (1024 + 128 * t + p) : (2048 + 128 * t + (p - 128)); }
        transpose_item(a.w_a_in, 3072, src, 32, 64 * kb, (bf16_t*)(ws + WS_WAIN), 1024, d, scr, lane); return; }
    r -= TI_AIN;
    if (r < TI_AOUT) { const int kb = r / 32, nb = r % 32; transpose_item(a.w_a_out, 1024, 32 * nb, 32, 64 * kb, (bf16_t*)(ws + WS_WAOUT), 1024, 32 * nb, scr, lane); return; }
    r -= TI_AOUT;
    if (r < 2 * TI_M1) { const int L = r / TI_M1, q = r % TI_M1, kb = q / 128, nb = q % 128;
        transpose_item(a.w_mlp1 + (size_t)L * DM * FF, FF, 32 * nb, 32, 64 * kb, (bf16_t*)(ws + WS_WM1) + (size_t)L * FF * DM, DM, 32 * nb, scr, lane); return; }
    r -= 2 * TI_M1;
    if (r < 2 * TI_M2) { const int L = r / TI_M2, q = r % TI_M2, kb = q / 32, nb = q % 32;
        transpose_item(a.w_mlp2 + (size_t)L * FF * DM, DM, 32 * nb, 32, 64 * kb, (bf16_t*)(ws + WS_WM2) + (size_t)L * DM * FF, FF, 32 * nb, scr, lane); return; }
    r -= 2 * TI_M2;
    if (r < TI_KV) { const int kb = r / 48, nb = r % 48, d = 32 * nb;
        transpose_item(a.w_kv, 1536, perm_head_cols(d), 32, 64 * kb, (bf16_t*)(ws + WS_WKVQ), DM, d, scr, lane); return; }
    r -= TI_KV;
    if (r < TI_QG) { const int kb = r / 40, nb = r % 40, d = 32 * nb; int src, nv = 32;
        if (d < 1024) src = perm_head_cols(d); else { const int p = d - 1024; src = 1024 + p; nv = 48 - p; nv = nv < 0 ? 0 : (nv > 32 ? 32 : nv); if (nv == 0) src = 0; }
        transpose_item(a.w_qg, 1072, src, nv, 64 * kb, (bf16_t*)(ws + WS_WKVQ), DM, 1536 + d, scr, lane); return; }
    r -= TI_QG;
    if (r < TI_O) { const int kb = r / 32, nb = r % 32; transpose_item(a.w_o, 1024, 32 * nb, 32, 64 * kb, (bf16_t*)(ws + WS_WO), 1024, 32 * nb, scr, lane); return; }
    r -= TI_O;
    if (r < 2 * TI_C1) { const int kv = r / TI_C1, q = r % TI_C1, kb = q / 8, nb = q % 8;
        transpose_item(a.cmp_w1 + (size_t)kv * 2048 * 256, 256, 32 * nb, 32, 64 * kb, (bf16_t*)(ws + WS_WC1) + (size_t)kv * 256 * 2048, 2048, 32 * nb, scr, lane); return; }
    r -= 2 * TI_C1;
    { const int kv = r / TI_C2, q = r % TI_C2, kb = q / 2, nb = q % 2;
        transpose_item(a.cmp_w2 + (size_t)kv * 256 * 64, 64, 32 * nb, 32, 64 * kb, (bf16_t*)(ws + WS_WC2) + (size_t)kv * 64 * 256, 256, 32 * nb, scr, lane); }
}

__device__ __forceinline__ void p0_mods(const Args& a, LAS unsigned char* lds, int vblk, int G) {
    LAS float* cact = (LAS float*)lds;
    LAS float* red = (LAS float*)(lds + 32768);
    const int tid = threadIdx.x, lane = tid & 63, wave = tid >> 6;
    bool have = false;
    for (int u = vblk; u < 224; u += G) {
        if (!have) { for (int i = tid; i < 8 * DM; i += 512) { const float cv = a.c[i]; cact[i] = cv / (1.0f + __expf(-cv)); } have = true; }
        __syncthreads();
        const int col = u * 64 + lane;
        const float* W; const float* bias; float* dst; int N, c0;
        if (col < 6144) { W = a.w_ada; bias = a.b_ada; dst = (float*)(a.ws + WS_MOD0); N = 6144; c0 = col; }
        else if (col < 12288) { W = a.w_ada + (size_t)DM * 6144; bias = a.b_ada + 6144; dst = (float*)(a.ws + WS_MOD1); N = 6144; c0 = col - 6144; }
        else { W = a.w_ada_kv; bias = a.b_ada_kv; dst = (float*)(a.ws + WS_MODKV); N = 2048; c0 = col - 12288; }
        float acc[8];
#pragma unroll
        for (int b = 0; b < 8; ++b) acc[b] = 0.f;
        const float* wp = W + (size_t)(wave * 128) * N + c0;
        const LAS float* cp = cact + wave * 128;
#pragma unroll 8
        for (int k = 0; k < 128; ++k) { const float w = __builtin_nontemporal_load(wp + (size_t)k * N);
#pragma unroll
            for (int b = 0; b < 8; ++b) acc[b] += w * cp[b * DM + k]; }
#pragma unroll
        for (int b = 0; b < 8; ++b) red[(wave * 8 + b) * 64 + lane] = acc[b];
        __syncthreads();
        { const int b = wave; float sacc = bias[c0];
#pragma unroll
          for (int w = 0; w < 8; ++w) sacc += red[(w * 8 + b) * 64 + lane];
          dst[(size_t)b * N + c0] = sacc; }
        __syncthreads();
    }
    __syncthreads();
}

__device__ __forceinline__ void p1_norm_row2(const Args& a, int m0, int lane) {
    const int b = m0 >> 11;
    const float* mod0 = (const float*)(a.ws + WS_MOD0) + (size_t)b * 6144;
    const f32x4* xr = (const f32x4*)(a.x + (size_t)m0 * DM) + lane;
    f32x4 v[2][4]; float s0 = 0.f, s1 = 0.f;
#pragma unroll
    for (int j = 0; j < 4; ++j) { v[0][j] = __builtin_nontemporal_load(xr + 64 * j); v[1][j] = __builtin_nontemporal_load(xr + 256 + 64 * j); }
#pragma unroll
    for (int j = 0; j < 4; ++j) { s0 += (v[0][j][0] * v[0][j][0] + v[0][j][1] * v[0][j][1]) + (v[0][j][2] * v[0][j][2] + v[0][j][3] * v[0][j][3]);
                                  s1 += (v[1][j][0] * v[1][j][0] + v[1][j][1] * v[1][j][1]) + (v[1][j][2] * v[1][j][2] + v[1][j][3] * v[1][j][3]); }
#pragma unroll
    for (int o = 1; o < 64; o <<= 1) { s0 += __shfl_xor(s0, o); s1 += __shfl_xor(s1, o); }
    const float r0 = rsqrtf(s0 * (1.0f / DM) + EPS), r1 = rsqrtf(s1 * (1.0f / DM) + EPS);
    u32x2* o8 = (u32x2*)((bf16_t*)(a.ws + WS_A2) + (size_t)m0 * DM) + lane;
#pragma unroll
    for (int j = 0; j < 4; ++j) { const int col = 4 * lane + 256 * j;
        const f32x4 gn = *(const f32x4*)(a.norm_gain + col), sh = *(const f32x4*)(mod0 + col), sc = *(const f32x4*)(mod0 + 1024 + col) + 1.0f;
        const f32x4 h0 = (v[0][j] * r0 * gn) * sc + sh, h1 = (v[1][j] * r1 * gn) * sc + sh;
        u32x2 w; w.x = cvtpk(h0[0], h0[1]); w.y = cvtpk(h0[2], h0[3]); o8[64 * j] = w;
        w.x = cvtpk(h1[0], h1[1]); w.y = cvtpk(h1[2], h1[3]); o8[256 + 64 * j] = w; }
}
__device__ __forceinline__ void p1_norm_stream(const Args& a, int wv, LAS unsigned char* wbuf, int lane) {
    const int mbase = 8 * wv, b = mbase >> 11;
    const float* mod0 = (const float*)(a.ws + WS_MOD0) + (size_t)b * 6144;
    const float* xb = a.x + (size_t)mbase * DM + 4 * lane;
#define P1_ISSUE(it_) do { _Pragma("unroll") for (int j = 0; j < 8; ++j) \
        __builtin_amdgcn_global_load_lds((const unsigned*)(xb + (size_t)(2 * (it_)) * DM + j * 256), (LAS unsigned*)(wbuf + ((it_) & 1) * 8192 + j * 1024), 16, 0, 2); } while (0)
    asm volatile("s_waitcnt lgkmcnt(0)" ::: "memory");
    P1_ISSUE(0);
    f32x4 ga[4], sh[4];
#pragma unroll
    for (int j = 0; j < 4; ++j) { const int col = 4 * lane + 256 * j;
        ga[j] = *(const f32x4*)(a.norm_gain + col) * (*(const f32x4*)(mod0 + 1024 + col) + 1.0f); sh[j] = *(const f32x4*)(mod0 + col); }
    asm volatile("" : "+v"(ga[0]), "+v"(ga[1]), "+v"(ga[2]), "+v"(ga[3]), "+v"(sh[0]), "+v"(sh[1]), "+v"(sh[2]), "+v"(sh[3]));
#pragma unroll
    for (int it = 0; it < 4; ++it) {
        if (it + 1 < 4) { asm volatile("s_waitcnt lgkmcnt(0)" ::: "memory"); P1_ISSUE(it + 1); asm volatile("s_waitcnt vmcnt(8)" ::: "memory"); }
        else asm volatile("s_waitcnt vmcnt(0)" ::: "memory");
        const LAS unsigned char* bp = wbuf + (it & 1) * 8192 + lane * 16;
        f32x4 v[2][4]; float s0 = 0.f, s1 = 0.f;
#pragma unroll
        for (int j = 0; j < 4; ++j) { v[0][j] = *(const LAS f32x4*)(bp + j * 1024); v[1][j] = *(const LAS f32x4*)(bp + (4 + j) * 1024); }
#pragma unroll
        for (int j = 0; j < 4; ++j) { s0 += (v[0][j][0] * v[0][j][0] + v[0][j][1] * v[0][j][1]) + (v[0][j][2] * v[0][j][2] + v[0][j][3] * v[0][j][3]);
                                      s1 += (v[1][j][0] * v[1][j][0] + v[1][j][1] * v[1][j][1]) + (v[1][j][2] * v[1][j][2] + v[1][j][3] * v[1][j][3]); }
#pragma unroll
        for (int o = 1; o < 64; o <<= 1) { s0 += __shfl_xor(s0, o); s1 += __shfl_xor(s1, o); }
        const float r0 = rsqrtf(s0 * (1.0f / DM) + EPS), r1 = rsqrtf(s1 * (1.0f / DM) + EPS);
        u32x2* o8 = (u32x2*)((bf16_t*)(a.ws + WS_A2) + (size_t)(mbase + 2 * it) * DM) + lane;
#pragma unroll
        for (int j = 0; j < 4; ++j) {
            const f32x4 h0 = (v[0][j] * r0) * ga[j] + sh[j], h1 = (v[1][j] * r1) * ga[j] + sh[j];
            u32x2 w; w.x = cvtpk(h0[0], h0[1]); w.y = cvtpk(h0[2], h0[3]); o8[64 * j] = w;
            w.x = cvtpk(h1[0], h1[1]); w.y = cvtpk(h1[2], h1[3]); o8[256 + 64 * j] = w; }
    }
#undef P1_ISSUE
}
__device__ __forceinline__ void p1_bias_task(const bf16_t* Wt, int n0, const float* shift, int shift_stride, float* bias, int bias_stride, int lane) {
    const int r = lane & 15, kq = lane >> 4;
    const bf16_t* wp = Wt + (size_t)(n0 + r) * DM + 8 * kq;
    const float* sp = shift + (size_t)(r & 7) * shift_stride + 8 * kq;
    f32x4 acc = (f32x4){0.f, 0.f, 0.f, 0.f};
#pragma unroll 8
    for (int k0 = 0; k0 < DM; k0 += 32) {
        const bf16x8 bf = *(const bf16x8*)(wp + k0);
        const f32x4 s0 = *(const f32x4*)(sp + k0), s1 = *(const f32x4*)(sp + k0 + 4);
        u32x4 aw; aw.x = cvtpk(s0[0], s0[1]); aw.y = cvtpk(s0[2], s0[3]); aw.z = cvtpk(s1[0], s1[1]); aw.w = cvtpk(s1[2], s1[3]);
        if (r >= 8) aw = (u32x4){0u, 0u, 0u, 0u};
        acc = __builtin_amdgcn_mfma_f32_16x16x32_bf16(__builtin_bit_cast(bf16x8, aw), bf, acc, 0, 0, 0);
    }
    if (kq < 2) {
#pragma unroll
        for (int e = 0; e < 4; ++e) bias[(size_t)(4 * kq + e) * bias_stride + n0 + r] = acc[e];
    }
}
__device__ __forceinline__ void p1_pebias(const Args& a, int idx, int lane) {
    const int kv = idx >> 8;
    const bf16_t* wrow = (const bf16_t*)(a.ws + WS_WC1) + (size_t)idx * 2048;
    const float* pe = a.cmp_pe + (size_t)kv * 2048;
    float d = 0.f;
#pragma unroll
    for (int j = 0; j < 4; ++j) { const int k = (lane + 64 * j) * 8; const u32x4 w = *(const u32x4*)(wrow + k); const f32x4 p0 = *(const f32x4*)(pe + k), p1 = *(const f32x4*)(pe + k + 4);
        d += p0[0] * bf_lo(w.x) + p0[1] * bf_hi(w.x) + p0[2] * bf_lo(w.y) + p0[3] * bf_hi(w.y) + p1[0] * bf_lo(w.z) + p1[1] * bf_hi(w.z) + p1[2] * bf_lo(w.w) + p1[3] * bf_hi(w.w); }
    d = wave_sum(d);
    if (lane == 0) ((float*)(a.ws + WS_PEB))[idx] = d;
}

__device__ __forceinline__ void unpack8(const u32x4 w, float (&f)[8]) { f[0] = bf_lo(w.x); f[1] = bf_hi(w.x); f[2] = bf_lo(w.y); f[3] = bf_hi(w.y); f[4] = bf_lo(w.z); f[5] = bf_hi(w.z); f[6] = bf_lo(w.w); f[7] = bf_hi(w.w); }
__device__ __forceinline__ void p3_conv(const Args& a, int gtid, int nthreads) {
    for (int it0 = gtid; it0 < 128 * 2048; it0 += nthreads) {
        const int pass = it0 / nthreads, vt = it0 - pass * nthreads;
        const int it = (nthreads == 131072) ? ((vt >> 14) * 32768 + pass * 16384 + (vt & 16383)) : it0;
        const int cch = it & 127, rch = it >> 7, col = cch * 8, r0 = (rch * 8) & (SEQ - 1);
        unsigned char* slab = a.ws + WS_R + (size_t)((rch * 8) >> 11) * SLAB;
        const bf16_t* GB = (const bf16_t*)(slab + SO_GB); const bf16_t* V = (const bf16_t*)(slab + SO_V); bf16_t* Y = (bf16_t*)(slab + SO_Y);
        float w0[8], w1[8], w2[8];
        { const f32x4 t0 = *(const f32x4*)(a.conv_w + col), t1 = *(const f32x4*)(a.conv_w + col + 4); w0[0] = t0[0]; w0[1] = t0[1]; w0[2] = t0[2]; w0[3] = t0[3]; w0[4] = t1[0]; w0[5] = t1[1]; w0[6] = t1[2]; w0[7] = t1[3]; }
        { const f32x4 t0 = *(const f32x4*)(a.conv_w + 1024 + col), t1 = *(const f32x4*)(a.conv_w + 1024 + col + 4); w1[0] = t0[0]; w1[1] = t0[1]; w1[2] = t0[2]; w1[3] = t0[3]; w1[4] = t1[0]; w1[5] = t1[1]; w1[6] = t1[2]; w1[7] = t1[3]; }
        { const f32x4 t0 = *(const f32x4*)(a.conv_w + 2048 + col), t1 = *(const f32x4*)(a.conv_w + 2048 + col + 4); w2[0] = t0[0]; w2[1] = t0[1]; w2[2] = t0[2]; w2[3] = t0[3]; w2[4] = t1[0]; w2[5] = t1[1]; w2[6] = t1[2]; w2[7] = t1[3]; }
        float vm2[8], vm1[8];
        if ((r0 & (SEQ - 1)) != 0) { unpack8(*(const u32x4*)(V + (size_t)(r0 - 2) * DM + col), vm2); unpack8(*(const u32x4*)(V + (size_t)(r0 - 1) * DM + col), vm1); }
        else {
#pragma unroll
            for (int e = 0; e < 8; ++e) { vm2[e] = 0.f; vm1[e] = 0.f; } }
#pragma unroll
        for (int i = 0; i < 8; ++i) { float vc[8], gb[8], y[8];
            unpack8(*(const u32x4*)(V + (size_t)(r0 + i) * DM + col), vc); unpack8(*(const u32x4*)(GB + (size_t)(r0 + i) * DM + col), gb);
#pragma unroll
            for (int e = 0; e < 8; ++e) { y[e] = gb[e] * (w2[e] * vc[e] + w1[e] * vm1[e] + w0[e] * vm2[e]); vm2[e] = vm1[e]; vm1[e] = vc[e]; }
            u32x4 w; w.x = cvtpk(y[0], y[1]); w.y = cvtpk(y[2], y[3]); w.z = cvtpk(y[4], y[5]); w.w = cvtpk(y[6], y[7]);
            *(u32x4*)(Y + (size_t)(r0 + i) * DM + col) = w; }
    }
}

__device__ __forceinline__ float gelu_tanh(float x) {
    const float z = 0.7978845608028654f * (x + 0.044715f * x * x * x);
    const float e = __builtin_amdgcn_exp2f(z * 2.8853900817779268f);
    const float th = 1.0f - 2.0f / (e + 1.0f);
    return 0.5f * x * (1.0f + th);
}
constexpr int C_CH = 2064;
constexpr int C_RB0 = 68608;
constexpr int C_HOFF = C_RB0, C_HROW = 528;
__device__ __forceinline__ void p8_unit(const Args& a, int u, LAS unsigned char* lds) {
    const int tid = threadIdx.x, lane = tid & 63, wid = __builtin_amdgcn_readfirstlane(tid >> 6), r = lane & 31, h = lane >> 5;
    const int kv = u >> 7, bg = (u >> 2) & 31, rq = u & 3;
    unsigned char* slab = a.ws + WS_R + (size_t)(bg >> 2) * SLAB;
    const bf16_t* src = (const bf16_t*)(slab + SO_KV) + ((size_t)(kv * 4 + (bg & 3)) * SEQ + 512 * rq) * 64;
    __syncthreads();
    { u32x4 v[8];
#pragma unroll
      for (int j = 0; j < 8; ++j) v[j] = *(const u32x4*)(src + (size_t)(tid + 512 * j) * 8);
      u32x4 vl = (u32x4){0u, 0u, 0u, 0u};
      if (tid < 128 && rq != 3) vl = *(const u32x4*)(src + (size_t)32 * 1024 + tid * 8);
#pragma unroll
      for (int j = 0; j < 8; ++j) { const int idx = tid + 512 * j; *(LAS u32x4*)(lds + (idx >> 7) * C_CH + (idx & 127) * 16) = v[j]; }
      if (tid < 128) *(LAS u32x4*)(lds + 32 * C_CH + tid * 16) = vl; }
    __syncthreads();
    f32x16 acc = f32x16{};
    const unsigned lds0 = (unsigned)(size_t)lds;
    const bf16_t* Wsrc = (const bf16_t*)(a.ws + WS_WC1) + (size_t)(kv * 256) * 2048;
    const int drow = 16 * wid + (lane >> 2);
    const bf16_t* dsrc0 = Wsrc + (size_t)drow * 2048 + 8 * ((lane & 3) ^ ((drow >> 2) & 3));
    const bf16_t* dsrc1 = dsrc0 + (size_t)128 * 2048;
    const unsigned ddst0 = lds0 + C_RB0 + wid * 1024, ddst1 = ddst0 + 8192;
    const int brow = 32 * wid + r;
    const unsigned boff = C_RB0 + brow * 64, bkey = (brow >> 2) & 3;
#define P8_DMA(stg) do { att::glds16(dsrc0 + 32 * (stg), (unsigned)__builtin_amdgcn_readfirstlane(ddst0 + ((stg) & 3) * 16384)); att::glds16(dsrc1 + 32 * (stg), (unsigned)__builtin_amdgcn_readfirstlane(ddst1 + ((stg) & 3) * 16384)); } while (0)
#define P8_STEP(stg, WAITN) do { asm volatile("s_waitcnt vmcnt(" #WAITN ") lgkmcnt(0)\n\ts_barrier" ::: "memory"); \
        if ((stg) + 3 < 64) P8_DMA((stg) + 3); \
        { const LAS unsigned char* bp = lds + boff + ((stg) & 3) * 16384; \
          const LAS unsigned char* ap = lds + (r + ((stg) >> 5)) * C_CH + ((32 * (stg)) & 1023) * 2 + 16 * h; \
          const bf16x8 a0 = *(const LAS bf16x8*)ap, a1 = *(const LAS bf16x8*)(ap + 32); \
          const bf16x8 b0 = *(const LAS bf16x8*)(bp + 16 * ((unsigned)h ^ bkey)), b1 = *(const LAS bf16x8*)(bp + 16 * ((unsigned)(2 + h) ^ bkey)); \
          acc = __builtin_amdgcn_mfma_f32_32x32x16_bf16(a0, b0, acc, 0, 0, 0); acc = __builtin_amdgcn_mfma_f32_32x32x16_bf16(a1, b1, acc, 0, 0, 0); } } while (0)
    P8_DMA(0); P8_DMA(1); P8_DMA(2);
    for (int s4 = 0; s4 < 60; s4 += 4) { P8_STEP(s4, 4); P8_STEP(s4 + 1, 4); P8_STEP(s4 + 2, 4); P8_STEP(s4 + 3, 4); }
    P8_STEP(60, 4); P8_STEP(61, 4); P8_STEP(62, 2); P8_STEP(63, 0);
    asm volatile("s_waitcnt lgkmcnt(0)\n\ts_barrier" ::: "memory");
#undef P8_DMA
#undef P8_STEP
    { const float pb = ((const float*)(a.ws + WS_PEB))[kv * 256 + 32 * wid + r];
      LAS bf16_t* H = (LAS bf16_t*)(lds + C_HOFF);
#pragma unroll
      for (int rg = 0; rg < 16; ++rg) { const int row = att::crow(rg, h); H[row * (C_HROW / 2) + 32 * wid + r] = (bf16_t)(cvtpk(gelu_tanh(acc[rg] + pb), 0.f) & 0xffffu); } }
    __syncthreads();
    if (wid == 0) {
        f32x16 o0 = f32x16{}, o1 = f32x16{};
        const bf16_t* W2 = (const bf16_t*)(a.ws + WS_WC2) + (size_t)kv * 64 * 256;
#pragma unroll
        for (int s = 0; s < 16; ++s) {
            const bf16x8 af = *(const LAS bf16x8*)(lds + C_HOFF + r * C_HROW + (16 * s + 8 * h) * 2);
            const bf16x8 b0 = *(const bf16x8*)(W2 + (size_t)r * 256 + 16 * s + 8 * h), b1 = *(const bf16x8*)(W2 + (size_t)(32 + r) * 256 + 16 * s + 8 * h);
            o0 = __builtin_amdgcn_mfma_f32_32x32x16_bf16(af, b0, o0, 0, 0, 0); o1 = __builtin_amdgcn_mfma_f32_32x32x16_bf16(af, b1, o1, 0, 0, 0);
        }
        const float gk0 = a.k_gain[r], gk1 = a.k_gain[32 + r];
        bf16_t* dst = (bf16_t*)(slab + (kv == 0 ? SO_KC : SO_VC)) + (size_t)(bg & 3) * 8192;
#pragma unroll
        for (int rg = 0; rg < 16; ++rg) { float v0 = o0[rg], v1 = o1[rg];
            if (kv == 0) { float ss = v0 * v0 + v1 * v1;
#pragma unroll
                for (int sft = 1; sft < 32; sft <<= 1) ss += __shfl_xor(ss, sft);
                const float rs = rsqrtf(ss * (1.0f / 64.0f) + EPS); v0 *= rs * gk0; v1 *= rs * gk1; }
            const int n = 32 * rq + att::crow(rg, h);
            if (n == 127) { v0 = 0.f; v1 = 0.f; }
            dst[n * 64 + r] = (bf16_t)(cvtpk(v0, 0.f) & 0xffffu); dst[n * 64 + 32 + r] = (bf16_t)(cvtpk(v1, 0.f) & 0xffffu); }
    }
}

__device__ __forceinline__ void p4_fixup(const Args& a, int pm) {
    const int tid = threadIdx.x;
    if (tid < 256) {
        const int rr = tid >> 7, cc = (tid & 127) * 8, pml = pm & 7, srow = pml * 256 + rr;
        unsigned char* slab = a.ws + WS_R + (size_t)(pm >> 3) * SLAB;
        const bf16_t* V = (const bf16_t*)(slab + SO_V); const bf16_t* GBH = (const bf16_t*)(slab + SO_GB) + (size_t)pml * 2 * DM; bf16_t* Y = (bf16_t*)(slab + SO_Y);
        float gb[8], v0[8], v1[8], v2[8], y[8];
        unpack8(*(const u32x4*)(GBH + (size_t)rr * DM + cc), gb);
        unpack8(*(const u32x4*)(V + (size_t)srow * DM + cc), v0);
        if (srow >= 1) unpack8(*(const u32x4*)(V + (size_t)(srow - 1) * DM + cc), v1); else {
#pragma unroll
            for (int e = 0; e < 8; ++e) v1[e] = 0.f; }
        if (srow >= 2) unpack8(*(const u32x4*)(V + (size_t)(srow - 2) * DM + cc), v2); else {
#pragma unroll
            for (int e = 0; e < 8; ++e) v2[e] = 0.f; }
#pragma unroll
        for (int e = 0; e < 8; ++e) y[e] = gb[e] * (a.conv_w[2 * DM + cc + e] * v0[e] + a.conv_w[DM + cc + e] * v1[e] + a.conv_w[cc + e] * v2[e]);
        u32x4 w; w.x = cvtpk(y[0], y[1]); w.y = cvtpk(y[2], y[3]); w.z = cvtpk(y[4], y[5]); w.w = cvtpk(y[6], y[7]);
        *(u32x4*)(Y + (size_t)srow * DM + cc) = w;
    }
}

__global__ void __launch_bounds__(NWAVES * 64, 2) yoco_fwd(Args args) {
    extern __shared__ __attribute__((aligned(16))) unsigned char lds_raw[];
    LAS unsigned char* lds = (LAS unsigned char*)lds_raw;
    const int tid = threadIdx.x, lane = tid & 63, wave = __builtin_amdgcn_readfirstlane(tid >> 6);
    const int G = gridDim.x, bx = blockIdx.x;
    int vcu = (G % 8 == 0) ? (bx % 8) * (G / 8) + bx / 8 : bx;
    int cid = bx;
    const int gw = vcu * NWAVES + wave, NGW = G * NWAVES;
    unsigned char* ws = args.ws;
    const int lo = args.ph_lo, hi = args.ph_hi;
    volatile LAS unsigned* MISC = (volatile LAS unsigned*)(lds + LDS_BYTES - 256);
    if (tid < 8) MISC[tid] = 0u;
    __syncthreads();
    XcdBarrier bar; bar.bar = (unsigned*)(ws + WS_BAR); bar.x = 0; bar.st = MISC;
    if (hi - lo > 1) bar = xcd_barrier_post((unsigned*)(ws + WS_BAR), MISC);
#define IN(k) (lo <= (k) && (k) < hi)
#define SEAM(k) do { if (IN(k) && IN((k) + 1)) xcd_barrier(bar); } while (0)
#define LSEAM(k) do { if (IN(k) && IN((k) + 1)) { if (local_ok) xcd_local_barrier(bar); else xcd_barrier(bar); } } while (0)
    bool local_ok = false;
    float* MOD0 = (float*)(ws + WS_MOD0); float* MOD1 = (float*)(ws + WS_MOD1); float* MODKV = (float*)(ws + WS_MODKV);
    float* SS1 = (float*)(ws + WS_SS1); float* SS2 = (float*)(ws + WS_SS2); float* SS3 = (float*)(ws + WS_SS3);
    bf16_t* A1 = (bf16_t*)(ws + WS_A1); bf16_t* A2 = (bf16_t*)(ws + WS_A2);
    bf16_t* HB = (bf16_t*)(ws + WS_H);

    if (IN(0)) {
        p0_mods(args, lds, vcu, G);
        LAS float* scr = (LAS float*)(lds + wave * 16384);
        for (int it = gw; it < TI_TOTAL; it += NGW) p0_item(args, it, scr, lane);
    }
    SEAM(0);
    if (IN(1)) {
        for (int wv = gw; wv < M_TOK / 8; wv += NGW) p1_norm_stream(args, wv, lds + wave * 16384, lane);
        asm volatile("s_waitcnt vmcnt(0) lgkmcnt(0)" ::: "memory");
        for (int it = gw; it < (2 * FF + NKVQ) / 16 + 512; it += NGW) {
            const int n = it * 16;
            if (n < FF) p1_bias_task((const bf16_t*)(ws + WS_WM1), n, MOD0 + 3072, 6144, (float*)(ws + WS_BM1L0), FF, lane);
            else if (n < 2 * FF) p1_bias_task((const bf16_t*)(ws + WS_WM1) + (size_t)FF * DM, n - FF, MOD1 + 3072, 6144, (float*)(ws + WS_BM1L1), FF, lane);
            else if (n < 2 * FF + 1536) p1_bias_task((const bf16_t*)(ws + WS_WKVQ), n - 2 * FF, MODKV, 2048, (float*)(ws + WS_BKVQ), NKVQ, lane);
            else if (n < 2 * FF + NKVQ) p1_bias_task((const bf16_t*)(ws + WS_WKVQ), n - 2 * FF, MOD1, 6144, (float*)(ws + WS_BKVQ), NKVQ, lane);
            else p1_pebias(args, it - (2 * FF + NKVQ) / 16, lane);
        }
    }
    SEAM(1);
    if (hi - lo > 1 && lo <= 1) {
        local_ok = MISC[3] != 0u;
        if (local_ok) { const int x = (int)MISC[4], rk = (int)MISC[2]; vcu = x * 32 + rk; cid = rk * 8 + x; }
    }
    if (IN(2)) {
        pg8::Gemm g{A2, A2, 1 << 30, (const bf16_t*)(ws + WS_WAIN), M_TOK, 3072, DM, (size_t)SEQ * DM * 2}; pg8::StaticOrder S; S.init_ain(G, cid);
        pg8::EpiAin E{ws + WS_R, args.conv_w, lds};
        pg8::gemm_phase(lds, g, S, E);
    }
    LSEAM(2);
    if (IN(4)) {
        pg8::Gemm g{(const bf16_t*)(ws + WS_R + SO_Y), (const bf16_t*)(ws + WS_R + SO_Y), 1 << 30, (const bf16_t*)(ws + WS_WAOUT), M_TOK, DM, DM, SLAB}; pg8::StaticOrder S; S.init(M_TOK, DM, G, cid);
        { pg8::Unit fu; for (int i = 0; S.next(i, fu); ++i) p4_fixup(args, fu.pm); asm volatile("s_waitcnt vmcnt(0)" ::: "memory"); __syncthreads(); }
        pg8::EpiRes<1, 0, 2> E{args.x, nullptr, MOD0 + 2048, 6144, args.norm_gain + 1024, MOD0 + 4096, 6144, A1, nullptr, nullptr, 0, nullptr, SS1, nullptr, nullptr, 0, lds};
        pg8::gemm_phase(lds, g, S, E);
    }
    LSEAM(4);
    if (IN(5)) {
        pg8::Gemm g{A1, A1, 1 << 30, (const bf16_t*)(ws + WS_WM1), M_TOK, FF, DM, (size_t)SEQ * DM * 2}; pg8::StaticOrder S; S.init(M_TOK, FF, G, cid);
        pg8::EpiMlp1 E{HB, (const float*)(ws + WS_BM1L0), SS1, lds};
        pg8::gemm_phase(lds, g, S, E);
    }
    LSEAM(5);
    if (IN(6)) {
        pg8::Gemm g{HB, HB, 1 << 30, (const bf16_t*)(ws + WS_WM2), M_TOK, DM, FF, (size_t)SEQ * FF * 2}; pg8::StaticOrder S; S.init(M_TOK, DM, G, cid);
        pg8::EpiRes<2, 2, 2> E{A1, nullptr, MOD0 + 5120, 6144, args.kv_norm_gain, MODKV + 1024, 2048, A1, args.norm_gain + 2048, MOD1 + 1024, 6144, A2, SS2, args.norm_gain + 1024, MOD0 + 4096, 6144, lds};
        pg8::gemm_phase(lds, g, S, E);
    }
    LSEAM(6);
    if (IN(7)) {
        pg8::Gemm g{A1, A2, 6, (const bf16_t*)(ws + WS_WKVQ), M_TOK, NKVQ, DM, (size_t)SEQ * DM * 2}; pg8::StaticOrder S; S.init(M_TOK, NKVQ, G, cid);
        pg8::EpiKVQ E{ws + WS_R, (const float*)(ws + WS_BKVQ), SS2, args.k_gain, args.q_gain, lds};
        pg8::gemm_phase(lds, g, S, E);
    }
    LSEAM(7);
    if (IN(8)) { for (int v = vcu; v < 256; v += G) { const int rk = v & 31; p8_unit(args, ((rk >> 4) << 7) | ((((v >> 5) << 2) | ((rk >> 2) & 3)) << 2) | (rk & 3), lds); } __syncthreads(); }
    LSEAM(8);
    if (IN(9)) {
        for (int v = vcu; v < 256; v += G) { const int bgp = v >> 3, s = v & 7;
            for (int i = 0; i < 4; ++i) { const int qb = (i == 0) ? s : (i == 1) ? 15 - s : (i == 2) ? 16 + s : 31 - s;
                att::attn_unit(bgp >> 2, bgp & 3, qb, ws + WS_R + (size_t)(bgp >> 2) * SLAB, lds); } }
    }
    LSEAM(9);
    if (IN(10)) {
        pg8::Gemm g{(const bf16_t*)(ws + WS_R + SO_O), (const bf16_t*)(ws + WS_R + SO_O), 1 << 30, (const bf16_t*)(ws + WS_WO), M_TOK, DM, DM, SLAB}; pg8::StaticOrder S; S.init(M_TOK, DM, G, cid);
        pg8::EpiRes<1, 2, 2> E{A2, nullptr, MOD1 + 2048, 6144, args.norm_gain + 3072, MOD1 + 4096, 6144, A1, nullptr, nullptr, 0, nullptr, SS3, args.norm_gain + 2048, MOD1 + 1024, 6144, lds};
        pg8::gemm_phase(lds, g, S, E);
    }
    LSEAM(10);
    if (IN(11)) {
        pg8::Gemm g{A1, A1, 1 << 30, (const bf16_t*)(ws + WS_WM1) + (size_t)FF * DM, M_TOK, FF, DM, (size_t)SEQ * DM * 2}; pg8::StaticOrder S; S.init(M_TOK, FF, G, cid);
        pg8::EpiMlp1 E{HB, (const float*)(ws + WS_BM1L1), SS3, lds};
        pg8::gemm_phase(lds, g, S, E);
    }
    LSEAM(11);
    if (IN(12)) {
        pg8::Gemm g{HB, HB, 1 << 30, (const bf16_t*)(ws + WS_WM2) + (size_t)DM * FF, M_TOK, DM, FF, (size_t)SEQ * FF * 2}; pg8::StaticOrder S; S.init(M_TOK, DM, G, cid);
        pg8::EpiRes<0, 2, 0> E{A1, args.out, MOD1 + 5120, 6144, nullptr, nullptr, 0, nullptr, nullptr, nullptr, 0, nullptr, nullptr, args.norm_gain + 3072, MOD1 + 4096, 6144, lds};
        pg8::gemm_phase(lds, g, S, E);
    }
#undef IN
#undef SEAM
}

extern "C" void kernel_launch(void* const* d_in, const int* in_sizes, int n_in, void* d_out, int out_size, void* d_ws, size_t ws_size, hipStream_t stream) {
    static int grid = 0;
    if (grid == 0) {
        if (n_in != 21 || in_sizes[0] != M_TOK * DM || out_size != M_TOK * DM || ws_size < WS_END) { fprintf(stderr, "kernel_launch: unexpected shapes (n_in %d, in0 %d, out %d, ws %zu); nothing launched\n", n_in, n_in > 0 ? in_sizes[0] : -1, out_size, ws_size); grid = -1; return; }
        int dev = 0, cus = 0, per_cu = 0;
        if (hipGetDevice(&dev) != hipSuccess || hipDeviceGetAttribute(&cus, hipDeviceAttributeMultiprocessorCount, dev) != hipSuccess) { grid = -1; return; }
        if (hipFuncSetAttribute((const void*)yoco_fwd, hipFuncAttributeMaxDynamicSharedMemorySize, LDS_BYTES) != hipSuccess) { fprintf(stderr, "kernel_launch: hipFuncSetAttribute failed\n"); grid = -1; return; }
        if (hipOccupancyMaxActiveBlocksPerMultiprocessor(&per_cu, (const void*)yoco_fwd, NWAVES * 64, LDS_BYTES) != hipSuccess || per_cu < 1) { fprintf(stderr, "kernel_launch: occupancy query says %d blocks per CU\n", per_cu); per_cu = 1; }
        (void)hipGetLastError();
        grid = cus;
        if (grid != 256) { fprintf(stderr, "kernel_launch: this build deals the w_a_in tiles to exactly 256 workgroups (device has %d CUs); nothing launched\n", cus); grid = -1; return; }
    }
    if (grid < 0) return;
    (void)hipMemsetAsync((char*)d_ws + WS_ZERO, 0, ZERO_BYTES, stream);
    Args a{};
    a.x = (const float*)d_in[0]; a.c = (const float*)d_in[1]; a.norm_gain = (const float*)d_in[2]; a.w_ada = (const float*)d_in[3]; a.b_ada = (const float*)d_in[4];
    a.w_a_in = (const float*)d_in[5]; a.conv_w = (const float*)d_in[6]; a.w_a_out = (const float*)d_in[7]; a.w_qg = (const float*)d_in[8]; a.q_gain = (const float*)d_in[9];
    a.w_o = (const float*)d_in[10]; a.kv_norm_gain = (const float*)d_in[11]; a.w_ada_kv = (const float*)d_in[12]; a.b_ada_kv = (const float*)d_in[13]; a.w_kv = (const float*)d_in[14];
    a.k_gain = (const float*)d_in[15]; a.cmp_pe = (const float*)d_in[16]; a.cmp_w1 = (const float*)d_in[17]; a.cmp_w2 = (const float*)d_in[18]; a.w_mlp1 = (const float*)d_in[19]; a.w_mlp2 = (const float*)d_in[20];
    a.out = (float*)d_out; a.ws = (unsigned char*)d_ws;
#if MK_N_LAUNCHES == 1
    a.ph_lo = 0; a.ph_hi = N_PHASES;
    void* kargs[] = {&a};
    hipError_t e = hipLaunchCooperativeKernel((const void*)yoco_fwd, dim3(grid), dim3(NWAVES * 64), kargs, LDS_BYTES, stream);
    if (e != hipSuccess) fprintf(stderr, "kernel_launch: cooperative launch failed: %s (grid %d)\n", hipGetErrorString(e), grid);
#else
    for (int p = 0; p < N_PHASES; ++p) { a.ph_lo = p; a.ph_hi = p + 1; hipLaunchKernelGGL(yoco_fwd, dim3(grid), dim3(NWAVES * 64), LDS_BYTES, stream, a); }
#endif
}
```

```cpp
#include <hip/hip_runtime.h>
#include <cstdio>
#include <cstdint>
#include <cmath>

#ifndef MK_N_LAUNCHES
#define MK_N_LAUNCHES 1
#endif
constexpr int N_PHASES = 13;

#define LAS __attribute__((address_space(3)))
typedef unsigned short bf16_t;
typedef short bf16x8 __attribute__((ext_vector_type(8)));
typedef short s16x4 __attribute__((ext_vector_type(4)));
typedef float f32x2 __attribute__((ext_vector_type(2)));
typedef float f32x4 __attribute__((ext_vector_type(4)));
typedef float f32x16 __attribute__((ext_vector_type(16)));
typedef unsigned u32x4 __attribute__((ext_vector_type(4)));
typedef unsigned u32x2 __attribute__((ext_vector_type(2)));
typedef __bf16 bf16x2_t __attribute__((ext_vector_type(2)));

constexpr int BATCH = 8, SEQ = 2048, DM = 1024, FF = 4096, M_TOK = BATCH * SEQ;
constexpr int NKVQ = 2816;
constexpr float EPS = 1e-6f;
constexpr float QSCALE = 0.125f * 1.4426950408889634f;

constexpr size_t MiB = 1u << 20;
constexpr size_t WS_ZERO = 0, ZERO_BYTES = 1 * MiB;
constexpr size_t WS_MOD0 = 0, WS_MOD1 = 196608, WS_MODKV = 393216;
constexpr size_t WS_SS1 = 524288, WS_SS2 = 589824, WS_SS3 = 655360;
constexpr size_t WS_BAR = 786432;
constexpr size_t WS_BM1L0 = 1 * MiB, WS_BM1L1 = WS_BM1L0 + 131072, WS_BKVQ = WS_BM1L1 + 131072, WS_PEB = WS_BKVQ + 131072, WS_WC2 = WS_PEB + 4096, WS_WC2T = 1 * MiB + 524288;
constexpr size_t WS_WAIN = 2 * MiB, WS_WAOUT = 8 * MiB, WS_WM1 = 10 * MiB  , WS_WM2 = 26 * MiB  , WS_WKVQ = 42 * MiB, WS_WO = 48 * MiB, WS_WC1 = 50 * MiB;
constexpr size_t WS_R = 56 * MiB;
constexpr size_t SLAB = 16 * MiB;
constexpr size_t SO_GB = 0, SO_V = 4 * MiB, SO_Y = 8 * MiB;
constexpr size_t WS_H = WS_R;
constexpr size_t SO_Q = 0, SO_KV = 4 * MiB  , SO_O = 10 * MiB, SO_GATES = 14 * MiB  , SO_KC = 14 * MiB + 512 * 1024  , SO_VC = SO_KC + 65536;
constexpr size_t WS_A1 = 184 * MiB, WS_A2 = 216 * MiB, WS_END = 248 * MiB;

constexpr int LDS_BYTES = 147456;
constexpr int NWAVES = 8;

__device__ __forceinline__ unsigned cvtpk(float lo, float hi) { f32x2 v = {lo, hi}; bf16x2_t b = __builtin_convertvector(v, bf16x2_t); return __builtin_bit_cast(unsigned, b); }
__device__ __forceinline__ float bf_lo(unsigned u) { return __builtin_bit_cast(float, u << 16); }
__device__ __forceinline__ float bf_hi(unsigned u) { return __builtin_bit_cast(float, u & 0xffff0000u); }
__device__ __forceinline__ float wave_sum(float v) {
#pragma unroll
    for (int o = 1; o < 64; o <<= 1) v += __shfl_xor(v, o);
    return v;
}
#define LDS_WAIT() asm volatile("s_waitcnt lgkmcnt(0)" ::: "memory")
#define LAUNDER(x) asm volatile("" : "+v"(x))

__device__ __forceinline__ float sum_rows4(float v) {
    auto a = __builtin_amdgcn_permlane16_swap(__float_as_uint(v), __float_as_uint(v), false, false); v = __uint_as_float(a[0]) + __uint_as_float(a[1]);
    auto b = __builtin_amdgcn_permlane32_swap(__float_as_uint(v), __float_as_uint(v), false, false); return __uint_as_float(b[0]) + __uint_as_float(b[1]);
}
namespace pg8 {
constexpr int BM = 256, BK = 64, HALF = 128, HTB = HALF * BK * 2, STAGE_BYTES = 8 * HTB, NXCD = 8, WGM = 8, VEC_LDS = 131072, GAIN_LDS = 135168;
__host__ __device__ __forceinline__ int lds_byte(int r, int c) { const int st = (r >> 4) * 2 + (c >> 5), rr = r & 15, cc = c & 31, ob = rr * 64 + cc * 2; return st * 1024 + (ob ^ (((ob >> 9) & 1) << 5)); }
__host__ __device__ __forceinline__ void stage_rc(int b, int& R, int& C) { const int st = b / 1024, sb = b % 1024, swz = sb ^ (((sb >> 9) & 1) << 5); R = (st >> 1) * 16 + swz / 64; C = (st & 1) * 32 + (swz % 64) / 2; }
__host__ __device__ __forceinline__ int perm32(int rho) { const int n = rho >> 4, i = rho & 15; return 8 * (i >> 2) + 4 * n + (i & 3); }

struct Unit { int pm, pn; };
struct Gemm { const bf16_t* A; const bf16_t* A2; int pn_split; const bf16_t* Bt; int M, N, K; size_t abatch; int lda = 0; size_t ahstep = 0, atstep = 0; };

struct StaticOrder {
    int nM, nN, nwg, G, c, ain;
    __device__ __forceinline__ void init(int M, int N, int G_, int c_) { nM = M / BM; nN = N / BM; nwg = nM * nN; G = G_; c = c_; ain = 0; }
    __device__ __forceinline__ void init_kvq(int G_, int c_) { init(M_TOK, 2816, G_, c_); ain = 2; }
    __device__ __forceinline__ void init_one(int pm_, int pn_) { nM = pm_; nN = pn_; nwg = 1; G = 1; c = 0; ain = 3; }
    __device__ __forceinline__ void init_ain(int G_, int c_) { init(M_TOK, 3072, G_, c_); ain = 1; }
    __device__ __forceinline__ bool next(int i, Unit& u) const {
        if (ain == 2) { const int x = c & 7, rk = c >> 3;
            if (rk < 24) { if (i >= 3) return false; const int idx = 24 * i + rk; u.pm = 8 * x + (idx & 7); u.pn = idx >> 3; return true; }
            const int j = rk - 24;
            if (i == 0) { u.pm = 8 * x + j; u.pn = 9; return true; }
            if (j < 4 || i >= 3) return false; u.pm = 8 * x + 2 * (j - 4) + (i - 1); u.pn = 10; return true; }
        if (ain == 3) { if (i >= 1) return false; u.pm = nM; u.pn = nN; return true; }
        if (ain) { if (i >= 3) return false; const int x = c & 7, rk = c >> 3, p = rk >> 3; u.pm = 8 * x + (rk & 7); u.pn = (i == 2) ? p : 4 + 2 * p + i; return true; }
        const long L = (long)i * G + c; if (L >= nwg) return false;
        int wgid = (int)L; { const int q = nwg / NXCD, r = nwg % NXCD, xcd = wgid % NXCD, off = wgid / NXCD; wgid = (xcd < r ? xcd * (q + 1) : r * (q + 1) + (xcd - r) * q) + off; }
        const int nig = WGM * nN, gid = wgid / nig, fm = gid * WGM, gsz = (nM - fm) < WGM ? (nM - fm) : WGM;
        u.pm = fm + ((wgid % nig) % gsz); u.pn = (wgid % nig) / gsz; return true;
    }
};

template <class Epi>
__device__ __forceinline__ void gemm_phase(LAS unsigned char* lds, const Gemm g, const StaticOrder& S, const Epi& E) {
    const int tid = threadIdx.x, wid = __builtin_amdgcn_readfirstlane(tid >> 6), lane = tid & 63, wr = wid >> 2, wc = wid & 3, fr = lane & 15, fq = lane >> 4;
    const int K = g.K, nt = K / BK;
    unsigned voffA[2], voffB[2];
#pragma unroll
    for (int i = 0; i < 2; ++i) { int R, C; stage_rc(tid * 16 + i * 8192, R, C); const int Rb = Epi::PERM ? ((R & ~31) + perm32(R & 31)) : R;
        voffA[i] = (unsigned)(R * (g.lda ? g.lda : K) + C) * 2u; voffB[i] = (unsigned)(Rb * K + C) * 2u; }
    const size_t kstep = (size_t)(BK * 2);
    const size_t hstep = (size_t)HALF * K * 2;
    const size_t tstep = 2 * hstep;
    const size_t ahs = g.ahstep ? g.ahstep : hstep, ats = g.atstep ? g.atstep : tstep;
    const unsigned ldsw = (unsigned)wid * 1024u;
    const int aoff = lds_byte(wr * 64 + fr, fq * 8), boff = lds_byte(wc * 32 + fr, fq * 8);
#define PG8_SA(b, h) (((b) * 2 + (h)) * HTB)
#define PG8_SB(b, h) ((4 + (b) * 2 + (h)) * HTB)
#define PG8_STAGE(bufoff, gbase, voff) do { _Pragma("unroll") for (int _i = 0; _i < 2; ++_i) \
        __builtin_amdgcn_global_load_lds((const unsigned*)((const char*)(gbase) + (voff)[_i]), (LAS unsigned*)(lds + (bufoff) + ldsw + _i * 8192), 16, 0, 0); } while (0)
#define PG8_LDA(dst, b, h) do { _Pragma("unroll") for (int m = 0; m < 4; ++m) _Pragma("unroll") for (int k = 0; k < 2; ++k) dst[m][k] = *(const LAS bf16x8*)(lds + PG8_SA(b, h) + aoff + m * 2048 + k * 1024); } while (0)
#define PG8_LDB(dst, b, h) do { _Pragma("unroll") for (int n = 0; n < 2; ++n) _Pragma("unroll") for (int k = 0; k < 2; ++k) dst[n][k] = *(const LAS bf16x8*)(lds + PG8_SB(b, h) + boff + n * 2048 + k * 1024); } while (0)
#define PG8_MMA(ai, bj, At, Bt) do { __builtin_amdgcn_s_setprio(1); _Pragma("unroll") for (int m = 0; m < 4; ++m) _Pragma("unroll") for (int n = 0; n < 2; ++n) _Pragma("unroll") for (int k = 0; k < 2; ++k) \
        acc[ai][bj][m][n] = __builtin_amdgcn_mfma_f32_16x16x32_bf16(Bt[n][k], At[m][k], acc[ai][bj][m][n], 0, 0, 0); __builtin_amdgcn_s_setprio(0); } while (0)
#define PG8_WAIT_V(n) asm volatile("s_waitcnt vmcnt(" #n ")" ::: "memory")
#define PG8_WAIT_L(n) asm volatile("s_waitcnt lgkmcnt(" #n ")" ::: "memory")
#define PG8_BAR __builtin_amdgcn_s_barrier()
#define PG8_SCHED __builtin_amdgcn_sched_barrier(0)
#define PG8_ABASE(u) ((const char*)((u).pn < g.pn_split ? g.A : g.A2) + (size_t)((u).pm >> 3) * g.abatch + (size_t)((u).pm & 7) * ats)
    Unit cur, nxt; int ui = 0;
    if (!S.next(0, cur)) return;
    f32x4 acc[2][2][4][2];
#pragma unroll
    for (int a = 0; a < 2; ++a)
#pragma unroll
        for (int b = 0; b < 2; ++b)
#pragma unroll
            for (int m = 0; m < 4; ++m)
#pragma unroll
                for (int n = 0; n < 2; ++n) acc[a][b][m][n] = (f32x4){0.f, 0.f, 0.f, 0.f};
    bf16x8 At[4][2], B0[2][2], B1[2][2];
    const char* cA = PG8_ABASE(cur); const char* cB = (const char*)g.Bt + (size_t)cur.pn * tstep;
#define PG8_VEC(u, slot) do { if (Epi::HAS_VEC && wid == 0) { \
        __builtin_amdgcn_global_load_lds((const unsigned*)(E.vec_rows(u) + 4 * lane), (LAS unsigned*)(lds + VEC_LDS + (slot) * 2048), 16, 0, 0); \
        __builtin_amdgcn_global_load_lds((const unsigned*)(E.vec_cols(u) + 4 * lane), (LAS unsigned*)(lds + VEC_LDS + (slot) * 2048 + 1024), 16, 0, 0); } } while (0)
    PG8_VEC(cur, 0);
    PG8_STAGE(PG8_SB(0, 0), cB, voffB); PG8_STAGE(PG8_SB(0, 1), cB + hstep, voffB); PG8_STAGE(PG8_SA(0, 0), cA, voffA); PG8_STAGE(PG8_SA(0, 1), cA + ahs, voffA);
    if (wr == 1) PG8_BAR;
    PG8_WAIT_V(2); PG8_BAR;
    PG8_STAGE(PG8_SB(1, 0), cB + kstep, voffB); PG8_STAGE(PG8_SA(1, 0), cA + kstep, voffA); PG8_STAGE(PG8_SB(1, 1), cB + hstep + kstep, voffB);
    PG8_WAIT_V(6); PG8_BAR;
    for (;;) {
        const bool has_next = S.next(ui + 1, nxt);
        const char* nA = has_next ? PG8_ABASE(nxt) : cA; const char* nB = has_next ? (const char*)g.Bt + (size_t)nxt.pn * tstep : cB;
        const bool skipb1 = Epi::HALF_N_TILE >= 0 && cur.pn == Epi::HALF_N_TILE;
        for (int t = 0; t < nt; t += 2) {
            const bool last = (t == nt - 2);
            const char* a1 = cA + (size_t)(t + 1) * kstep;
            const char* a2 = last ? nA : cA + (size_t)(t + 2) * kstep; const char* b2 = last ? nB : cB + (size_t)(t + 2) * kstep;
            const char* a3 = a2 + kstep; const char* b3 = b2 + kstep;
            PG8_LDB(B0, 0, 0); PG8_LDB(B1, 0, 1); PG8_SCHED; PG8_LDA(At, 0, 0); PG8_STAGE(PG8_SA(1, 1), a1 + ahs, voffA);
            PG8_WAIT_V(8); PG8_WAIT_L(0); PG8_BAR; PG8_MMA(0, 0, At, B0); if (!skipb1) PG8_MMA(0, 1, At, B1); PG8_BAR; PG8_SCHED;
            PG8_LDA(At, 0, 1); PG8_STAGE(PG8_SB(0, 0), b2, voffB); PG8_STAGE(PG8_SB(0, 1), b2 + hstep, voffB); PG8_STAGE(PG8_SA(0, 0), a2, voffA);
            PG8_WAIT_V(8); PG8_WAIT_L(0); PG8_BAR; PG8_MMA(1, 0, At, B0); if (!skipb1) PG8_MMA(1, 1, At, B1); PG8_BAR; PG8_SCHED;
            PG8_LDB(B0, 1, 0); PG8_LDB(B1, 1, 1); PG8_SCHED; PG8_LDA(At, 1, 0); PG8_STAGE(PG8_SA(0, 1), a2 + ahs, voffA);
            PG8_WAIT_V(8); PG8_WAIT_L(0); PG8_BAR; PG8_MMA(0, 0, At, B0); if (!skipb1) PG8_MMA(0, 1, At, B1); PG8_BAR; PG8_SCHED;
            PG8_LDA(At, 1, 1); PG8_STAGE(PG8_SB(1, 0), b3, voffB); PG8_STAGE(PG8_SB(1, 1), b3 + hstep, voffB); PG8_STAGE(PG8_SA(1, 0), a3, voffA);
            PG8_WAIT_V(8); PG8_WAIT_L(0); PG8_BAR; PG8_MMA(1, 0, At, B0); if (!skipb1) PG8_MMA(1, 1, At, B1); PG8_BAR; PG8_SCHED;
        }
        if (wr == 0) PG8_BAR;
        E(acc, cur, wr, wc, fr, fq, ui & 1);
        if (!has_next) break;
        PG8_VEC(nxt, (ui + 1) & 1);
#pragma unroll
        for (int a = 0; a < 2; ++a)
#pragma unroll
            for (int b = 0; b < 2; ++b)
#pragma unroll
                for (int m = 0; m < 4; ++m)
#pragma unroll
                    for (int n = 0; n < 2; ++n) acc[a][b][m][n] = (f32x4){0.f, 0.f, 0.f, 0.f};
        cur = nxt; cA = nA; cB = nB; ++ui;
        if (wr == 1) PG8_BAR;
    }
    PG8_WAIT_V(0);
    PG8_BAR;
#undef PG8_SA
#undef PG8_SB
#undef PG8_STAGE
#undef PG8_LDA
#undef PG8_LDB
#undef PG8_MMA
#undef PG8_WAIT_V
#undef PG8_WAIT_L
#undef PG8_BAR
#undef PG8_SCHED
#undef PG8_ABASE
#undef PG8_VEC
}

typedef f32x4 Acc[2][2][4][2];

struct EpiAin {
    static constexpr bool PERM = true, HAS_VEC = false; static constexpr int HALF_N_TILE = -1;
    __device__ __forceinline__ const float* vec_rows(const Unit&) const { return nullptr; } __device__ __forceinline__ const float* vec_cols(const Unit&) const { return nullptr; }
    static constexpr bool HAS_PRE = false; struct Pre {};
    unsigned char* slab0;
    const float* conv_w;
    LAS unsigned char* lds;
    __device__ __forceinline__ void operator()(const Acc& acc, const Unit& u, int wr, int wc, int fr, int fq, int vslot) const {
        const int rip0 = wr * 64 + fr;
        const int row0 = (u.pm & 7) * BM + rip0;
        unsigned char* slab = slab0 + (size_t)(u.pm >> 3) * SLAB;
        bf16_t* V = (bf16_t*)(slab + SO_V);
        if (u.pn < 4) {
            bf16_t* Y = (bf16_t*)(slab + SO_Y); bf16_t* GBH = (bf16_t*)(slab + SO_GB) + (size_t)(u.pm & 7) * 2 * DM;
            const int col0 = u.pn * BM + wc * 32 + 8 * fq;
            {
                const int lane_ = threadIdx.x & 63, wid_ = __builtin_amdgcn_readfirstlane(threadIdx.x >> 6);
                asm volatile("s_waitcnt vmcnt(0)\n\ts_barrier" ::: "memory");
                const bf16_t* gsrc = V + ((size_t)((u.pm & 7) * BM) + 32 * wid_) * DM + u.pn * BM;
                const int rl_ = lane_ >> 5, cp_ = lane_ & 31;
                unsigned vo_[4];
#pragma unroll
                for (int k = 0; k < 4; ++k) vo_[k] = (unsigned)(rl_ * DM + ((cp_ ^ (((2 * k + rl_) & 7) << 2)) << 3));
#pragma unroll
                for (int i = 0; i < 16; ++i)
                    __builtin_amdgcn_global_load_lds((const unsigned*)((gsrc + (size_t)(2 * i) * DM) + vo_[i & 3]), (LAS unsigned*)(lds + (32 * wid_ + 2 * i) * 512), 16, 0, 0);
                asm volatile("s_waitcnt vmcnt(0)\n\ts_barrier" ::: "memory");
            }
            const LAS unsigned char* ldr = lds + rip0 * 512;
            int sw_[3];
#pragma unroll
            for (int k = 0; k < 3; ++k) sw_[k] = ((fr - k) & 7) << 2;
#pragma unroll
            for (int bj = 0; bj < 2; ++bj) { const int cw = col0 + bj * HALF; const int ch = 16 * bj + 4 * wc + fq;
                f32x4 w0[2], w1[2], w2[2];
#pragma unroll
                for (int n = 0; n < 2; ++n) { w0[n] = *(const f32x4*)(conv_w + cw + 4 * n); w1[n] = *(const f32x4*)(conv_w + DM + cw + 4 * n); w2[n] = *(const f32x4*)(conv_w + 2 * DM + cw + 4 * n); }
#pragma unroll
                for (int ai = 0; ai < 2; ++ai)
#pragma unroll
                    for (int m = 0; m < 4; ++m) { const int rip = rip0 + ai * HALF + m * 16;
                        const f32x4 g0 = acc[ai][bj][m][0], g1 = acc[ai][bj][m][1];
                        u32x4 w;
                        if (rip >= 2) {
                            const LAS unsigned char* rp = ldr + (ai * HALF + m * 16) * 512;
                            const u32x4 a = *(const LAS u32x4*)(rp + ((ch ^ sw_[0]) << 4)), b1 = *(const LAS u32x4*)(rp - 512 + ((ch ^ sw_[1]) << 4)), b2 = *(const LAS u32x4*)(rp - 1024 + ((ch ^ sw_[2]) << 4));
                            const f32x4 v0a = (f32x4){bf_lo(a.x), bf_hi(a.x), bf_lo(a.y), bf_hi(a.y)}, v0b = (f32x4){bf_lo(a.z), bf_hi(a.z), bf_lo(a.w), bf_hi(a.w)};
                            const f32x4 v1a = (f32x4){bf_lo(b1.x), bf_hi(b1.x), bf_lo(b1.y), bf_hi(b1.y)}, v1b = (f32x4){bf_lo(b1.z), bf_hi(b1.z), bf_lo(b1.w), bf_hi(b1.w)};
                            const f32x4 v2a = (f32x4){bf_lo(b2.x), bf_hi(b2.x), bf_lo(b2.y), bf_hi(b2.y)}, v2b = (f32x4){bf_lo(b2.z), bf_hi(b2.z), bf_lo(b2.w), bf_hi(b2.w)};
                            const f32x4 ya = g0 * (w2[0] * v0a + w1[0] * v1a + w0[0] * v2a), yb = g1 * (w2[1] * v0b + w1[1] * v1b + w0[1] * v2b);
                            w.x = cvtpk(ya[0], ya[1]); w.y = cvtpk(ya[2], ya[3]); w.z = cvtpk(yb[0], yb[1]); w.w = cvtpk(yb[2], yb[3]);
                            *(u32x4*)(Y + (size_t)(row0 + ai * HALF + m * 16) * DM + cw) = w;
                        } else {
                            w.x = cvtpk(g0[0], g0[1]); w.y = cvtpk(g0[2], g0[3]); w.z = cvtpk(g1[0], g1[1]); w.w = cvtpk(g1[2], g1[3]);
                            *(u32x4*)(GBH + (size_t)rip * DM + cw) = w;
                        } }
            }
        } else {
            const int col0 = (u.pn - 4) * HALF + wc * 32 + 8 * fq;
#pragma unroll
            for (int ai = 0; ai < 2; ++ai)
#pragma unroll
                for (int m = 0; m < 4; ++m) { bf16_t* rowp = V + (size_t)(row0 + ai * HALF + m * 16) * DM + col0;
                    const f32x4 v0 = acc[ai][0][m][0] * acc[ai][1][m][0], v1 = acc[ai][0][m][1] * acc[ai][1][m][1];
                    u32x4 w; w.x = cvtpk(v0[0], v0[1]); w.y = cvtpk(v0[2], v0[3]); w.z = cvtpk(v1[0], v1[1]); w.w = cvtpk(v1[2], v1[3]);
                    *(u32x4*)rowp = w; }
        }
    }
};

constexpr int RES_AUX = 2;
template <int NA, int INM, int OUTM> struct EpiRes {
    static constexpr bool PERM = true, HAS_VEC = false; static constexpr int HALF_N_TILE = -1;
    __device__ __forceinline__ const float* vec_rows(const Unit&) const { return nullptr; } __device__ __forceinline__ const float* vec_cols(const Unit&) const { return nullptr; }
    const void* xin; void* xout; const float* gate; int gate_stride;
    const float* gain0; const float* sc0; int sc0_stride; bf16_t* A0;
    const float* gain1; const float* sc1; int sc1_stride; bf16_t* A1;
    float* sumsq;
    const float* gain_in; const float* sc_in; int sc_in_stride;
    LAS unsigned char* lds = nullptr;
    __device__ __forceinline__ void operator()(const Acc& acc, const Unit& u, int wr, int wc, int fr, int fq, int vslot) const {
        constexpr bool IN16 = INM != 0;
        const int b = u.pm >> 3;
        const int row0 = u.pm * BM + wr * 64 + fr, col0 = u.pn * BM + wc * 32 + 8 * fq;
        const size_t tbase = (size_t)u.pm * BM * DM + (size_t)u.pn * BM;
        const unsigned loff = (unsigned)((wr * 64 + fr) * DM + wc * 32 + 8 * fq);
        f32x4 gv[2][2], a0[2][2], a1[2][2], ia[2][2];
        constexpr int NH = IN16 ? 1 : 2, ROWB = IN16 ? 512 : 1024;
        const int lane_ = threadIdx.x & 63, wid_ = __builtin_amdgcn_readfirstlane(threadIdx.x >> 6);
        asm volatile("s_waitcnt vmcnt(0)\n\ts_barrier" ::: "memory");
#pragma unroll
        for (int hh = 0; hh < NH; ++hh) {
            if (hh > 0) asm volatile("s_waitcnt lgkmcnt(0)\n\ts_barrier" ::: "memory");
            if constexpr (IN16) {
                const bf16_t* gsrc = (const bf16_t*)xin + tbase + (size_t)(32 * wid_) * DM;
                const int rl_ = lane_ >> 5, cp_ = lane_ & 31;
                unsigned vo_[4];
#pragma unroll
                for (int k = 0; k < 4; ++k) vo_[k] = (unsigned)(rl_ * DM + ((cp_ ^ (((2 * k + rl_) & 7) << 2)) << 3));
#pragma unroll
                for (int i = 0; i < 16; ++i)
                    __builtin_amdgcn_global_load_lds((const unsigned*)((gsrc + (size_t)(2 * i) * DM) + vo_[i & 3]), (LAS unsigned*)(lds + (32 * wid_ + 2 * i) * 512), 16, 0, RES_AUX);
            } else {
                const float* gsrc = (const float*)xin + tbase + (size_t)(hh * HALF + 16 * wid_) * DM;
#pragma unroll 2
                for (int i = 0; i < 16; ++i)
                    __builtin_amdgcn_global_load_lds((const unsigned*)((gsrc + (size_t)i * DM) + (unsigned)((lane_ ^ i) << 2)), (LAS unsigned*)(lds + (16 * wid_ + i) * 1024), 16, 0, RES_AUX);
            }
            if (hh == 0) {
#pragma unroll
                for (int bj = 0; bj < 2; ++bj)
#pragma unroll
                    for (int n = 0; n < 2; ++n) { const int c = col0 + bj * HALF + 4 * n;
                        gv[bj][n] = *(const f32x4*)(gate + (size_t)b * gate_stride + c);
                        if (NA >= 1) a0[bj][n] = *(const f32x4*)(gain0 + c) * (*(const f32x4*)(sc0 + (size_t)b * sc0_stride + c) + 1.0f);
                        if (NA >= 2) a1[bj][n] = *(const f32x4*)(gain1 + c) * (*(const f32x4*)(sc1 + (size_t)b * sc1_stride + c) + 1.0f);
                        if (INM == 2) { const f32x4 t = *(const f32x4*)(gain_in + c) * (*(const f32x4*)(sc_in + (size_t)b * sc_in_stride + c) + 1.0f); ia[bj][n] = (f32x4){__builtin_amdgcn_rcpf(t[0]), __builtin_amdgcn_rcpf(t[1]), __builtin_amdgcn_rcpf(t[2]), __builtin_amdgcn_rcpf(t[3])}; } }
            }
            asm volatile("s_waitcnt vmcnt(0)\n\ts_barrier" ::: "memory");
            const LAS unsigned char* ldr = lds + (wr * 64 + fr) * ROWB;
#pragma unroll
            for (int qq = 0; qq < 8 / NH; ++qq) { const int q = hh * (8 / NH) + qq, ai = q >> 2, m = q & 3; const int row = row0 + ai * HALF + m * 16; const size_t off = tbase + (size_t)((ai * HALF + m * 16) * DM); float ss = 0.f;
#pragma unroll
                for (int bj = 0; bj < 2; ++bj) { const size_t o = off + bj * HALF;
                    f32x4 x0, x1;
                    if constexpr (IN16) { const u32x4 w = *(const LAS u32x4*)(ldr + (ai * HALF + m * 16) * 512 + (((16 * bj + 4 * wc + fq) ^ ((fr & 7) << 2)) << 4));
                        x0 = (f32x4){bf_lo(w.x), bf_hi(w.x), bf_lo(w.y), bf_hi(w.y)}; x1 = (f32x4){bf_lo(w.z), bf_hi(w.z), bf_lo(w.w), bf_hi(w.w)}; }
                    else { const int c0_ = 32 * bj + 8 * wc + 2 * fq; x0 = *(const LAS f32x4*)(ldr + (m * 16) * 1024 + ((c0_ ^ fr) << 4)); x1 = *(const LAS f32x4*)(ldr + (m * 16) * 1024 + (((c0_ + 1) ^ fr) << 4)); }
                    if (INM == 2) { x0 = x0 * ia[bj][0]; x1 = x1 * ia[bj][1]; }
                    x0 = x0 + gv[bj][0] * acc[ai][bj][m][0]; x1 = x1 + gv[bj][1] * acc[ai][bj][m][1];
                    if (OUTM == 0) {
                        f32x4 s0 = x0, s1 = x1;
#pragma unroll
                        for (int e = 0; e < 4; ++e) { auto rr = __builtin_amdgcn_permlane16_swap(__float_as_uint(s0[e]), __float_as_uint(s1[e]), false, false);
                            rr = __builtin_amdgcn_permlane32_swap(rr[0], rr[1], false, false); s0[e] = __uint_as_float(rr[0]); s1[e] = __uint_as_float(rr[1]); }
                        const int adj0 = -4 * fq, adj1 = 16 - 4 * fq;
                        *(f32x4*)(((float*)xout + o) + (loff + adj0)) = s0; *(f32x4*)(((float*)xout + o) + (loff + adj1)) = s1; }
                    if (NA >= 1) { ss += ((x0[0] * x0[0] + x0[1] * x0[1]) + (x0[2] * x0[2] + x0[3] * x0[3])) + ((x1[0] * x1[0] + x1[1] * x1[1]) + (x1[2] * x1[2] + x1[3] * x1[3]));
                        const f32x4 t0 = x0 * a0[bj][0], t1 = x1 * a0[bj][1]; u32x4 w; w.x = cvtpk(t0[0], t0[1]); w.y = cvtpk(t0[2], t0[3]); w.z = cvtpk(t1[0], t1[1]); w.w = cvtpk(t1[2], t1[3]); *(u32x4*)((A0 + o) + loff) = w; }
                    if (NA >= 2) { const f32x4 t0 = x0 * a1[bj][0], t1 = x1 * a1[bj][1]; u32x4 w; w.x = cvtpk(t0[0], t0[1]); w.y = cvtpk(t0[2], t0[3]); w.z = cvtpk(t1[0], t1[1]); w.w = cvtpk(t1[2], t1[3]); *(u32x4*)((A1 + o) + loff) = w; } }
                if (NA >= 1) { ss = sum_rows4(ss); if (fq == 0) unsafeAtomicAdd(sumsq + row, ss); } }
        }
    }
};

struct EpiMlp1 {
    static constexpr bool PERM = true, HAS_VEC = true; static constexpr int HALF_N_TILE = -1;
    bf16_t* H; const float* bias; const float* sumsq; LAS unsigned char* lds;
    __device__ __forceinline__ const float* vec_rows(const Unit& u) const { return sumsq + (size_t)u.pm * BM; }
    __device__ __forceinline__ const float* vec_cols(const Unit& u) const { return bias + (size_t)(u.pm >> 3) * FF + (size_t)u.pn * BM; }
    __device__ __forceinline__ void operator()(const Acc& acc, const Unit& u, int wr, int wc, int fr, int fq, int vslot) const {
        const int row0 = u.pm * BM + wr * 64 + fr, col0 = u.pn * BM + wc * 32 + 8 * fq;
        const LAS float* lv = (const LAS float*)(lds + VEC_LDS + vslot * 2048);
        f32x4 bv[2][2];
#pragma unroll
        for (int bj = 0; bj < 2; ++bj)
#pragma unroll
            for (int n = 0; n < 2; ++n) bv[bj][n] = *(const LAS f32x4*)(lv + 256 + bj * HALF + wc * 32 + 8 * fq + 4 * n);
        float ssv[8];
#pragma unroll
        for (int q = 0; q < 8; ++q) ssv[q] = lv[wr * 64 + fr + (q >> 2) * HALF + (q & 3) * 16];
        asm volatile("" : "+v"(ssv[0]), "+v"(ssv[1]), "+v"(ssv[2]), "+v"(ssv[3]), "+v"(ssv[4]), "+v"(ssv[5]), "+v"(ssv[6]), "+v"(ssv[7]));
#pragma unroll
        for (int ai = 0; ai < 2; ++ai)
#pragma unroll
            for (int m = 0; m < 4; ++m) { const int row = row0 + ai * HALF + m * 16; const float rs = rsqrtf(ssv[ai * 4 + m] * (1.0f / DM) + EPS);
                bf16_t* rowp = H + (size_t)row * FF + col0;
#pragma unroll
                for (int bj = 0; bj < 2; ++bj) { f32x4 v0 = acc[ai][bj][m][0] * rs + bv[bj][0], v1 = acc[ai][bj][m][1] * rs + bv[bj][1];
#pragma unroll
                    for (int e = 0; e < 4; ++e) { const float r0 = fmaxf(v0[e], 0.f), r1 = fmaxf(v1[e], 0.f); v0[e] = r0 * r0; v1[e] = r1 * r1; }
                    u32x4 w; w.x = cvtpk(v0[0], v0[1]); w.y = cvtpk(v0[2], v0[3]); w.z = cvtpk(v1[0], v1[1]); w.w = cvtpk(v1[2], v1[3]);
                    *(u32x4*)(rowp + bj * HALF) = w; } }
    }
};

struct EpiKVQ {
    static constexpr bool PERM = true, HAS_VEC = true; static constexpr int HALF_N_TILE = 10;
    unsigned char* slab0; const float* bias; const float* sumsq; const float* k_gain; const float* q_gain; LAS unsigned char* lds;
    unsigned* rdy = nullptr;
    __device__ __forceinline__ const float* vec_rows(const Unit& u) const { return sumsq + (size_t)u.pm * BM; }
    __device__ __forceinline__ const float* vec_cols(const Unit& u) const { return bias + (size_t)(u.pm >> 3) * NKVQ + (size_t)u.pn * BM; }
    __device__ __forceinline__ void operator()(const Acc& acc, const Unit& u, int wr, int wc, int fr, int fq, int vslot) const {
        const int b = u.pm >> 3, pn = u.pn;
        const int row0 = u.pm * BM + wr * 64 + fr;
        unsigned char* slab = slab0 + (size_t)b * SLAB;
        bf16_t* KV = (bf16_t*)(slab + SO_KV); bf16_t* Q = (bf16_t*)(slab + SO_Q); float* gates = (float*)(slab + SO_GATES);
        const LAS float* lv = (const LAS float*)(lds + VEC_LDS + vslot * 2048);
        f32x4 bv[2][2];
#pragma unroll
        for (int bj = 0; bj < 2; ++bj)
#pragma unroll
            for (int n = 0; n < 2; ++n) bv[bj][n] = *(const LAS f32x4*)(lv + 256 + bj * HALF + wc * 32 + 8 * fq + 4 * n);
        float ssv[8];
#pragma unroll
        for (int q = 0; q < 8; ++q) ssv[q] = lv[wr * 64 + fr + (q >> 2) * HALF + (q & 3) * 16];
        asm volatile("" : "+v"(ssv[0]), "+v"(ssv[1]), "+v"(ssv[2]), "+v"(ssv[3]), "+v"(ssv[4]), "+v"(ssv[5]), "+v"(ssv[6]), "+v"(ssv[7]));
        if (pn == 10) {
            if (wc < 2) {
#pragma unroll
                for (int ai = 0; ai < 2; ++ai)
#pragma unroll
                    for (int m = 0; m < 4; ++m) { const int row = row0 + ai * HALF + m * 16; const float rs = rsqrtf(ssv[ai * 4 + m] * (1.0f / DM) + EPS);
#pragma unroll
                        for (int n = 0; n < 2; ++n) { const int c = wc * 32 + 8 * fq + 4 * n;
                            if (c < 48) { const f32x4 v = acc[ai][0][m][n] * rs + bv[0][n]; f32x4 o;
#pragma unroll
                                for (int e = 0; e < 4; ++e) o[e] = 1.0f / (1.0f + __expf(-v[e]));
                                *(f32x4*)(gates + (size_t)(row & (SEQ - 1)) * 48 + c) = o; } } }
            }
            return;
        }
        const bool is_q = pn >= 6;
        const bool do_norm = is_q || pn == 2 || pn == 4;
        f32x4 gn[2][2];
        { const LAS float* gp = (const LAS float*)(lds + GAIN_LDS) + (is_q ? 192 : (pn == 2 ? 64 : 128)); const float sc = is_q ? QSCALE : 1.0f;
#pragma unroll
          for (int bj = 0; bj < 2; ++bj)
#pragma unroll
              for (int n = 0; n < 2; ++n) gn[bj][n] = do_norm ? *(const LAS f32x4*)(gp + 32 * bj + 8 * fq + 4 * n) * sc : (f32x4){1.f, 1.f, 1.f, 1.f}; }
#pragma unroll
        for (int ai = 0; ai < 2; ++ai)
#pragma unroll
            for (int m = 0; m < 4; ++m) { const int row = row0 + ai * HALF + m * 16; const float rs = rsqrtf(ssv[ai * 4 + m] * (1.0f / DM) + EPS);
                f32x4 v[2][2]; float ss = 0.f;
#pragma unroll
                for (int bj = 0; bj < 2; ++bj)
#pragma unroll
                    for (int n = 0; n < 2; ++n) { v[bj][n] = acc[ai][bj][m][n] * rs + bv[bj][n]; const f32x4 t = v[bj][n]; ss += (t[0] * t[0] + t[1] * t[1]) + (t[2] * t[2] + t[3] * t[3]); }
                float hs = 1.0f;
                if (do_norm) { ss = sum_rows4(ss); hs = rsqrtf(ss * (1.0f / 64.0f) + EPS); }
                bf16_t* rowp;
                if (is_q) rowp = Q + (size_t)(row & (SEQ - 1)) * DM + ((pn - 6) * 4 + wc) * 64 + 8 * fq;
                else rowp = KV + ((size_t)(pn * 4 + wc) * SEQ + (row & (SEQ - 1))) * 64 + 8 * fq;
#pragma unroll
                for (int bj = 0; bj < 2; ++bj) { const f32x4 v0 = v[bj][0] * hs * gn[bj][0], v1 = v[bj][1] * hs * gn[bj][1];
                    u32x4 w; w.x = cvtpk(v0[0], v0[1]); w.y = cvtpk(v0[2], v0[3]); w.z = cvtpk(v1[0], v1[1]); w.w = cvtpk(v1[2], v1[3]);
                    *(u32x4*)(rowp + 32 * bj) = w; } }
        if (rdy != nullptr && pn < 2) { asm volatile("s_waitcnt vmcnt(0)\n\ts_barrier" ::: "memory");
            if (threadIdx.x == 0) __hip_atomic_fetch_add(rdy + 64 * pn, 1u, __ATOMIC_RELAXED, __HIP_MEMORY_SCOPE_AGENT); }
    }
};
}

namespace att {
constexpr int SLOTB = 8192;
constexpr int L_K = 0, L_V = 3 * SLOTB, L_WS = 6 * SLOTB, L_SEL = L_WS + 4096, L_NIB = L_SEL + 256, L_SC = L_NIB + 768, L_IA = L_SC + 8704, L_IB = L_IA + 33792, L_END = L_IB + 33792, L_OST = L_IA;
static_assert(L_END <= 131072 && (L_IA % 16) == 0 && (L_SC % 16) == 0, "attention LDS map");
#define SBAR() __builtin_amdgcn_sched_barrier(0)
#define ATT_WAIT_BAR(N) asm volatile("s_waitcnt vmcnt(" #N ") lgkmcnt(0)\n\ts_barrier" ::: "memory")
__device__ __forceinline__ int crow(int r, int hi) { return (r & 3) + 8 * (r >> 2) + 4 * hi; }
__device__ __forceinline__ void glds16(const void* gsrc, unsigned lds_dst) { unsigned keep;
    asm volatile("s_mov_b32 %0, m0\n\ts_mov_b32 m0, %2\n\ts_nop 0\n\tglobal_load_lds_dwordx4 %1, off\n\ts_mov_b32 m0, %0" : "=&s"(keep) : "v"(gsrc), "s"(lds_dst) : "memory"); }

__device__ __forceinline__ void qkt_c(f32x16& p0, f32x16& p1, const LAS unsigned char* Kslot, const bf16x8* qr, const f32x16& ci, int r32, int hi) {
    const LAS unsigned char* kb = Kslot + hi * 1024 + r32 * 16;
    bf16x8 kf[8];
#pragma unroll
    for (int i = 0; i < 8; ++i) kf[i] = *(const LAS bf16x8*)(kb + (i >> 1) * 2048 + (i & 1) * 512);
    asm volatile("" : "+v"(kf[0]), "+v"(kf[1]), "+v"(kf[2]), "+v"(kf[3]), "+v"(kf[4]), "+v"(kf[5]), "+v"(kf[6]), "+v"(kf[7]));
    p0 = __builtin_amdgcn_mfma_f32_32x32x16_bf16(kf[0], qr[0], ci, 0, 0, 0); p1 = __builtin_amdgcn_mfma_f32_32x32x16_bf16(kf[1], qr[0], ci, 0, 0, 0);
#pragma unroll
    for (int d0 = 1; d0 < 4; ++d0) { p0 = __builtin_amdgcn_mfma_f32_32x32x16_bf16(kf[2 * d0], qr[d0], p0, 0, 0, 0); p1 = __builtin_amdgcn_mfma_f32_32x32x16_bf16(kf[2 * d0 + 1], qr[d0], p1, 0, 0, 0); }
}
__device__ __forceinline__ void qkt(f32x16& p0, f32x16& p1, const LAS unsigned char* Kslot, const bf16x8* qr, int r32, int hi) {
    const LAS unsigned char* kb = Kslot + hi * 1024 + r32 * 16;
    bf16x8 kf[8];
#pragma unroll
    for (int i = 0; i < 8; ++i) kf[i] = *(const LAS bf16x8*)(kb + (i >> 1) * 2048 + (i & 1) * 512);
    asm volatile("" : "+v"(kf[0]), "+v"(kf[1]), "+v"(kf[2]), "+v"(kf[3]), "+v"(kf[4]), "+v"(kf[5]), "+v"(kf[6]), "+v"(kf[7]));
    const f32x16 z = f32x16{};
    p0 = __builtin_amdgcn_mfma_f32_32x32x16_bf16(kf[0], qr[0], z, 0, 0, 0); p1 = __builtin_amdgcn_mfma_f32_32x32x16_bf16(kf[1], qr[0], z, 0, 0, 0);
#pragma unroll
    for (int d0 = 1; d0 < 4; ++d0) { p0 = __builtin_amdgcn_mfma_f32_32x32x16_bf16(kf[2 * d0], qr[d0], p0, 0, 0, 0); p1 = __builtin_amdgcn_mfma_f32_32x32x16_bf16(kf[2 * d0 + 1], qr[d0], p1, 0, 0, 0); }
}
__device__ __forceinline__ void range_mask(f32x16& p0, f32x16& p1, int lo, int hv, int hi) {
    const int lo2 = lo - 4 * hi, hv2 = hv - 4 * hi;
#pragma unroll
    for (int r = 0; r < 16; ++r) { const int kc = (r & 3) + 8 * (r >> 2); if (kc < lo2 || kc > hv2) p0[r] = -INFINITY; if (kc + 32 < lo2 || kc + 32 > hv2) p1[r] = -INFINITY; }
}
__device__ __forceinline__ float max3f(float a, float b, float c) { float r; asm("v_max3_f32 %0, %1, %2, %3" : "=v"(r) : "v"(a), "v"(b), "v"(c)); return r; }
__device__ __forceinline__ float max2f(float a, float b) { float r; asm("v_max_f32_e32 %0, %1, %2" : "=v"(r) : "v"(a), "v"(b)); return r; }
__device__ __forceinline__ float rowmax(const f32x16& p0, const f32x16& p1) {
    float a = max3f(p0[0], p0[1], p1[0]), b = max3f(p0[2], p0[3], p1[1]); a = max3f(a, p1[2], p1[3]);
#pragma unroll
    for (int r = 4; r < 16; r += 4) { a = max3f(a, p0[r], p0[r + 1]); b = max3f(b, p0[r + 2], p0[r + 3]); a = max3f(a, p1[r], p1[r + 1]); b = max3f(b, p1[r + 2], p1[r + 3]); }
    const float m = max2f(a, b);
    auto rr = __builtin_amdgcn_permlane32_swap(__float_as_uint(m), __float_as_uint(m), false, false);
    return max2f(__uint_as_float(rr[0]), __uint_as_float(rr[1]));
}
__device__ __forceinline__ float halfsum(float a) {
    auto rr = __builtin_amdgcn_permlane32_swap(__float_as_uint(a), __float_as_uint(a), false, false);
    return __uint_as_float(rr[0]) + __uint_as_float(rr[1]);
}
__device__ __forceinline__ void pv(f32x16* o, int vb, bf16x8 pa0, bf16x8 pa1, bf16x8 pa2, bf16x8 pa3) {
    s16x4 lo[8], hi4[8];
#pragma unroll
    for (int q = 0; q < 8; ++q) {
        asm volatile("ds_read_b64_tr_b16 %0,%1 offset:%c2" : "=&v"(lo[q]) : "v"(vb), "i"((q >> 2) * 4096 + (q & 3) * 1024) : "memory");
        asm volatile("ds_read_b64_tr_b16 %0,%1 offset:%c2" : "=&v"(hi4[q]) : "v"(vb), "i"((q >> 2) * 4096 + (q & 3) * 1024 + 512) : "memory"); }
    asm volatile("s_waitcnt lgkmcnt(0)" ::: "memory"); SBAR();
#define PK(k) (bf16x8){lo[k][0], lo[k][1], lo[k][2], lo[k][3], hi4[k][0], hi4[k][1], hi4[k][2], hi4[k][3]}
    o[0] = __builtin_amdgcn_mfma_f32_32x32x16_bf16(pa0, PK(0), o[0], 0, 0, 0);
    o[1] = __builtin_amdgcn_mfma_f32_32x32x16_bf16(pa0, PK(4), o[1], 0, 0, 0);
    o[0] = __builtin_amdgcn_mfma_f32_32x32x16_bf16(pa1, PK(1), o[0], 0, 0, 0);
    o[1] = __builtin_amdgcn_mfma_f32_32x32x16_bf16(pa1, PK(5), o[1], 0, 0, 0);
    o[0] = __builtin_amdgcn_mfma_f32_32x32x16_bf16(pa2, PK(2), o[0], 0, 0, 0);
    o[1] = __builtin_amdgcn_mfma_f32_32x32x16_bf16(pa2, PK(6), o[1], 0, 0, 0);
    o[0] = __builtin_amdgcn_mfma_f32_32x32x16_bf16(pa3, PK(3), o[0], 0, 0, 0);
    o[1] = __builtin_amdgcn_mfma_f32_32x32x16_bf16(pa3, PK(7), o[1], 0, 0, 0);
#undef PK
}
__device__ __forceinline__ bf16x8 pack8(const f32x16& p, int base) {
    u32x4 w; w.x = cvtpk(p[base], p[base + 1]); w.y = cvtpk(p[base + 2], p[base + 3]); w.z = cvtpk(p[base + 4], p[base + 5]); w.w = cvtpk(p[base + 6], p[base + 7]);
    return __builtin_bit_cast(bf16x8, w);
}
__device__ __forceinline__ void row_bcast(float v, float (&out)[16], LAS float* wsf, int r32, int hi) {
    if (hi == 0) wsf[r32] = v;
#pragma unroll
    for (int i = 0; i < 4; ++i) { const f32x4 t = *(const LAS f32x4*)(wsf + 8 * i + 4 * hi); out[4 * i] = t[0]; out[4 * i + 1] = t[1]; out[4 * i + 2] = t[2]; out[4 * i + 3] = t[3]; }
}

struct Ctx {
    int lane, r32, hi, wid, ql, qb; unsigned lds0; LAS unsigned char* shm; LAS float* wsf; int koff, voff; unsigned kdst, vdst; int vb0;
};
__device__ __forceinline__ void dma_k(const Ctx& c, const bf16_t* base, int tile, int slot) { glds16(base + (size_t)tile * 4096 + c.koff, (unsigned)__builtin_amdgcn_readfirstlane(c.kdst + slot * SLOTB)); }
__device__ __forceinline__ void dma_v(const Ctx& c, const bf16_t* base, int tile, int slot) { glds16(base + (size_t)tile * 4096 + c.voff, (unsigned)__builtin_amdgcn_readfirstlane(c.vdst + slot * SLOTB)); }

constexpr float THR = 8.0f;
struct BrState { float mhat, l; f32x16 negm; f32x16 o[2]; };
__device__ __forceinline__ void br_reset(BrState& st) { st.mhat = 0.f; st.l = 0.f; st.negm = f32x16{}; st.o[0] = f32x16{}; st.o[1] = f32x16{}; }
__device__ __forceinline__ void stream_step(const Ctx& c, int slot, const bf16x8* qr, bool row_on, bool use_range, int lo, int hv, bool first, BrState& st) {
    f32x16 p0, p1;
    if (__any(!row_on)) { f32x16 ci;
#pragma unroll
        for (int r = 0; r < 16; ++r) ci[r] = row_on ? st.negm[r] : -INFINITY;
        qkt_c(p0, p1, c.shm + L_K + slot * SLOTB, qr, ci, c.r32, c.hi);
    } else qkt_c(p0, p1, c.shm + L_K + slot * SLOTB, qr, st.negm, c.r32, c.hi);
    if (use_range) range_mask(p0, p1, lo, hv, c.hi);
    const float rm = rowmax(p0, p1);
    if (first || __any(rm > THR)) {
        float dl = first ? rm : fmaxf(rm, 0.f);
        if (dl == -INFINITY) dl = 0.f;
        st.mhat += dl;
#pragma unroll
        for (int r = 0; r < 16; ++r) { p0[r] -= dl; p1[r] -= dl; st.negm[r] = -st.mhat; }
        if (!first) { const float f = __builtin_amdgcn_exp2f(-dl); st.l *= f; float al[16]; row_bcast(f, al, c.wsf, c.r32, c.hi);
#pragma unroll
            for (int r = 0; r < 16; ++r) { st.o[0][r] *= al[r]; st.o[1][r] *= al[r]; } }
    }
#pragma unroll
    for (int r = 0; r < 16; ++r) { p0[r] = __builtin_amdgcn_exp2f(p0[r]); p1[r] = __builtin_amdgcn_exp2f(p1[r]); }
    { const f32x16 sv = p0 + p1; st.l += ((sv[0] + sv[1]) + (sv[2] + sv[3])) + ((sv[4] + sv[5]) + (sv[6] + sv[7])) + ((sv[8] + sv[9]) + (sv[10] + sv[11])) + ((sv[12] + sv[13]) + (sv[14] + sv[15])); }
    pv(st.o, c.vb0 + slot * SLOTB, pack8(p0, 0), pack8(p0, 8), pack8(p1, 0), pack8(p1, 8));
}
struct Cursor { unsigned sm, wm; };
__device__ __forceinline__ int cur_pop(Cursor& k, int& br) {
    if (k.sm) { const int t = __builtin_ctz(k.sm); k.sm &= k.sm - 1u; br = 1; return t; }
    const int t = 31 - __builtin_clz(k.wm); k.wm &= ~(1u << t); br = 2; return t;
}

typedef __attribute__((address_space(3))) const char* lds_cptr;
typedef short v4i16_t __attribute__((ext_vector_type(4)));
__device__ __forceinline__ void kload8(bf16x8* kf, lds_cptr kp) {
    kf[0] = *(const LAS bf16x8*)(kp);        kf[1] = *(const LAS bf16x8*)(kp + 512);
    kf[2] = *(const LAS bf16x8*)(kp + 2048); kf[3] = *(const LAS bf16x8*)(kp + 2560);
    kf[4] = *(const LAS bf16x8*)(kp + 4096); kf[5] = *(const LAS bf16x8*)(kp + 4608);
    kf[6] = *(const LAS bf16x8*)(kp + 6144); kf[7] = *(const LAS bf16x8*)(kp + 6656);
}
__device__ __forceinline__ void kload2(bf16x8* kf, lds_cptr kp, int j) { kf[2 * j] = *(const LAS bf16x8*)(kp + j * 2048); kf[2 * j + 1] = *(const LAS bf16x8*)(kp + j * 2048 + 512); }
__device__ __forceinline__ s16x4 vtr(lds_cptr p) { return __builtin_bit_cast(s16x4, __builtin_amdgcn_ds_read_tr16_b64_v4i16((LAS v4i16_t*)p)); }
__device__ __forceinline__ float fadd_s(float a, float b) { float r; asm("v_add_f32_e32 %0, %1, %2" : "=v"(r) : "v"(a), "v"(b)); return r; }
__device__ __forceinline__ float fsub_s(float a, float b) { float r; asm("v_sub_f32_e32 %0, %1, %2" : "=v"(r) : "v"(a), "v"(b)); return r; }
template <int THRL>
__device__ __forceinline__ void sel_stream(const Ctx& c, const bf16_t* Kb, const bf16_t* Vb, const bf16x8* qr, unsigned msel, int qb, f32x16* o, float& l_out) {
  const int lane = c.lane, r32 = c.r32, hi = c.hi;
  LAS float* wsf = c.wsf;
  const lds_cptr shm3 = (lds_cptr)c.shm;
  const lds_cptr kp0 = shm3 + L_K + hi * 1024 + r32 * 16;
  const lds_cptr vp0 = shm3 + L_V + ((lane >> 4) & 1) * 32 + (lane & 3) * 8 + (4 * hi + ((lane & 15) >> 2)) * 64;
  const int NTr = qb + 1, NT = NTr < 4 ? 4 : NTr;
  #define WAIT_BAR(N) asm volatile("s_waitcnt vmcnt(" #N ") lgkmcnt(0)\n\ts_barrier":::"memory")
  #define TILE_OF(t) (((t) < NTr) ? (t) : qb)
  #define DMA_K(t, slotb) glds16(Kb + (size_t)TILE_OF(t) * 4096 + c.koff, (unsigned)__builtin_amdgcn_readfirstlane(c.kdst + (slotb)))
  #define DMA_V(t, slotb) glds16(Vb + (size_t)TILE_OF(t) * 4096 + c.voff, (unsigned)__builtin_amdgcn_readfirstlane(c.vdst + (slotb)))
  #define CMASK(P0, P1, t) do { const bool on_ = ((t) < NTr) && (((msel >> ((t) & 31)) & 1u) != 0u); \
      if (__any(!on_)) { const float ng_ = on_ ? 0.f : -INFINITY; _Pragma("unroll") for (int r = 0; r < 16; ++r) { P0[r] += ng_; P1[r] += ng_; } } \
      if ((t) == qb) range_mask(P0, P1, 0, c.ql, hi); } while (0)
  float mhat = 0.f, l_reg = 0.f; o[0] = f32x16{}; o[1] = f32x16{}; f32x16 negm = f32x16{}; asm volatile("" : "+v"(negm));
  bf16x8 kf[8];
  bool resc = false;
  #define START(P0,P1) do{ const float rm=rowmax(P0,P1); resc=false; \
    { const float dl=rm; mhat=fadd_s(mhat,dl); \
      _Pragma("unroll") for(int r=0;r<16;++r){P0[r]=fsub_s(P0[r],dl);P1[r]=fsub_s(P1[r],dl);} \
      _Pragma("unroll") for(int r=0;r<16;++r)negm[r]=-mhat; asm volatile("":"+v"(negm)); } \
    _Pragma("unroll") for(int r=0;r<16;++r)P0[r]=__builtin_amdgcn_exp2f(P0[r]); }while(0)
  #define RESC() do{ if(resc){ asm volatile("s_waitcnt lgkmcnt(0)":::"memory"); \
      _Pragma("unroll") for(int d_=0;d_<2;++d_) _Pragma("unroll") for(int r=0;r<16;++r)o[d_][r]*=wsf[crow(r,hi)]; } }while(0)
  f32x16 pA0,pA1,pB0,pB1;
  int sl_prev=SLOTB,sl_cur=2*SLOTB,sl_next=0;
  #define ROT() do{sl_prev=sl_cur;sl_cur=sl_next;sl_next=(sl_next==2*SLOTB)?0:sl_next+SLOTB;}while(0)
  DMA_K(1,0); DMA_K(2,SLOTB);
  { const f32x16 z = f32x16{}; qkt_c(pA0,pA1,c.shm+L_K+2*SLOTB,qr,z,r32,hi); }
  asm volatile("s_nop 15\n\ts_nop 7":"+v"(pA0),"+v"(pA1)); CMASK(pA0,pA1,0);
  START(pA0,pA1);
  _Pragma("unroll") for(int r=0;r<16;++r)pA1[r]=__builtin_amdgcn_exp2f(pA1[r]);
  WAIT_BAR(0);
  DMA_K(3,2*SLOTB);DMA_V(1,0);
  ROT();
  kload8(kf,kp0+sl_cur);
  WAIT_BAR(2);
  s16x4 vlo[8],vhi[8]; u32x4 pw0,pw1,pw2,pw3;
  #define PKW(P,B) cvtpk(P[B],P[B+1])
  #define PAF(k) __builtin_bit_cast(bf16x8,pw##k)
  #define VFR(i) (bf16x8){vlo[i][0],vlo[i][1],vlo[i][2],vlo[i][3],vhi[i][0],vhi[i][1],vhi[i][2],vhi[i][3]}
  #define PIN(x) asm volatile("":"+v"(x))
  #define MX3(a,b,c) __builtin_fmaxf(__builtin_fmaxf((a),(b)),(c))
  #define GAPA(MF,A0,A1,A2,A3,W0,W1,PW) do{ MF; sacc+=A0; sacc+=A1; sacc+=A2; sacc+=A3; PIN(sacc); W0; W1; PIN(PW); SBAR(); }while(0)
  #define EX(v) __builtin_amdgcn_exp2f(v)
  #define GAPB(MF,X,B) do{ MF; X[B]=EX(X[B]); X[B+1]=EX(X[B+1]); X[B+2]=EX(X[B+2]); X[B+3]=EX(X[B+3]); PIN(X); SBAR(); }while(0)
  #define VRD(i) do{ vlo[i]=vtr(vp_+(((i)>>2)*4096+((i)&3)*1024)); vhi[i]=vtr(vp_+(((i)>>2)*4096+((i)&3)*1024+512)); }while(0)
  #define KRD(G,j) do{ if(G){ kload2(kf,kp0+sl_next,j); SBAR(); } }while(0)
  #define STEP(C0,C1,P0,P1,t,GK,GV,GL) do{ SBAR(); \
    const lds_cptr vp_=vp0+sl_prev; \
    VRD(0); SBAR(); float sacc=(P0[0]+P0[1]); \
    GAPA(C0=__builtin_amdgcn_mfma_f32_32x32x16_bf16(kf[0],qr[0],negm,0,0,0), P0[2],P0[3],P0[4],P0[5],     pw0[0]=PKW(P0,0), pw0[1]=PKW(P0,2), pw0); \
    VRD(4); SBAR(); GAPA(C1=__builtin_amdgcn_mfma_f32_32x32x16_bf16(kf[1],qr[0],negm,0,0,0), P0[6],P0[7],P0[8],P0[9],     pw0[2]=PKW(P0,4), pw0[3]=PKW(P0,6), pw0); \
    VRD(1); SBAR(); GAPA(C0=__builtin_amdgcn_mfma_f32_32x32x16_bf16(kf[2],qr[1],C0,0,0,0),   P0[10],P0[11],P0[12],P0[13], pw1[0]=PKW(P0,8), pw1[1]=PKW(P0,10), pw1); \
    VRD(5); SBAR(); GAPA(C1=__builtin_amdgcn_mfma_f32_32x32x16_bf16(kf[3],qr[1],C1,0,0,0),   P0[14],P0[15],P1[0],P1[1],   pw1[2]=PKW(P0,12),pw1[3]=PKW(P0,14), pw1); \
    VRD(2); SBAR(); GAPA(C0=__builtin_amdgcn_mfma_f32_32x32x16_bf16(kf[4],qr[2],C0,0,0,0),   P1[2],P1[3],P1[4],P1[5],     pw2[0]=PKW(P1,0), pw2[1]=PKW(P1,2), pw2); \
    VRD(6); SBAR(); GAPA(C1=__builtin_amdgcn_mfma_f32_32x32x16_bf16(kf[5],qr[2],C1,0,0,0),   P1[6],P1[7],P1[8],P1[9],     pw2[2]=PKW(P1,4), pw2[3]=PKW(P1,6), pw2); \
    VRD(3); SBAR(); GAPA(C0=__builtin_amdgcn_mfma_f32_32x32x16_bf16(kf[6],qr[3],C0,0,0,0),   P1[10],P1[11],P1[12],P1[13], pw3[0]=PKW(P1,8), pw3[1]=PKW(P1,10), pw3); \
    VRD(7); SBAR(); GAPA(C1=__builtin_amdgcn_mfma_f32_32x32x16_bf16(kf[7],qr[3],C1,0,0,0),   P1[14],P1[15],0.f,0.f,       pw3[2]=PKW(P1,12),pw3[3]=PKW(P1,14), pw3); \
    l_reg+=sacc; \
    if(GK){DMA_K((t)+3,sl_cur);} if(GV){DMA_V((t)+1,sl_next);} \
    CMASK(C0,C1,t); \
    { float a=MX3(C0[0],C0[1],C1[0]),b=MX3(C0[2],C0[3],C1[1]); a=MX3(a,C1[2],C1[3]); \
      _Pragma("unroll") for(int r=4;r<16;r+=4){a=MX3(a,C0[r],C0[r+1]);b=MX3(b,C0[r+2],C0[r+3]);a=MX3(a,C1[r],C1[r+1]);b=MX3(b,C1[r+2],C1[r+3]);} \
      float rm=__builtin_fmaxf(a,b); { auto rr=__builtin_amdgcn_permlane32_swap(__float_as_uint(rm),__float_as_uint(rm),false,false); rm=__builtin_fmaxf(__uint_as_float(rr[0]),__uint_as_float(rr[1])); } \
      resc=false; \
      if(__builtin_expect(__any(rm>(float)THRL),0)){ const float dl=__builtin_fmaxf(rm,0.f); mhat+=dl; \
        _Pragma("unroll") for(int r=0;r<16;++r){C0[r]-=dl;C1[r]-=dl;} \
        _Pragma("unroll") for(int r=0;r<16;++r)negm[r]=-mhat; asm volatile("":"+v"(negm)); \
        const float f=__builtin_amdgcn_exp2f(-dl); l_reg*=f; if(hi==0)wsf[r32]=f; resc=true; } } \
    SBAR(); \
    GAPB(o[0]=__builtin_amdgcn_mfma_f32_32x32x16_bf16(PAF(0),VFR(0),o[0],0,0,0), C0,0); \
    GAPB(o[1]=__builtin_amdgcn_mfma_f32_32x32x16_bf16(PAF(0),VFR(4),o[1],0,0,0), C0,4); \
    KRD(GL,0); GAPB(o[0]=__builtin_amdgcn_mfma_f32_32x32x16_bf16(PAF(1),VFR(1),o[0],0,0,0), C0,8); \
    KRD(GL,1); GAPB(o[1]=__builtin_amdgcn_mfma_f32_32x32x16_bf16(PAF(1),VFR(5),o[1],0,0,0), C0,12); \
    KRD(GL,2); GAPB(o[0]=__builtin_amdgcn_mfma_f32_32x32x16_bf16(PAF(2),VFR(2),o[0],0,0,0), C1,0); \
    KRD(GL,3); GAPB(o[1]=__builtin_amdgcn_mfma_f32_32x32x16_bf16(PAF(2),VFR(6),o[1],0,0,0), C1,4); \
    GAPB(o[0]=__builtin_amdgcn_mfma_f32_32x32x16_bf16(PAF(3),VFR(3),o[0],0,0,0), C1,8); \
    GAPB(o[1]=__builtin_amdgcn_mfma_f32_32x32x16_bf16(PAF(3),VFR(7),o[1],0,0,0), C1,12); \
    }while(0)
  #define ENDW(tt) do{ if((tt)+3<NT){WAIT_BAR(2);} else if((tt)+2<NT){WAIT_BAR(1);} else {WAIT_BAR(0);} }while(0)
  int t=1;
  if (NT & 1) {
    STEP(pB0,pB1,pA0,pA1,1,(4<NT),(2<NT),(2<NT)); ENDW(1); RESC(); ROT();
    pA0 = pB0; pA1 = pB1; t = 2; }
  for(;t+1<NT;t+=2){
    STEP(pB0,pB1,pA0,pA1,t,(t+3<NT),(t+1<NT),(t+1<NT));       ENDW(t);   RESC(); ROT();
    STEP(pA0,pA1,pB0,pB1,t+1,(t+4<NT),(t+2<NT),(t+2<NT));     ENDW(t+1); RESC(); ROT();
  }
  STEP(pB0,pB1,pA0,pA1,NT-1,false,false,false); RESC();
  { float sacc=pB0[0]+pB0[1]; _Pragma("unroll") for(int r=2;r<16;++r)sacc+=pB0[r]; _Pragma("unroll") for(int r=0;r<16;++r)sacc+=pB1[r]; l_reg+=sacc;
    SBAR(); pv(o, c.vb0 + sl_cur, pack8(pB0,0), pack8(pB0,8), pack8(pB1,0), pack8(pB1,8)); }
  l_out = l_reg;
  asm volatile("s_waitcnt lgkmcnt(0)\n\ts_barrier":::"memory");
  #undef WAIT_BAR
  #undef TILE_OF
  #undef DMA_K
  #undef DMA_V
  #undef CMASK
  #undef START
  #undef RESC
  #undef ROT
  #undef PKW
  #undef PAF
  #undef VFR
  #undef PIN
  #undef MX3
  #undef GAPA
  #undef EX
  #undef GAPB
  #undef VRD
  #undef KRD
  #undef STEP
  #undef ENDW
}

__device__ __forceinline__ void attn_unit(int b, int g, int qb, unsigned char* slab, LAS unsigned char* shm) {
    const bf16_t* Q = (const bf16_t*)(slab + SO_Q); const bf16_t* KV = (const bf16_t*)(slab + SO_KV); const bf16_t* KC = (const bf16_t*)(slab + SO_KC); const bf16_t* VC = (const bf16_t*)(slab + SO_VC);
    const float* gates = (const float*)(slab + SO_GATES); bf16_t* O = (bf16_t*)(slab + SO_O);
    Ctx c;
    const int tid = threadIdx.x;
    c.lane = tid & 63; c.r32 = c.lane & 31; c.hi = c.lane >> 5; c.wid = __builtin_amdgcn_readfirstlane(tid >> 6);
    const int kh = c.wid >> 1, qh = c.wid & 1, head = g * 4 + kh;
    c.ql = qh * 32 + c.r32; c.qb = qb; c.shm = shm; c.lds0 = (unsigned)(size_t)shm;
    c.wsf = (LAS float*)(shm + L_WS) + c.wid * 128;
    c.koff = c.lane * 64 + c.wid * 8;
    c.voff = (16 * (c.wid & 3) + (c.lane >> 2)) * 64 + (c.wid >> 2) * 32 + (c.lane & 3) * 8;
    c.kdst = c.lds0 + L_K + c.wid * 1024; c.vdst = c.lds0 + L_V + c.wid * 1024;
    c.vb0 = (int)(c.lds0 + L_V) + ((c.lane >> 4) & 1) * 32 + (c.lane & 3) * 8 + (4 * c.hi + ((c.lane & 15) >> 2)) * 64;
    const int t = qb * 64 + c.ql;
    const size_t mrow = (size_t)t;
    const size_t bg = (size_t)g;
    const bf16_t* KSb = KV + ((size_t)2 * 4 + g) * (SEQ * 64);
    const bf16_t* VSb = KV + ((size_t)3 * 4 + g) * (SEQ * 64);
    const bf16_t* KWb = KV + ((size_t)4 * 4 + g) * (SEQ * 64);
    const bf16_t* VWb = KV + ((size_t)5 * 4 + g) * (SEQ * 64);
    const bf16_t* KCb = KC + bg * 8192; const bf16_t* VCb = VC + bg * 8192;
    dma_k(c, KCb, 0, 0); dma_k(c, KCb, 1, 1); dma_v(c, VCb, 0, 0); dma_v(c, VCb, 1, 1);
    dma_k(c, KSb, 0, 2); dma_v(c, VSb, 0, 2);
    bf16x8 qr[4];
    { const bf16_t* Qw = Q + mrow * DM + head * 64 + c.hi * 8;
#pragma unroll
      for (int d0 = 0; d0 < 4; ++d0) qr[d0] = *(const bf16x8*)(Qw + d0 * 16); }
    const float* gp = gates + mrow * 48 + head * 3;
    const float g0 = gp[0], g1 = gp[1], g2 = gp[2];
    f32x16 ot[2];
    f32x16 o[2];
    const bool two = qb >= 16;
    ATT_WAIT_BAR(2);
    {
        f32x16 a0, a1, b0, b1;
        qkt(a0, a1, shm + L_K, qr, c.r32, c.hi);
        const int nmax = (t >= 31) ? ((t - 31) >> 4) : -1;
        range_mask(a0, a1, 0, nmax, c.hi);
        float rm = rowmax(a0, a1);
        if (two) { qkt(b0, b1, shm + L_K + SLOTB, qr, c.r32, c.hi); range_mask(b0, b1, 0, nmax - 64, c.hi); rm = fmaxf(rm, rowmax(b0, b1)); }
        const float mu = (rm == -INFINITY) ? 0.f : rm;
        float s = 0.f;
#pragma unroll
        for (int r = 0; r < 16; ++r) { a0[r] = __builtin_amdgcn_exp2f(a0[r] - mu); a1[r] = __builtin_amdgcn_exp2f(a1[r] - mu); s += a0[r] + a1[r]; }
        if (two) {
#pragma unroll
            for (int r = 0; r < 16; ++r) { b0[r] = __builtin_amdgcn_exp2f(b0[r] - mu); b1[r] = __builtin_amdgcn_exp2f(b1[r] - mu); s += b0[r] + b1[r]; }
        }
        s = halfsum(s);
        const float inv = (s > 0.f) ? 1.0f / s : 0.f;
#pragma unroll
        for (int r = 0; r < 16; ++r) { a0[r] *= inv; a1[r] *= inv; }
        if (two) {
#pragma unroll
            for (int r = 0; r < 16; ++r) { b0[r] *= inv; b1[r] *= inv; }
            int qlx = c.ql; LAUNDER(qlx);
            LAS float* IA = (LAS float*)(shm + L_IA) + (kh * 64 + qlx) * 33;
            LAS float* IB = (LAS float*)(shm + L_IB) + (kh * 64 + qlx) * 33;
#pragma unroll
            for (int i = 0; i < 4; ++i) {
                const int j = 2 * i + c.hi;
                IA[j]      = a0[4 * i] + a0[4 * i + 1] + a0[4 * i + 2] + 0.5f * a0[4 * i + 3]; IB[j + 1]  = 0.5f * a0[4 * i + 3];
                IA[j + 8]  = a1[4 * i] + a1[4 * i + 1] + a1[4 * i + 2] + 0.5f * a1[4 * i + 3]; IB[j + 9]  = 0.5f * a1[4 * i + 3];
                IA[j + 16] = b0[4 * i] + b0[4 * i + 1] + b0[4 * i + 2] + 0.5f * b0[4 * i + 3]; IB[j + 17] = 0.5f * b0[4 * i + 3];
                IA[j + 24] = b1[4 * i] + b1[4 * i + 1] + b1[4 * i + 2] + 0.5f * b1[4 * i + 3]; IB[j + 25] = 0.5f * b1[4 * i + 3];
            }
        }
        o[0] = f32x16{}; o[1] = f32x16{};
        pv(o, c.vb0, pack8(a0, 0), pack8(a0, 8), pack8(a1, 0), pack8(a1, 8));
        if (two) pv(o, c.vb0 + SLOTB, pack8(b0, 0), pack8(b0, 8), pack8(b1, 0), pack8(b1, 8));
        float cf[16]; row_bcast(g0, cf, c.wsf, c.r32, c.hi);
#pragma unroll
        for (int r = 0; r < 16; ++r) { ot[0][r] = o[0][r] * cf[r]; ot[1][r] = o[1][r] * cf[r]; }
    }
    ATT_WAIT_BAR(0);
    LAS unsigned* SEL = (LAS unsigned*)(shm + L_SEL);
    if (two) {
        int q = tid & 63, jg = tid >> 6; LAUNDER(q); LAUNDER(jg);
        LAS float* SC = (LAS float*)(shm + L_SC);
        const LAS float* IA = (const LAS float*)(shm + L_IA); const LAS float* IB = (const LAS float*)(shm + L_IB);
#pragma unroll
        for (int jj = 0; jj < 4; ++jj) { const int j = 4 * jg + jj; float sc = 0.f;
#pragma unroll
            for (int k = 0; k < 4; ++k) { sc += IA[(k * 64 + q) * 33 + j]; if (j > 0) sc += IB[(k * 64 + q) * 33 + j]; }
            const bool forced = (j == 0) || (j == qb) || (j == qb - 1);
            SC[q * 33 + j] = forced ? 1e30f : ((j <= qb) ? sc : -1e30f); }
        ATT_WAIT_BAR(0);
        unsigned nib = 0u;
        float sj[4];
#pragma unroll
        for (int jj = 0; jj < 4; ++jj) sj[jj] = SC[q * 33 + 4 * jg + jj];
        int rank[4] = {0, 0, 0, 0};
        float sall[32];
#pragma unroll
        for (int i = 0; i < 32; ++i) sall[i] = SC[q * 33 + i];
#pragma unroll
        for (int i = 0; i < 32; ++i) { const float si = sall[i];
#pragma unroll
            for (int jj = 0; jj < 4; ++jj) { const int j = 4 * jg + jj; rank[jj] += (si > sj[jj] || (si == sj[jj] && i < j)) ? 1 : 0; } }
#pragma unroll
        for (int jj = 0; jj < 4; ++jj) nib |= (rank[jj] < 16 ? 1u : 0u) << jj;
        ((LAS unsigned char*)(shm + L_NIB))[q * 8 + jg] = (unsigned char)nib;
        ATT_WAIT_BAR(0);
    }
    int lnx = c.lane, qlx2 = c.ql; LAUNDER(lnx); LAUNDER(qlx2);
    LAS float* accp = (LAS float*)(shm + L_IA) + c.wid * 2048 + lnx;
#pragma unroll
    for (int r = 0; r < 16; ++r) { accp[r * 64] = ot[0][r]; accp[(16 + r) * 64] = ot[1][r]; }
    unsigned msel = (qb == 31) ? 0xffffffffu : ((1u << (qb + 1)) - 1u);
    if (two) { const u32x2 nb = *(const LAS u32x2*)(shm + L_NIB + qlx2 * 8); unsigned mk = 0u;
#pragma unroll
        for (int k = 0; k < 4; ++k) { mk |= ((nb.x >> (8 * k)) & 15u) << (4 * k); mk |= ((nb.y >> (8 * k)) & 15u) << (16 + 4 * k); }
        msel = mk; }
    {
        float l_sel; f32x16 osel[2];
        sel_stream<8>(c, KSb, VSb, qr, msel, qb, osel, l_sel);
        const float lt = halfsum(l_sel);
        float cf[16]; row_bcast((lt > 0.f) ? g1 / lt : 0.f, cf, c.wsf, c.r32, c.hi);
#pragma unroll
        for (int r = 0; r < 16; ++r) { accp[r * 64] += osel[0][r] * cf[r]; accp[(16 + r) * 64] += osel[1][r] * cf[r]; }
    }
    {
        const int lo_t = qb >= 8 ? qb - 8 : 0, nw = qb - lo_t + 1;
        dma_k(c, KWb, qb, 0); dma_v(c, VWb, qb, 0);
        if (nw > 1) { dma_k(c, KWb, qb - 1, 1); dma_v(c, VWb, qb - 1, 1); }
        BrState st; br_reset(st);
        int slot = 0;
        for (int j = 0; j < nw; ++j) {
            if (j + 1 < nw) ATT_WAIT_BAR(2); else ATT_WAIT_BAR(0);
            if (j + 2 < nw) { const int ps = (slot == 0) ? 2 : slot - 1; dma_k(c, KWb, qb - j - 2, ps); dma_v(c, VWb, qb - j - 2, ps); }
            const int tc = qb - j;
            bool use_range = false; int lo = 0, hv = 63;
            if (j == 0) { use_range = true; hv = c.ql; }
            else if (tc == qb - 8) { use_range = true; lo = c.ql + 1; }
            stream_step(c, slot, qr, true, use_range, lo, hv, j == 0, st);
            slot = (slot == 2) ? 0 : slot + 1;
        }
        const float lt = halfsum(st.l);
        float cf[16]; row_bcast((lt > 0.f) ? g2 / lt : 0.f, cf, c.wsf, c.r32, c.hi);
#pragma unroll
        for (int r = 0; r < 16; ++r) { ot[0][r] = accp[r * 64] + st.o[0][r] * cf[r]; ot[1][r] = accp[(16 + r) * 64] + st.o[1][r] * cf[r]; }
        LDS_WAIT();
    }
    {
        LAS bf16_t* stg = (LAS bf16_t*)(shm + L_IA) + c.wid * 4096;
        int lny = c.lane; LAUNDER(lny);
        LAS bf16_t* stw = stg + ((lny >> 5) * 4) * 64 + (lny & 31);
#pragma unroll
        for (int r = 0; r < 16; ++r) { const int orow = (r & 3) + 8 * (r >> 2);
#pragma unroll
            for (int d0 = 0; d0 < 2; ++d0) stw[orow * 64 + d0 * 32] = (bf16_t)(cvtpk(ot[d0][r], 0.f) & 0xffffu); }
        LDS_WAIT();
        bf16_t* Ow = O + ((size_t)qb * 64 + qh * 32) * DM + head * 64;
#pragma unroll
        for (int i = 0; i < 4; ++i) { const int row = i * 8 + (lny >> 3), chn = lny & 7; const u32x4 v = *(const LAS u32x4*)(stg + row * 64 + chn * 8); *(u32x4*)(Ow + (size_t)row * DM + chn * 8) = v; }
    }
    ATT_WAIT_BAR(0);
}
#undef SBAR
}

#define XB_TMO      128
#define XB_XCNT(j)  (256  + 64 * (j))
#define XB_XSUB(j)  (1280 + 64 * (j))
#define XB_XGEN(j)  (2304 + 64 * (j))
#define XB_TOP      3328
#define XB_TOPGEN   3392
#define XB_LSUB(j)  (3456 + 64 * (j))
#define XB_LGEN(j)  (4480 + 64 * (j))
#define XCD_BAR_WORDS 5504
#define XB_P8RDY(x) (28672 + 128 * (x))
#define XB_SPIN_CAP (1u << 18)
__device__ __forceinline__ unsigned xb_ld(unsigned* p)              { return __hip_atomic_load(p, __ATOMIC_RELAXED, __HIP_MEMORY_SCOPE_AGENT); }
__device__ __forceinline__ unsigned xb_add(unsigned* p, unsigned v) { return __hip_atomic_fetch_add(p, v, __ATOMIC_RELAXED, __HIP_MEMORY_SCOPE_AGENT); }
__device__ __forceinline__ unsigned xb_xcc_id() { return (unsigned)__builtin_amdgcn_s_getreg((3 << 11) | 20) & 0xFu; }
#define XB_SPIN(cond, bar) do { unsigned _sp = 0; while (cond) { __builtin_amdgcn_s_sleep(1); \
    if ((++_sp & 255u) == 0u) { if (xb_ld(&(bar)[XB_TMO])) break; if (_sp > XB_SPIN_CAP) { atomicAdd(&(bar)[XB_TMO], 1u); break; } } } } while (0)
struct XcdBarrier { unsigned* bar; unsigned x; volatile LAS unsigned* st; };
__device__ __forceinline__ XcdBarrier xcd_barrier_post(unsigned* bar, volatile LAS unsigned* st) {
    XcdBarrier b; b.bar = bar; b.x = xb_xcc_id(); b.st = st;
    if (threadIdx.x == 0) { st[2] = xb_add(&bar[XB_XCNT(b.x)], 1u); st[4] = b.x; }
    return b;
}
__device__ __forceinline__ void xcd_barrier_complete(unsigned* bar, unsigned x, unsigned& nloc, unsigned& nx, unsigned& uniform) {
    const unsigned G = gridDim.x * gridDim.y * gridDim.z;
    unsigned sum, cnt, mine, sp = 0u, uni;
    for (;;) {
        sum = 0u; cnt = 0u; mine = 0u; uni = 1u;
#pragma unroll
        for (unsigned j = 0; j < 16; ++j) { const unsigned c = xb_ld(&bar[XB_XCNT(j)]); sum += c; cnt += (c > 0u) ? 1u : 0u; mine = (j == x) ? c : mine;
            if (j < 8u ? (c != 32u) : (c != 0u)) uni = 0u; }
        if (sum == G) break;
        __builtin_amdgcn_s_sleep(1);
        if ((++sp & 255u) == 0u) { if (xb_ld(&bar[XB_TMO])) break; if (sp > XB_SPIN_CAP) { atomicAdd(&bar[XB_TMO], 1u); break; } }
    }
    nloc = mine > 0u ? mine : 1u; nx = cnt > 0u ? cnt : 1u;
    uniform = (uni != 0u && sum == G && G == 256u) ? 1u : 0u;
}
__device__ __forceinline__ void xcd_barrier(const XcdBarrier& b) {
    asm volatile("s_waitcnt vmcnt(0)" ::: "memory");
    __syncthreads();
    if (threadIdx.x == 0) {
        unsigned* bar = b.bar;
        __builtin_amdgcn_s_waitcnt(0);
        unsigned nloc = b.st[0], nx = b.st[1];
        if (nloc == 0u) { unsigned uf; xcd_barrier_complete(bar, b.x, nloc, nx, uf); b.st[0] = nloc; b.st[1] = nx; b.st[3] = uf; }
        const unsigned old = xb_add(&bar[XB_XSUB(b.x)], 1u);
        const unsigned gen = old / nloc;
        if (old + 1u == (gen + 1u) * nloc) {
            __builtin_amdgcn_fence(__ATOMIC_RELEASE, "agent");
            asm volatile("s_waitcnt vmcnt(0)" ::: "memory");
            const unsigned og = xb_add(&bar[XB_TOP], 1u);
            const unsigned tg = og / nx;
            if (og + 1u == (tg + 1u) * nx) xb_add(&bar[XB_TOPGEN], 1u);
            else XB_SPIN(xb_ld(&bar[XB_TOPGEN]) == tg, bar);
            __builtin_amdgcn_fence(__ATOMIC_ACQUIRE, "agent");
            xb_add(&bar[XB_XGEN(b.x)], 1u);
            asm volatile("s_waitcnt vmcnt(0)" ::: "memory");
        } else {
            XB_SPIN(xb_ld(&bar[XB_XGEN(b.x)]) == gen, bar);
            __builtin_amdgcn_fence(__ATOMIC_ACQUIRE, "agent");
            asm volatile("s_waitcnt vmcnt(0)" ::: "memory");
        }
    }
    __syncthreads();
}

__device__ __forceinline__ void xcd_local_barrier(const XcdBarrier& b) {
    asm volatile("s_waitcnt vmcnt(0)" ::: "memory");
    __syncthreads();
    if (threadIdx.x == 0) {
        unsigned* bar = b.bar;
        __builtin_amdgcn_s_waitcnt(0);
        const unsigned nloc = b.st[0];
        const unsigned old = xb_add(&bar[XB_LSUB(b.x)], 1u);
        const unsigned gen = old / nloc;
        if (old + 1u == (gen + 1u) * nloc) xb_add(&bar[XB_LGEN(b.x)], 1u);
        else XB_SPIN(xb_ld(&bar[XB_LGEN(b.x)]) == gen, bar);
        __builtin_amdgcn_fence(__ATOMIC_ACQUIRE, "agent");
        asm volatile("s_waitcnt vmcnt(0)" ::: "memory");
    }
    __syncthreads();
}

struct Args {
    const float *x, *c, *norm_gain, *w_ada, *b_ada, *w_a_in, *conv_w, *w_a_out, *w_qg, *q_gain, *w_o, *kv_norm_gain, *w_ada_kv, *b_ada_kv, *w_kv, *k_gain, *cmp_pe, *cmp_w1, *cmp_w2, *w_mlp1, *w_mlp2;
    float* out; unsigned char* ws; int ph_lo, ph_hi;
};

__device__ __forceinline__ void transpose_item(const float* W, int ldn, int srccol, int nvalid, int k0, bf16_t* WT, int Kd, int drow0, LAS float* scr, int lane) {
    if (nvalid == 32) {
        f32x4 t[8];
#pragma unroll
        for (int i = 0; i < 8; ++i) t[i] = __builtin_nontemporal_load((const f32x4*)(W + (size_t)(k0 + 8 * i + (lane >> 3)) * ldn + srccol + (lane & 7) * 4));
#pragma unroll
        for (int i = 0; i < 8; ++i) { LAS float* d = scr + (8 * i + (lane >> 3)) * 33 + (lane & 7) * 4; d[0] = t[i][0]; d[1] = t[i][1]; d[2] = t[i][2]; d[3] = t[i][3]; }
    } else {
#pragma unroll 8
        for (int i = 0; i < 32; ++i) { const int kk = 2 * i + (lane >> 5), n = lane & 31; scr[kk * 33 + n] = (n < nvalid) ? W[(size_t)(k0 + kk) * ldn + srccol + n] : 0.f; }
    }
    LDS_WAIT(); asm volatile("" ::: "memory");
    const int ch = lane & 7;
#pragma unroll
    for (int j = 0; j < 4; ++j) { const int n = (lane >> 3) + 8 * j; const LAS float* s = scr + (8 * ch) * 33 + n;
        u32x4 o; o.x = cvtpk(s[0 * 33], s[1 * 33]); o.y = cvtpk(s[2 * 33], s[3 * 33]); o.z = cvtpk(s[4 * 33], s[5 * 33]); o.w = cvtpk(s[6 * 33], s[7 * 33]);
        *(u32x4*)(WT + (size_t)(drow0 + n) * Kd + k0 + 8 * ch) = o; }
    LDS_WAIT(); asm volatile("" ::: "memory");
}
__device__ __forceinline__ int perm_head_cols(int d) { const int t = d >> 8, p = d & 255; return 256 * t + 64 * ((p >> 5) & 3) + 32 * (p >> 7) + (p & 31); }

constexpr int TI_AIN = 1536, TI_AOUT = 512, TI_M1 = 2048, TI_M2 = 2048, TI_KV = 768, TI_QG = 640, TI_O = 512, TI_C1 = 256, TI_C2 = 8;
constexpr int TI_TOTAL = TI_AIN + TI_AOUT + 2 * TI_M1 + 2 * TI_M2 + TI_KV + TI_QG + TI_O + 2 * TI_C1 + 2 * TI_C2;

__device__ __forceinline__ void p0_item(const Args& a, int it, LAS float* scr, int lane) {
    unsigned char* ws = a.ws;
    int r = it;
    if (r < TI_AIN) { const int kb = r / 96, nb = r % 96, d = 32 * nb; int src;
        if (d < 1024) src = d; else { const int t = (d - 1024) >> 8, p = (d - 1024) & 255; src = (p < 128) ? (1024 + 128 * t + p) : (2048 + 128 * t + (p - 128)); }
        transpose_item(a.w_a_in, 3072, src, 32, 64 * kb, (bf16_t*)(ws + WS_WAIN), 1024, d, scr, lane); return; }
    r -= TI_AIN;
    if (r < TI_AOUT) { const int kb = r / 32, nb = r % 32; transpose_item(a.w_a_out, 1024, 32 * nb, 32, 64 * kb, (bf16_t*)(ws + WS_WAOUT), 1024, 32 * nb, scr, lane); return; }
    r -= TI_AOUT;
    if (r < 2 * TI_M1) { const int L = r / TI_M1, q = r % TI_M1, kb = q / 128, nb = q % 128;
        transpose_item(a.w_mlp1 + (size_t)L * DM * FF, FF, 32 * nb, 32, 64 * kb, (bf16_t*)(ws + WS_WM1) + (size_t)L * FF * DM, DM, 32 * nb, scr, lane); return; }
    r -= 2 * TI_M1;
    if (r < 2 * TI_M2) { const int L = r / TI_M2, q = r % TI_M2, kb = q / 32, nb = q % 32;
        transpose_item(a.w_mlp2 + (size_t)L * FF * DM, DM, 32 * nb, 32, 64 * kb, (bf16_t*)(ws + WS_WM2) + (size_t)L * DM * FF, FF, 32 * nb, scr, lane); return; }
    r -= 2 * TI_M2;
    if (r < TI_KV) { const int kb = r / 48, nb = r % 48, d = 32 * nb;
        transpose_item(a.w_kv, 1536, perm_head_cols(d), 32, 64 * kb, (bf16_t*)(ws + WS_WKVQ), DM, d, scr, lane); return; }
    r -= TI_KV;
    if (r < TI_QG) { const int kb = r / 40, nb = r % 40, d = 32 * nb; int src, nv = 32;
        if (d < 1024) src = perm_head_cols(d); else { const int p = d - 1024; src = 1024 + p; nv = 48 - p; nv = nv < 0 ? 0 : (nv > 32 ? 32 : nv); if (nv == 0) src = 0; }
        transpose_item(a.w_qg, 1072, src, nv, 64 * kb, (bf16_t*)(ws + WS_WKVQ), DM, 1536 + d, scr, lane); return; }
    r -= TI_QG;
    if (r < TI_O) { const int kb = r / 32, nb = r % 32; transpose_item(a.w_o, 1024, 32 * nb, 32, 64 * kb, (bf16_t*)(ws + WS_WO), 1024, 32 * nb, scr, lane); return; }
    r -= TI_O;
    if (r < 2 * TI_C1) { const int kv = r / TI_C1, q = r % TI_C1, kb = q / 8, nb = q % 8;
        transpose_item(a.cmp_w1 + (size_t)kv * 2048 * 256, 256, 32 * nb, 32, 64 * kb, (bf16_t*)(ws + WS_WC1) + (size_t)kv * 256 * 2048, 2048, 32 * nb, scr, lane); return; }
    r -= 2 * TI_C1;
    { const int kv = r / TI_C2, q = r % TI_C2, kb = q / 2, nb = q % 2;
        transpose_item(a.cmp_w2 + (size_t)kv * 256 * 64, 64, 32 * nb, 32, 64 * kb, (bf16_t*)(ws + WS_WC2) + (size_t)kv * 64 * 256, 256, 32 * nb, scr, lane); }
}

__device__ __forceinline__ void p0_mods(const Args& a, LAS unsigned char* lds, int vblk, int G) {
    LAS float* cact = (LAS float*)lds;
    LAS float* red = (LAS float*)(lds + 32768);
    const int tid = threadIdx.x, lane = tid & 63, wave = tid >> 6;
    bool have = false;
    for (int u = vblk; u < 224; u += G) {
        if (!have) { for (int i = tid; i < 8 * DM; i += 512) { const float cv = a.c[i]; cact[i] = cv / (1.0f + __expf(-cv)); } have = true; }
        __syncthreads();
        const int col = u * 64 + lane;
        const float* W; const float* bias; float* dst; int N, c0;
        if (col < 6144) { W = a.w_ada; bias = a.b_ada; dst = (float*)(a.ws + WS_MOD0); N = 6144; c0 = col; }
        else if (col < 12288) { W = a.w_ada + (size_t)DM * 6144; bias = a.b_ada + 6144; dst = (float*)(a.ws + WS_MOD1); N = 6144; c0 = col - 6144; }
        else { W = a.w_ada_kv; bias = a.b_ada_kv; dst = (float*)(a.ws + WS_MODKV); N = 2048; c0 = col - 12288; }
        float acc[8];
#pragma unroll
        for (int b = 0; b < 8; ++b) acc[b] = 0.f;
        const float* wp = W + (size_t)(wave * 128) * N + c0;
        const LAS float* cp = cact + wave * 128;
#pragma unroll 8
        for (int k = 0; k < 128; ++k) { const float w = __builtin_nontemporal_load(wp + (size_t)k * N);
#pragma unroll
            for (int b = 0; b < 8; ++b) acc[b] += w * cp[b * DM + k]; }
#pragma unroll
        for (int b = 0; b < 8; ++b) red[(wave * 8 + b) * 64 + lane] = acc[b];
        __syncthreads();
        { const int b = wave; float sacc = bias[c0];
#pragma unroll
          for (int w = 0; w < 8; ++w) sacc += red[(w * 8 + b) * 64 + lane];
          dst[(size_t)b * N + c0] = sacc; }
        __syncthreads();
    }
    __syncthreads();
}

__device__ __forceinline__ void p1_norm_row2(const Args& a, int m0, int lane) {
    const int b = m0 >> 11;
    const float* mod0 = (const float*)(a.ws + WS_MOD0) + (size_t)b * 6144;
    const f32x4* xr = (const f32x4*)(a.x + (size_t)m0 * DM) + lane;
    f32x4 v[2][4]; float s0 = 0.f, s1 = 0.f;
#pragma unroll
    for (int j = 0; j < 4; ++j) { v[0][j] = __builtin_nontemporal_load(xr + 64 * j); v[1][j] = __builtin_nontemporal_load(xr + 256 + 64 * j); }
#pragma unroll
    for (int j = 0; j < 4; ++j) { s0 += (v[0][j][0] * v[0][j][0] + v[0][j][1] * v[0][j][1]) + (v[0][j][2] * v[0][j][2] + v[0][j][3] * v[0][j][3]);
                                  s1 += (v[1][j][0] * v[1][j][0] + v[1][j][1] * v[1][j][1]) + (v[1][j][2] * v[1][j][2] + v[1][j][3] * v[1][j][3]); }
#pragma unroll
    for (int o = 1; o < 64; o <<= 1) { s0 += __shfl_xor(s0, o); s1 += __shfl_xor(s1, o); }
    const float r0 = rsqrtf(s0 * (1.0f / DM) + EPS), r1 = rsqrtf(s1 * (1.0f / DM) + EPS);
    u32x2* o8 = (u32x2*)((bf16_t*)(a.ws + WS_A2) + (size_t)m0 * DM) + lane;
#pragma unroll
    for (int j = 0; j < 4; ++j) { const int col = 4 * lane + 256 * j;
        const f32x4 gn = *(const f32x4*)(a.norm_gain + col), sh = *(const f32x4*)(mod0 + col), sc = *(const f32x4*)(mod0 + 1024 + col) + 1.0f;
        const f32x4 h0 = (v[0][j] * r0 * gn) * sc + sh, h1 = (v[1][j] * r1 * gn) * sc + sh;
        u32x2 w; w.x = cvtpk(h0[0], h0[1]); w.y = cvtpk(h0[2], h0[3]); o8[64 * j] = w;
        w.x = cvtpk(h1[0], h1[1]); w.y = cvtpk(h1[2], h1[3]); o8[256 + 64 * j] = w; }
}
__device__ __forceinline__ void p1_norm_stream(const Args& a, int wv, LAS unsigned char* wbuf, int lane) {
    const int mbase = 8 * wv, b = mbase >> 11;
    const float* mod0 = (const float*)(a.ws + WS_MOD0) + (size_t)b * 6144;
    const float* xb = a.x + (size_t)mbase * DM + 4 * lane;
#define P1_ISSUE(it_) do { _Pragma("unroll") for (int j = 0; j < 8; ++j) \
        __builtin_amdgcn_global_load_lds((const unsigned*)(xb + (size_t)(2 * (it_)) * DM + j * 256), (LAS unsigned*)(wbuf + ((it_) & 1) * 8192 + j * 1024), 16, 0, 2); } while (0)
    asm volatile("s_waitcnt lgkmcnt(0)" ::: "memory");
    P1_ISSUE(0);
    f32x4 ga[4], sh[4];
#pragma unroll
    for (int j = 0; j < 4; ++j) { const int col = 4 * lane + 256 * j;
        ga[j] = *(const f32x4*)(a.norm_gain + col) * (*(const f32x4*)(mod0 + 1024 + col) + 1.0f); sh[j] = *(const f32x4*)(mod0 + col); }
    asm volatile("" : "+v"(ga[0]), "+v"(ga[1]), "+v"(ga[2]), "+v"(ga[3]), "+v"(sh[0]), "+v"(sh[1]), "+v"(sh[2]), "+v"(sh[3]));
#pragma unroll
    for (int it = 0; it < 4; ++it) {
        if (it + 1 < 4) { asm volatile("s_waitcnt lgkmcnt(0)" ::: "memory"); P1_ISSUE(it + 1); asm volatile("s_waitcnt vmcnt(8)" ::: "memory"); }
        else asm volatile("s_waitcnt vmcnt(0)" ::: "memory");
        const LAS unsigned char* bp = wbuf + (it & 1) * 8192 + lane * 16;
        f32x4 v[2][4]; float s0 = 0.f, s1 = 0.f;
#pragma unroll
        for (int j = 0; j < 4; ++j) { v[0][j] = *(const LAS f32x4*)(bp + j * 1024); v[1][j] = *(const LAS f32x4*)(bp + (4 + j) * 1024); }
#pragma unroll
        for (int j = 0; j < 4; ++j) { s0 += (v[0][j][0] * v[0][j][0] + v[0][j][1] * v[0][j][1]) + (v[0][j][2] * v[0][j][2] + v[0][j][3] * v[0][j][3]);
                                      s1 += (v[1][j][0] * v[1][j][0] + v[1][j][1] * v[1][j][1]) + (v[1][j][2] * v[1][j][2] + v[1][j][3] * v[1][j][3]); }
#pragma unroll
        for (int o = 1; o < 64; o <<= 1) { s0 += __shfl_xor(s0, o); s1 += __shfl_xor(s1, o); }
        const float r0 = rsqrtf(s0 * (1.0f / DM) + EPS), r1 = rsqrtf(s1 * (1.0f / DM) + EPS);
        u32x2* o8 = (u32x2*)((bf16_t*)(a.ws + WS_A2) + (size_t)(mbase + 2 * it) * DM) + lane;
#pragma unroll
        for (int j = 0; j < 4; ++j) {
            const f32x4 h0 = (v[0][j] * r0) * ga[j] + sh[j], h1 = (v[1][j] * r1) * ga[j] + sh[j];
            u32x2 w; w.x = cvtpk(h0[0], h0[1]); w.y = cvtpk(h0[2], h0[3]); o8[64 * j] = w;
            w.x = cvtpk(h1[0], h1[1]); w.y = cvtpk(h1[2], h1[3]); o8[256 + 64 * j] = w; }
    }
#undef P1_ISSUE
}
__device__ __forceinline__ void p1_bias_task(const bf16_t* Wt, int n0, const float* shift, int shift_stride, float* bias, int bias_stride, int lane) {
    const int r = lane & 15, kq = lane >> 4;
    const bf16_t* wp = Wt + (size_t)(n0 + r) * DM + 8 * kq;
    const float* sp = shift + (size_t)(r & 7) * shift_stride + 8 * kq;
    f32x4 acc = (f32x4){0.f, 0.f, 0.f, 0.f};
#pragma unroll 8
    for (int k0 = 0; k0 < DM; k0 += 32) {
        const bf16x8 bf = *(const bf16x8*)(wp + k0);
        const f32x4 s0 = *(const f32x4*)(sp + k0), s1 = *(const f32x4*)(sp + k0 + 4);
        u32x4 aw; aw.x = cvtpk(s0[0], s0[1]); aw.y = cvtpk(s0[2], s0[3]); aw.z = cvtpk(s1[0], s1[1]); aw.w = cvtpk(s1[2], s1[3]);
        if (r >= 8) aw = (u32x4){0u, 0u, 0u, 0u};
        acc = __builtin_amdgcn_mfma_f32_16x16x32_bf16(__builtin_bit_cast(bf16x8, aw), bf, acc, 0, 0, 0);
    }
    if (kq < 2) {
#pragma unroll
        for (int e = 0; e < 4; ++e) bias[(size_t)(4 * kq + e) * bias_stride + n0 + r] = acc[e];
    }
}
__device__ __forceinline__ void p1_pebias(const Args& a, int idx, int lane) {
    const int kv = idx >> 8;
    const bf16_t* wrow = (const bf16_t*)(a.ws + WS_WC1) + (size_t)idx * 2048;
    const float* pe = a.cmp_pe + (size_t)kv * 2048;
    float d = 0.f;
#pragma unroll
    for (int j = 0; j < 4; ++j) { const int k = (lane + 64 * j) * 8; const u32x4 w = *(const u32x4*)(wrow + k); const f32x4 p0 = *(const f32x4*)(pe + k), p1 = *(const f32x4*)(pe + k + 4);
        d += p0[0] * bf_lo(w.x) + p0[1] * bf_hi(w.x) + p0[2] * bf_lo(w.y) + p0[3] * bf_hi(w.y) + p1[0] * bf_lo(w.z) + p1[1] * bf_hi(w.z) + p1[2] * bf_lo(w.w) + p1[3] * bf_hi(w.w); }
    d = wave_sum(d);
    if (lane == 0) ((float*)(a.ws + WS_PEB))[idx] = d;
}

__device__ __forceinline__ void unpack8(const u32x4 w, float (&f)[8]) { f[0] = bf_lo(w.x); f[1] = bf_hi(w.x); f[2] = bf_lo(w.y); f[3] = bf_hi(w.y); f[4] = bf_lo(w.z); f[5] = bf_hi(w.z); f[6] = bf_lo(w.w); f[7] = bf_hi(w.w); }
__device__ __forceinline__ void p3_conv(const Args& a, int gtid, int nthreads) {
    for (int it0 = gtid; it0 < 128 * 2048; it0 += nthreads) {
        const int pass = it0 / nthreads, vt = it0 - pass * nthreads;
        const int it = (nthreads == 131072) ? ((vt >> 14) * 32768 + pass * 16384 + (vt & 16383)) : it0;
        const int cch = it & 127, rch = it >> 7, col = cch * 8, r0 = (rch * 8) & (SEQ - 1);
        unsigned char* slab = a.ws + WS_R + (size_t)((rch * 8) >> 11) * SLAB;
        const bf16_t* GB = (const bf16_t*)(slab + SO_GB); const bf16_t* V = (const bf16_t*)(slab + SO_V); bf16_t* Y = (bf16_t*)(slab + SO_Y);
        float w0[8], w1[8], w2[8];
        { const f32x4 t0 = *(const f32x4*)(a.conv_w + col), t1 = *(const f32x4*)(a.conv_w + col + 4); w0[0] = t0[0]; w0[1] = t0[1]; w0[2] = t0[2]; w0[3] = t0[3]; w0[4] = t1[0]; w0[5] = t1[1]; w0[6] = t1[2]; w0[7] = t1[3]; }
        { const f32x4 t0 = *(const f32x4*)(a.conv_w + 1024 + col), t1 = *(const f32x4*)(a.conv_w + 1024 + col + 4); w1[0] = t0[0]; w1[1] = t0[1]; w1[2] = t0[2]; w1[3] = t0[3]; w1[4] = t1[0]; w1[5] = t1[1]; w1[6] = t1[2]; w1[7] = t1[3]; }
        { const f32x4 t0 = *(const f32x4*)(a.conv_w + 2048 + col), t1 = *(const f32x4*)(a.conv_w + 2048 + col + 4); w2[0] = t0[0]; w2[1] = t0[1]; w2[2] = t0[2]; w2[3] = t0[3]; w2[4] = t1[0]; w2[5] = t1[1]; w2[6] = t1[2]; w2[7] = t1[3]; }
        float vm2[8], vm1[8];
        if ((r0 & (SEQ - 1)) != 0) { unpack8(*(const u32x4*)(V + (size_t)(r0 - 2) * DM + col), vm2); unpack8(*(const u32x4*)(V + (size_t)(r0 - 1) * DM + col), vm1); }
        else {
#pragma unroll
            for (int e = 0; e < 8; ++e) { vm2[e] = 0.f; vm1[e] = 0.f; } }
#pragma unroll
        for (int i = 0; i < 8; ++i) { float vc[8], gb[8], y[8];
            unpack8(*(const u32x4*)(V + (size_t)(r0 + i) * DM + col), vc); unpack8(*(const u32x4*)(GB + (size_t)(r0 + i) * DM + col), gb);
#pragma unroll
            for (int e = 0; e < 8; ++e) { y[e] = gb[e] * (w2[e] * vc[e] + w1[e] * vm1[e] + w0[e] * vm2[e]); vm2[e] = vm1[e]; vm1[e] = vc[e]; }
            u32x4 w; w.x = cvtpk(y[0], y[1]); w.y = cvtpk(y[2], y[3]); w.z = cvtpk(y[4], y[5]); w.w = cvtpk(y[6], y[7]);
            *(u32x4*)(Y + (size_t)(r0 + i) * DM + col) = w; }
    }
}

__device__ __forceinline__ float gelu_tanh(float x) {
    const float z = 0.7978845608028654f * (x + 0.044715f * x * x * x);
    const float e = __builtin_amdgcn_exp2f(z * 2.8853900817779268f);
    return x - x * __builtin_amdgcn_rcpf(e + 1.0f);
}
constexpr int C_CH = 2064;
constexpr int C_RB0 = 68608;
constexpr int C_HOFF = C_RB0, C_HROW = 528;
__device__ __forceinline__ void p8_unit(const Args& a, int u, LAS unsigned char* lds) {
    const int tid = threadIdx.x, lane = tid & 63, wid = __builtin_amdgcn_readfirstlane(tid >> 6), r = lane & 31, h = lane >> 5;
    const int kv = u >> 7, bg = (u >> 2) & 31, rq = u & 3;
    unsigned char* slab = a.ws + WS_R + (size_t)(bg >> 2) * SLAB;
    const bf16_t* src = (const bf16_t*)(slab + SO_KV) + ((size_t)(kv * 4 + (bg & 3)) * SEQ + 512 * rq) * 64;
    __syncthreads();
    { u32x4 v[8];
#pragma unroll
      for (int j = 0; j < 8; ++j) v[j] = *(const u32x4*)(src + (size_t)(tid + 512 * j) * 8);
      u32x4 vl = (u32x4){0u, 0u, 0u, 0u};
      if (tid < 128 && rq != 3) vl = *(const u32x4*)(src + (size_t)32 * 1024 + tid * 8);
#pragma unroll
      for (int j = 0; j < 8; ++j) { const int idx = tid + 512 * j; *(LAS u32x4*)(lds + (idx >> 7) * C_CH + (idx & 127) * 16) = v[j]; }
      if (tid < 128) *(LAS u32x4*)(lds + 32 * C_CH + tid * 16) = vl; }
    __syncthreads();
    f32x16 acc = f32x16{};
    const unsigned lds0 = (unsigned)(size_t)lds;
    const bf16_t* Wsrc = (const bf16_t*)(a.ws + WS_WC1) + (size_t)(kv * 256) * 2048;
    const int drow = 16 * wid + (lane >> 2);
    const bf16_t* dsrc0 = Wsrc + (size_t)drow * 2048 + 8 * ((lane & 3) ^ ((drow >> 2) & 3));
    const bf16_t* dsrc1 = dsrc0 + (size_t)128 * 2048;
    const unsigned ddst0 = lds0 + C_RB0 + wid * 1024, ddst1 = ddst0 + 8192;
    const int brow = 32 * wid + r;
    const unsigned boff = C_RB0 + brow * 64, bkey = (brow >> 2) & 3;
#define P8_DMA(stg) do { att::glds16(dsrc0 + 32 * (stg), (unsigned)__builtin_amdgcn_readfirstlane(ddst0 + ((stg) & 3) * 16384)); att::glds16(dsrc1 + 32 * (stg), (unsigned)__builtin_amdgcn_readfirstlane(ddst1 + ((stg) & 3) * 16384)); } while (0)
#define P8_STEP(stg, WAITN) do { asm volatile("s_waitcnt vmcnt(" #WAITN ") lgkmcnt(0)\n\ts_barrier" ::: "memory"); \
        if ((stg) + 3 < 64) P8_DMA((stg) + 3); \
        { const LAS unsigned char* bp = lds + boff + ((stg) & 3) * 16384; \
          const LAS unsigned char* ap = lds + (r + ((stg) >> 5)) * C_CH + ((32 * (stg)) & 1023) * 2 + 16 * h; \
          const bf16x8 a0 = *(const LAS bf16x8*)ap, a1 = *(const LAS bf16x8*)(ap + 32); \
          const bf16x8 b0 = *(const LAS bf16x8*)(bp + 16 * ((unsigned)h ^ bkey)), b1 = *(const LAS bf16x8*)(bp + 16 * ((unsigned)(2 + h) ^ bkey)); \
          acc = __builtin_amdgcn_mfma_f32_32x32x16_bf16(a0, b0, acc, 0, 0, 0); acc = __builtin_amdgcn_mfma_f32_32x32x16_bf16(a1, b1, acc, 0, 0, 0); } } while (0)
    P8_DMA(0); P8_DMA(1); P8_DMA(2);
    for (int s4 = 0; s4 < 60; s4 += 4) { P8_STEP(s4, 4); P8_STEP(s4 + 1, 4); P8_STEP(s4 + 2, 4); P8_STEP(s4 + 3, 4); }
    P8_STEP(60, 4); P8_STEP(61, 4); P8_STEP(62, 2); P8_STEP(63, 0);
    asm volatile("s_waitcnt lgkmcnt(0)\n\ts_barrier" ::: "memory");
#undef P8_DMA
#undef P8_STEP
    { const float pb = ((const float*)(a.ws + WS_PEB))[kv * 256 + 32 * wid + r];
      LAS bf16_t* H = (LAS bf16_t*)(lds + C_HOFF);
#pragma unroll
      for (int rg = 0; rg < 16; ++rg) { const int row = att::crow(rg, h); H[row * (C_HROW / 2) + 32 * wid + r] = (bf16_t)(cvtpk(gelu_tanh(acc[rg] + pb), 0.f) & 0xffffu); } }
    __syncthreads();
    if (wid == 0) {
        f32x16 o0 = f32x16{}, o1 = f32x16{};
        const bf16_t* W2 = (const bf16_t*)(a.ws + WS_WC2) + (size_t)kv * 64 * 256;
#pragma unroll
        for (int s = 0; s < 16; ++s) {
            const bf16x8 af = *(const LAS bf16x8*)(lds + C_HOFF + r * C_HROW + (16 * s + 8 * h) * 2);
            const bf16x8 b0 = *(const bf16x8*)(W2 + (size_t)r * 256 + 16 * s + 8 * h), b1 = *(const bf16x8*)(W2 + (size_t)(32 + r) * 256 + 16 * s + 8 * h);
            o0 = __builtin_amdgcn_mfma_f32_32x32x16_bf16(af, b0, o0, 0, 0, 0); o1 = __builtin_amdgcn_mfma_f32_32x32x16_bf16(af, b1, o1, 0, 0, 0);
        }
        const float gk0 = a.k_gain[r], gk1 = a.k_gain[32 + r];
        bf16_t* dst = (bf16_t*)(slab + (kv == 0 ? SO_KC : SO_VC)) + (size_t)(bg & 3) * 8192;
#pragma unroll
        for (int rg = 0; rg < 16; ++rg) { float v0 = o0[rg], v1 = o1[rg];
            if (kv == 0) { float ss = v0 * v0 + v1 * v1;
#pragma unroll
                for (int sft = 1; sft < 32; sft <<= 1) ss += __shfl_xor(ss, sft);
                const float rs = rsqrtf(ss * (1.0f / 64.0f) + EPS); v0 *= rs * gk0; v1 *= rs * gk1; }
            const int n = 32 * rq + att::crow(rg, h);
            if (n == 127) { v0 = 0.f; v1 = 0.f; }
            dst[n * 64 + r] = (bf16_t)(cvtpk(v0, 0.f) & 0xffffu); dst[n * 64 + 32 + r] = (bf16_t)(cvtpk(v1, 0.f) & 0xffffu); }
    }
}

__device__ __forceinline__ void p8_unit128(const Args& a, int kv, int b, int g, LAS unsigned char* lds) {
    constexpr int STG = 24576, AOFF = 16384, HROW = 528, NS = 5;
    const int tid = threadIdx.x, lane = tid & 63, wid = __builtin_amdgcn_readfirstlane(tid >> 6), r = lane & 31, h = lane >> 5;
    unsigned char* slab = a.ws + WS_R + (size_t)b * SLAB;
    const bf16_t* Asrc = (const bf16_t*)(slab + SO_KV) + (size_t)(kv * 4 + g) * SEQ * 64;
    const bf16_t* Wsrc = (const bf16_t*)(a.ws + WS_WC1) + (size_t)(kv * 256) * 2048;
    const unsigned lds0 = (unsigned)(size_t)lds;
    const int drow = 16 * wid + (lane >> 2);
    const int dpc = 8 * ((lane & 3) ^ ((drow >> 2) & 3));
    const bf16_t* wsrc0 = Wsrc + (size_t)drow * 2048 + dpc;
    const bf16_t* wsrc1 = wsrc0 + (size_t)128 * 2048;
    const bf16_t* asrc = Asrc + (size_t)drow * 1024 + dpc;
    const unsigned wdst = lds0 + wid * 1024;
    const unsigned akey = (r >> 2) & 3, brow = 32 * wid + r, bkey = (brow >> 2) & 3;
    f32x16 acc[4];
#pragma unroll
    for (int rb = 0; rb < 4; ++rb) acc[rb] = f32x16{};
    asm volatile("s_waitcnt vmcnt(0) lgkmcnt(0)\n\ts_barrier" ::: "memory");
#define P8B_DMA(stg, slot) do { const unsigned sb_ = wdst + (slot) * STG; \
        att::glds16(wsrc0 + 32 * (stg), (unsigned)__builtin_amdgcn_readfirstlane(sb_)); att::glds16(wsrc1 + 32 * (stg), (unsigned)__builtin_amdgcn_readfirstlane(sb_ + 8192)); \
        att::glds16(asrc + 32 * (stg), (unsigned)__builtin_amdgcn_readfirstlane(sb_ + AOFF)); } while (0)
#define P8B_STEP(stg, slot, WAITN) do { asm volatile("s_waitcnt vmcnt(" #WAITN ") lgkmcnt(0)\n\ts_barrier" ::: "memory"); \
        if ((stg) + 4 < 64) P8B_DMA((stg) + 4, ((slot) + 4) % NS); \
        { const LAS unsigned char* sp = lds + (slot) * STG; const LAS unsigned char* bp = sp + brow * 64; \
          const bf16x8 b0 = *(const LAS bf16x8*)(bp + 16 * ((unsigned)h ^ bkey)), b1 = *(const LAS bf16x8*)(bp + 16 * ((unsigned)(2 + h) ^ bkey)); \
          _Pragma("unroll") for (int rb = 0; rb < 4; ++rb) { const LAS unsigned char* ap = sp + AOFF + (32 * rb + r) * 64; \
              const bf16x8 a0 = *(const LAS bf16x8*)(ap + 16 * ((unsigned)h ^ akey)), a1 = *(const LAS bf16x8*)(ap + 16 * ((unsigned)(2 + h) ^ akey)); \
              acc[rb] = __builtin_amdgcn_mfma_f32_32x32x16_bf16(a0, b0, acc[rb], 0, 0, 0); acc[rb] = __builtin_amdgcn_mfma_f32_32x32x16_bf16(a1, b1, acc[rb], 0, 0, 0); } } } while (0)
    P8B_DMA(0, 0); P8B_DMA(1, 1); P8B_DMA(2, 2); P8B_DMA(3, 3);
    for (int s5 = 0; s5 < 60; s5 += 5) { P8B_STEP(s5, 0, 9); P8B_STEP(s5 + 1, 1, 9); P8B_STEP(s5 + 2, 2, 9); P8B_STEP(s5 + 3, 3, 9); P8B_STEP(s5 + 4, 4, 9); }
    P8B_STEP(60, 0, 9); P8B_STEP(61, 1, 6); P8B_STEP(62, 2, 3); P8B_STEP(63, 3, 0);
    asm volatile("s_waitcnt lgkmcnt(0)\n\ts_barrier" ::: "memory");
#undef P8B_DMA
#undef P8B_STEP
    { const float pb = ((const float*)(a.ws + WS_PEB))[kv * 256 + 32 * wid + r];
      LAS bf16_t* H = (LAS bf16_t*)lds;
#pragma unroll
      for (int rb = 0; rb < 4; ++rb)
#pragma unroll
        for (int rg = 0; rg < 16; ++rg) { const int row = 32 * rb + att::crow(rg, h); H[row * (HROW / 2) + 32 * wid + r] = (bf16_t)(cvtpk(gelu_tanh(acc[rb][rg] + pb), 0.f) & 0xffffu); } }
    __syncthreads();
    if (wid < 4) {
        f32x16 o0 = f32x16{}, o1 = f32x16{};
        const bf16_t* W2 = (const bf16_t*)(a.ws + WS_WC2) + (size_t)kv * 64 * 256;
#pragma unroll
        for (int s = 0; s < 16; ++s) {
            const bf16x8 af = *(const LAS bf16x8*)(lds + (32 * wid + r) * HROW + (16 * s + 8 * h) * 2);
            const bf16x8 b0 = *(const bf16x8*)(W2 + (size_t)r * 256 + 16 * s + 8 * h), b1 = *(const bf16x8*)(W2 + (size_t)(32 + r) * 256 + 16 * s + 8 * h);
            o0 = __builtin_amdgcn_mfma_f32_32x32x16_bf16(af, b0, o0, 0, 0, 0); o1 = __builtin_amdgcn_mfma_f32_32x32x16_bf16(af, b1, o1, 0, 0, 0);
        }
        const float gk0 = a.k_gain[r], gk1 = a.k_gain[32 + r];
        bf16_t* dst = (bf16_t*)(slab + (kv == 0 ? SO_KC : SO_VC)) + (size_t)g * 8192;
#pragma unroll
        for (int rg = 0; rg < 16; ++rg) { float v0 = o0[rg], v1 = o1[rg];
            if (kv == 0) { float ss = v0 * v0 + v1 * v1;
#pragma unroll
                for (int sft = 1; sft < 32; sft <<= 1) ss += __shfl_xor(ss, sft);
                const float rs = rsqrtf(ss * (1.0f / 64.0f) + EPS); v0 *= rs * gk0; v1 *= rs * gk1; }
            const int n = 32 * wid + att::crow(rg, h);
            if (n == 127) { v0 = 0.f; v1 = 0.f; }
            dst[n * 64 + r] = (bf16_t)(cvtpk(v0, 0.f) & 0xffffu); dst[n * 64 + 32 + r] = (bf16_t)(cvtpk(v1, 0.f) & 0xffffu); }
    }
    __syncthreads();
}

struct EpiCmp {
    static constexpr bool PERM = true, HAS_VEC = false; static constexpr int HALF_N_TILE = -1;
    __device__ __forceinline__ const float* vec_rows(const pg8::Unit&) const { return nullptr; } __device__ __forceinline__ const float* vec_cols(const pg8::Unit&) const { return nullptr; }
    unsigned char* slab; const float* peb; const bf16_t* W2all; const float* k_gain; LAS unsigned char* lds;
    __device__ __forceinline__ void operator()(const pg8::Acc& acc, const pg8::Unit& u, int wr, int wc, int fr, int fq, int vslot) const {
        constexpr int HROW = 528;
        const int kv = u.pn, gp = u.pm & 1;
        const int tid = threadIdx.x, lane = tid & 63, wid = __builtin_amdgcn_readfirstlane(tid >> 6), r = lane & 31, h = lane >> 5;
        f32x4 pq[2][2];
#pragma unroll
        for (int bj = 0; bj < 2; ++bj) { const int col0 = bj * pg8::HALF + wc * 32 + 8 * fq; pq[bj][0] = *(const f32x4*)(peb + kv * 256 + col0); pq[bj][1] = *(const f32x4*)(peb + kv * 256 + col0 + 4); }
        const float gk0 = k_gain[r], gk1 = k_gain[32 + r];
        asm volatile("s_waitcnt vmcnt(0)\n\ts_barrier" ::: "memory");
#pragma unroll
        for (int bj = 0; bj < 2; ++bj) { const int col0 = bj * pg8::HALF + wc * 32 + 8 * fq;
            const f32x4 p0 = pq[bj][0], p1 = pq[bj][1];
#pragma unroll
            for (int ai = 0; ai < 2; ++ai)
#pragma unroll
                for (int m = 0; m < 4; ++m) { const int row = ai * pg8::HALF + wr * 64 + m * 16 + fr;
                    const f32x4 v0 = acc[ai][bj][m][0] + p0, v1 = acc[ai][bj][m][1] + p1;
                    u32x4 w; w.x = cvtpk(gelu_tanh(v0[0]), gelu_tanh(v0[1])); w.y = cvtpk(gelu_tanh(v0[2]), gelu_tanh(v0[3])); w.z = cvtpk(gelu_tanh(v1[0]), gelu_tanh(v1[1])); w.w = cvtpk(gelu_tanh(v1[2]), gelu_tanh(v1[3]));
                    *(LAS u32x4*)(lds + row * HROW + col0 * 2) = w; } }
        const bf16_t* W2 = W2all + (size_t)kv * 64 * 256;
        bf16x8 wb[16][2];
#pragma unroll
        for (int s = 0; s < 16; ++s) { wb[s][0] = *(const bf16x8*)(W2 + ((size_t)(2 * s + h) * 64 + r) * 8); wb[s][1] = *(const bf16x8*)(W2 + ((size_t)(2 * s + h) * 64 + 32 + r) * 8); }
        asm volatile("s_waitcnt lgkmcnt(0)\n\ts_barrier" ::: "memory");
        f32x16 o0 = f32x16{}, o1 = f32x16{};
#pragma unroll
        for (int s = 0; s < 16; ++s) asm volatile("" : "+v"(wb[s][0]), "+v"(wb[s][1]));
#pragma unroll
        for (int s = 0; s < 16; ++s) {
            const bf16x8 af = *(const LAS bf16x8*)(lds + (32 * wid + r) * HROW + (16 * s + 8 * h) * 2);
            o0 = __builtin_amdgcn_mfma_f32_32x32x16_bf16(af, wb[s][0], o0, 0, 0, 0); o1 = __builtin_amdgcn_mfma_f32_32x32x16_bf16(af, wb[s][1], o1, 0, 0, 0);
        }
        const int g = 2 * gp + (wid >> 2);
        bf16_t* dst = (bf16_t*)(slab + (kv == 0 ? SO_KC : SO_VC)) + (size_t)g * 8192;
        if (kv == 0) {
            float ss[16];
#pragma unroll
            for (int rg = 0; rg < 16; ++rg) ss[rg] = o0[rg] * o0[rg] + o1[rg] * o1[rg];
#pragma unroll
            for (int sft = 1; sft < 32; sft <<= 1) { float t_[16];
#pragma unroll
                for (int rg = 0; rg < 16; ++rg) t_[rg] = __shfl_xor(ss[rg], sft);
#pragma unroll
                for (int rg = 0; rg < 16; ++rg) ss[rg] += t_[rg]; }
#pragma unroll
            for (int rg = 0; rg < 16; ++rg) { const float rs = rsqrtf(ss[rg] * (1.0f / 64.0f) + EPS); o0[rg] *= rs * gk0; o1[rg] *= rs * gk1; }
        }
#pragma unroll
        for (int rg = 0; rg < 16; ++rg) { float v0 = o0[rg], v1 = o1[rg];
            const int n = 32 * (wid & 3) + att::crow(rg, h);
            if (n == 127) { v0 = 0.f; v1 = 0.f; }
            dst[n * 64 + r] = (bf16_t)(cvtpk(v0, 0.f) & 0xffffu); dst[n * 64 + 32 + r] = (bf16_t)(cvtpk(v1, 0.f) & 0xffffu); }
    }
};

__device__ __forceinline__ void p4_fixup(const Args& a, int pm) {
    const int tid = threadIdx.x;
    if (tid < 256) {
        const int rr = tid >> 7, cc = (tid & 127) * 8, pml = pm & 7, srow = pml * 256 + rr;
        unsigned char* slab = a.ws + WS_R + (size_t)(pm >> 3) * SLAB;
        const bf16_t* V = (const bf16_t*)(slab + SO_V); const bf16_t* GBH = (const bf16_t*)(slab + SO_GB) + (size_t)pml * 2 * DM; bf16_t* Y = (bf16_t*)(slab + SO_Y);
        float gb[8], v0[8], v1[8], v2[8], y[8];
        unpack8(*(const u32x4*)(GBH + (size_t)rr * DM + cc), gb);
        unpack8(*(const u32x4*)(V + (size_t)srow * DM + cc), v0);
        if (srow >= 1) unpack8(*(const u32x4*)(V + (size_t)(srow - 1) * DM + cc), v1); else {
#pragma unroll
            for (int e = 0; e < 8; ++e) v1[e] = 0.f; }
        if (srow >= 2) unpack8(*(const u32x4*)(V + (size_t)(srow - 2) * DM + cc), v2); else {
#pragma unroll
            for (int e = 0; e < 8; ++e) v2[e] = 0.f; }
#pragma unroll
        for (int e = 0; e < 8; ++e) y[e] = gb[e] * (a.conv_w[2 * DM + cc + e] * v0[e] + a.conv_w[DM + cc + e] * v1[e] + a.conv_w[cc + e] * v2[e]);
        u32x4 w; w.x = cvtpk(y[0], y[1]); w.y = cvtpk(y[2], y[3]); w.z = cvtpk(y[4], y[5]); w.w = cvtpk(y[6], y[7]);
        *(u32x4*)(Y + (size_t)srow * DM + cc) = w;
    }
}

__global__ void __launch_bounds__(NWAVES * 64, 2) yoco_fwd(Args args) {
    extern __shared__ __attribute__((aligned(16))) unsigned char lds_raw[];
    LAS unsigned char* lds = (LAS unsigned char*)lds_raw;
    const int tid = threadIdx.x, lane = tid & 63, wave = __builtin_amdgcn_readfirstlane(tid >> 6);
    const int G = gridDim.x, bx = blockIdx.x;
    int vcu = (G % 8 == 0) ? (bx % 8) * (G / 8) + bx / 8 : bx;
    int cid = bx;
    const int gw = vcu * NWAVES + wave, NGW = G * NWAVES;
    unsigned char* ws = args.ws;
    const int lo = args.ph_lo, hi = args.ph_hi;
    volatile LAS unsigned* MISC = (volatile LAS unsigned*)(lds + LDS_BYTES - 256);
    if (tid < 8) MISC[tid] = 0u;
    __syncthreads();
    XcdBarrier bar; bar.bar = (unsigned*)(ws + WS_BAR); bar.x = 0; bar.st = MISC;
    if (hi - lo > 1) bar = xcd_barrier_post((unsigned*)(ws + WS_BAR), MISC);
#define IN(k) (lo <= (k) && (k) < hi)
#define SEAM(k) do { if (IN(k) && IN((k) + 1)) xcd_barrier(bar); } while (0)
#define LSEAM(k) do { if (IN(k) && IN((k) + 1)) { if (local_ok) xcd_local_barrier(bar); else xcd_barrier(bar); } } while (0)
    bool local_ok = false;
    float* MOD0 = (float*)(ws + WS_MOD0); float* MOD1 = (float*)(ws + WS_MOD1); float* MODKV = (float*)(ws + WS_MODKV);
    float* SS1 = (float*)(ws + WS_SS1); float* SS2 = (float*)(ws + WS_SS2); float* SS3 = (float*)(ws + WS_SS3);
    bf16_t* A1 = (bf16_t*)(ws + WS_A1); bf16_t* A2 = (bf16_t*)(ws + WS_A2);
    bf16_t* HB = (bf16_t*)(ws + WS_H);

    if (IN(0)) {
        p0_mods(args, lds, vcu, G);
        LAS float* scr = (LAS float*)(lds + wave * 16384);
        for (int it = gw; it < TI_TOTAL; it += NGW) p0_item(args, it, scr, lane);
    }
    SEAM(0);
    if (IN(1)) {
        for (int wv = gw; wv < M_TOK / 8; wv += NGW) p1_norm_stream(args, wv, lds + wave * 16384, lane);
        asm volatile("s_waitcnt vmcnt(0) lgkmcnt(0)" ::: "memory");
        for (int it = gw; it < (2 * FF + NKVQ) / 16 + 512 + 64; it += NGW) {
            const int n = it * 16;
            if (n < FF) p1_bias_task((const bf16_t*)(ws + WS_WM1), n, MOD0 + 3072, 6144, (float*)(ws + WS_BM1L0), FF, lane);
            else if (n < 2 * FF) p1_bias_task((const bf16_t*)(ws + WS_WM1) + (size_t)FF * DM, n - FF, MOD1 + 3072, 6144, (float*)(ws + WS_BM1L1), FF, lane);
            else if (n < 2 * FF + 1536) p1_bias_task((const bf16_t*)(ws + WS_WKVQ), n - 2 * FF, MODKV, 2048, (float*)(ws + WS_BKVQ), NKVQ, lane);
            else if (n < 2 * FF + NKVQ) p1_bias_task((const bf16_t*)(ws + WS_WKVQ), n - 2 * FF, MOD1, 6144, (float*)(ws + WS_BKVQ), NKVQ, lane);
            else if (it < (2 * FF + NKVQ) / 16 + 512) p1_pebias(args, it - (2 * FF + NKVQ) / 16, lane);
            else { const int q = it - ((2 * FF + NKVQ) / 16 + 512), kv = q >> 5, ch = q & 31;
                const u32x4 w = *(const u32x4*)((const bf16_t*)(ws + WS_WC2) + ((size_t)kv * 64 + lane) * 256 + 8 * ch);
                *(u32x4*)((bf16_t*)(ws + WS_WC2T) + (((size_t)kv * 32 + ch) * 64 + lane) * 8) = w; }
        }
    }
    SEAM(1);
    if (hi - lo > 1 && lo <= 1) {
        local_ok = MISC[3] != 0u;
        if (local_ok) { const int x = (int)MISC[4], rk = (int)MISC[2]; vcu = x * 32 + rk; cid = rk * 8 + x; }
    }
    if (IN(2)) {
        pg8::Gemm g{A2, A2, 1 << 30, (const bf16_t*)(ws + WS_WAIN), M_TOK, 3072, DM, (size_t)SEQ * DM * 2}; pg8::StaticOrder S; S.init_ain(G, cid);
        pg8::EpiAin E{ws + WS_R, args.conv_w, lds};
        pg8::gemm_phase(lds, g, S, E);
    }
    LSEAM(2);
    if (IN(4)) {
        pg8::Gemm g{(const bf16_t*)(ws + WS_R + SO_Y), (const bf16_t*)(ws + WS_R + SO_Y), 1 << 30, (const bf16_t*)(ws + WS_WAOUT), M_TOK, DM, DM, SLAB}; pg8::StaticOrder S; S.init(M_TOK, DM, G, cid);
        { pg8::Unit fu; for (int i = 0; S.next(i, fu); ++i) p4_fixup(args, fu.pm); asm volatile("s_waitcnt vmcnt(0)" ::: "memory"); __syncthreads(); }
        pg8::EpiRes<1, 0, 2> E{args.x, nullptr, MOD0 + 2048, 6144, args.norm_gain + 1024, MOD0 + 4096, 6144, A1, nullptr, nullptr, 0, nullptr, SS1, nullptr, nullptr, 0, lds};
        pg8::gemm_phase(lds, g, S, E);
    }
    LSEAM(4);
    if (IN(5)) {
        pg8::Gemm g{A1, A1, 1 << 30, (const bf16_t*)(ws + WS_WM1), M_TOK, FF, DM, (size_t)SEQ * DM * 2}; pg8::StaticOrder S; S.init(M_TOK, FF, G, cid);
        pg8::EpiMlp1 E{HB, (const float*)(ws + WS_BM1L0), SS1, lds};
        pg8::gemm_phase(lds, g, S, E);
    }
    LSEAM(5);
    if (IN(6)) {
        pg8::Gemm g{HB, HB, 1 << 30, (const bf16_t*)(ws + WS_WM2), M_TOK, DM, FF, (size_t)SEQ * FF * 2}; pg8::StaticOrder S; S.init(M_TOK, DM, G, cid);
        pg8::EpiRes<2, 2, 2> E{A1, nullptr, MOD0 + 5120, 6144, args.kv_norm_gain, MODKV + 1024, 2048, A1, args.norm_gain + 2048, MOD1 + 1024, 6144, A2, SS2, args.norm_gain + 1024, MOD0 + 4096, 6144, lds};
        pg8::gemm_phase(lds, g, S, E);
    }
    LSEAM(6);
    if (IN(7)) {
        pg8::Gemm g{A1, A2, 6, (const bf16_t*)(ws + WS_WKVQ), M_TOK, NKVQ, DM, (size_t)SEQ * DM * 2}; pg8::StaticOrder S; S.init_kvq(G, cid);
        unsigned* rdy = local_ok ? bar.bar + XB_P8RDY(vcu >> 5) : nullptr;
        pg8::EpiKVQ E{ws + WS_R, (const float*)(ws + WS_BKVQ), SS2, args.k_gain, args.q_gain, lds, rdy};
        if (wave == 0) __builtin_amdgcn_global_load_lds((const unsigned*)(lane < 48 ? args.k_gain + 4 * lane : args.q_gain + 4 * (lane - 48)), (LAS unsigned*)(lds + pg8::GAIN_LDS), 16, 0, 0);
        pg8::gemm_phase(lds, g, S, E);
        if (local_ok && (vcu & 31) >= 24 && (vcu & 31) < 28) { const int j = (vcu & 31) - 24, kv = j >> 1, gp = j & 1;
            if (threadIdx.x == 0) { XB_SPIN(xb_ld(&rdy[64 * kv]) < 8u, bar.bar); __builtin_amdgcn_fence(__ATOMIC_ACQUIRE, "agent"); asm volatile("s_waitcnt vmcnt(0)" ::: "memory"); }
            __syncthreads();
            unsigned char* slabx = ws + WS_R + (size_t)(vcu >> 5) * SLAB;
            const bf16_t* A8 = (const bf16_t*)(slabx + SO_KV);
            pg8::Gemm g8{A8, A8, 1 << 30, (const bf16_t*)(ws + WS_WC1), 256, 256, 2048, 0, 1024, (size_t)SEQ * 64 * 2, (size_t)SEQ * 64 * 2 * 2};
            pg8::StaticOrder S8; S8.init_one(2 * kv + gp, kv);
            EpiCmp E8{slabx, (const float*)(ws + WS_PEB), (const bf16_t*)(ws + WS_WC2T), args.k_gain, lds};
            pg8::gemm_phase(lds, g8, S8, E8); }
    }
    LSEAM(7);
    if (IN(8) && !local_ok) { for (int v = vcu; v < 256; v += G) { const int rk = v & 31; p8_unit(args, ((rk >> 4) << 7) | ((((v >> 5) << 2) | ((rk >> 2) & 3)) << 2) | (rk & 3), lds); } __syncthreads(); }
    if (!local_ok) LSEAM(8);
    if (IN(9)) {
        for (int v = vcu; v < 256; v += G) { const int bgp = v >> 3, s = v & 7;
            for (int i = 0; i < 4; ++i) { const int qb = (i == 0) ? s : (i == 1) ? 15 - s : (i == 2) ? 16 + s : 31 - s;
                att::attn_unit(bgp >> 2, bgp & 3, qb, ws + WS_R + (size_t)(bgp >> 2) * SLAB, lds); } }
    }
    LSEAM(9);
    if (IN(10)) {
        pg8::Gemm g{(const bf16_t*)(ws + WS_R + SO_O), (const bf16_t*)(ws + WS_R + SO_O), 1 << 30, (const bf16_t*)(ws + WS_WO), M_TOK, DM, DM, SLAB}; pg8::StaticOrder S; S.init(M_TOK, DM, G, cid);
        pg8::EpiRes<1, 2, 2> E{A2, nullptr, MOD1 + 2048, 6144, args.norm_gain + 3072, MOD1 + 4096, 6144, A1, nullptr, nullptr, 0, nullptr, SS3, args.norm_gain + 2048, MOD1 + 1024, 6144, lds};
        pg8::gemm_phase(lds, g, S, E);
    }
    LSEAM(10);
    if (IN(11)) {
        pg8::Gemm g{A1, A1, 1 << 30, (const bf16_t*)(ws + WS_WM1) + (size_t)FF * DM, M_TOK, FF, DM, (size_t)SEQ * DM * 2}; pg8::StaticOrder S; S.init(M_TOK, FF, G, cid);
        pg8::EpiMlp1 E{HB, (const float*)(ws + WS_BM1L1), SS3, lds};
        pg8::gemm_phase(lds, g, S, E);
    }
    LSEAM(11);
    if (IN(12)) {
        pg8::Gemm g{HB, HB, 1 << 30, (const bf16_t*)(ws + WS_WM2) + (size_t)DM * FF, M_TOK, DM, FF, (size_t)SEQ * FF * 2}; pg8::StaticOrder S; S.init(M_TOK, DM, G, cid);
        pg8::EpiRes<0, 2, 0> E{A1, args.out, MOD1 + 5120, 6144, nullptr, nullptr, 0, nullptr, nullptr, nullptr, 0, nullptr, nullptr, args.norm_gain + 3072, MOD1 + 4096, 6144, lds};
        pg8::gemm_phase(lds, g, S, E);
    }
#undef IN
#undef SEAM
}

extern "C" void kernel_launch(void* const* d_in, const int* in_sizes, int n_in, void* d_out, int out_size, void* d_ws, size_t ws_size, hipStream_t stream) {
    static int grid = 0;
    if (grid == 0) {
        if (n_in != 21 || in_sizes[0] != M_TOK * DM || out_size != M_TOK * DM || ws_size < WS_END) { fprintf(stderr, "kernel_launch: unexpected shapes (n_in %d, in0 %d, out %d, ws %zu); nothing launched\n", n_in, n_in > 0 ? in_sizes[0] : -1, out_size, ws_size); grid = -1; return; }
        int dev = 0, cus = 0, per_cu = 0;
        if (hipGetDevice(&dev) != hipSuccess || hipDeviceGetAttribute(&cus, hipDeviceAttributeMultiprocessorCount, dev) != hipSuccess) { grid = -1; return; }
        if (hipFuncSetAttribute((const void*)yoco_fwd, hipFuncAttributeMaxDynamicSharedMemorySize, LDS_BYTES) != hipSuccess) { fprintf(stderr, "kernel_launch: hipFuncSetAttribute failed\n"); grid = -1; return; }
        if (hipOccupancyMaxActiveBlocksPerMultiprocessor(&per_cu, (const void*)yoco_fwd, NWAVES * 64, LDS_BYTES) != hipSuccess || per_cu < 1) { fprintf(stderr, "kernel_launch: occupancy query says %d blocks per CU\n", per_cu); per_cu = 1; }
        (void)hipGetLastError();
        grid = cus;
        if (grid != 256) { fprintf(stderr, "kernel_launch: this build deals the w_a_in tiles to exactly 256 workgroups (device has %d CUs); nothing launched\n", cus); grid = -1; return; }
    }
    if (grid < 0) return;
    (void)hipMemsetAsync((char*)d_ws + WS_ZERO, 0, ZERO_BYTES, stream);
    Args a{};
    a.x = (const float*)d_in[0]; a.c = (const float*)d_in[1]; a.norm_gain = (const float*)d_in[2]; a.w_ada = (const float*)d_in[3]; a.b_ada = (const float*)d_in[4];
    a.w_a_in = (const float*)d_in[5]; a.conv_w = (const float*)d_in[6]; a.w_a_out = (const float*)d_in[7]; a.w_qg = (const float*)d_in[8]; a.q_gain = (const float*)d_in[9];
    a.w_o = (const float*)d_in[10]; a.kv_norm_gain = (const float*)d_in[11]; a.w_ada_kv = (const float*)d_in[12]; a.b_ada_kv = (const float*)d_in[13]; a.w_kv = (const float*)d_in[14];
    a.k_gain = (const float*)d_in[15]; a.cmp_pe = (const float*)d_in[16]; a.cmp_w1 = (const float*)d_in[17]; a.cmp_w2 = (const float*)d_in[18]; a.w_mlp1 = (const float*)d_in[19]; a.w_mlp2 = (const float*)d_in[20];
    a.out = (float*)d_out; a.ws = (unsigned char*)d_ws;
#if MK_N_LAUNCHES == 1
    a.ph_lo = 0; a.ph_hi = N_PHASES;
    void* kargs[] = {&a};
    hipError_t e = hipLaunchCooperativeKernel((const void*)yoco_fwd, dim3(grid), dim3(NWAVES * 64), kargs, LDS_BYTES, stream);
    if (e != hipSuccess) fprintf(stderr, "kernel_launch: cooperative launch failed: %s (grid %d)\n", hipGetErrorString(e), grid);
#else
    for (int p = 0; p < N_PHASES; ++p) { a.ph_lo = p; a.ph_hi = p + 1; hipLaunchKernelGGL(yoco_fwd, dim3(grid), dim3(NWAVES * 64), LDS_BYTES, stream, a); }
#endif
}
```
